# Optimizing an MI355X kernel written in HIP

```python
import math
import jax, jax.numpy as jnp
from jax import lax
import numpy as np

D_MODEL = 1024
BATCH = 1
SEQ = 16384
DEPTH = 4

GLA_HEADS = 4
GLA_DK = 128
GLA_DV = 128
GLA_GATE_RANK = 16
GLA_GATE_TEMP = 16.0
GLA_CHUNK = 32
SB_HEADS = 4
SB_DH = 128
NSA_HEADS = 8
NSA_GROUPS = 1
NSA_DH = 64
CMP_BLOCK = 32
CMP_STRIDE = 16
CMP_HIDDEN = 256
SEL_BLOCK = 64
SEL_TOP_N = 8
WINDOW = 512
SEL_FORCE = 1000.0
REL_BUCKETS = 32
REL_MAX_DIST = 1024
FFN_HIDDEN = 4 * D_MODEL
Q_BLOCK = 128
N_BRANCHES = 3
RMS_EPS = 1e-6
NEG_BIG = -1e30

GLA_QK = GLA_HEADS * GLA_DK
GLA_V = GLA_HEADS * GLA_DV
SB_W = SB_HEADS * SB_DH
NSA_Q = NSA_HEADS * NSA_DH
NSA_KV = NSA_GROUPS * NSA_DH
IN_SIZES = (GLA_QK, GLA_QK, GLA_V, GLA_GATE_RANK, GLA_V,
            SB_W, SB_W, SB_W,
            NSA_Q, NSA_KV, NSA_KV, NSA_KV, NSA_KV, NSA_KV, NSA_KV, NSA_HEADS * N_BRANCHES,
            N_BRANCHES * D_MODEL)
N_IN = sum(IN_SIZES)

kernel_name = 'hybrid_gla_stickbreak_nsa_trunk'


def _rms(x, g):
    xf = x.astype(jnp.float32)
    y = xf * lax.rsqrt(jnp.mean(xf * xf, axis=-1, keepdims=True) + RMS_EPS)
    return (y * g.astype(jnp.float32)).astype(x.dtype)


def _masked_softmax(s, mask):
    s = jnp.where(mask, s.astype(jnp.float32), NEG_BIG)
    p = jax.nn.softmax(s, axis=-1)
    return jnp.where(mask, p, 0.0)


def _rel_bucket(dist):
    n = jnp.maximum(dist, 0)
    max_exact = REL_BUCKETS // 2
    nf = jnp.maximum(n, 1).astype(jnp.float32)
    large = max_exact + (jnp.log(nf / max_exact) / math.log(REL_MAX_DIST / max_exact)
                         * (REL_BUCKETS - max_exact)).astype(jnp.int32)
    large = jnp.minimum(large, REL_BUCKETS - 1)
    return jnp.where(n < max_exact, n, large)


def _gla(q, k, v, a_low, r, w_a2, b_a, norm_g):
    B, S, _ = q.shape
    H, DK, DV, C = GLA_HEADS, GLA_DK, GLA_DV, GLA_CHUNK
    nc = S // C
    f32 = jnp.float32
    log_a = jax.nn.log_sigmoid((a_low @ w_a2 + b_a).astype(f32)) / GLA_GATE_TEMP

    def chunks(t, d):
        return t.astype(f32).reshape(B, nc, C, H, d).transpose(1, 0, 3, 2, 4)

    qc, kc, vc, gc = chunks(q, DK) * (DK ** -0.5), chunks(k, DK), chunks(v, DV), chunks(log_a, DK)
    causal = jnp.tril(jnp.ones((C, C), bool))

    def step(state, inp):
        qi, ki, vi, gi = inp
        b = jnp.cumsum(gi, axis=2)
        o_inter = jnp.einsum('bhtk,bhkv->bhtv', qi * jnp.exp(b), state)
        diff = b[:, :, :, None, :] - b[:, :, None, :, :]
        decay = jnp.exp(jnp.where(causal[:, :, None], diff, -jnp.inf))
        scores = jnp.einsum('bhtk,bhsk,bhtsk->bhts', qi, ki, decay)
        o_intra = jnp.einsum('bhts,bhsv->bhtv', scores, vi)
        b_last = b[:, :, -1:, :]
        new_state = (state * jnp.exp(b_last[:, :, 0, :, None])
                     + jnp.einsum('bhsk,bhsv->bhkv', ki * jnp.exp(b_last - b), vi))
        return new_state, o_inter + o_intra

    _, o = lax.scan(step, jnp.zeros((B, H, DK, DV), f32), (qc, kc, vc, gc))
    o = o.transpose(1, 0, 3, 2, 4).reshape(B, S, H, DV)
    o = _rms(o, norm_g).reshape(B, S, H * DV) * jax.nn.silu(r.astype(f32))
    return o.astype(q.dtype)


def _stick_breaking(q, k, v):
    B, S, _ = q.shape
    H, DH = SB_HEADS, SB_DH
    nb = S // Q_BLOCK
    f32 = jnp.float32
    qt = q.reshape(B, S, H, DH).transpose(0, 2, 1, 3)
    kt = k.reshape(B, S, H, DH).transpose(0, 2, 1, 3)
    vt = v.reshape(B, S, H, DH).transpose(0, 2, 1, 3)
    idx = jnp.arange(Q_BLOCK)
    tri = (idx[:, None] > idx[None, :]).astype(f32)
    outs = []
    for c in range(nb):
        nk = c + 1
        K = nk * Q_BLOCK
        qi = qt[:, :, c * Q_BLOCK:K]
        kk = kt[:, :, :K]
        vv = vt[:, :, :K]
        qpos = c * Q_BLOCK + idx
        kpos = jnp.arange(K)
        causal = kpos[None, :] < qpos[:, None]
        z = jnp.einsum('bhqd,bhkd->bhqk', qi, kk).astype(f32) * (DH ** -0.5)
        l1mb = jnp.where(causal, jax.nn.log_sigmoid(-z), 0.0).reshape(B, H, Q_BLOCK, nk, Q_BLOCK)
        within = jnp.einsum('bhqnj,js->bhqns', l1mb, tri)
        blk = jnp.arange(nk)
        later = (blk[:, None] > blk[None, :]).astype(f32)
        after = jnp.einsum('bhqm,mn->bhqn', l1mb.sum(axis=-1), later)
        rest = (within + after[..., None]).reshape(B, H, Q_BLOCK, K)
        a = jnp.where(causal, jnp.exp(jax.nn.log_sigmoid(z) + rest), 0.0)
        outs.append(jnp.einsum('bhqk,bhkd->bhqd', a.astype(vv.dtype), vv))
    o = jnp.concatenate(outs, axis=2)
    return o.transpose(0, 2, 1, 3).reshape(B, S, H * DH)


def _nsa(q, kc, vc, ks, vs, kw, vw, gate, q_g, k_g, pe_k, pe_v, wk1, wk2, wv1, wv2, rel_bias):
    B, S, _ = q.shape
    H, G, D = NSA_HEADS, NSA_GROUPS, NSA_DH
    R = H // G
    f32 = jnp.float32
    scale = D ** -0.5
    q = _rms(q.reshape(B, S, H, D), q_g)
    ks = _rms(ks.reshape(B, S, G, D), k_g)
    kw = _rms(kw.reshape(B, S, G, D), k_g)
    vs = vs.reshape(B, S, G, D)
    vw = vw.reshape(B, S, G, D)
    kc = kc.reshape(B, S, G, D)
    vc = vc.reshape(B, S, G, D)

    n_cmp = (S - CMP_BLOCK) // CMP_STRIDE + 1
    tok_idx = jnp.arange(n_cmp)[:, None] * CMP_STRIDE + jnp.arange(CMP_BLOCK)[None, :]

    def compress(t, pe, w1, w2):
        blocks = t[:, tok_idx] + pe[:, None, :]
        blocks = blocks.transpose(0, 1, 3, 2, 4).reshape(B, n_cmp, G, CMP_BLOCK * D)
        return jax.nn.gelu(blocks @ w1) @ w2

    k_cmp = _rms(compress(kc, pe_k, wk1, wk2), k_g)
    v_cmp = compress(vc, pe_v, wv1, wv2)
    cmp_end = jnp.arange(n_cmp) * CMP_STRIDE + CMP_BLOCK - 1

    n_sel = S // SEL_BLOCK
    top_n = min(SEL_TOP_N, n_sel)
    span = CMP_BLOCK // CMP_STRIDE
    ratio = SEL_BLOCK // CMP_STRIDE
    ov_idx = jnp.arange(n_sel)[:, None] * ratio - (span - 1) + jnp.arange(ratio + span - 1)[None, :]
    ov_valid = (ov_idx >= 0) & (ov_idx < n_cmp)
    ov_idx = jnp.clip(ov_idx, 0, n_cmp - 1)
    ks_blk = ks.reshape(B, n_sel, SEL_BLOCK, G, D).transpose(0, 3, 1, 2, 4)
    vs_blk = vs.reshape(B, n_sel, SEL_BLOCK, G, D).transpose(0, 3, 1, 2, 4)
    kw_pad = jnp.pad(kw, ((0, 0), (WINDOW, 0), (0, 0), (0, 0)))
    vw_pad = jnp.pad(vw, ((0, 0), (WINDOW, 0), (0, 0), (0, 0)))
    bias_tab = rel_bias.reshape(REL_BUCKETS, G, R)
    nb = S // Q_BLOCK
    qb = q.reshape(B, nb, Q_BLOCK, G, R, D).transpose(1, 0, 2, 3, 4, 5)
    gb = jax.nn.sigmoid(gate.astype(f32)).reshape(B, nb, Q_BLOCK, G, R, N_BRANCHES).transpose(1, 0, 2, 3, 4, 5)
    b_ix = jnp.arange(B)[:, None, None, None]
    g_ix = jnp.arange(G)[None, None, :, None]
    blk = jnp.arange(n_sel)

    def block(args):
        qi, gi, c = args
        qpos = c * Q_BLOCK + jnp.arange(Q_BLOCK)
        s = jnp.einsum('bqgrd,bngd->bqgrn', qi, k_cmp).astype(f32) * scale
        s = s + bias_tab[_rel_bucket(qpos[:, None] - cmp_end[None, :])].transpose(0, 2, 3, 1)[None]
        m = (cmp_end[None, :] <= qpos[:, None])[None, :, None, None, :]
        p = _masked_softmax(s, m)
        o_cmp = jnp.einsum('bqgrn,bngd->bqgrd', p.astype(v_cmp.dtype), v_cmp)
        imp = p.sum(axis=3)
        imp = jnp.sum(jnp.where(ov_valid, imp[..., ov_idx], 0.0), axis=-1)
        cur = (qpos // SEL_BLOCK)[:, None]
        causal_blk = blk[None, :] * SEL_BLOCK <= qpos[:, None]
        forced = (blk[None, :] == cur) | (blk[None, :] == cur - 1) | (blk[None, :] == 0)
        score = jnp.where(causal_blk[None, :, None, :],
                          imp + jnp.where(forced, SEL_FORCE, 0.0)[None, :, None, :], NEG_BIG)
        _, sel = lax.top_k(score, top_n)
        k_sel = ks_blk[b_ix, g_ix, sel].reshape(B, Q_BLOCK, G, top_n * SEL_BLOCK, D)
        v_sel = vs_blk[b_ix, g_ix, sel].reshape(B, Q_BLOCK, G, top_n * SEL_BLOCK, D)
        kpos = (sel[..., None] * SEL_BLOCK + jnp.arange(SEL_BLOCK)).reshape(B, Q_BLOCK, G, top_n * SEL_BLOCK)
        dist = qpos[None, :, None, None] - kpos
        s = jnp.einsum('bqgrd,bqgld->bqgrl', qi, k_sel).astype(f32) * scale
        s = s + bias_tab[_rel_bucket(dist), g_ix].transpose(0, 1, 2, 4, 3)
        p = _masked_softmax(s, (dist >= 0)[:, :, :, None, :])
        o_slc = jnp.einsum('bqgrl,bqgld->bqgrd', p.astype(v_sel.dtype), v_sel)
        start = c * Q_BLOCK
        k_w = lax.dynamic_slice_in_dim(kw_pad, start, Q_BLOCK + WINDOW, axis=1)
        v_w = lax.dynamic_slice_in_dim(vw_pad, start, Q_BLOCK + WINDOW, axis=1)
        kpos_w = start - WINDOW + jnp.arange(Q_BLOCK + WINDOW)
        dist_w = qpos[:, None] - kpos_w[None, :]
        m = (dist_w >= 0) & (dist_w < WINDOW) & (kpos_w >= 0)[None, :]
        s = jnp.einsum('bqgrd,bkgd->bqgrk', qi, k_w).astype(f32) * scale
        s = s + bias_tab[_rel_bucket(dist_w)].transpose(0, 2, 3, 1)[None]
        p = _masked_softmax(s, m[None, :, None, None, :])
        o_win = jnp.einsum('bqgrk,bkgd->bqgrd', p.astype(v_w.dtype), v_w)
        o = gi[..., 0:1] * o_cmp + gi[..., 1:2] * o_slc + gi[..., 2:3] * o_win
        return o.reshape(B, Q_BLOCK, H * D)

    o = lax.map(block, (qb, gb, jnp.arange(nb)))
    return o.transpose(1, 0, 2, 3).reshape(B, S, H * D).astype(q.dtype)


def setup_inputs(seed: int = 0) -> dict:
    key = jax.random.key(seed)
    ks = jax.random.split(key, 24)
    f32 = jnp.float32
    L = DEPTH

    def nrm(k, shape, scale):
        return jax.random.normal(k, shape, f32) * scale

    def gain(k, shape):
        return 1.0 + 0.05 * jax.random.normal(k, shape, f32)

    return {
        'x': nrm(ks[0], (BATCH, SEQ, D_MODEL), 1.0),
        'ln_mix_g': gain(ks[1], (L, D_MODEL)),
        'ln_mlp_g': gain(ks[2], (L, D_MODEL)),
        'w_in': nrm(ks[3], (L, D_MODEL, N_IN), D_MODEL ** -0.5),
        'gla_w_a2': nrm(ks[4], (L, GLA_GATE_RANK, GLA_QK), GLA_GATE_RANK ** -0.5),
        'gla_b_a': nrm(ks[5], (L, GLA_QK), 0.1),
        'gla_norm_g': gain(ks[6], (L, GLA_DV)),
        'nsa_q_norm_g': gain(ks[7], (L, NSA_DH)),
        'nsa_k_norm_g': gain(ks[8], (L, NSA_DH)),
        'nsa_pe_k': nrm(ks[9], (L, CMP_BLOCK, NSA_DH), 0.1),
        'nsa_pe_v': nrm(ks[10], (L, CMP_BLOCK, NSA_DH), 0.1),
        'nsa_wk1': nrm(ks[11], (L, CMP_BLOCK * NSA_DH, CMP_HIDDEN), (CMP_BLOCK * NSA_DH) ** -0.5),
        'nsa_wk2': nrm(ks[12], (L, CMP_HIDDEN, NSA_DH), CMP_HIDDEN ** -0.5),
        'nsa_wv1': nrm(ks[13], (L, CMP_BLOCK * NSA_DH, CMP_HIDDEN), (CMP_BLOCK * NSA_DH) ** -0.5),
        'nsa_wv2': nrm(ks[14], (L, CMP_HIDDEN, NSA_DH), CMP_HIDDEN ** -0.5),
        'rel_bias': nrm(ks[15], (REL_BUCKETS, NSA_HEADS), 0.2),
        'w_br_gla': nrm(ks[16], (L, GLA_V, D_MODEL), GLA_V ** -0.5),
        'w_br_sb': nrm(ks[17], (L, SB_W, D_MODEL), SB_W ** -0.5),
        'w_br_nsa': nrm(ks[18], (L, NSA_Q, D_MODEL), NSA_Q ** -0.5),
        'w_out': nrm(ks[19], (L, D_MODEL, D_MODEL), D_MODEL ** -0.5),
        'w_up': nrm(ks[20], (L, D_MODEL, FFN_HIDDEN), D_MODEL ** -0.5),
        'w_down': nrm(ks[21], (L, FFN_HIDDEN, D_MODEL), FFN_HIDDEN ** -0.5),
    }


def reference(x, ln_mix_g, ln_mlp_g, w_in, gla_w_a2, gla_b_a, gla_norm_g, nsa_q_norm_g,
              nsa_k_norm_g, nsa_pe_k, nsa_pe_v, nsa_wk1, nsa_wk2, nsa_wv1, nsa_wv2, rel_bias,
              w_br_gla, w_br_sb, w_br_nsa, w_out, w_up, w_down):
    split_pts = np.cumsum(IN_SIZES)[:-1].tolist()
    for l in range(DEPTH):
        h = _rms(x, ln_mix_g[l])
        proj = h @ w_in[l]
        (gq, gk, gv, ga, gr, sq, sk, sv, nq, nkc, nvc, nks, nvs, nkw, nvw, ngate,
         mgate) = jnp.split(proj, split_pts, axis=-1)
        o_gla = _gla(gq, gk, gv, ga, gr, gla_w_a2[l], gla_b_a[l], gla_norm_g[l])
        o_sb = _stick_breaking(sq, sk, sv)
        o_nsa = _nsa(nq, nkc, nvc, nks, nvs, nkw, nvw, ngate, nsa_q_norm_g[l], nsa_k_norm_g[l],
                     nsa_pe_k[l], nsa_pe_v[l], nsa_wk1[l], nsa_wk2[l], nsa_wv1[l], nsa_wv2[l],
                     rel_bias)
        g_a, g_b, g_c = jnp.split(jax.nn.sigmoid(mgate), N_BRANCHES, axis=-1)
        merged = (g_a * (o_gla @ w_br_gla[l]) + g_b * (o_sb @ w_br_sb[l])
                  + g_c * (o_nsa @ w_br_nsa[l]))
        x = x + merged @ w_out[l]
        h = _rms(x, ln_mlp_g[l])
        x = x + jnp.square(jax.nn.relu(h @ w_up[l])) @ w_down[l]
    return x
```

```cpp
#include <hip/hip_runtime.h>
#include <hip/hip_cooperative_groups.h>
#include <cstdio>
#include <cstdint>
namespace cg = cooperative_groups;
namespace pg8 {
#define PG8_LAS __attribute__((address_space(3)))
typedef unsigned short bf16_t;
typedef short bf16x8 __attribute__((ext_vector_type(8)));
typedef float f32x4 __attribute__((ext_vector_type(4)));
typedef unsigned u32x4 __attribute__((ext_vector_type(4)));
constexpr int BM = 256, BK = 64, HALF = 128, HTB = HALF * BK * 2  , STAGE_BYTES = 8 * HTB, NXCD = 8, WGM = 8;

__host__ __device__ __forceinline__ int lds_byte(int r, int c) { const int st = (r >> 4) * 2 + (c >> 5), rr = r & 15, cc = c & 31, ob = rr * 64 + cc * 2; return st * 1024 + (ob ^ (((ob >> 9) & 1) << 5)); }
__host__ __device__ __forceinline__ void stage_rc(int b, int& R, int& C) { const int st = b / 1024, sb = b % 1024, swz = sb ^ (((sb >> 9) & 1) << 5); R = (st >> 1) * 16 + swz / 64; C = (st & 1) * 32 + (swz % 64) / 2; }
__host__ __device__ __forceinline__ int perm32(int rho) { const int n = rho >> 4, i = rho & 15; return 8 * (i >> 2) + 4 * n + (i & 3); }

struct Unit { int pm, pn; };
struct Gemm { const bf16_t* A; const bf16_t* Bt; int M, N, K; };

struct StaticOrder {
    int nM, nN, nwg, G, c;
    __host__ __device__ void init(int M, int N, int G_, int c_) { nM = M / BM; nN = N / BM; nwg = nM * nN; G = G_; c = c_; }
    __host__ __device__ bool next(int i, Unit& u) const {
        const long L = (long)i * G + c; if (L >= nwg) return false;
        int wgid = (int)L; { const int q = nwg / NXCD, r = nwg % NXCD, xcd = wgid % NXCD, off = wgid / NXCD; wgid = (xcd < r ? xcd * (q + 1) : r * (q + 1) + (xcd - r) * q) + off; }
        const int nig = WGM * nN, gid = wgid / nig, fm = gid * WGM, gsz = (nM - fm) < WGM ? (nM - fm) : WGM;
        u.pm = fm + ((wgid % nig) % gsz); u.pn = (wgid % nig) / gsz; return true;
    }
    __device__ __forceinline__ void a_ready(const Unit&) const {}
    __device__ __forceinline__ void done(const Unit&) const {}
};

__device__ __forceinline__ unsigned cvt_pk_bf16(float lo, float hi) { unsigned r; asm volatile("v_cvt_pk_bf16_f32 %0, %1, %2" : "=v"(r) : "v"(lo), "v"(hi)); return r; }
__device__ __forceinline__ float bflo(unsigned w) { return __uint_as_float(w << 16); }
__device__ __forceinline__ float bfhi(unsigned w) { return __uint_as_float(w & 0xffff0000u); }
template <int ACT> struct EpiBf16 {
    static constexpr bool PERM = true, AFTER_DRAIN = false;
    bf16_t* O; int ldc;
    __device__ __forceinline__ void operator()(const f32x4 (&acc)[2][2][4][2], const Unit& u, int wr, int wc, int fr, int fq) const {
        const int row0 = u.pm * BM + wr * 64 + fr; const int col0 = u.pn * BM + wc * 32 + 8 * fq;
#pragma unroll
        for (int ai = 0; ai < 2; ++ai)
#pragma unroll
            for (int m = 0; m < 4; ++m) { bf16_t* rowp = O + (size_t)(row0 + ai * HALF + m * 16) * ldc + col0;
#pragma unroll
                for (int bj = 0; bj < 2; ++bj) { f32x4 v0 = acc[ai][bj][m][0], v1 = acc[ai][bj][m][1];
                    if (ACT == 2) {
#pragma unroll
                        for (int e = 0; e < 4; ++e) { float a = fmaxf(v0[e], 0.f), b = fmaxf(v1[e], 0.f); v0[e] = a * a; v1[e] = b * b; } }
                    u32x4 w; w.x = cvt_pk_bf16(v0[0], v0[1]); w.y = cvt_pk_bf16(v0[2], v0[3]); w.z = cvt_pk_bf16(v1[0], v1[1]); w.w = cvt_pk_bf16(v1[2], v1[3]);
                    *(u32x4*)(rowp + bj * HALF) = w; } }
    }
};
struct EpiGate {
    static constexpr bool PERM = true, AFTER_DRAIN = false;
    bf16_t* O; const bf16_t* gate; int gld; int first;
    __device__ __forceinline__ void operator()(const f32x4 (&acc)[2][2][4][2], const Unit& u, int wr, int wc, int fr, int fq) const {
        const int row0 = u.pm * BM + wr * 64 + fr; const int col0 = u.pn * BM + wc * 32 + 8 * fq;
#pragma unroll
        for (int ai = 0; ai < 2; ++ai)
#pragma unroll
            for (int m = 0; m < 4; ++m) { const int row = row0 + ai * HALF + m * 16; bf16_t* rowp = O + (size_t)row * 1024 + col0; const bf16_t* gp = gate + (size_t)row * gld + col0;
#pragma unroll
                for (int bj = 0; bj < 2; ++bj) { const f32x4 v0 = acc[ai][bj][m][0], v1 = acc[ai][bj][m][1];
                    const u32x4 gw = *(const u32x4*)(gp + bj * HALF);
                    u32x4 ow = (u32x4){0u, 0u, 0u, 0u}; if (!first) ow = *(const u32x4*)(rowp + bj * HALF);
                    float gv[8] = {bflo(gw.x), bfhi(gw.x), bflo(gw.y), bfhi(gw.y), bflo(gw.z), bfhi(gw.z), bflo(gw.w), bfhi(gw.w)};
                    float ov[8] = {bflo(ow.x), bfhi(ow.x), bflo(ow.y), bfhi(ow.y), bflo(ow.z), bfhi(ow.z), bflo(ow.w), bfhi(ow.w)};
                    float av[8] = {v0[0], v0[1], v0[2], v0[3], v1[0], v1[1], v1[2], v1[3]};
                    float r[8];
#pragma unroll
                    for (int e = 0; e < 8; ++e) { const float s = 1.f / (1.f + __expf(-gv[e])); r[e] = ov[e] + s * av[e]; }
                    u32x4 w; w.x = cvt_pk_bf16(r[0], r[1]); w.y = cvt_pk_bf16(r[2], r[3]); w.z = cvt_pk_bf16(r[4], r[5]); w.w = cvt_pk_bf16(r[6], r[7]);
                    *(u32x4*)(rowp + bj * HALF) = w; } }
    }
};
struct EpiRes {
    static constexpr bool PERM = false, AFTER_DRAIN = false;
    const float* src; float* out;
    __device__ __forceinline__ void operator()(const f32x4 (&acc)[2][2][4][2], const Unit& u, int wr, int wc, int fr, int fq) const {
        const int col0 = u.pn * BM + wc * 32 + 4 * fq;
#pragma unroll
        for (int ai = 0; ai < 2; ++ai)
#pragma unroll
            for (int m = 0; m < 4; ++m) { const size_t off = (size_t)(u.pm * BM + ai * HALF + wr * 64 + m * 16 + fr) * 1024 + col0;
#pragma unroll
                for (int bj = 0; bj < 2; ++bj)
#pragma unroll
                    for (int n = 0; n < 2; ++n) { const f32x4 bs = *(const f32x4*)(src + off + bj * HALF + n * 16); *(f32x4*)(out + off + bj * HALF + n * 16) = bs + acc[ai][bj][m][n]; } }
    }
};
template <class Epi, class Sched, bool ALIGN_EPI = false, bool SP2 = false>
__device__ __forceinline__ void gemm_phase(PG8_LAS unsigned char* lds, const Gemm g, const Sched& S, const Epi& E) {
    int tid_ = threadIdx.x; asm volatile("" : "+v"(tid_));
    const int tid = tid_, wid = __builtin_amdgcn_readfirstlane(tid >> 6), lane = tid & 63, wr = wid >> 2, wc = wid & 3, fr = lane & 15, fq = lane >> 4;
    const int K = g.K, nt = K / BK;
    unsigned voffA[2], voffB[2];
#pragma unroll
    for (int i = 0; i < 2; ++i) { int R, C; stage_rc(tid * 16 + i * 8192, R, C); const int Rb = Epi::PERM ? ((R & ~31) + perm32(R & 31)) : R;
        voffA[i] = (unsigned)(R * K + C) * 2u; voffB[i] = (unsigned)(Rb * K + C) * 2u; }
    const size_t kstep = (size_t)(BK * 2);
    const size_t hstep = (size_t)HALF * K * 2;
    const size_t tstep = 2 * hstep;
    const unsigned ldsw = (unsigned)wid * 1024u;
    const int aoff = lds_byte(wr * 64 + fr, fq * 8), boff = lds_byte(wc * 32 + fr, fq * 8);
#define PG8_SA(b, h) (((b) * 2 + (h)) * HTB)
#define PG8_SB(b, h) ((4 + (b) * 2 + (h)) * HTB)
#define PG8_STAGE(bufoff, gbase, voff) do { _Pragma("unroll") for (int _i = 0; _i < 2; ++_i) \
        __builtin_amdgcn_global_load_lds((const unsigned*)((const char*)(gbase) + (voff)[_i]), (PG8_LAS unsigned*)(lds + (bufoff) + ldsw + _i * 8192), 16, 0, 0); } while (0)
#define PG8_LDA(dst, b, h) do { _Pragma("unroll") for (int m = 0; m < 4; ++m) _Pragma("unroll") for (int k = 0; k < 2; ++k) dst[m][k] = *(const PG8_LAS bf16x8*)(lds + PG8_SA(b, h) + aoff + m * 2048 + k * 1024); } while (0)
#define PG8_LDB(dst, b, h) do { _Pragma("unroll") for (int n = 0; n < 2; ++n) _Pragma("unroll") for (int k = 0; k < 2; ++k) dst[n][k] = *(const PG8_LAS bf16x8*)(lds + PG8_SB(b, h) + boff + n * 2048 + k * 1024); } while (0)
#define PG8_MMA(ai, bj, At, Bt) do { __builtin_amdgcn_s_setprio(1); _Pragma("unroll") for (int m = 0; m < 4; ++m) _Pragma("unroll") for (int n = 0; n < 2; ++n) _Pragma("unroll") for (int k = 0; k < 2; ++k) \
        acc[ai][bj][m][n] = __builtin_amdgcn_mfma_f32_16x16x32_bf16(Bt[n][k], At[m][k], acc[ai][bj][m][n], 0, 0, 0); __builtin_amdgcn_s_setprio(0); } while (0)
#define PG8_WAIT_V(n) asm volatile("s_waitcnt vmcnt(" #n ")" ::: "memory")
#define PG8_WAIT_L(n) asm volatile("s_waitcnt lgkmcnt(" #n ")" ::: "memory")
#define PG8_BAR __builtin_amdgcn_s_barrier()
#define PG8_SCHED __builtin_amdgcn_sched_barrier(0)
    Unit cur, nxt; int ui = 0;
    if (!S.next(0, cur)) return;
    f32x4 acc[2][2][4][2];
#pragma unroll
    for (int a = 0; a < 2; ++a)
#pragma unroll
        for (int b = 0; b < 2; ++b)
#pragma unroll
            for (int m = 0; m < 4; ++m)
#pragma unroll
                for (int n = 0; n < 2; ++n) acc[a][b][m][n] = (f32x4){0.f, 0.f, 0.f, 0.f};
    bf16x8 At[4][2], B0[2][2], B1[2][2];
    const char* cA = (const char*)g.A + (size_t)cur.pm * tstep; const char* cB = (const char*)g.Bt + (size_t)cur.pn * tstep;
    S.a_ready(cur);
    if constexpr (SP2) {
        PG8_STAGE(PG8_SB(0, 0), cB, voffB); PG8_STAGE(PG8_SB(0, 1), cB + hstep, voffB); PG8_STAGE(PG8_SA(0, 0), cA, voffA); PG8_STAGE(PG8_SA(0, 1), cA + hstep, voffA);
        if (wr == 1) PG8_BAR;
        PG8_WAIT_V(2); PG8_BAR;
        PG8_STAGE(PG8_SB(1, 0), cB + kstep, voffB); PG8_STAGE(PG8_SA(1, 0), cA + kstep, voffA); PG8_STAGE(PG8_SB(1, 1), cB + hstep + kstep, voffB);
        PG8_WAIT_V(6); PG8_BAR;
    } else {
        PG8_STAGE(PG8_SB(0, 0), cB, voffB); PG8_STAGE(PG8_SA(0, 0), cA, voffA); PG8_STAGE(PG8_SB(0, 1), cB + hstep, voffB); PG8_STAGE(PG8_SA(0, 1), cA + hstep, voffA);
        if (wr == 1) PG8_BAR;
        PG8_WAIT_V(4); PG8_BAR;
        PG8_STAGE(PG8_SB(1, 0), cB + kstep, voffB); PG8_STAGE(PG8_SA(1, 0), cA + kstep, voffA); PG8_STAGE(PG8_SB(1, 1), cB + hstep + kstep, voffB);
        PG8_WAIT_V(6); PG8_BAR;
    }
    for (;;) {
        const bool has_next = S.next(ui + 1, nxt);
        const char* nA = has_next ? (const char*)g.A + (size_t)nxt.pm * tstep : cA; const char* nB = has_next ? (const char*)g.Bt + (size_t)nxt.pn * tstep : cB;
        for (int t = 0; t < nt; t += 2) {
            const bool last = (t == nt - 2);
            const char* a1 = cA + (size_t)(t + 1) * kstep;
            const char* a2 = last ? nA : cA + (size_t)(t + 2) * kstep; const char* b2 = last ? nB : cB + (size_t)(t + 2) * kstep;
            const char* a3 = a2 + kstep; const char* b3 = b2 + kstep;
            if (last && has_next) S.a_ready(nxt);
            if constexpr (SP2) {
            PG8_LDB(B0, 0, 0); PG8_LDB(B1, 0, 1); PG8_SCHED; PG8_LDA(At, 0, 0); PG8_STAGE(PG8_SA(1, 1), a1 + hstep, voffA);
            PG8_WAIT_V(8); PG8_WAIT_L(0); PG8_BAR; PG8_MMA(0, 0, At, B0); PG8_MMA(0, 1, At, B1); PG8_BAR; PG8_SCHED;
            PG8_LDA(At, 0, 1); PG8_STAGE(PG8_SB(0, 0), b2, voffB); PG8_STAGE(PG8_SB(0, 1), b2 + hstep, voffB); PG8_STAGE(PG8_SA(0, 0), a2, voffA);
            PG8_WAIT_V(8); PG8_WAIT_L(0); PG8_BAR; PG8_MMA(1, 0, At, B0); PG8_MMA(1, 1, At, B1); PG8_BAR; PG8_SCHED;
            PG8_LDB(B0, 1, 0); PG8_LDB(B1, 1, 1); PG8_SCHED; PG8_LDA(At, 1, 0); PG8_STAGE(PG8_SA(0, 1), a2 + hstep, voffA);
            PG8_WAIT_V(8); PG8_WAIT_L(0); PG8_BAR; PG8_MMA(0, 0, At, B0); PG8_MMA(0, 1, At, B1); PG8_BAR; PG8_SCHED;
            PG8_LDA(At, 1, 1); PG8_STAGE(PG8_SB(1, 0), b3, voffB); PG8_STAGE(PG8_SB(1, 1), b3 + hstep, voffB); PG8_STAGE(PG8_SA(1, 0), a3, voffA);
            PG8_WAIT_V(8); PG8_WAIT_L(0); PG8_BAR; PG8_MMA(1, 0, At, B0); PG8_MMA(1, 1, At, B1); PG8_BAR; PG8_SCHED;
            } else {
            PG8_LDB(B0, 0, 0); PG8_SCHED; PG8_LDA(At, 0, 0); PG8_STAGE(PG8_SA(1, 1), a1 + hstep, voffA);
            PG8_WAIT_L(8); PG8_BAR; PG8_WAIT_L(0); PG8_MMA(0, 0, At, B0); PG8_BAR; PG8_SCHED;
            PG8_LDB(B1, 0, 1); PG8_STAGE(PG8_SB(0, 0), b2, voffB);
            PG8_BAR; PG8_WAIT_L(0); PG8_MMA(0, 1, At, B1); PG8_BAR;
            PG8_LDA(At, 0, 1); PG8_STAGE(PG8_SA(0, 0), a2, voffA);
            PG8_BAR; PG8_WAIT_L(0); PG8_MMA(1, 0, At, B0); PG8_BAR; PG8_SCHED;
            PG8_STAGE(PG8_SB(0, 1), b2 + hstep, voffB);
            PG8_WAIT_V(6); PG8_BAR; PG8_MMA(1, 1, At, B1); PG8_BAR;
            PG8_LDB(B0, 1, 0); PG8_SCHED; PG8_LDA(At, 1, 0); PG8_STAGE(PG8_SA(0, 1), a2 + hstep, voffA);
            PG8_WAIT_L(8); PG8_BAR; PG8_WAIT_L(0); PG8_MMA(0, 0, At, B0); PG8_BAR; PG8_SCHED;
            PG8_LDB(B1, 1, 1); PG8_STAGE(PG8_SB(1, 0), b3, voffB);
            PG8_BAR; PG8_WAIT_L(0); PG8_MMA(0, 1, At, B1); PG8_BAR;
            PG8_LDA(At, 1, 1); PG8_STAGE(PG8_SA(1, 0), a3, voffA);
            PG8_BAR; PG8_WAIT_L(0); PG8_MMA(1, 0, At, B0); PG8_BAR; PG8_SCHED;
            PG8_STAGE(PG8_SB(1, 1), b3 + hstep, voffB);
            PG8_WAIT_V(6); PG8_BAR; PG8_MMA(1, 1, At, B1); PG8_BAR;
            }
        }
        if constexpr (ALIGN_EPI) { if (wr == 0) PG8_BAR; }
        if constexpr (!Epi::AFTER_DRAIN) { E(acc, cur, wr, wc, fr, fq); S.done(cur); }
        if (!has_next) break;
#pragma unroll
        for (int a = 0; a < 2; ++a)
#pragma unroll
            for (int b = 0; b < 2; ++b)
#pragma unroll
                for (int m = 0; m < 4; ++m)
#pragma unroll
                    for (int n = 0; n < 2; ++n) acc[a][b][m][n] = (f32x4){0.f, 0.f, 0.f, 0.f};
        cur = nxt; cA = nA; cB = nB; ++ui;
        if constexpr (ALIGN_EPI) { if (wr == 1) PG8_BAR; }
    }
    PG8_WAIT_V(0);
    if constexpr (!ALIGN_EPI) { if (wr == 0) PG8_BAR; }
    PG8_BAR;
    if constexpr (Epi::AFTER_DRAIN) { E.fused(acc, cur, wr, wc, fr, fq, lds, wid, lane); S.done(cur); }
#undef PG8_SA
#undef PG8_SB
#undef PG8_STAGE
#undef PG8_LDA
#undef PG8_LDB
#undef PG8_MMA
#undef PG8_WAIT_V
#undef PG8_WAIT_L
#undef PG8_BAR
#undef PG8_SCHED
}
}

#define LAS __attribute__((address_space(3)))
typedef unsigned short bf16_t;
typedef short bf16x8 __attribute__((ext_vector_type(8)));
typedef float f32x4 __attribute__((ext_vector_type(4)));
typedef unsigned u32x4 __attribute__((ext_vector_type(4)));
typedef unsigned u32x2 __attribute__((ext_vector_type(2)));
using pg8::cvt_pk_bf16; using pg8::bflo; using pg8::bfhi;

constexpr int M = 16384, DM = 1024, NIN = 7592, NPAD = 7680, FF = 4096, DEPTH = 4;
constexpr int C_GQ = 0, C_GK = 512, C_GV = 1024, C_GA = 1536, C_GR = 1552, C_SQ = 2064, C_SK = 2576, C_SV = 3088, C_NQ = 3600, C_NKC = 4112, C_NVC = 4176,
              C_NKS = 4240, C_NVS = 4304, C_NKW = 4368, C_NVW = 4432, C_NGATE = 4496, C_MGATE = 4520;
constexpr size_t MiB = 1u << 20;
constexpr size_t WS_PROJ = 0, WS_HID = 0, WS_HN = 240 * MiB, WS_OGLA = 272 * MiB, WS_OSB = 288 * MiB, WS_ONSA = 304 * MiB;
constexpr size_t WS_WIN = 320 * MiB, WS_WUP = 335 * MiB, WS_WDN = 343 * MiB, WS_WOUT = 351 * MiB, WS_WBR = 353 * MiB, WS_WK1 = 356 * MiB, WS_WV1 = 357 * MiB,
                 WS_WK2 = 358 * MiB, WS_WV2 = 358 * MiB + 65536, WS_CB = 358 * MiB + 131072, WS_LUT = 358 * MiB + 196608;
constexpr size_t WS_GST = 360 * MiB, WS_GDC = 424 * MiB, WS_SVT = 425 * MiB, WS_QN = 441 * MiB, WS_KSN = 457 * MiB, WS_KWN = 459 * MiB, WS_VST = 461 * MiB, WS_VWT = 463 * MiB,
                 WS_KCMP = 465 * MiB, WS_VCMPT = 465 * MiB + 131072, WS_END = 466 * MiB;
constexpr int LDS_BYTES = 133120;
constexpr float LOG2E = 1.4426950408889634f;

struct KArgs { const float* in[22]; float* out; unsigned char* ws; };

__device__ __forceinline__ float bf2f(bf16_t v) { return __uint_as_float(((unsigned)v) << 16); }
__device__ __forceinline__ bf16_t f2bf(float f) { unsigned u = __float_as_uint(f); return (bf16_t)((u + 0x7fffu + ((u >> 16) & 1u)) >> 16); }
__device__ __forceinline__ f32x4 mfma16(bf16x8 a, bf16x8 b, f32x4 c) { return __builtin_amdgcn_mfma_f32_16x16x32_bf16(a, b, c, 0, 0, 0); }
__device__ __forceinline__ float wave_sum(float v) {
#pragma unroll
    for (int o = 1; o < 64; o <<= 1) v += __shfl_xor(v, o);
    return v;
}
#define LDS_FENCE() asm volatile("s_waitcnt lgkmcnt(0)" ::: "memory")
__device__ __forceinline__ void unpack8(const u32x4 w, float (&f)[8]) { f[0] = bflo(w.x); f[1] = bfhi(w.x); f[2] = bflo(w.y); f[3] = bfhi(w.y); f[4] = bflo(w.z); f[5] = bfhi(w.z); f[6] = bflo(w.w); f[7] = bfhi(w.w); }
__device__ __forceinline__ u32x4 pack8(const float (&r)[8]) { u32x4 w; w.x = cvt_pk_bf16(r[0], r[1]); w.y = cvt_pk_bf16(r[2], r[3]); w.z = cvt_pk_bf16(r[4], r[5]); w.w = cvt_pk_bf16(r[6], r[7]); return w; }

__device__ __forceinline__ void transpose_item(const float* W, int K, int N, int Npad, bf16_t* WT, LAS float* scr, int item, int lane) {
    const int nblk = Npad / 32, kb = item / nblk, nb = item % nblk, k0 = 64 * kb, n0 = 32 * nb;
    const int nn = n0 + (lane & 31);
#pragma unroll 8
    for (int i = 0; i < 32; ++i) { const int kk = 2 * i + (lane >> 5); scr[kk * 33 + (lane & 31)] = (nn < N) ? W[(size_t)(k0 + kk) * N + nn] : 0.f; }
    LDS_FENCE();
    const int c = lane & 7;
#pragma unroll
    for (int j = 0; j < 4; ++j) { const int n = (lane >> 3) + 8 * j; const LAS float* s = scr + (8 * c) * 33 + n;
        u32x4 o; o.x = cvt_pk_bf16(s[0 * 33], s[1 * 33]); o.y = cvt_pk_bf16(s[2 * 33], s[3 * 33]); o.z = cvt_pk_bf16(s[4 * 33], s[5 * 33]); o.w = cvt_pk_bf16(s[6 * 33], s[7 * 33]);
        *(u32x4*)(WT + (size_t)(n0 + n) * K + k0 + 8 * c) = o; }
    LDS_FENCE();
}
__device__ __forceinline__ int rel_bucket(int n) {
    if (n < 16) return n;
    int large = 16 + (int)(logf((float)n / 16.f) / 4.1588830833596715f * 16.f);
    return large < 31 ? large : 31;
}
__device__ __forceinline__ void rms_row(const float* xrow, const float* g, bf16_t* orow, int lane) {
    const f32x4* xr = (const f32x4*)xrow + lane; f32x4 v[4]; float s = 0.f;
#pragma unroll
    for (int j = 0; j < 4; ++j) { v[j] = xr[64 * j]; s += (v[j].x * v[j].x + v[j].y * v[j].y) + (v[j].z * v[j].z + v[j].w * v[j].w); }
    const float rinv = rsqrtf(wave_sum(s) * (1.f / 1024.f) + 1e-6f);
    u32x2* o8 = (u32x2*)orow + lane;
#pragma unroll
    for (int j = 0; j < 4; ++j) { const f32x4 gg = ((const f32x4*)g)[lane + 64 * j]; u32x2 w; w.x = cvt_pk_bf16(v[j].x * rinv * gg.x, v[j].y * rinv * gg.y); w.y = cvt_pk_bf16(v[j].z * rinv * gg.z, v[j].w * rinv * gg.w); o8[64 * j] = w; }
}
__device__ __forceinline__ void phase_convert(const KArgs& a, int l, LAS unsigned char* lds, int gw, int NGW, int wave, int lane) {
    unsigned char* ws = a.ws;
    LAS float* scr = (LAS float*)(lds + wave * 8704);
    constexpr int I0 = 16 * 240, I1 = 16 * 128, I2 = 64 * 32, I3 = 16 * 32, I4 = 8 * 32, I7 = 32 * 8, I9 = 4 * 2, IB = 128, IL = 128;
    constexpr int NIT = I0 + I1 + I2 + I3 + 3 * I4 + 2 * I7 + 2 * I9 + IB + IL;
    for (int it = gw; it < NIT; it += NGW) {
        int r = it;
        if (r < I0) { transpose_item(a.in[3] + (size_t)l * DM * NIN, DM, NIN, NPAD, (bf16_t*)(ws + WS_WIN), scr, r, lane); continue; } r -= I0;
        if (r < I1) { transpose_item(a.in[20] + (size_t)l * DM * FF, DM, FF, FF, (bf16_t*)(ws + WS_WUP), scr, r, lane); continue; } r -= I1;
        if (r < I2) { transpose_item(a.in[21] + (size_t)l * FF * DM, FF, DM, DM, (bf16_t*)(ws + WS_WDN), scr, r, lane); continue; } r -= I2;
        if (r < I3) { transpose_item(a.in[19] + (size_t)l * DM * DM, DM, DM, DM, (bf16_t*)(ws + WS_WOUT), scr, r, lane); continue; } r -= I3;
        if (r < 3 * I4) { const int b = r / I4; transpose_item(a.in[16 + b] + (size_t)l * 512 * DM, 512, DM, DM, (bf16_t*)(ws + WS_WBR + b * MiB), scr, r % I4, lane); continue; } r -= 3 * I4;
        if (r < I7) { transpose_item(a.in[11] + (size_t)l * 2048 * 256, 2048, 256, 256, (bf16_t*)(ws + WS_WK1), scr, r, lane); continue; } r -= I7;
        if (r < I7) { transpose_item(a.in[13] + (size_t)l * 2048 * 256, 2048, 256, 256, (bf16_t*)(ws + WS_WV1), scr, r, lane); continue; } r -= I7;
        if (r < I9) { transpose_item(a.in[12] + (size_t)l * 256 * 64, 256, 64, 64, (bf16_t*)(ws + WS_WK2), scr, r, lane); continue; } r -= I9;
        if (r < I9) { transpose_item(a.in[14] + (size_t)l * 256 * 64, 256, 64, 64, (bf16_t*)(ws + WS_WV2), scr, r, lane); continue; } r -= I9;
        if (r < IB) {
            const int p = r >> 3, which = (r >> 2) & 1, col = (r & 3) * 64 + lane;
            const float* pe = a.in[which ? 10 : 9] + (size_t)l * 2048; const float* w1 = a.in[which ? 13 : 11] + (size_t)l * 2048 * 256;
            float s = 0.f;
            for (int k = 128 * p; k < 128 * p + 128; ++k) s += pe[k] * w1[(size_t)k * 256 + col];
            ((float*)(ws + WS_CB))[p * 512 + which * 256 + col] = s; continue; } r -= IB;
        {
            const int idx = r * 64 + lane; const int d = idx >> 3, h = idx & 7;
            ((float*)(ws + WS_LUT))[idx] = a.in[15][rel_bucket(d) * 8 + h] * LOG2E; }
    }
}
__device__ __forceinline__ void phase_rms(const float* x, const float* g, bf16_t* hn, int gw, int NGW, int lane) {
    for (int m = gw; m < M; m += NGW) rms_row(x + (size_t)m * DM, g, hn + (size_t)m * DM, lane);
}

__device__ __forceinline__ void rms64_to(const bf16_t* src, const float* g, float scale, bf16_t* dst) {
    u32x4 w[8]; float ss = 0.f;
#pragma unroll
    for (int i = 0; i < 8; ++i) { w[i] = ((const u32x4*)src)[i]; float f[8]; unpack8(w[i], f);
#pragma unroll
        for (int e = 0; e < 8; ++e) ss += f[e] * f[e]; }
    const float rinv = rsqrtf(ss * (1.f / 64.f) + 1e-6f) * scale;
#pragma unroll
    for (int i = 0; i < 8; ++i) { float f[8]; unpack8(w[i], f); float r[8];
#pragma unroll
        for (int e = 0; e < 8; ++e) r[e] = f[e] * rinv * g[8 * i + e];
        ((u32x4*)dst)[i] = pack8(r); }
}
__device__ __forceinline__ void pre_item(const KArgs& a, int l, LAS unsigned char* lds, int item, int tid) {
    unsigned char* ws = a.ws; const bf16_t* proj = (const bf16_t*)(ws + WS_PROJ);
    const int t0 = item * 64;
    {
        const int tl = tid >> 3, h = tid & 7;
        rms64_to(proj + (size_t)(t0 + tl) * NPAD + C_NQ + h * 64, a.in[7] + l * 64, 0.125f * LOG2E, (bf16_t*)(ws + WS_QN) + (size_t)(t0 + tl) * 512 + h * 64);
    }
    if (tid < 128) {
        const int tl = tid >> 1, which = tid & 1;
        rms64_to(proj + (size_t)(t0 + tl) * NPAD + (which ? C_NKW : C_NKS), a.in[8] + l * 64, 1.f, (bf16_t*)(ws + (which ? WS_KWN : WS_KSN)) + (size_t)(t0 + tl) * 64);
    }
    LAS bf16_t* T = (LAS bf16_t*)lds;
    for (int idx = tid; idx < 64 * 80; idx += 512) { const int t = idx / 80, p = idx % 80; const int col = p < 64 ? C_SV + 8 * p : (p < 72 ? C_NVS + 8 * (p - 64) : C_NVW + 8 * (p - 72));
        const u32x4 w = *(const u32x4*)(proj + (size_t)(t0 + t) * NPAD + col);
        LAS unsigned* d = (LAS unsigned*)(T + t * 648 + 8 * p); d[0] = w.x; d[1] = w.y; d[2] = w.z; d[3] = w.w; }
    __syncthreads();
    for (int idx = tid; idx < 640 * 8; idx += 512) { const int c = idx >> 3, p = idx & 7;
        unsigned short e[8];
#pragma unroll
        for (int j = 0; j < 8; ++j) e[j] = T[(8 * p + j) * 648 + c];
        u32x4 w; w.x = e[0] | ((unsigned)e[1] << 16); w.y = e[2] | ((unsigned)e[3] << 16); w.z = e[4] | ((unsigned)e[5] << 16); w.w = e[6] | ((unsigned)e[7] << 16);
        bf16_t* dst = c < 512 ? (bf16_t*)(ws + WS_SVT) + (size_t)c * M : (c < 576 ? (bf16_t*)(ws + WS_VST) + (size_t)(c - 512) * M : (bf16_t*)(ws + WS_VWT) + (size_t)(c - 576) * M);
        *(u32x4*)(dst + t0 + 8 * p) = w; }
    __syncthreads();
}
__device__ __forceinline__ void cmp_item(const KArgs& a, int l, LAS unsigned char* lds, int item, int tid, int wave, int lane) {
    unsigned char* ws = a.ws; const bf16_t* proj = (const bf16_t*)(ws + WS_PROJ);
    const int which = item & 1, grp = item >> 1, i0 = 16 * grp;
    const int srcoff = which ? C_NVC : C_NKC;
    const bf16_t* w1T = (const bf16_t*)(ws + (which ? WS_WV1 : WS_WK1)); const bf16_t* w2T = (const bf16_t*)(ws + (which ? WS_WV2 : WS_WK2));
    LAS bf16_t* hidL = (LAS bf16_t*)lds;
    LAS float* outL = (LAS float*)(lds + 16384);
    LAS float* rinvL = (LAS float*)(lds + 24576);
    const int r = lane & 15, g = lane >> 4;
    int irow = i0 + r; if (irow > 1022) irow = 1022;
    const bf16_t* arow = proj + (size_t)(16 * irow) * NPAD + srcoff;
    f32x4 acc[2] = {(f32x4){0.f, 0.f, 0.f, 0.f}, (f32x4){0.f, 0.f, 0.f, 0.f}};
    const bf16_t* b0 = w1T + (size_t)(32 * wave + r) * 2048 + 8 * g; const bf16_t* b1 = b0 + 16 * 2048;
#pragma unroll 4
    for (int ks = 0; ks < 64; ++ks) { const int k = 32 * ks + 8 * g;
        const bf16x8 af = *(const bf16x8*)(arow + (size_t)(k >> 6) * NPAD + (k & 63));
        const bf16x8 bf0 = *(const bf16x8*)(b0 + 32 * ks), bf1 = *(const bf16x8*)(b1 + 32 * ks);
        acc[0] = mfma16(af, bf0, acc[0]); acc[1] = mfma16(af, bf1, acc[1]); }
    const float* cb = (const float*)(ws + WS_CB);
#pragma unroll
    for (int nb = 0; nb < 2; ++nb) { const int col = 32 * wave + 16 * nb + r; float bs = 0.f;
        for (int p = 0; p < 16; ++p) bs += cb[p * 512 + which * 256 + col];
#pragma unroll
        for (int j = 0; j < 4; ++j) { const float x = acc[nb][j] + bs; const float u = 0.7978845608028654f * (x + 0.044715f * x * x * x);
            const float th = 1.f - 2.f / (__expf(2.f * u) + 1.f); hidL[(4 * g + j) * 264 + col] = f2bf(0.5f * x * (1.f + th)); } }
    __syncthreads();
    if (wave < 4) { f32x4 c2 = (f32x4){0.f, 0.f, 0.f, 0.f};
#pragma unroll
        for (int ks = 0; ks < 8; ++ks) { const bf16x8 af = *(const LAS bf16x8*)(hidL + r * 264 + 32 * ks + 8 * g); const bf16x8 bfr = *(const bf16x8*)(w2T + (size_t)(16 * wave + r) * 256 + 32 * ks + 8 * g); c2 = mfma16(af, bfr, c2); }
#pragma unroll
        for (int j = 0; j < 4; ++j) outL[(4 * g + j) * 65 + 16 * wave + r] = c2[j]; }
    __syncthreads();
    if (tid < 16) { float ss = 0.f; for (int d = 0; d < 64; ++d) { const float v = outL[tid * 65 + d]; ss += v * v; } rinvL[tid] = rsqrtf(ss * (1.f / 64.f) + 1e-6f); }
    __syncthreads();
    const float* kg = a.in[8] + l * 64;
    for (int idx = tid; idx < 1024; idx += 512) { const int row = idx >> 6, d = idx & 63, i = i0 + row; const float v = outL[row * 65 + d];
        if (which == 0) ((bf16_t*)(ws + WS_KCMP))[(size_t)i * 64 + d] = (i <= 1022) ? f2bf(v * rinvL[row] * kg[d]) : (bf16_t)0;
        else ((bf16_t*)(ws + WS_VCMPT))[(size_t)d * 1024 + i] = (i <= 1022) ? f2bf(v) : (bf16_t)0; }
    __syncthreads();
}
__device__ __forceinline__ void gla_decay(const KArgs& a, int l, int c, int h, LAS float* bL, LAS float* aL, int tid) {
    const bf16_t* proj = (const bf16_t*)(a.ws + WS_PROJ);
    { const int t = tid >> 4, r = tid & 15; aL[tid] = bf2f(proj[(size_t)(32 * c + t) * NPAD + C_GA + r]); }
    __syncthreads();
    if (tid < 128) { const int hk = h * 128 + tid; float w[16];
#pragma unroll
        for (int r = 0; r < 16; ++r) w[r] = a.in[4][(size_t)l * 16 * 512 + r * 512 + hk];
        const float ba = a.in[5][l * 512 + hk]; float cum = 0.f;
        for (int t = 0; t < 32; ++t) { float x = ba;
#pragma unroll
            for (int r = 0; r < 16; ++r) x += aL[t * 16 + r] * w[r];
            const float ls = fminf(x, 0.f) - __logf(1.f + __expf(-fabsf(x)));
            cum += ls * (1.f / 16.f); bL[t * 128 + tid] = cum; } }
    __syncthreads();
}
__device__ __forceinline__ void gla_g1_item(const KArgs& a, int l, LAS unsigned char* lds, int item, int tid, int wave, int lane) {
    unsigned char* ws = a.ws; const bf16_t* proj = (const bf16_t*)(ws + WS_PROJ);
    const int c = item >> 2, h = item & 3;
    LAS float* bL = (LAS float*)lds; LAS float* aL = (LAS float*)(lds + 16384);
    LAS bf16_t* kT = (LAS bf16_t*)(lds + 20480);
    LAS bf16_t* vT = (LAS bf16_t*)(lds + 20480 + 10240);
    gla_decay(a, l, c, h, bL, aL, tid);
    for (int idx = tid; idx < 32 * 128; idx += 512) { const int s = idx >> 7, k = idx & 127; const size_t ro = (size_t)(32 * c + s) * NPAD + h * 128 + k;
        kT[k * 40 + s] = f2bf(bf2f(proj[ro + C_GK]) * __expf(bL[31 * 128 + k] - bL[s * 128 + k])); vT[k * 40 + s] = proj[ro + C_GV]; }
    if (tid < 128) ((float*)(ws + WS_GDC))[(size_t)(c * 4 + h) * 128 + tid] = __expf(bL[31 * 128 + tid]);
    __syncthreads();
    const int r = lane & 15, g = lane >> 4;
    const bf16x8 af = *(const LAS bf16x8*)(vT + (16 * wave + r) * 40 + 8 * g);
    bf16_t* dst = (bf16_t*)(ws + WS_GST) + (size_t)(c * 4 + h) * 16384;
#pragma unroll
    for (int kb = 0; kb < 8; ++kb) { const bf16x8 bfr = *(const LAS bf16x8*)(kT + (16 * kb + r) * 40 + 8 * g);
        const f32x4 d = mfma16(af, bfr, (f32x4){0.f, 0.f, 0.f, 0.f});
#pragma unroll
        for (int j = 0; j < 4; ++j) dst[(size_t)(16 * wave + 4 * g + j) * 128 + 16 * kb + r] = f2bf(d[j]); }
    __syncthreads();
}
__device__ __forceinline__ void gla_scan(const KArgs& a, int cid) {
    bf16_t* st = (bf16_t*)(a.ws + WS_GST); const float* dc = (const float*)(a.ws + WS_GDC);
    const int h = cid >> 14, vk = cid & 16383, k = cid & 127;
    float state = 0.f;
    for (int c0 = 0; c0 < 512; c0 += 8) { float kv[8], d[8];
#pragma unroll
        for (int i = 0; i < 8; ++i) { kv[i] = bf2f(st[(size_t)((c0 + i) * 4 + h) * 16384 + vk]); d[i] = dc[(size_t)((c0 + i) * 4 + h) * 128 + k]; }
#pragma unroll
        for (int i = 0; i < 8; ++i) { st[(size_t)((c0 + i) * 4 + h) * 16384 + vk] = f2bf(state); state = state * d[i] + kv[i]; } }
}
__device__ __forceinline__ void gla_g3_item(const KArgs& a, int l, LAS unsigned char* lds, int item, int tid, int wave, int lane) {
    unsigned char* ws = a.ws; const bf16_t* proj = (const bf16_t*)(ws + WS_PROJ);
    const int c = item >> 2, h = item & 3;
    LAS float* bL = (LAS float*)lds; LAS float* aL = (LAS float*)(lds + 16384);
    LAS bf16_t* qL = (LAS bf16_t*)(lds + 20480);
    LAS bf16_t* kL = (LAS bf16_t*)(lds + 20480 + 8704);
    LAS bf16_t* vT = (LAS bf16_t*)(lds + 20480 + 17408);
    LAS bf16_t* scL = (LAS bf16_t*)(lds + 20480 + 27648);
    LAS float* oL = (LAS float*)(lds + 20480 + 30208);
    gla_decay(a, l, c, h, bL, aL, tid);
    for (int idx = tid; idx < 32 * 128; idx += 512) { const int s = idx >> 7, k = idx & 127; const size_t ro = (size_t)(32 * c + s) * NPAD + h * 128 + k; const float b = bL[s * 128 + k];
        qL[s * 136 + k] = f2bf(bf2f(proj[ro + C_GQ]) * __expf(b) * 0.08838834764831845f); kL[s * 136 + k] = f2bf(bf2f(proj[ro + C_GK]) * __expf(-b)); vT[k * 40 + s] = proj[ro + C_GV]; }
    __syncthreads();
    const int r = lane & 15, g = lane >> 4;
    if (wave < 4) { const int mb = wave >> 1, nb = wave & 1; f32x4 d = (f32x4){0.f, 0.f, 0.f, 0.f};
#pragma unroll
        for (int ks = 0; ks < 4; ++ks) d = mfma16(*(const LAS bf16x8*)(qL + (16 * mb + r) * 136 + 32 * ks + 8 * g), *(const LAS bf16x8*)(kL + (16 * nb + r) * 136 + 32 * ks + 8 * g), d);
#pragma unroll
        for (int j = 0; j < 4; ++j) { const int t = 16 * mb + 4 * g + j, s = 16 * nb + r; scL[t * 40 + s] = (s <= t) ? f2bf(d[j]) : (bf16_t)0; } }
    __syncthreads();
    const bf16_t* stT = (const bf16_t*)(ws + WS_GST) + (size_t)(c * 4 + h) * 16384;
#pragma unroll
    for (int mb = 0; mb < 2; ++mb) { f32x4 d = (f32x4){0.f, 0.f, 0.f, 0.f};
#pragma unroll
        for (int ks = 0; ks < 4; ++ks) d = mfma16(*(const LAS bf16x8*)(qL + (16 * mb + r) * 136 + 32 * ks + 8 * g), *(const bf16x8*)(stT + (size_t)(16 * wave + r) * 128 + 32 * ks + 8 * g), d);
        d = mfma16(*(const LAS bf16x8*)(scL + (16 * mb + r) * 40 + 8 * g), *(const LAS bf16x8*)(vT + (16 * wave + r) * 40 + 8 * g), d);
#pragma unroll
        for (int j = 0; j < 4; ++j) oL[(16 * mb + 4 * g + j) * 132 + 16 * wave + r] = d[j]; }
    __syncthreads();
    { const int t = tid >> 4, v0 = (tid & 15) * 8; float o[8]; float ss = 0.f;
#pragma unroll
        for (int e = 0; e < 8; ++e) { o[e] = oL[t * 132 + v0 + e]; ss += o[e] * o[e]; }
        ss += __shfl_xor(ss, 1); ss += __shfl_xor(ss, 2); ss += __shfl_xor(ss, 4); ss += __shfl_xor(ss, 8);
        const float rinv = rsqrtf(ss * (1.f / 128.f) + 1e-6f);
        const u32x4 rw = *(const u32x4*)(proj + (size_t)(32 * c + t) * NPAD + C_GR + h * 128 + v0); float rr[8]; unpack8(rw, rr);
        const float* ng = a.in[6] + l * 128 + v0; float res[8];
#pragma unroll
        for (int e = 0; e < 8; ++e) { const float on = o[e] * rinv * ng[e]; const float si = rr[e] / (1.f + __expf(-rr[e])); res[e] = on * si; }
        *(u32x4*)((bf16_t*)(ws + WS_OGLA) + (size_t)(32 * c + t) * 512 + h * 128 + v0) = pack8(res); }
    __syncthreads();
}

__device__ __forceinline__ void sb_unit(const KArgs& a, LAS unsigned char* lds, int h, int qb, int tid, int wave, int lane) {
    unsigned char* ws = a.ws; const bf16_t* proj = (const bf16_t*)(ws + WS_PROJ); const bf16_t* svt = (const bf16_t*)(ws + WS_SVT) + (size_t)h * 128 * M;
    constexpr int KROW = 136, VROW = 72, KT_B = 64 * KROW * 2, VT_B = 128 * VROW * 2, BUF_B = KT_B + VT_B;
    const int n = lane & 15, g = lane >> 4;
    const int tq = 128 * qb + 16 * wave + n;
    const float SC = 0.08838834764831845f * LOG2E;
    bf16x8 qf[4];
#pragma unroll
    for (int ks = 0; ks < 4; ++ks) qf[ks] = *(const bf16x8*)(proj + (size_t)tq * NPAD + C_SQ + h * 128 + 32 * ks + 8 * g);
    f32x4 O[8];
#pragma unroll
    for (int i = 0; i < 8; ++i) O[i] = (f32x4){0.f, 0.f, 0.f, 0.f};
    float carry = 1.f;
    const int ntiles = 2 * qb + 2;
    const int krow_l = 8 * (n >> 2) + (n & 3);
    u32x4 stK[2], stV[2];
    auto gload = [&](int T) {
#pragma unroll
        for (int i = 0; i < 2; ++i) { const int idx = tid + 512 * i; stK[i] = *(const u32x4*)(proj + (size_t)(64 * T + (idx >> 4)) * NPAD + C_SK + h * 128 + 8 * (idx & 15));
            stV[i] = *(const u32x4*)(svt + (size_t)(idx >> 3) * M + 64 * T + 8 * (idx & 7)); } };
    auto lstore = [&](int buf) {
#pragma unroll
        for (int i = 0; i < 2; ++i) { const int idx = tid + 512 * i; LAS unsigned char* base = lds + buf * BUF_B;
            *(LAS u32x4*)(base + ((idx >> 4) * KROW + 8 * (idx & 15)) * 2) = stK[i];
            *(LAS u32x4*)(base + KT_B + ((idx >> 3) * VROW + 8 * (idx & 7)) * 2) = stV[i]; } };
    gload(ntiles - 1); lstore(0); __syncthreads();
    const int wq_lo = 128 * qb + 16 * wave;
    for (int it = 0; it < ntiles; ++it) { const int T = ntiles - 1 - it, buf = it & 1;
        if (it + 1 < ntiles) gload(T - 1);
        if (64 * T < wq_lo + 15) {
            const LAS bf16_t* Kt = (const LAS bf16_t*)(lds + buf * BUF_B); const LAS bf16_t* Vt = (const LAS bf16_t*)(lds + buf * BUF_B + KT_B);
            const bool diag = (64 * T + 63 >= wq_lo);
#pragma unroll
            for (int cc = 1; cc >= 0; --cc) {
                f32x4 S[2];
#pragma unroll
                for (int pb = 0; pb < 2; ++pb) { f32x4 s = (f32x4){0.f, 0.f, 0.f, 0.f};
#pragma unroll
                    for (int ks = 0; ks < 4; ++ks) s = mfma16(*(const LAS bf16x8*)(Kt + (32 * cc + krow_l + 4 * pb) * KROW + 32 * ks + 8 * g), qf[ks], s);
                    S[pb] = s; }
                float beta[8], rr[8];
#pragma unroll
                for (int j = 0; j < 8; ++j) { float z = fminf(S[j >> 2][j & 3] * SC, 60.f);
                    if (diag) { const int key = 64 * T + 32 * cc + 8 * g + j; if (key >= tq) z = -1e30f; }
                    const float e = __builtin_amdgcn_exp2f(z); const float rc = __builtin_amdgcn_rcpf(1.f + e); rr[j] = rc; beta[j] = e * rc; }
                float ex[8]; ex[7] = 1.f;
#pragma unroll
                for (int j = 6; j >= 0; --j) ex[j] = ex[j + 1] * rr[j + 1];
                const float Tg = ex[0] * rr[0];
                const float t1 = __shfl_xor(Tg, 16), t2 = __shfl_xor(Tg, 32), t3 = __shfl_xor(t1, 32);
                const float gex = (g == 0) ? t1 * t2 * t3 : ((g == 1) ? t2 * t3 : ((g == 2) ? t1 : 1.f));
                const float base = gex * carry;
                carry = carry * (Tg * t1) * (t2 * t3);
                float w[8];
#pragma unroll
                for (int j = 0; j < 8; ++j) w[j] = beta[j] * ex[j] * base;
                const u32x4 pw = pack8(w); bf16x8 pf; __builtin_memcpy(&pf, &pw, 16);
#pragma unroll
                for (int db = 0; db < 8; ++db) O[db] = mfma16(*(const LAS bf16x8*)(Vt + (16 * db + n) * VROW + 32 * cc + 8 * g), pf, O[db]);
            }
        }
        if (it + 1 < ntiles) lstore(buf ^ 1);
        __syncthreads();
    }
    bf16_t* orow = (bf16_t*)(ws + WS_OSB) + (size_t)tq * 512 + h * 128;
#pragma unroll
    for (int db = 0; db < 8; ++db) { u32x2 w; w.x = cvt_pk_bf16(O[db][0], O[db][1]); w.y = cvt_pk_bf16(O[db][2], O[db][3]); *(u32x2*)(orow + 16 * db + 4 * g) = w; }
}

template <int MODE>
__device__ __forceinline__ void nsa_chunk(const bf16_t* Kb, const bf16_t* VT, int vstride, int kb, const bf16x8 (&qf)[2], const LAS float* LUT, LAS float* impq,
                                          int tq, int h, int n, int g, int qs, int qsel, float inv, float& lsum, f32x4 (&O)[4]) {
    const int krow = kb + 8 * (n >> 2) + (n & 3);
    f32x4 S[2];
#pragma unroll
    for (int pb = 0; pb < 2; ++pb) { const bf16_t* kp = Kb + (size_t)(krow + 4 * pb) * 64 + 8 * g;
        f32x4 s = mfma16(*(const bf16x8*)kp, qf[0], (f32x4){0.f, 0.f, 0.f, 0.f}); S[pb] = mfma16(*(const bf16x8*)(kp + 32), qf[1], s); }
    float p[8];
#pragma unroll
    for (int j = 0; j < 8; ++j) { const int key = kb + 8 * g + j; int dist; bool valid;
        if (MODE <= 1) { dist = tq - 16 * key - 31; valid = dist >= 0 && key <= 1022; }
        else if (MODE == 2) { dist = tq - key; valid = dist >= 0 && qs == qsel; }
        else { dist = tq - key; valid = dist >= 0 && dist < 512; }
        int di = dist < 0 ? 0 : (dist > 1023 ? 1023 : dist);
        const float bias = LUT[di * 8 + h];
        float pv = valid ? __builtin_amdgcn_exp2f(S[j >> 2][j & 3] + bias) : 0.f;
        if (MODE == 1) pv *= inv;
        p[j] = pv; if (MODE != 1) lsum += pv; }
    if (MODE == 0) return;
    if (MODE == 1) {
#pragma unroll
        for (int j = 0; j < 8; ++j) { float v = p[j]; v += __shfl_xor(v, 1); v += __shfl_xor(v, 2); v += __shfl_xor(v, 4); if (h == 0) impq[kb + 8 * g + j] = v; } }
    const u32x4 pw = pack8(p); bf16x8 pf; __builtin_memcpy(&pf, &pw, 16);
#pragma unroll
    for (int db = 0; db < 4; ++db) O[db] = mfma16(*(const bf16x8*)(VT + (size_t)(16 * db + n) * vstride + kb + 8 * g), pf, O[db]);
}
__device__ __forceinline__ float lred(float l) { l += __shfl_xor(l, 16); l += __shfl_xor(l, 32); return l; }
__device__ __forceinline__ void nsa_unit(const KArgs& a, LAS unsigned char* lds, int unit, int wave, int lane) {
    unsigned char* ws = a.ws; const bf16_t* proj = (const bf16_t*)(ws + WS_PROJ);
    const LAS float* LUT = (const LAS float*)lds;
    LAS float* imp = (LAS float*)(lds + 32768 + wave * 8192);
    LAS int* selL = (LAS int*)(lds + 98304 + wave * 128);
    const int t0 = 2 * unit, n = lane & 15, g = lane >> 4, qs = n >> 3, h = n & 7, tq = t0 + qs;
    bf16x8 qf[2];
    qf[0] = *(const bf16x8*)((const bf16_t*)(ws + WS_QN) + (size_t)tq * 512 + h * 64 + 8 * g); qf[1] = *(const bf16x8*)((const bf16_t*)(ws + WS_QN) + (size_t)tq * 512 + h * 64 + 32 + 8 * g);
    const bf16_t* gp = proj + (size_t)tq * NPAD + C_NGATE + h * 3;
    const float g0 = 1.f / (1.f + __expf(-bf2f(gp[0]))), g1 = 1.f / (1.f + __expf(-bf2f(gp[1]))), g2 = 1.f / (1.f + __expf(-bf2f(gp[2])));
    f32x4 Ot[4], Ob[4];
#pragma unroll
    for (int i = 0; i < 4; ++i) { Ot[i] = (f32x4){0.f, 0.f, 0.f, 0.f}; Ob[i] = (f32x4){0.f, 0.f, 0.f, 0.f}; }
    const int nvmax = (t0 + 1 >= 31) ? (((t0 + 1 - 31) >> 4) + 1) : 0; const int nch = (nvmax + 31) >> 5;
    const bf16_t* KC = (const bf16_t*)(ws + WS_KCMP); const bf16_t* VCT = (const bf16_t*)(ws + WS_VCMPT);
    float lsum = 0.f;
    for (int c = 0; c < nch; ++c) nsa_chunk<0>(KC, VCT, 1024, 32 * c, qf, LUT, imp + qs * 1024, tq, h, n, g, qs, 0, 0.f, lsum, Ob);
    { const float l = lred(lsum); const float inv = l > 0.f ? 1.f / l : 0.f; float dummy = 0.f;
      for (int c = 0; c < nch; ++c) nsa_chunk<1>(KC, VCT, 1024, 32 * c, qf, LUT, imp + qs * 1024, tq, h, n, g, qs, 0, inv, dummy, Ob); }
#pragma unroll
    for (int i = 0; i < 4; ++i) { Ot[i] += Ob[i] * g0; Ob[i] = (f32x4){0.f, 0.f, 0.f, 0.f}; }
    LDS_FENCE();
    for (int q2 = 0; q2 < 2; ++q2) { const int tqq = t0 + q2, cur = tqq >> 6; const LAS float* iq = imp + q2 * 1024;
        float val[4];
#pragma unroll
        for (int r = 0; r < 4; ++r) { const int b = lane + 64 * r; float v = -1.f;
            if (b >= 1 && b <= cur - 2) { v = 0.f;
#pragma unroll
                for (int i = 0; i < 5; ++i) v += iq[4 * b - 1 + i]; }
            val[r] = v; }
        int cnt = 0;
        if (lane == 0) { selL[q2 * 16 + 1] = 0; if (cur >= 1) selL[q2 * 16 + 2] = cur; if (cur >= 2) selL[q2 * 16 + 3] = cur - 1; }
        cnt = 1 + (cur >= 1) + (cur >= 2);
        int ncand = cur - 2; if (ncand < 0) ncand = 0; const int npick = ncand < 5 ? ncand : 5;
        for (int rd = 0; rd < npick; ++rd) { float bv = val[0]; int bi = lane;
#pragma unroll
            for (int r = 1; r < 4; ++r) if (val[r] > bv) { bv = val[r]; bi = lane + 64 * r; }
#pragma unroll
            for (int o = 1; o < 64; o <<= 1) { const float ov = __shfl_xor(bv, o); const int oi = __shfl_xor(bi, o); if (ov > bv || (ov == bv && oi < bi)) { bv = ov; bi = oi; } }
            if (lane == 0) selL[q2 * 16 + 1 + cnt] = bi; ++cnt;
#pragma unroll
            for (int r = 0; r < 4; ++r) if (bi == lane + 64 * r) val[r] = -2.f; }
        if (lane == 0) selL[q2 * 16] = cnt; }
    LDS_FENCE();
    lsum = 0.f;
    for (int q2 = 0; q2 < 2; ++q2) { const int cnt = __builtin_amdgcn_readfirstlane(selL[q2 * 16]);
        for (int si = 0; si < cnt; ++si) { const int b = __builtin_amdgcn_readfirstlane(selL[q2 * 16 + 1 + si]);
            nsa_chunk<2>((const bf16_t*)(ws + WS_KSN), (const bf16_t*)(ws + WS_VST), M, 64 * b, qf, LUT, imp, tq, h, n, g, qs, q2, 0.f, lsum, Ob);
            nsa_chunk<2>((const bf16_t*)(ws + WS_KSN), (const bf16_t*)(ws + WS_VST), M, 64 * b + 32, qf, LUT, imp, tq, h, n, g, qs, q2, 0.f, lsum, Ob); } }
    { const float l = lred(lsum); const float sc = l > 0.f ? g1 / l : 0.f;
#pragma unroll
      for (int i = 0; i < 4; ++i) { Ot[i] += Ob[i] * sc; Ob[i] = (f32x4){0.f, 0.f, 0.f, 0.f}; } }
    lsum = 0.f;
    { int lo = t0 - 511; if (lo < 0) lo = 0; lo &= ~31;
      for (int kb = lo; kb <= t0 + 1; kb += 32) nsa_chunk<3>((const bf16_t*)(ws + WS_KWN), (const bf16_t*)(ws + WS_VWT), M, kb, qf, LUT, imp, tq, h, n, g, qs, 0, 0.f, lsum, Ob);
      const float l = lred(lsum); const float sc = l > 0.f ? g2 / l : 0.f;
#pragma unroll
      for (int i = 0; i < 4; ++i) Ot[i] += Ob[i] * sc; }
    bf16_t* orow = (bf16_t*)(ws + WS_ONSA) + (size_t)tq * 512 + h * 64;
#pragma unroll
    for (int db = 0; db < 4; ++db) { u32x2 w; w.x = cvt_pk_bf16(Ot[db][0], Ot[db][1]); w.y = cvt_pk_bf16(Ot[db][2], Ot[db][3]); *(u32x2*)(orow + 16 * db + 4 * g) = w; }
}

#define GSYNC() cg::this_grid().sync()
__global__ void __launch_bounds__(512) fwd_mega(KArgs a) {
    extern __shared__ __attribute__((aligned(16))) unsigned char lds_raw[];
    LAS unsigned char* lds = (LAS unsigned char*)lds_raw;
    const int G = gridDim.x, bid = blockIdx.x, NGW = G * 8;
#define IDS() int tid = threadIdx.x; asm volatile("" : "+v"(tid)); const int lane = tid & 63, wave = __builtin_amdgcn_readfirstlane(tid >> 6); const int gw = bid * 8 + wave; (void)lane; (void)gw;
    unsigned char* ws = a.ws;
    bf16_t* PROJ = (bf16_t*)(ws + WS_PROJ); bf16_t* HN = (bf16_t*)(ws + WS_HN); bf16_t* HID = (bf16_t*)(ws + WS_HID);
#pragma unroll 1
    for (int l = 0; l < DEPTH; ++l) {
        const float* xsrc = (l == 0) ? a.in[0] : a.out;
        { IDS(); phase_convert(a, l, lds, gw, NGW, wave, lane);
          phase_rms(xsrc, a.in[1] + l * DM, HN, gw, NGW, lane); }
        GSYNC();
        { pg8::Gemm g{HN, (const bf16_t*)(ws + WS_WIN), M, NPAD, DM}; pg8::StaticOrder S; S.init(M, NPAD, G, bid);
          pg8::EpiBf16<0> E{PROJ, NPAD};
          pg8::gemm_phase<pg8::EpiBf16<0>, pg8::StaticOrder, true, true>(lds, g, S, E); }
        GSYNC();
        { IDS(); for (int it = bid; it < 256; it += G) pre_item(a, l, lds, it, tid); }
        { IDS(); for (int it = bid; it < 128; it += G) cmp_item(a, l, lds, it, tid, wave, lane); }
        { IDS(); for (int it = bid; it < 2048; it += G) gla_g1_item(a, l, lds, it, tid, wave, lane); }
        GSYNC();
        {   IDS();
            { const float* lg = (const float*)(ws + WS_LUT); LAS float* LUT = (LAS float*)lds; for (int i = tid; i < 8192; i += 512) LUT[i] = lg[i]; }
            LAS int* ctr = (LAS int*)(lds + 99328);
            if (tid == 0) *ctr = 0;
            __syncthreads();
            if (wave < 4) for (int c0 = (bid * 4 + wave) * 64; c0 < 65536; c0 += G * 256) gla_scan(a, c0 + lane);
            const int nper = (8192 + G - 1) / G;
            for (;;) { int idx = 0; if (lane == 0) idx = atomicAdd((int*)ctr, 1); idx = __builtin_amdgcn_readfirstlane(idx);
                if (idx >= nper) break; const int unit = bid + G * (nper - 1 - idx); if (unit < 8192) nsa_unit(a, lds, unit, wave, lane); }
            __syncthreads();
        }
        GSYNC();
        { IDS(); for (int idx = bid; idx < 512; idx += G) { int h, qb; if (idx < 256) { h = idx & 3; qb = 127 - (idx >> 2); } else { const int j = idx - 256; h = j & 3; qb = j >> 2; }
            sb_unit(a, lds, h, qb, tid, wave, lane); } }
        { IDS(); for (int it = bid; it < 2048; it += G) gla_g3_item(a, l, lds, it, tid, wave, lane); }
        GSYNC();
        for (int b = 0; b < 3; ++b) {
            pg8::Gemm g{(const bf16_t*)(ws + WS_OGLA + b * 16 * MiB), (const bf16_t*)(ws + WS_WBR + b * MiB), M, DM, 512}; pg8::StaticOrder S; S.init(M, DM, G, bid);
            pg8::EpiGate E{HN, PROJ + C_MGATE + b * DM, NPAD, b == 0 ? 1 : 0};
            pg8::gemm_phase<pg8::EpiGate, pg8::StaticOrder, true, true>(lds, g, S, E); }
        GSYNC();
        { pg8::Gemm g{HN, (const bf16_t*)(ws + WS_WOUT), M, DM, DM}; pg8::StaticOrder S; S.init(M, DM, G, bid);
          pg8::EpiRes E{xsrc, a.out};
          pg8::gemm_phase<pg8::EpiRes, pg8::StaticOrder, true, true>(lds, g, S, E); }
        GSYNC();
        { IDS(); phase_rms(a.out, a.in[2] + l * DM, HN, gw, NGW, lane); }
        GSYNC();
        { pg8::Gemm g{HN, (const bf16_t*)(ws + WS_WUP), M, FF, DM}; pg8::StaticOrder S; S.init(M, FF, G, bid);
          pg8::EpiBf16<2> E{HID, FF};
          pg8::gemm_phase<pg8::EpiBf16<2>, pg8::StaticOrder, true, true>(lds, g, S, E); }
        GSYNC();
        { pg8::Gemm g{HID, (const bf16_t*)(ws + WS_WDN), M, DM, FF}; pg8::StaticOrder S; S.init(M, DM, G, bid);
          pg8::EpiRes E{a.out, a.out};
          pg8::gemm_phase<pg8::EpiRes, pg8::StaticOrder, true, true>(lds, g, S, E); }
        GSYNC();
    }
}

extern "C" void kernel_launch(void* const* d_in, const int* in_sizes, int n_in, void* d_out, int out_size, void* d_ws, size_t ws_size, hipStream_t stream) {
    static int grid = 0;
    if (grid == 0) {
        if (n_in != 22 || ws_size < WS_END) { fprintf(stderr, "kernel_launch: unexpected n_in %d or ws_size %zu (< %zu)\n", n_in, ws_size, (size_t)WS_END); grid = -1; return; }
        int dev = 0, cus = 0, per_cu = 0;
        hipGetDevice(&dev); hipDeviceGetAttribute(&cus, hipDeviceAttributeMultiprocessorCount, dev);
        hipFuncSetAttribute((const void*)fwd_mega, hipFuncAttributeMaxDynamicSharedMemorySize, LDS_BYTES);
        hipOccupancyMaxActiveBlocksPerMultiprocessor(&per_cu, (const void*)fwd_mega, 512, LDS_BYTES);
        if (per_cu < 1) { fprintf(stderr, "kernel_launch: occupancy query says %d blocks/CU\n", per_cu); per_cu = 1; }
        (void)hipGetLastError();
        grid = cus * 1;
    }
    if (grid < 0) return;
    KArgs a{};
    for (int i = 0; i < 22; ++i) a.in[i] = (const float*)d_in[i];
    a.out = (float*)d_out; a.ws = (unsigned char*)d_ws;
    void* args[] = {&a};
    hipError_t e = hipLaunchCooperativeKernel((const void*)fwd_mega, dim3(grid), dim3(512), args, LDS_BYTES, stream);
    if (e != hipSuccess) fprintf(stderr, "cooperative launch failed: %s (grid %d)\n", hipGetErrorString(e), grid);
}
```

```cpp
#include <hip/hip_runtime.h>
#include <hip/hip_cooperative_groups.h>
#include <cstdio>
#include <cstdint>
namespace cg = cooperative_groups;
namespace pg8 {
#define PG8_LAS __attribute__((address_space(3)))
typedef unsigned short bf16_t;
typedef short bf16x8 __attribute__((ext_vector_type(8)));
typedef float f32x4 __attribute__((ext_vector_type(4)));
typedef unsigned u32x4 __attribute__((ext_vector_type(4)));
constexpr int BM = 256, BK = 64, HALF = 128, HTB = HALF * BK * 2  , STAGE_BYTES = 8 * HTB, NXCD = 8, WGM = 8;

__host__ __device__ __forceinline__ int lds_byte(int r, int c) { const int st = (r >> 4) * 2 + (c >> 5), rr = r & 15, cc = c & 31, ob = rr * 64 + cc * 2; return st * 1024 + (ob ^ (((ob >> 9) & 1) << 5)); }
__host__ __device__ __forceinline__ void stage_rc(int b, int& R, int& C) { const int st = b / 1024, sb = b % 1024, swz = sb ^ (((sb >> 9) & 1) << 5); R = (st >> 1) * 16 + swz / 64; C = (st & 1) * 32 + (swz % 64) / 2; }
__host__ __device__ __forceinline__ int perm32(int rho) { const int n = rho >> 4, i = rho & 15; return 8 * (i >> 2) + 4 * n + (i & 3); }

struct Unit { int pm, pn; };
struct Gemm { const bf16_t* A; const bf16_t* Bt; int M, N, K; };

struct StaticOrder {
    int nM, nN, nwg, G, c;
    __host__ __device__ void init(int M, int N, int G_, int c_) { nM = M / BM; nN = N / BM; nwg = nM * nN; G = G_; c = c_; }
    __host__ __device__ bool next(int i, Unit& u) const {
        const long L = (long)i * G + c; if (L >= nwg) return false;
        int wgid = (int)L; { const int q = nwg / NXCD, r = nwg % NXCD, xcd = wgid % NXCD, off = wgid / NXCD; wgid = (xcd < r ? xcd * (q + 1) : r * (q + 1) + (xcd - r) * q) + off; }
        const int nig = WGM * nN, gid = wgid / nig, fm = gid * WGM, gsz = (nM - fm) < WGM ? (nM - fm) : WGM;
        u.pm = fm + ((wgid % nig) % gsz); u.pn = (wgid % nig) / gsz; return true;
    }
    __device__ __forceinline__ void a_ready(const Unit&) const {}
    __device__ __forceinline__ void done(const Unit&) const {}
};

__device__ __forceinline__ unsigned cvt_pk_bf16(float lo, float hi) { unsigned r; asm volatile("v_cvt_pk_bf16_f32 %0, %1, %2" : "=v"(r) : "v"(lo), "v"(hi)); return r; }
__device__ __forceinline__ float bflo(unsigned w) { return __uint_as_float(w << 16); }
__device__ __forceinline__ float bfhi(unsigned w) { return __uint_as_float(w & 0xffff0000u); }
template <int ACT> struct EpiBf16 {
    static constexpr bool PERM = true, AFTER_DRAIN = false;
    bf16_t* O; int ldc;
    __device__ __forceinline__ void operator()(const f32x4 (&acc)[2][2][4][2], const Unit& u, int wr, int wc, int fr, int fq) const {
        const int row0 = u.pm * BM + wr * 64 + fr; const int col0 = u.pn * BM + wc * 32 + 8 * fq;
#pragma unroll
        for (int ai = 0; ai < 2; ++ai)
#pragma unroll
            for (int m = 0; m < 4; ++m) { bf16_t* rowp = O + (size_t)(row0 + ai * HALF + m * 16) * ldc + col0;
#pragma unroll
                for (int bj = 0; bj < 2; ++bj) { f32x4 v0 = acc[ai][bj][m][0], v1 = acc[ai][bj][m][1];
                    if (ACT == 2) {
#pragma unroll
                        for (int e = 0; e < 4; ++e) { float a = fmaxf(v0[e], 0.f), b = fmaxf(v1[e], 0.f); v0[e] = a * a; v1[e] = b * b; } }
                    u32x4 w; w.x = cvt_pk_bf16(v0[0], v0[1]); w.y = cvt_pk_bf16(v0[2], v0[3]); w.z = cvt_pk_bf16(v1[0], v1[1]); w.w = cvt_pk_bf16(v1[2], v1[3]);
                    *(u32x4*)(rowp + bj * HALF) = w; } }
    }
};
struct EpiGate {
    static constexpr bool PERM = true, AFTER_DRAIN = false;
    bf16_t* O; const bf16_t* gate; int gld; int first;
    __device__ __forceinline__ void operator()(const f32x4 (&acc)[2][2][4][2], const Unit& u, int wr, int wc, int fr, int fq) const {
        const int row0 = u.pm * BM + wr * 64 + fr; const int col0 = u.pn * BM + wc * 32 + 8 * fq;
#pragma unroll
        for (int ai = 0; ai < 2; ++ai)
#pragma unroll
            for (int m = 0; m < 4; ++m) { const int row = row0 + ai * HALF + m * 16; bf16_t* rowp = O + (size_t)row * 1024 + col0; const bf16_t* gp = gate + (size_t)row * gld + col0;
#pragma unroll
                for (int bj = 0; bj < 2; ++bj) { const f32x4 v0 = acc[ai][bj][m][0], v1 = acc[ai][bj][m][1];
                    const u32x4 gw = *(const u32x4*)(gp + bj * HALF);
                    u32x4 ow = (u32x4){0u, 0u, 0u, 0u}; if (!first) ow = *(const u32x4*)(rowp + bj * HALF);
                    float gv[8] = {bflo(gw.x), bfhi(gw.x), bflo(gw.y), bfhi(gw.y), bflo(gw.z), bfhi(gw.z), bflo(gw.w), bfhi(gw.w)};
                    float ov[8] = {bflo(ow.x), bfhi(ow.x), bflo(ow.y), bfhi(ow.y), bflo(ow.z), bfhi(ow.z), bflo(ow.w), bfhi(ow.w)};
                    float av[8] = {v0[0], v0[1], v0[2], v0[3], v1[0], v1[1], v1[2], v1[3]};
                    float r[8];
#pragma unroll
                    for (int e = 0; e < 8; ++e) { const float s = 1.f / (1.f + __expf(-gv[e])); r[e] = ov[e] + s * av[e]; }
                    u32x4 w; w.x = cvt_pk_bf16(r[0], r[1]); w.y = cvt_pk_bf16(r[2], r[3]); w.z = cvt_pk_bf16(r[4], r[5]); w.w = cvt_pk_bf16(r[6], r[7]);
                    *(u32x4*)(rowp + bj * HALF) = w; } }
    }
};
struct EpiRes {
    static constexpr bool PERM = false, AFTER_DRAIN = false;
    const float* src; float* out;
    __device__ __forceinline__ void operator()(const f32x4 (&acc)[2][2][4][2], const Unit& u, int wr, int wc, int fr, int fq) const {
        const int col0 = u.pn * BM + wc * 32 + 4 * fq;
#pragma unroll
        for (int ai = 0; ai < 2; ++ai)
#pragma unroll
            for (int m = 0; m < 4; ++m) { const size_t off = (size_t)(u.pm * BM + ai * HALF + wr * 64 + m * 16 + fr) * 1024 + col0;
#pragma unroll
                for (int bj = 0; bj < 2; ++bj)
#pragma unroll
                    for (int n = 0; n < 2; ++n) { const f32x4 bs = *(const f32x4*)(src + off + bj * HALF + n * 16); *(f32x4*)(out + off + bj * HALF + n * 16) = bs + acc[ai][bj][m][n]; } }
    }
};
template <class Epi, class Sched, bool ALIGN_EPI = false, bool SP2 = false>
__device__ __forceinline__ void gemm_phase(PG8_LAS unsigned char* lds, const Gemm g, const Sched& S, const Epi& E) {
    int tid_ = threadIdx.x; asm volatile("" : "+v"(tid_));
    const int tid = tid_, wid = __builtin_amdgcn_readfirstlane(tid >> 6), lane = tid & 63, wr = wid >> 2, wc = wid & 3, fr = lane & 15, fq = lane >> 4;
    const int K = g.K, nt = K / BK;
    unsigned voffA[2], voffB[2];
#pragma unroll
    for (int i = 0; i < 2; ++i) { int R, C; stage_rc(tid * 16 + i * 8192, R, C); const int Rb = Epi::PERM ? ((R & ~31) + perm32(R & 31)) : R;
        voffA[i] = (unsigned)(R * K + C) * 2u; voffB[i] = (unsigned)(Rb * K + C) * 2u; }
    const size_t kstep = (size_t)(BK * 2);
    const size_t hstep = (size_t)HALF * K * 2;
    const size_t tstep = 2 * hstep;
    const unsigned ldsw = (unsigned)wid * 1024u;
    const int aoff = lds_byte(wr * 64 + fr, fq * 8), boff = lds_byte(wc * 32 + fr, fq * 8);
#define PG8_SA(b, h) (((b) * 2 + (h)) * HTB)
#define PG8_SB(b, h) ((4 + (b) * 2 + (h)) * HTB)
#define PG8_STAGE(bufoff, gbase, voff) do { _Pragma("unroll") for (int _i = 0; _i < 2; ++_i) \
        __builtin_amdgcn_global_load_lds((const unsigned*)((const char*)(gbase) + (voff)[_i]), (PG8_LAS unsigned*)(lds + (bufoff) + ldsw + _i * 8192), 16, 0, 0); } while (0)
#define PG8_LDA(dst, b, h) do { _Pragma("unroll") for (int m = 0; m < 4; ++m) _Pragma("unroll") for (int k = 0; k < 2; ++k) dst[m][k] = *(const PG8_LAS bf16x8*)(lds + PG8_SA(b, h) + aoff + m * 2048 + k * 1024); } while (0)
#define PG8_LDB(dst, b, h) do { _Pragma("unroll") for (int n = 0; n < 2; ++n) _Pragma("unroll") for (int k = 0; k < 2; ++k) dst[n][k] = *(const PG8_LAS bf16x8*)(lds + PG8_SB(b, h) + boff + n * 2048 + k * 1024); } while (0)
#define PG8_MMA(ai, bj, At, Bt) do { __builtin_amdgcn_s_setprio(1); _Pragma("unroll") for (int m = 0; m < 4; ++m) _Pragma("unroll") for (int n = 0; n < 2; ++n) _Pragma("unroll") for (int k = 0; k < 2; ++k) \
        acc[ai][bj][m][n] = __builtin_amdgcn_mfma_f32_16x16x32_bf16(Bt[n][k], At[m][k], acc[ai][bj][m][n], 0, 0, 0); __builtin_amdgcn_s_setprio(0); } while (0)
#define PG8_WAIT_V(n) asm volatile("s_waitcnt vmcnt(" #n ")" ::: "memory")
#define PG8_WAIT_L(n) asm volatile("s_waitcnt lgkmcnt(" #n ")" ::: "memory")
#define PG8_BAR __builtin_amdgcn_s_barrier()
#define PG8_SCHED __builtin_amdgcn_sched_barrier(0)
    Unit cur, nxt; int ui = 0;
    if (!S.next(0, cur)) return;
    f32x4 acc[2][2][4][2];
#pragma unroll
    for (int a = 0; a < 2; ++a)
#pragma unroll
        for (int b = 0; b < 2; ++b)
#pragma unroll
            for (int m = 0; m < 4; ++m)
#pragma unroll
                for (int n = 0; n < 2; ++n) acc[a][b][m][n] = (f32x4){0.f, 0.f, 0.f, 0.f};
    bf16x8 At[4][2], B0[2][2], B1[2][2];
    const char* cA = (const char*)g.A + (size_t)cur.pm * tstep; const char* cB = (const char*)g.Bt + (size_t)cur.pn * tstep;
    S.a_ready(cur);
    if constexpr (SP2) {
        PG8_STAGE(PG8_SB(0, 0), cB, voffB); PG8_STAGE(PG8_SB(0, 1), cB + hstep, voffB); PG8_STAGE(PG8_SA(0, 0), cA, voffA); PG8_STAGE(PG8_SA(0, 1), cA + hstep, voffA);
        if (wr == 1) PG8_BAR;
        PG8_WAIT_V(2); PG8_BAR;
        PG8_STAGE(PG8_SB(1, 0), cB + kstep, voffB); PG8_STAGE(PG8_SA(1, 0), cA + kstep, voffA); PG8_STAGE(PG8_SB(1, 1), cB + hstep + kstep, voffB);
        PG8_WAIT_V(6); PG8_BAR;
    } else {
        PG8_STAGE(PG8_SB(0, 0), cB, voffB); PG8_STAGE(PG8_SA(0, 0), cA, voffA); PG8_STAGE(PG8_SB(0, 1), cB + hstep, voffB); PG8_STAGE(PG8_SA(0, 1), cA + hstep, voffA);
        if (wr == 1) PG8_BAR;
        PG8_WAIT_V(4); PG8_BAR;
        PG8_STAGE(PG8_SB(1, 0), cB + kstep, voffB); PG8_STAGE(PG8_SA(1, 0), cA + kstep, voffA); PG8_STAGE(PG8_SB(1, 1), cB + hstep + kstep, voffB);
        PG8_WAIT_V(6); PG8_BAR;
    }
    for (;;) {
        const bool has_next = S.next(ui + 1, nxt);
        const char* nA = has_next ? (const char*)g.A + (size_t)nxt.pm * tstep : cA; const char* nB = has_next ? (const char*)g.Bt + (size_t)nxt.pn * tstep : cB;
        for (int t = 0; t < nt; t += 2) {
            const bool last = (t == nt - 2);
            const char* a1 = cA + (size_t)(t + 1) * kstep;
            const char* a2 = last ? nA : cA + (size_t)(t + 2) * kstep; const char* b2 = last ? nB : cB + (size_t)(t + 2) * kstep;
            const char* a3 = a2 + kstep; const char* b3 = b2 + kstep;
            if (last && has_next) S.a_ready(nxt);
            if constexpr (SP2) {
            PG8_LDB(B0, 0, 0); PG8_LDB(B1, 0, 1); PG8_SCHED; PG8_LDA(At, 0, 0); PG8_STAGE(PG8_SA(1, 1), a1 + hstep, voffA);
            PG8_WAIT_V(8); PG8_WAIT_L(0); PG8_BAR; PG8_MMA(0, 0, At, B0); PG8_MMA(0, 1, At, B1); PG8_BAR; PG8_SCHED;
            PG8_LDA(At, 0, 1); PG8_STAGE(PG8_SB(0, 0), b2, voffB); PG8_STAGE(PG8_SB(0, 1), b2 + hstep, voffB); PG8_STAGE(PG8_SA(0, 0), a2, voffA);
            PG8_WAIT_V(8); PG8_WAIT_L(0); PG8_BAR; PG8_MMA(1, 0, At, B0); PG8_MMA(1, 1, At, B1); PG8_BAR; PG8_SCHED;
            PG8_LDB(B0, 1, 0); PG8_LDB(B1, 1, 1); PG8_SCHED; PG8_LDA(At, 1, 0); PG8_STAGE(PG8_SA(0, 1), a2 + hstep, voffA);
            PG8_WAIT_V(8); PG8_WAIT_L(0); PG8_BAR; PG8_MMA(0, 0, At, B0); PG8_MMA(0, 1, At, B1); PG8_BAR; PG8_SCHED;
            PG8_LDA(At, 1, 1); PG8_STAGE(PG8_SB(1, 0), b3, voffB); PG8_STAGE(PG8_SB(1, 1), b3 + hstep, voffB); PG8_STAGE(PG8_SA(1, 0), a3, voffA);
            PG8_WAIT_V(8); PG8_WAIT_L(0); PG8_BAR; PG8_MMA(1, 0, At, B0); PG8_MMA(1, 1, At, B1); PG8_BAR; PG8_SCHED;
            } else {
            PG8_LDB(B0, 0, 0); PG8_SCHED; PG8_LDA(At, 0, 0); PG8_STAGE(PG8_SA(1, 1), a1 + hstep, voffA);
            PG8_WAIT_L(8); PG8_BAR; PG8_WAIT_L(0); PG8_MMA(0, 0, At, B0); PG8_BAR; PG8_SCHED;
            PG8_LDB(B1, 0, 1); PG8_STAGE(PG8_SB(0, 0), b2, voffB);
            PG8_BAR; PG8_WAIT_L(0); PG8_MMA(0, 1, At, B1); PG8_BAR;
            PG8_LDA(At, 0, 1); PG8_STAGE(PG8_SA(0, 0), a2, voffA);
            PG8_BAR; PG8_WAIT_L(0); PG8_MMA(1, 0, At, B0); PG8_BAR; PG8_SCHED;
            PG8_STAGE(PG8_SB(0, 1), b2 + hstep, voffB);
            PG8_WAIT_V(6); PG8_BAR; PG8_MMA(1, 1, At, B1); PG8_BAR;
            PG8_LDB(B0, 1, 0); PG8_SCHED; PG8_LDA(At, 1, 0); PG8_STAGE(PG8_SA(0, 1), a2 + hstep, voffA);
            PG8_WAIT_L(8); PG8_BAR; PG8_WAIT_L(0); PG8_MMA(0, 0, At, B0); PG8_BAR; PG8_SCHED;
            PG8_LDB(B1, 1, 1); PG8_STAGE(PG8_SB(1, 0), b3, voffB);
            PG8_BAR; PG8_WAIT_L(0); PG8_MMA(0, 1, At, B1); PG8_BAR;
            PG8_LDA(At, 1, 1); PG8_STAGE(PG8_SA(1, 0), a3, voffA);
            PG8_BAR; PG8_WAIT_L(0); PG8_MMA(1, 0, At, B0); PG8_BAR; PG8_SCHED;
            PG8_STAGE(PG8_SB(1, 1), b3 + hstep, voffB);
            PG8_WAIT_V(6); PG8_BAR; PG8_MMA(1, 1, At, B1); PG8_BAR;
            }
        }
        if constexpr (ALIGN_EPI) { if (wr == 0) PG8_BAR; }
        if constexpr (!Epi::AFTER_DRAIN) { E(acc, cur, wr, wc, fr, fq); S.done(cur); }
        if (!has_next) break;
#pragma unroll
        for (int a = 0; a < 2; ++a)
#pragma unroll
            for (int b = 0; b < 2; ++b)
#pragma unroll
                for (int m = 0; m < 4; ++m)
#pragma unroll
                    for (int n = 0; n < 2; ++n) acc[a][b][m][n] = (f32x4){0.f, 0.f, 0.f, 0.f};
        cur = nxt; cA = nA; cB = nB; ++ui;
        if constexpr (ALIGN_EPI) { if (wr == 1) PG8_BAR; }
    }
    PG8_WAIT_V(0);
    if constexpr (!ALIGN_EPI) { if (wr == 0) PG8_BAR; }
    PG8_BAR;
    if constexpr (Epi::AFTER_DRAIN) { E.fused(acc, cur, wr, wc, fr, fq, lds, wid, lane); S.done(cur); }
#undef PG8_SA
#undef PG8_SB
#undef PG8_STAGE
#undef PG8_LDA
#undef PG8_LDB
#undef PG8_MMA
#undef PG8_WAIT_V
#undef PG8_WAIT_L
#undef PG8_BAR
#undef PG8_SCHED
}
}

#define LAS __attribute__((address_space(3)))
typedef unsigned short bf16_t;
typedef short bf16x8 __attribute__((ext_vector_type(8)));
typedef float f32x4 __attribute__((ext_vector_type(4)));
typedef unsigned u32x4 __attribute__((ext_vector_type(4)));
typedef unsigned u32x2 __attribute__((ext_vector_type(2)));
using pg8::cvt_pk_bf16; using pg8::bflo; using pg8::bfhi;

constexpr int M = 16384, DM = 1024, NIN = 7592, NPAD = 7680, FF = 4096, DEPTH = 4;
constexpr int C_GQ = 0, C_GK = 512, C_GV = 1024, C_GA = 1536, C_GR = 1552, C_SQ = 2064, C_SK = 2576, C_SV = 3088, C_NQ = 3600, C_NKC = 4112, C_NVC = 4176,
              C_NKS = 4240, C_NVS = 4304, C_NKW = 4368, C_NVW = 4432, C_NGATE = 4496, C_MGATE = 4520;
constexpr size_t MiB = 1u << 20;
constexpr size_t WS_PROJ = 0, WS_HID = 0, WS_HN = 240 * MiB, WS_OGLA = 272 * MiB, WS_OSB = 288 * MiB, WS_ONSA = 304 * MiB;
constexpr size_t WS_WIN = 320 * MiB, WS_WUP = 335 * MiB, WS_WDN = 343 * MiB, WS_WOUT = 351 * MiB, WS_WBR = 353 * MiB, WS_WK1 = 356 * MiB, WS_WV1 = 357 * MiB,
                 WS_WK2 = 358 * MiB, WS_WV2 = 358 * MiB + 65536, WS_CB = 358 * MiB + 131072, WS_LUT = 358 * MiB + 196608;
constexpr size_t WS_GST = 360 * MiB, WS_GDC = 424 * MiB, WS_SVT = 425 * MiB, WS_QN = 441 * MiB, WS_KSN = 457 * MiB, WS_KWN = 459 * MiB, WS_VST = 461 * MiB, WS_VWT = 463 * MiB,
                 WS_KCMP = 465 * MiB, WS_VCMPT = 465 * MiB + 131072, WS_END = 466 * MiB;
constexpr int LDS_BYTES = 133120;
constexpr float LOG2E = 1.4426950408889634f;

struct KArgs { const float* in[22]; float* out; unsigned char* ws; };

__device__ __forceinline__ float bf2f(bf16_t v) { return __uint_as_float(((unsigned)v) << 16); }
__device__ __forceinline__ bf16_t f2bf(float f) { unsigned u = __float_as_uint(f); return (bf16_t)((u + 0x7fffu + ((u >> 16) & 1u)) >> 16); }
__device__ __forceinline__ f32x4 mfma16(bf16x8 a, bf16x8 b, f32x4 c) { return __builtin_amdgcn_mfma_f32_16x16x32_bf16(a, b, c, 0, 0, 0); }
__device__ __forceinline__ float wave_sum(float v) {
#pragma unroll
    for (int o = 1; o < 64; o <<= 1) v += __shfl_xor(v, o);
    return v;
}
#define LDS_FENCE() asm volatile("s_waitcnt lgkmcnt(0)" ::: "memory")
__device__ __forceinline__ void unpack8(const u32x4 w, float (&f)[8]) { f[0] = bflo(w.x); f[1] = bfhi(w.x); f[2] = bflo(w.y); f[3] = bfhi(w.y); f[4] = bflo(w.z); f[5] = bfhi(w.z); f[6] = bflo(w.w); f[7] = bfhi(w.w); }
__device__ __forceinline__ u32x4 pack8(const float (&r)[8]) { u32x4 w; w.x = cvt_pk_bf16(r[0], r[1]); w.y = cvt_pk_bf16(r[2], r[3]); w.z = cvt_pk_bf16(r[4], r[5]); w.w = cvt_pk_bf16(r[6], r[7]); return w; }

__device__ __forceinline__ void transpose_item(const float* W, int K, int N, int Npad, bf16_t* WT, LAS float* scr, int item, int lane) {
    const int nblk = Npad / 32, kb = item / nblk, nb = item % nblk, k0 = 64 * kb, n0 = 32 * nb;
    const int nn = n0 + (lane & 31);
#pragma unroll 8
    for (int i = 0; i < 32; ++i) { const int kk = 2 * i + (lane >> 5); scr[kk * 33 + (lane & 31)] = (nn < N) ? W[(size_t)(k0 + kk) * N + nn] : 0.f; }
    LDS_FENCE();
    const int c = lane & 7;
#pragma unroll
    for (int j = 0; j < 4; ++j) { const int n = (lane >> 3) + 8 * j; const LAS float* s = scr + (8 * c) * 33 + n;
        u32x4 o; o.x = cvt_pk_bf16(s[0 * 33], s[1 * 33]); o.y = cvt_pk_bf16(s[2 * 33], s[3 * 33]); o.z = cvt_pk_bf16(s[4 * 33], s[5 * 33]); o.w = cvt_pk_bf16(s[6 * 33], s[7 * 33]);
        *(u32x4*)(WT + (size_t)(n0 + n) * K + k0 + 8 * c) = o; }
    LDS_FENCE();
}
__device__ __forceinline__ int rel_bucket(int n) {
    if (n < 16) return n;
    int large = 16 + (int)(logf((float)n / 16.f) / 4.1588830833596715f * 16.f);
    return large < 31 ? large : 31;
}
__device__ __forceinline__ void rms_row(const float* xrow, const float* g, bf16_t* orow, int lane) {
    const f32x4* xr = (const f32x4*)xrow + lane; f32x4 v[4]; float s = 0.f;
#pragma unroll
    for (int j = 0; j < 4; ++j) { v[j] = xr[64 * j]; s += (v[j].x * v[j].x + v[j].y * v[j].y) + (v[j].z * v[j].z + v[j].w * v[j].w); }
    const float rinv = rsqrtf(wave_sum(s) * (1.f / 1024.f) + 1e-6f);
    u32x2* o8 = (u32x2*)orow + lane;
#pragma unroll
    for (int j = 0; j < 4; ++j) { const f32x4 gg = ((const f32x4*)g)[lane + 64 * j]; u32x2 w; w.x = cvt_pk_bf16(v[j].x * rinv * gg.x, v[j].y * rinv * gg.y); w.y = cvt_pk_bf16(v[j].z * rinv * gg.z, v[j].w * rinv * gg.w); o8[64 * j] = w; }
}
__device__ __forceinline__ void phase_convert(const KArgs& a, int l, LAS unsigned char* lds, int gw, int NGW, int wave, int lane) {
    unsigned char* ws = a.ws;
    LAS float* scr = (LAS float*)(lds + wave * 8704);
    constexpr int I0 = 16 * 240, I1 = 16 * 128, I2 = 64 * 32, I3 = 16 * 32, I4 = 8 * 32, I7 = 32 * 8, I9 = 4 * 2, IB = 128, IL = 128;
    constexpr int NIT = I0 + I1 + I2 + I3 + 3 * I4 + 2 * I7 + 2 * I9 + IB + IL;
    for (int it = gw; it < NIT; it += NGW) {
        int r = it;
        if (r < I0) { transpose_item(a.in[3] + (size_t)l * DM * NIN, DM, NIN, NPAD, (bf16_t*)(ws + WS_WIN), scr, r, lane); continue; } r -= I0;
        if (r < I1) { transpose_item(a.in[20] + (size_t)l * DM * FF, DM, FF, FF, (bf16_t*)(ws + WS_WUP), scr, r, lane); continue; } r -= I1;
        if (r < I2) { transpose_item(a.in[21] + (size_t)l * FF * DM, FF, DM, DM, (bf16_t*)(ws + WS_WDN), scr, r, lane); continue; } r -= I2;
        if (r < I3) { transpose_item(a.in[19] + (size_t)l * DM * DM, DM, DM, DM, (bf16_t*)(ws + WS_WOUT), scr, r, lane); continue; } r -= I3;
        if (r < 3 * I4) { const int b = r / I4; transpose_item(a.in[16 + b] + (size_t)l * 512 * DM, 512, DM, DM, (bf16_t*)(ws + WS_WBR + b * MiB), scr, r % I4, lane); continue; } r -= 3 * I4;
        if (r < I7) { transpose_item(a.in[11] + (size_t)l * 2048 * 256, 2048, 256, 256, (bf16_t*)(ws + WS_WK1), scr, r, lane); continue; } r -= I7;
        if (r < I7) { transpose_item(a.in[13] + (size_t)l * 2048 * 256, 2048, 256, 256, (bf16_t*)(ws + WS_WV1), scr, r, lane); continue; } r -= I7;
        if (r < I9) { transpose_item(a.in[12] + (size_t)l * 256 * 64, 256, 64, 64, (bf16_t*)(ws + WS_WK2), scr, r, lane); continue; } r -= I9;
        if (r < I9) { transpose_item(a.in[14] + (size_t)l * 256 * 64, 256, 64, 64, (bf16_t*)(ws + WS_WV2), scr, r, lane); continue; } r -= I9;
        if (r < IB) {
            const int p = r >> 3, which = (r >> 2) & 1, col = (r & 3) * 64 + lane;
            const float* pe = a.in[which ? 10 : 9] + (size_t)l * 2048; const float* w1 = a.in[which ? 13 : 11] + (size_t)l * 2048 * 256;
            float s = 0.f;
#pragma unroll 1
            for (int k0 = 128 * p; k0 < 128 * p + 128; k0 += 16) { float wv[16];
#pragma unroll
                for (int i = 0; i < 16; ++i) wv[i] = w1[(size_t)(k0 + i) * 256 + col];
#pragma unroll
                for (int i = 0; i < 16; ++i) s += pe[k0 + i] * wv[i]; }
            ((float*)(ws + WS_CB))[p * 512 + which * 256 + col] = s; continue; } r -= IB;
        {
            const int idx = r * 64 + lane; const int d = idx >> 3, h = idx & 7;
            ((float*)(ws + WS_LUT))[idx] = a.in[15][rel_bucket(d) * 8 + h] * LOG2E; }
    }
}
__device__ __forceinline__ void phase_rms(const float* x, const float* g, bf16_t* hn, int gw, int NGW, int lane) {
    for (int m = gw; m < M; m += NGW) rms_row(x + (size_t)m * DM, g, hn + (size_t)m * DM, lane);
}

__device__ __forceinline__ void rms64_to(const bf16_t* src, const float* g, float scale, bf16_t* dst) {
    u32x4 w[8]; float ss = 0.f;
#pragma unroll
    for (int i = 0; i < 8; ++i) { w[i] = ((const u32x4*)src)[i]; float f[8]; unpack8(w[i], f);
#pragma unroll
        for (int e = 0; e < 8; ++e) ss += f[e] * f[e]; }
    const float rinv = rsqrtf(ss * (1.f / 64.f) + 1e-6f) * scale;
#pragma unroll
    for (int i = 0; i < 8; ++i) { float f[8]; unpack8(w[i], f); float r[8];
#pragma unroll
        for (int e = 0; e < 8; ++e) r[e] = f[e] * rinv * g[8 * i + e];
        ((u32x4*)dst)[i] = pack8(r); }
}
__device__ __forceinline__ void pre_item(const KArgs& a, int l, LAS unsigned char* lds, int item, int tid) {
    unsigned char* ws = a.ws; const bf16_t* proj = (const bf16_t*)(ws + WS_PROJ);
    const int t0 = item * 64;
    {
        const int tl = tid >> 3, h = tid & 7;
        rms64_to(proj + (size_t)(t0 + tl) * NPAD + C_NQ + h * 64, a.in[7] + l * 64, 0.125f * LOG2E, (bf16_t*)(ws + WS_QN) + (size_t)(t0 + tl) * 512 + h * 64);
    }
    if (tid < 128) {
        const int tl = tid >> 1, which = tid & 1;
        rms64_to(proj + (size_t)(t0 + tl) * NPAD + (which ? C_NKW : C_NKS), a.in[8] + l * 64, 1.f, (bf16_t*)(ws + (which ? WS_KWN : WS_KSN)) + (size_t)(t0 + tl) * 64);
    }
    LAS bf16_t* T = (LAS bf16_t*)lds;
    for (int idx = tid; idx < 64 * 80; idx += 512) { const int t = idx / 80, p = idx % 80; const int col = p < 64 ? C_SV + 8 * p : (p < 72 ? C_NVS + 8 * (p - 64) : C_NVW + 8 * (p - 72));
        const u32x4 w = *(const u32x4*)(proj + (size_t)(t0 + t) * NPAD + col);
        LAS unsigned* d = (LAS unsigned*)(T + t * 648 + 8 * p); d[0] = w.x; d[1] = w.y; d[2] = w.z; d[3] = w.w; }
    __syncthreads();
    for (int idx = tid; idx < 640 * 8; idx += 512) { const int c = idx >> 3, p = idx & 7;
        unsigned short e[8];
#pragma unroll
        for (int j = 0; j < 8; ++j) e[j] = T[(8 * p + j) * 648 + c];
        u32x4 w; w.x = e[0] | ((unsigned)e[1] << 16); w.y = e[2] | ((unsigned)e[3] << 16); w.z = e[4] | ((unsigned)e[5] << 16); w.w = e[6] | ((unsigned)e[7] << 16);
        const int tk = t0 + 8 * p;
        if (c < 512) *(u32x4*)((bf16_t*)(ws + WS_SVT) + (size_t)c * M + tk) = w;
        else { const int d = (c - 512) & 63; bf16_t* vb = (bf16_t*)(ws + (c < 576 ? WS_VST : WS_VWT)); *(u32x4*)(vb + ((size_t)((tk >> 5) * 64 + d)) * 32 + (tk & 31)) = w; } }
    __syncthreads();
}
__device__ __forceinline__ void cmp_item(const KArgs& a, int l, LAS unsigned char* lds, int item, int tid, int wave, int lane) {
    unsigned char* ws = a.ws; const bf16_t* proj = (const bf16_t*)(ws + WS_PROJ);
    const int which = item & 1, grp = item >> 1, i0 = 16 * grp;
    const int srcoff = which ? C_NVC : C_NKC;
    const bf16_t* w1T = (const bf16_t*)(ws + (which ? WS_WV1 : WS_WK1)); const bf16_t* w2T = (const bf16_t*)(ws + (which ? WS_WV2 : WS_WK2));
    LAS bf16_t* hidL = (LAS bf16_t*)lds;
    LAS float* outL = (LAS float*)(lds + 16384);
    LAS float* rinvL = (LAS float*)(lds + 24576);
    const int r = lane & 15, g = lane >> 4;
    int irow = i0 + r; if (irow > 1022) irow = 1022;
    const bf16_t* arow = proj + (size_t)(16 * irow) * NPAD + srcoff;
    f32x4 acc[2] = {(f32x4){0.f, 0.f, 0.f, 0.f}, (f32x4){0.f, 0.f, 0.f, 0.f}};
    const bf16_t* b0 = w1T + (size_t)(32 * wave + r) * 2048 + 8 * g; const bf16_t* b1 = b0 + 16 * 2048;
#pragma unroll 8
    for (int ks = 0; ks < 64; ++ks) { const int k = 32 * ks + 8 * g;
        const bf16x8 af = *(const bf16x8*)(arow + (size_t)(k >> 6) * NPAD + (k & 63));
        const bf16x8 bf0 = *(const bf16x8*)(b0 + 32 * ks), bf1 = *(const bf16x8*)(b1 + 32 * ks);
        acc[0] = mfma16(af, bf0, acc[0]); acc[1] = mfma16(af, bf1, acc[1]); }
    const float* cb = (const float*)(ws + WS_CB);
#pragma unroll
    for (int nb = 0; nb < 2; ++nb) { const int col = 32 * wave + 16 * nb + r; float bs = 0.f;
#pragma unroll
        for (int p = 0; p < 16; ++p) bs += cb[p * 512 + which * 256 + col];
#pragma unroll
        for (int j = 0; j < 4; ++j) { const float x = acc[nb][j] + bs; const float u = 0.7978845608028654f * (x + 0.044715f * x * x * x);
            const float th = 1.f - 2.f / (__expf(2.f * u) + 1.f); hidL[(4 * g + j) * 264 + col] = f2bf(0.5f * x * (1.f + th)); } }
    __syncthreads();
    if (wave < 4) { f32x4 c2 = (f32x4){0.f, 0.f, 0.f, 0.f};
#pragma unroll
        for (int ks = 0; ks < 8; ++ks) { const bf16x8 af = *(const LAS bf16x8*)(hidL + r * 264 + 32 * ks + 8 * g); const bf16x8 bfr = *(const bf16x8*)(w2T + (size_t)(16 * wave + r) * 256 + 32 * ks + 8 * g); c2 = mfma16(af, bfr, c2); }
#pragma unroll
        for (int j = 0; j < 4; ++j) outL[(4 * g + j) * 65 + 16 * wave + r] = c2[j]; }
    __syncthreads();
    if (tid < 16) { float ss = 0.f; for (int d = 0; d < 64; ++d) { const float v = outL[tid * 65 + d]; ss += v * v; } rinvL[tid] = rsqrtf(ss * (1.f / 64.f) + 1e-6f); }
    __syncthreads();
    const float* kg = a.in[8] + l * 64;
    for (int idx = tid; idx < 1024; idx += 512) { const int row = idx >> 6, d = idx & 63, i = i0 + row; const float v = outL[row * 65 + d];
        if (which == 0) ((bf16_t*)(ws + WS_KCMP))[(size_t)i * 64 + d] = (i <= 1022) ? f2bf(v * rinvL[row] * kg[d]) : (bf16_t)0;
        else ((bf16_t*)(ws + WS_VCMPT))[((size_t)((i >> 5) * 64 + d)) * 32 + (i & 31)] = (i <= 1022) ? f2bf(v) : (bf16_t)0; }
    __syncthreads();
}
__device__ __forceinline__ void gla_decay(const KArgs& a, int l, int c, int h, LAS float* bL, LAS float* aL, int tid) {
    const bf16_t* proj = (const bf16_t*)(a.ws + WS_PROJ);
    LAS float* segL = aL + 512;
    { const int t = tid >> 4, r = tid & 15; aL[tid] = bf2f(proj[(size_t)(32 * c + t) * NPAD + C_GA + r]); }
    __syncthreads();
    const int kk = tid & 127, sg = tid >> 7;
    { const int hk = h * 128 + kk; float w[16];
#pragma unroll
        for (int r = 0; r < 16; ++r) w[r] = a.in[4][(size_t)l * 16 * 512 + r * 512 + hk];
        const float ba = a.in[5][l * 512 + hk]; float cum = 0.f;
#pragma unroll
        for (int tt = 0; tt < 8; ++tt) { const int t = 8 * sg + tt; float x = ba;
#pragma unroll
            for (int r = 0; r < 16; ++r) x += aL[t * 16 + r] * w[r];
            const float ls = fminf(x, 0.f) - __logf(1.f + __expf(-fabsf(x)));
            cum += ls * (1.f / 16.f); bL[t * 128 + kk] = cum; }
        segL[sg * 128 + kk] = cum; }
    __syncthreads();
    { float off = 0.f;
#pragma unroll
        for (int q = 0; q < 3; ++q) if (q < sg) off += segL[q * 128 + kk];
        if (sg > 0) {
#pragma unroll
            for (int tt = 0; tt < 8; ++tt) bL[(8 * sg + tt) * 128 + kk] += off; } }
    __syncthreads();
}
__device__ __forceinline__ void gla_g1_item(const KArgs& a, int l, LAS unsigned char* lds, int item, int tid, int wave, int lane) {
    unsigned char* ws = a.ws; const bf16_t* proj = (const bf16_t*)(ws + WS_PROJ);
    const int c = item >> 2, h = item & 3;
    LAS float* bL = (LAS float*)lds; LAS float* aL = (LAS float*)(lds + 16384);
    LAS bf16_t* kT = (LAS bf16_t*)(lds + 20480);
    LAS bf16_t* vT = (LAS bf16_t*)(lds + 20480 + 10240);
    gla_decay(a, l, c, h, bL, aL, tid);
    for (int idx = tid; idx < 32 * 128; idx += 512) { const int s = idx >> 7, k = idx & 127; const size_t ro = (size_t)(32 * c + s) * NPAD + h * 128 + k;
        kT[k * 40 + s] = f2bf(bf2f(proj[ro + C_GK]) * __expf(bL[31 * 128 + k] - bL[s * 128 + k])); vT[k * 40 + s] = proj[ro + C_GV]; }
    if (tid < 128) ((float*)(ws + WS_GDC))[(size_t)(c * 4 + h) * 128 + tid] = __expf(bL[31 * 128 + tid]);
    __syncthreads();
    const int r = lane & 15, g = lane >> 4;
    const bf16x8 af = *(const LAS bf16x8*)(vT + (16 * wave + r) * 40 + 8 * g);
    bf16_t* dst = (bf16_t*)(ws + WS_GST) + (size_t)(c * 4 + h) * 16384;
#pragma unroll
    for (int kb = 0; kb < 8; ++kb) { const bf16x8 bfr = *(const LAS bf16x8*)(kT + (16 * kb + r) * 40 + 8 * g);
        const f32x4 d = mfma16(af, bfr, (f32x4){0.f, 0.f, 0.f, 0.f});
#pragma unroll
        for (int j = 0; j < 4; ++j) dst[(size_t)(16 * wave + 4 * g + j) * 128 + 16 * kb + r] = f2bf(d[j]); }
    __syncthreads();
}
__device__ __forceinline__ void gla_scan(const KArgs& a, int cid) {
    bf16_t* st = (bf16_t*)(a.ws + WS_GST); const float* dc = (const float*)(a.ws + WS_GDC);
    const int h = cid >> 14, vk = cid & 16383, k = cid & 127;
    float state = 0.f;
    for (int c0 = 0; c0 < 512; c0 += 8) { float kv[8], d[8];
#pragma unroll
        for (int i = 0; i < 8; ++i) { kv[i] = bf2f(st[(size_t)((c0 + i) * 4 + h) * 16384 + vk]); d[i] = dc[(size_t)((c0 + i) * 4 + h) * 128 + k]; }
#pragma unroll
        for (int i = 0; i < 8; ++i) { st[(size_t)((c0 + i) * 4 + h) * 16384 + vk] = f2bf(state); state = state * d[i] + kv[i]; } }
}
__device__ __forceinline__ void gla_g3_item(const KArgs& a, int l, LAS unsigned char* lds, int item, int tid, int wave, int lane) {
    unsigned char* ws = a.ws; const bf16_t* proj = (const bf16_t*)(ws + WS_PROJ);
    const int c = item >> 2, h = item & 3;
    LAS float* bL = (LAS float*)lds; LAS float* aL = (LAS float*)(lds + 16384);
    LAS bf16_t* qL = (LAS bf16_t*)(lds + 20480);
    LAS bf16_t* kL = (LAS bf16_t*)(lds + 20480 + 8704);
    LAS bf16_t* vT = (LAS bf16_t*)(lds + 20480 + 17408);
    LAS bf16_t* scL = (LAS bf16_t*)(lds + 20480 + 27648);
    LAS float* oL = (LAS float*)(lds + 20480 + 30208);
    gla_decay(a, l, c, h, bL, aL, tid);
    for (int idx = tid; idx < 32 * 128; idx += 512) { const int s = idx >> 7, k = idx & 127; const size_t ro = (size_t)(32 * c + s) * NPAD + h * 128 + k; const float b = bL[s * 128 + k];
        qL[s * 136 + k] = f2bf(bf2f(proj[ro + C_GQ]) * __expf(b) * 0.08838834764831845f); kL[s * 136 + k] = f2bf(bf2f(proj[ro + C_GK]) * __expf(-b)); vT[k * 40 + s] = proj[ro + C_GV]; }
    __syncthreads();
    const int r = lane & 15, g = lane >> 4;
    if (wave < 4) { const int mb = wave >> 1, nb = wave & 1; f32x4 d = (f32x4){0.f, 0.f, 0.f, 0.f};
#pragma unroll
        for (int ks = 0; ks < 4; ++ks) d = mfma16(*(const LAS bf16x8*)(qL + (16 * mb + r) * 136 + 32 * ks + 8 * g), *(const LAS bf16x8*)(kL + (16 * nb + r) * 136 + 32 * ks + 8 * g), d);
#pragma unroll
        for (int j = 0; j < 4; ++j) { const int t = 16 * mb + 4 * g + j, s = 16 * nb + r; scL[t * 40 + s] = (s <= t) ? f2bf(d[j]) : (bf16_t)0; } }
    __syncthreads();
    const bf16_t* stT = (const bf16_t*)(ws + WS_GST) + (size_t)(c * 4 + h) * 16384;
#pragma unroll
    for (int mb = 0; mb < 2; ++mb) { f32x4 d = (f32x4){0.f, 0.f, 0.f, 0.f};
#pragma unroll
        for (int ks = 0; ks < 4; ++ks) d = mfma16(*(const LAS bf16x8*)(qL + (16 * mb + r) * 136 + 32 * ks + 8 * g), *(const bf16x8*)(stT + (size_t)(16 * wave + r) * 128 + 32 * ks + 8 * g), d);
        d = mfma16(*(const LAS bf16x8*)(scL + (16 * mb + r) * 40 + 8 * g), *(const LAS bf16x8*)(vT + (16 * wave + r) * 40 + 8 * g), d);
#pragma unroll
        for (int j = 0; j < 4; ++j) oL[(16 * mb + 4 * g + j) * 132 + 16 * wave + r] = d[j]; }
    __syncthreads();
    { const int t = tid >> 4, v0 = (tid & 15) * 8; float o[8]; float ss = 0.f;
#pragma unroll
        for (int e = 0; e < 8; ++e) { o[e] = oL[t * 132 + v0 + e]; ss += o[e] * o[e]; }
        ss += __shfl_xor(ss, 1); ss += __shfl_xor(ss, 2); ss += __shfl_xor(ss, 4); ss += __shfl_xor(ss, 8);
        const float rinv = rsqrtf(ss * (1.f / 128.f) + 1e-6f);
        const u32x4 rw = *(const u32x4*)(proj + (size_t)(32 * c + t) * NPAD + C_GR + h * 128 + v0); float rr[8]; unpack8(rw, rr);
        const float* ng = a.in[6] + l * 128 + v0; float res[8];
#pragma unroll
        for (int e = 0; e < 8; ++e) { const float on = o[e] * rinv * ng[e]; const float si = rr[e] / (1.f + __expf(-rr[e])); res[e] = on * si; }
        *(u32x4*)((bf16_t*)(ws + WS_OGLA) + (size_t)(32 * c + t) * 512 + h * 128 + v0) = pack8(res); }
    __syncthreads();
}

__device__ __forceinline__ void sb_unit(const KArgs& a, LAS unsigned char* lds, int h, int qb, int tid, int wave, int lane) {
    unsigned char* ws = a.ws; const bf16_t* proj = (const bf16_t*)(ws + WS_PROJ); const bf16_t* svt = (const bf16_t*)(ws + WS_SVT) + (size_t)h * 128 * M;
    constexpr int KROW = 136, VROW = 72, KT_B = 64 * KROW * 2, VT_B = 128 * VROW * 2, BUF_B = KT_B + VT_B;
    const int n = lane & 15, g = lane >> 4;
    const int tq = 128 * qb + 16 * wave + n;
    const float SC = 0.08838834764831845f * LOG2E;
    bf16x8 qf[4];
#pragma unroll
    for (int ks = 0; ks < 4; ++ks) { const u32x4 w = *(const u32x4*)(proj + (size_t)tq * NPAD + C_SQ + h * 128 + 32 * ks + 8 * g); float f[8]; unpack8(w, f);
#pragma unroll
        for (int e = 0; e < 8; ++e) f[e] *= SC;
        const u32x4 pw = pack8(f); __builtin_memcpy(&qf[ks], &pw, 16); }
    f32x4 O[8];
#pragma unroll
    for (int i = 0; i < 8; ++i) O[i] = (f32x4){0.f, 0.f, 0.f, 0.f};
    float carry = 1.f;
    const int ntiles = 2 * qb + 2;
    u32x4 stK[2], stV[2];
    auto gload = [&](int T) {
#pragma unroll
        for (int i = 0; i < 2; ++i) { const int idx = tid + 512 * i; stK[i] = *(const u32x4*)(proj + (size_t)(64 * T + (idx >> 4)) * NPAD + C_SK + h * 128 + 8 * (idx & 15));
            stV[i] = *(const u32x4*)(svt + (size_t)(idx >> 3) * M + 64 * T + 8 * (idx & 7)); } };
    auto lstore = [&](int buf) {
#pragma unroll
        for (int i = 0; i < 2; ++i) { const int idx = tid + 512 * i; LAS unsigned char* base = lds + buf * BUF_B;
            const int k = idx >> 4, rho = (k & 32) | ((k & 4) << 2) | ((k & 24) >> 1) | (k & 3);
            *(LAS u32x4*)(base + (rho * KROW + 8 * (idx & 15)) * 2) = stK[i];
            *(LAS u32x4*)(base + KT_B + ((idx >> 3) * VROW + 8 * (idx & 7)) * 2) = stV[i]; } };
    gload(ntiles - 1); lstore(0); __syncthreads();
    const int wq_lo = 128 * qb + 16 * wave;
    for (int it = 0; it < ntiles; ++it) { const int T = ntiles - 1 - it, buf = it & 1;
        if (it + 1 < ntiles) gload(T - 1);
        if (64 * T < wq_lo + 15) {
            const LAS bf16_t* Kt = (const LAS bf16_t*)(lds + buf * BUF_B); const LAS bf16_t* Vt = (const LAS bf16_t*)(lds + buf * BUF_B + KT_B);
            const bool diag = (64 * T + 63 >= wq_lo);
#pragma unroll
            for (int cc = 1; cc >= 0; --cc) {
                f32x4 S[2];
#pragma unroll
                for (int pb = 0; pb < 2; ++pb) { f32x4 sv = (f32x4){0.f, 0.f, 0.f, 0.f};
#pragma unroll
                    for (int ks = 0; ks < 4; ++ks) sv = mfma16(*(const LAS bf16x8*)(Kt + (32 * cc + 16 * pb + n) * KROW + 32 * ks + 8 * g), qf[ks], sv);
                    S[pb] = sv; }
                float e[8], P[8];
#pragma unroll
                for (int j = 0; j < 8; ++j) { float z = fminf(S[j >> 2][j & 3], 15.f);
                    if (diag) { const int key = 64 * T + 32 * cc + 8 * g + j; if (key >= tq) z = -1e30f; }
                    e[j] = __builtin_amdgcn_exp2f(z); }
                P[0] = 1.f;
#pragma unroll
                for (int j = 1; j < 8; ++j) P[j] = P[j - 1] * (1.f + e[j - 1]);
                const float Tg = __builtin_amdgcn_rcpf(P[7] * (1.f + e[7]));
                const float t1 = __shfl_xor(Tg, 16), t2 = __shfl_xor(Tg, 32), t3 = __shfl_xor(t1, 32);
                const float gex = (g == 0) ? t1 * t2 * t3 : ((g == 1) ? t2 * t3 : ((g == 2) ? t1 : 1.f));
                const float cf = Tg * gex * carry;
                carry = carry * (Tg * t1) * (t2 * t3);
                float w[8];
#pragma unroll
                for (int j = 0; j < 8; ++j) w[j] = e[j] * P[j] * cf;
                const u32x4 pw = pack8(w); bf16x8 pf; __builtin_memcpy(&pf, &pw, 16);
#pragma unroll
                for (int db = 0; db < 8; ++db) O[db] = mfma16(*(const LAS bf16x8*)(Vt + (16 * db + n) * VROW + 32 * cc + 8 * g), pf, O[db]);
            }
        }
        if (it + 1 < ntiles) lstore(buf ^ 1);
        __syncthreads();
    }
    bf16_t* orow = (bf16_t*)(ws + WS_OSB) + (size_t)tq * 512 + h * 128;
#pragma unroll
    for (int db = 0; db < 8; ++db) { u32x2 w; w.x = cvt_pk_bf16(O[db][0], O[db][1]); w.y = cvt_pk_bf16(O[db][2], O[db][3]); *(u32x2*)(orow + 16 * db + 4 * g) = w; }
}

struct NFrag { bf16x8 k[4]; bf16x8 v[4]; };
template <bool LV> __device__ __forceinline__ void nsa_load(NFrag& f, const bf16_t* Kb, const bf16_t* VB, int kb, int n, int g) {
    const bf16_t* kp = Kb + (size_t)(kb + 8 * (n >> 2) + (n & 3)) * 64 + 8 * g;
    f.k[0] = *(const bf16x8*)kp; f.k[1] = *(const bf16x8*)(kp + 32); f.k[2] = *(const bf16x8*)(kp + 256); f.k[3] = *(const bf16x8*)(kp + 288);
    if (LV) { const bf16_t* vp = VB + ((size_t)(kb >> 5) * 64 + n) * 32 + 8 * g;
#pragma unroll
        for (int db = 0; db < 4; ++db) f.v[db] = *(const bf16x8*)(vp + db * 512); }
}
template <int MODE>
__device__ __forceinline__ void nsa_compute(const NFrag& f, int kb, const bf16x8 (&qf)[2], const LAS float* LUT, LAS float* impq,
                                            int tq, int h, int g, int qs, int qsel, float inv, float& lsum, f32x4 (&O)[4]) {
    f32x4 S[2];
#pragma unroll
    for (int pb = 0; pb < 2; ++pb) { f32x4 sv = mfma16(f.k[2 * pb], qf[0], (f32x4){0.f, 0.f, 0.f, 0.f}); S[pb] = mfma16(f.k[2 * pb + 1], qf[1], sv); }
    float p[8];
#pragma unroll
    for (int j = 0; j < 8; ++j) { const int key = kb + 8 * g + j; int dist; bool valid;
        if (MODE <= 1) { dist = tq - 16 * key - 31; valid = dist >= 0 && key <= 1022; }
        else if (MODE == 2) { dist = tq - key; valid = dist >= 0 && qs == qsel; }
        else { dist = tq - key; valid = dist >= 0 && dist < 512; }
        int di = dist < 0 ? 0 : (dist > 1023 ? 1023 : dist);
        const float bias = LUT[di * 8 + h];
        float pv = valid ? __builtin_amdgcn_exp2f(S[j >> 2][j & 3] + bias) : 0.f;
        if (MODE == 1) pv *= inv;
        p[j] = pv; if (MODE != 1) lsum += pv; }
    if (MODE == 0) return;
    if (MODE == 1) {
#pragma unroll
        for (int j = 0; j < 8; ++j) { float v = p[j]; v += __shfl_xor(v, 1); v += __shfl_xor(v, 2); v += __shfl_xor(v, 4); if (h == 0) impq[kb + 8 * g + j] = v; } }
    const u32x4 pw = pack8(p); bf16x8 pf; __builtin_memcpy(&pf, &pw, 16);
#pragma unroll
    for (int db = 0; db < 4; ++db) O[db] = mfma16(f.v[db], pf, O[db]);
}
template <int MODE, class KBF, class QSF>
__device__ __forceinline__ void nsa_run(int niter, const bf16_t* Kb, const bf16_t* VB, KBF kbf, QSF qsf, const bf16x8 (&qf)[2], const LAS float* LUT, LAS float* impq,
                                        int tq, int h, int n, int g, int qs, float inv, float& lsum, f32x4 (&O)[4]) {
    if (niter <= 0) return;
    NFrag cur; nsa_load<MODE != 0>(cur, Kb, VB, kbf(0), n, g);
    for (int i = 0; i < niter; ++i) { NFrag nxt; const int inx = (i + 1 < niter) ? i + 1 : i; nsa_load<MODE != 0>(nxt, Kb, VB, kbf(inx), n, g);
        nsa_compute<MODE>(cur, kbf(i), qf, LUT, impq, tq, h, g, qs, qsf(i), inv, lsum, O); cur = nxt; }
}
__device__ __forceinline__ float lred(float l) { l += __shfl_xor(l, 16); l += __shfl_xor(l, 32); return l; }
__device__ __forceinline__ void nsa_unit(const KArgs& a, LAS unsigned char* lds, int unit, int wave, int lane) {
    unsigned char* ws = a.ws; const bf16_t* proj = (const bf16_t*)(ws + WS_PROJ);
    const LAS float* LUT = (const LAS float*)lds;
    LAS float* imp = (LAS float*)(lds + 32768 + wave * 8192);
    LAS int* selL = (LAS int*)(lds + 98304 + wave * 128);
    const int t0 = 2 * unit, n = lane & 15, g = lane >> 4, qs = n >> 3, h = n & 7, tq = t0 + qs;
    bf16x8 qf[2];
    qf[0] = *(const bf16x8*)((const bf16_t*)(ws + WS_QN) + (size_t)tq * 512 + h * 64 + 8 * g); qf[1] = *(const bf16x8*)((const bf16_t*)(ws + WS_QN) + (size_t)tq * 512 + h * 64 + 32 + 8 * g);
    const bf16_t* gp = proj + (size_t)tq * NPAD + C_NGATE + h * 3;
    const float g0 = 1.f / (1.f + __expf(-bf2f(gp[0]))), g1 = 1.f / (1.f + __expf(-bf2f(gp[1]))), g2 = 1.f / (1.f + __expf(-bf2f(gp[2])));
    f32x4 Ot[4], Ob[4];
#pragma unroll
    for (int i = 0; i < 4; ++i) { Ot[i] = (f32x4){0.f, 0.f, 0.f, 0.f}; Ob[i] = (f32x4){0.f, 0.f, 0.f, 0.f}; }
    const int nvmax = (t0 + 1 >= 31) ? (((t0 + 1 - 31) >> 4) + 1) : 0; const int nch = (nvmax + 31) >> 5;
    const bf16_t* KC = (const bf16_t*)(ws + WS_KCMP); const bf16_t* VCT = (const bf16_t*)(ws + WS_VCMPT);
    auto kb_lin = [](int i) { return 32 * i; }; auto qs_zero = [](int) { return 0; };
    float lsum = 0.f;
    nsa_run<0>(nch, KC, VCT, kb_lin, qs_zero, qf, LUT, imp + qs * 1024, tq, h, n, g, qs, 0.f, lsum, Ob);
    { const float l = lred(lsum); const float inv = l > 0.f ? 1.f / l : 0.f; float dummy = 0.f;
      nsa_run<1>(nch, KC, VCT, kb_lin, qs_zero, qf, LUT, imp + qs * 1024, tq, h, n, g, qs, inv, dummy, Ob); }
#pragma unroll
    for (int i = 0; i < 4; ++i) { Ot[i] += Ob[i] * g0; Ob[i] = (f32x4){0.f, 0.f, 0.f, 0.f}; }
    LDS_FENCE();
    int cnts[2];
#pragma unroll
    for (int q2 = 0; q2 < 2; ++q2) { const int tqq = t0 + q2, cur = tqq >> 6; const LAS float* iq = imp + q2 * 1024;
        float val[4];
#pragma unroll
        for (int r = 0; r < 4; ++r) { const int b = lane + 64 * r; float v = -1.f;
            if (b >= 1 && b <= cur - 2) { v = 0.f;
#pragma unroll
                for (int i = 0; i < 5; ++i) v += iq[4 * b - 1 + i]; }
            val[r] = v; }
        int cnt = 0;
        if (lane == 0) { selL[q2 * 8 + 0] = 0; if (cur >= 1) selL[q2 * 8 + 1] = cur; if (cur >= 2) selL[q2 * 8 + 2] = cur - 1; }
        cnt = 1 + (cur >= 1) + (cur >= 2);
        int ncand = cur - 2; if (ncand < 0) ncand = 0; const int npick = ncand < 5 ? ncand : 5;
        for (int rd = 0; rd < npick; ++rd) { float bv = val[0]; int bi = lane;
#pragma unroll
            for (int r = 1; r < 4; ++r) if (val[r] > bv) { bv = val[r]; bi = lane + 64 * r; }
#pragma unroll
            for (int o = 1; o < 64; o <<= 1) { const float ov = __shfl_xor(bv, o); const int oi = __shfl_xor(bi, o); if (ov > bv || (ov == bv && oi < bi)) { bv = ov; bi = oi; } }
            if (lane == 0) selL[q2 * 8 + cnt] = bi; ++cnt;
#pragma unroll
            for (int r = 0; r < 4; ++r) if (bi == lane + 64 * r) val[r] = -2.f; }
        cnts[q2] = cnt; }
    LDS_FENCE();
    lsum = 0.f;
    { const int c0 = cnts[0], c1 = cnts[1];
      auto kbf = [&](int i) { const int bidx = i >> 1; const int slot = bidx < c0 ? bidx : 8 + (bidx - c0); return 64 * __builtin_amdgcn_readfirstlane(selL[slot]) + 32 * (i & 1); };
      auto qsf = [&](int i) { return ((i >> 1) < c0) ? 0 : 1; };
      nsa_run<2>(2 * (c0 + c1), (const bf16_t*)(ws + WS_KSN), (const bf16_t*)(ws + WS_VST), kbf, qsf, qf, LUT, imp, tq, h, n, g, qs, 0.f, lsum, Ob); }
    { const float l = lred(lsum); const float sc = l > 0.f ? g1 / l : 0.f;
#pragma unroll
      for (int i = 0; i < 4; ++i) { Ot[i] += Ob[i] * sc; Ob[i] = (f32x4){0.f, 0.f, 0.f, 0.f}; } }
    lsum = 0.f;
    { int lo = t0 - 511; if (lo < 0) lo = 0; lo &= ~31; const int nw = ((t0 + 1 - lo) >> 5) + 1;
      auto kbf = [&](int i) { return lo + 32 * i; };
      nsa_run<3>(nw, (const bf16_t*)(ws + WS_KWN), (const bf16_t*)(ws + WS_VWT), kbf, qs_zero, qf, LUT, imp, tq, h, n, g, qs, 0.f, lsum, Ob);
      const float l = lred(lsum); const float sc = l > 0.f ? g2 / l : 0.f;
#pragma unroll
      for (int i = 0; i < 4; ++i) Ot[i] += Ob[i] * sc; }
    bf16_t* orow = (bf16_t*)(ws + WS_ONSA) + (size_t)tq * 512 + h * 64;
#pragma unroll
    for (int db = 0; db < 4; ++db) { u32x2 w; w.x = cvt_pk_bf16(Ot[db][0], Ot[db][1]); w.y = cvt_pk_bf16(Ot[db][2], Ot[db][3]); *(u32x2*)(orow + 16 * db + 4 * g) = w; }
}

#define GSYNC() cg::this_grid().sync()
__global__ void __launch_bounds__(512) fwd_mega(KArgs a) {
    extern __shared__ __attribute__((aligned(16))) unsigned char lds_raw[];
    LAS unsigned char* lds = (LAS unsigned char*)lds_raw;
    const int G = gridDim.x, bid = blockIdx.x, NGW = G * 8;
#define IDS() int tid = threadIdx.x; asm volatile("" : "+v"(tid)); const int lane = tid & 63, wave = __builtin_amdgcn_readfirstlane(tid >> 6); const int gw = bid * 8 + wave; (void)lane; (void)gw;
    unsigned char* ws = a.ws;
    bf16_t* PROJ = (bf16_t*)(ws + WS_PROJ); bf16_t* HN = (bf16_t*)(ws + WS_HN); bf16_t* HID = (bf16_t*)(ws + WS_HID);
#pragma unroll 1
    for (int l = 0; l < DEPTH; ++l) {
        const float* xsrc = (l == 0) ? a.in[0] : a.out;
        { IDS(); phase_convert(a, l, lds, gw, NGW, wave, lane);
          phase_rms(xsrc, a.in[1] + l * DM, HN, gw, NGW, lane); }
        GSYNC();
        { pg8::Gemm g{HN, (const bf16_t*)(ws + WS_WIN), M, NPAD, DM}; pg8::StaticOrder S; S.init(M, NPAD, G, bid);
          pg8::EpiBf16<0> E{PROJ, NPAD};
          pg8::gemm_phase<pg8::EpiBf16<0>, pg8::StaticOrder, true, true>(lds, g, S, E); }
        GSYNC();
        { IDS(); for (int it = bid; it < 256; it += G) pre_item(a, l, lds, it, tid); }
        { IDS(); for (int it = bid; it < 128; it += G) cmp_item(a, l, lds, it, tid, wave, lane); }
        { IDS(); for (int it = bid; it < 2048; it += G) gla_g1_item(a, l, lds, it, tid, wave, lane); }
        GSYNC();
        {   IDS();
            { const float* lg = (const float*)(ws + WS_LUT); LAS float* LUT = (LAS float*)lds; for (int i = tid; i < 8192; i += 512) LUT[i] = lg[i]; }
            LAS int* ctr = (LAS int*)(lds + 99328);
            if (tid == 0) *ctr = 0;
            __syncthreads();
            if (wave < 4) for (int c0 = (bid * 4 + wave) * 64; c0 < 65536; c0 += G * 256) gla_scan(a, c0 + lane);
            const int nper = (8192 + G - 1) / G;
            for (;;) { int idx = 0; if (lane == 0) idx = atomicAdd((int*)ctr, 1); idx = __builtin_amdgcn_readfirstlane(idx);
                if (idx >= nper) break; const int unit = bid + G * (nper - 1 - idx); if (unit < 8192) nsa_unit(a, lds, unit, wave, lane); }
            __syncthreads();
        }
        GSYNC();
        { IDS(); for (int idx = bid; idx < 512; idx += G) { int h, qb; if (idx < 256) { h = idx & 3; qb = 127 - (idx >> 2); } else { const int j = idx - 256; h = j & 3; qb = j >> 2; }
            sb_unit(a, lds, h, qb, tid, wave, lane); } }
        { IDS(); for (int it = bid; it < 2048; it += G) gla_g3_item(a, l, lds, it, tid, wave, lane); }
        GSYNC();
        for (int b = 0; b < 3; ++b) {
            pg8::Gemm g{(const bf16_t*)(ws + WS_OGLA + b * 16 * MiB), (const bf16_t*)(ws + WS_WBR + b * MiB), M, DM, 512}; pg8::StaticOrder S; S.init(M, DM, G, bid);
            pg8::EpiGate E{HN, PROJ + C_MGATE + b * DM, NPAD, b == 0 ? 1 : 0};
            pg8::gemm_phase<pg8::EpiGate, pg8::StaticOrder, true, true>(lds, g, S, E); }
        GSYNC();
        { pg8::Gemm g{HN, (const bf16_t*)(ws + WS_WOUT), M, DM, DM}; pg8::StaticOrder S; S.init(M, DM, G, bid);
          pg8::EpiRes E{xsrc, a.out};
          pg8::gemm_phase<pg8::EpiRes, pg8::StaticOrder, true, true>(lds, g, S, E); }
        GSYNC();
        { IDS(); phase_rms(a.out, a.in[2] + l * DM, HN, gw, NGW, lane); }
        GSYNC();
        { pg8::Gemm g{HN, (const bf16_t*)(ws + WS_WUP), M, FF, DM}; pg8::StaticOrder S; S.init(M, FF, G, bid);
          pg8::EpiBf16<2> E{HID, FF};
          pg8::gemm_phase<pg8::EpiBf16<2>, pg8::StaticOrder, true, true>(lds, g, S, E); }
        GSYNC();
        { pg8::Gemm g{HID, (const bf16_t*)(ws + WS_WDN), M, DM, FF}; pg8::StaticOrder S; S.init(M, DM, G, bid);
          pg8::EpiRes E{a.out, a.out};
          pg8::gemm_phase<pg8::EpiRes, pg8::StaticOrder, true, true>(lds, g, S, E); }
        GSYNC();
    }
}

extern "C" void kernel_launch(void* const* d_in, const int* in_sizes, int n_in, void* d_out, int out_size, void* d_ws, size_t ws_size, hipStream_t stream) {
    static int grid = 0;
    if (grid == 0) {
        if (n_in != 22 || ws_size < WS_END) { fprintf(stderr, "kernel_launch: unexpected n_in %d or ws_size %zu (< %zu)\n", n_in, ws_size, (size_t)WS_END); grid = -1; return; }
        int dev = 0, cus = 0, per_cu = 0;
        hipGetDevice(&dev); hipDeviceGetAttribute(&cus, hipDeviceAttributeMultiprocessorCount, dev);
        hipFuncSetAttribute((const void*)fwd_mega, hipFuncAttributeMaxDynamicSharedMemorySize, LDS_BYTES);
        hipOccupancyMaxActiveBlocksPerMultiprocessor(&per_cu, (const void*)fwd_mega, 512, LDS_BYTES);
        if (per_cu < 1) { fprintf(stderr, "kernel_launch: occupancy query says %d blocks/CU\n", per_cu); per_cu = 1; }
        (void)hipGetLastError();
        grid = cus * 1;
    }
    if (grid < 0) return;
    KArgs a{};
    for (int i = 0; i < 22; ++i) a.in[i] = (const float*)d_in[i];
    a.out = (float*)d_out; a.ws = (unsigned char*)d_ws;
    void* args[] = {&a};
    hipError_t e = hipLaunchCooperativeKernel((const void*)fwd_mega, dim3(grid), dim3(512), args, LDS_BYTES, stream);
    if (e != hipSuccess) fprintf(stderr, "cooperative launch failed: %s (grid %d)\n", hipGetErrorString(e), grid);
}
```

```cpp
#include <hip/hip_runtime.h>
#include <hip/hip_cooperative_groups.h>
#include <cstdio>
#include <cstdint>
namespace cg = cooperative_groups;
namespace pg8 {
#define PG8_LAS __attribute__((address_space(3)))
typedef unsigned short bf16_t;
typedef short bf16x8 __attribute__((ext_vector_type(8)));
typedef float f32x4 __attribute__((ext_vector_type(4)));
typedef unsigned u32x4 __attribute__((ext_vector_type(4)));
constexpr int BM = 256, BK = 64, HALF = 128, HTB = HALF * BK * 2  , STAGE_BYTES = 8 * HTB, NXCD = 8, WGM = 8;

__host__ __device__ __forceinline__ int lds_byte(int r, int c) { const int st = (r >> 4) * 2 + (c >> 5), rr = r & 15, cc = c & 31, ob = rr * 64 + cc * 2; return st * 1024 + (ob ^ (((ob >> 9) & 1) << 5)); }
__host__ __device__ __forceinline__ void stage_rc(int b, int& R, int& C) { const int st = b / 1024, sb = b % 1024, swz = sb ^ (((sb >> 9) & 1) << 5); R = (st >> 1) * 16 + swz / 64; C = (st & 1) * 32 + (swz % 64) / 2; }
__host__ __device__ __forceinline__ int perm32(int rho) { const int n = rho >> 4, i = rho & 15; return 8 * (i >> 2) + 4 * n + (i & 3); }

struct Unit { int pm, pn; };
struct Gemm { const bf16_t* A; const bf16_t* Bt; int M, N, K; };

struct StaticOrder {
    int nM, nN, nwg, G, c;
    __host__ __device__ void init(int M, int N, int G_, int c_) { nM = M / BM; nN = N / BM; nwg = nM * nN; G = G_; c = c_; }
    __host__ __device__ bool next(int i, Unit& u) const {
        const long L = (long)i * G + c; if (L >= nwg) return false;
        int wgid = (int)L; { const int q = nwg / NXCD, r = nwg % NXCD, xcd = wgid % NXCD, off = wgid / NXCD; wgid = (xcd < r ? xcd * (q + 1) : r * (q + 1) + (xcd - r) * q) + off; }
        const int nig = WGM * nN, gid = wgid / nig, fm = gid * WGM, gsz = (nM - fm) < WGM ? (nM - fm) : WGM;
        u.pm = fm + ((wgid % nig) % gsz); u.pn = (wgid % nig) / gsz; return true;
    }
    __device__ __forceinline__ void a_ready(const Unit&) const {}
    __device__ __forceinline__ void done(const Unit&) const {}
};

__device__ __forceinline__ unsigned cvt_pk_bf16(float lo, float hi) { unsigned r; asm("v_cvt_pk_bf16_f32 %0, %1, %2" : "=v"(r) : "v"(lo), "v"(hi)); return r; }
__device__ __forceinline__ float bflo(unsigned w) { return __uint_as_float(w << 16); }
__device__ __forceinline__ float bfhi(unsigned w) { return __uint_as_float(w & 0xffff0000u); }
template <int ACT> struct EpiBf16 {
    static constexpr bool PERM = true, AFTER_DRAIN = false;
    bf16_t* O; int ldc;
    __device__ __forceinline__ void operator()(const f32x4 (&acc)[2][2][4][2], const Unit& u, int wr, int wc, int fr, int fq) const {
        const int row0 = u.pm * BM + wr * 64 + fr; const int col0 = u.pn * BM + wc * 32 + 8 * fq;
#pragma unroll
        for (int ai = 0; ai < 2; ++ai)
#pragma unroll
            for (int m = 0; m < 4; ++m) { bf16_t* rowp = O + (size_t)(row0 + ai * HALF + m * 16) * ldc + col0;
#pragma unroll
                for (int bj = 0; bj < 2; ++bj) { f32x4 v0 = acc[ai][bj][m][0], v1 = acc[ai][bj][m][1];
                    if (ACT == 2) {
#pragma unroll
                        for (int e = 0; e < 4; ++e) { float a = fmaxf(v0[e], 0.f), b = fmaxf(v1[e], 0.f); v0[e] = a * a; v1[e] = b * b; } }
                    u32x4 w; w.x = cvt_pk_bf16(v0[0], v0[1]); w.y = cvt_pk_bf16(v0[2], v0[3]); w.z = cvt_pk_bf16(v1[0], v1[1]); w.w = cvt_pk_bf16(v1[2], v1[3]);
                    *(u32x4*)(rowp + bj * HALF) = w; } }
    }
};
struct EpiGate {
    static constexpr bool PERM = true, AFTER_DRAIN = false;
    bf16_t* O; const bf16_t* gate; int gld; int first;
    __device__ __forceinline__ void operator()(const f32x4 (&acc)[2][2][4][2], const Unit& u, int wr, int wc, int fr, int fq) const {
        const int row0 = u.pm * BM + wr * 64 + fr; const int col0 = u.pn * BM + wc * 32 + 8 * fq;
#pragma unroll
        for (int ai = 0; ai < 2; ++ai)
#pragma unroll
            for (int m = 0; m < 4; ++m) { const int row = row0 + ai * HALF + m * 16; bf16_t* rowp = O + (size_t)row * 1024 + col0; const bf16_t* gp = gate + (size_t)row * gld + col0;
#pragma unroll
                for (int bj = 0; bj < 2; ++bj) { const f32x4 v0 = acc[ai][bj][m][0], v1 = acc[ai][bj][m][1];
                    const u32x4 gw = *(const u32x4*)(gp + bj * HALF);
                    u32x4 ow = (u32x4){0u, 0u, 0u, 0u}; if (!first) ow = *(const u32x4*)(rowp + bj * HALF);
                    float gv[8] = {bflo(gw.x), bfhi(gw.x), bflo(gw.y), bfhi(gw.y), bflo(gw.z), bfhi(gw.z), bflo(gw.w), bfhi(gw.w)};
                    float ov[8] = {bflo(ow.x), bfhi(ow.x), bflo(ow.y), bfhi(ow.y), bflo(ow.z), bfhi(ow.z), bflo(ow.w), bfhi(ow.w)};
                    float av[8] = {v0[0], v0[1], v0[2], v0[3], v1[0], v1[1], v1[2], v1[3]};
                    float r[8];
#pragma unroll
                    for (int e = 0; e < 8; ++e) { const float s = 1.f / (1.f + __expf(-gv[e])); r[e] = ov[e] + s * av[e]; }
                    u32x4 w; w.x = cvt_pk_bf16(r[0], r[1]); w.y = cvt_pk_bf16(r[2], r[3]); w.z = cvt_pk_bf16(r[4], r[5]); w.w = cvt_pk_bf16(r[6], r[7]);
                    *(u32x4*)(rowp + bj * HALF) = w; } }
    }
};
struct EpiRes {
    static constexpr bool PERM = false, AFTER_DRAIN = false;
    const float* src; float* out;
    __device__ __forceinline__ void operator()(const f32x4 (&acc)[2][2][4][2], const Unit& u, int wr, int wc, int fr, int fq) const {
        const int col0 = u.pn * BM + wc * 32 + 4 * fq;
#pragma unroll
        for (int ai = 0; ai < 2; ++ai)
#pragma unroll
            for (int m = 0; m < 4; ++m) { const size_t off = (size_t)(u.pm * BM + ai * HALF + wr * 64 + m * 16 + fr) * 1024 + col0;
#pragma unroll
                for (int bj = 0; bj < 2; ++bj)
#pragma unroll
                    for (int n = 0; n < 2; ++n) { const f32x4 bs = *(const f32x4*)(src + off + bj * HALF + n * 16); *(f32x4*)(out + off + bj * HALF + n * 16) = bs + acc[ai][bj][m][n]; } }
    }
};
template <class Epi, class Sched, bool ALIGN_EPI = false, bool SP2 = false>
__device__ __forceinline__ void gemm_phase(PG8_LAS unsigned char* lds, const Gemm g, const Sched& S, const Epi& E) {
    int tid_ = threadIdx.x; asm volatile("" : "+v"(tid_));
    const int tid = tid_, wid = __builtin_amdgcn_readfirstlane(tid >> 6), lane = tid & 63, wr = wid >> 2, wc = wid & 3, fr = lane & 15, fq = lane >> 4;
    const int K = g.K, nt = K / BK;
    unsigned voffA[2], voffB[2];
#pragma unroll
    for (int i = 0; i < 2; ++i) { int R, C; stage_rc(tid * 16 + i * 8192, R, C); const int Rb = Epi::PERM ? ((R & ~31) + perm32(R & 31)) : R;
        voffA[i] = (unsigned)(R * K + C) * 2u; voffB[i] = (unsigned)(Rb * K + C) * 2u; }
    const size_t kstep = (size_t)(BK * 2);
    const size_t hstep = (size_t)HALF * K * 2;
    const size_t tstep = 2 * hstep;
    const unsigned ldsw = (unsigned)wid * 1024u;
    const int aoff = lds_byte(wr * 64 + fr, fq * 8), boff = lds_byte(wc * 32 + fr, fq * 8);
#define PG8_SA(b, h) (((b) * 2 + (h)) * HTB)
#define PG8_SB(b, h) ((4 + (b) * 2 + (h)) * HTB)
#define PG8_STAGE(bufoff, gbase, voff) do { _Pragma("unroll") for (int _i = 0; _i < 2; ++_i) \
        __builtin_amdgcn_global_load_lds((const unsigned*)((const char*)(gbase) + (voff)[_i]), (PG8_LAS unsigned*)(lds + (bufoff) + ldsw + _i * 8192), 16, 0, 0); } while (0)
#define PG8_LDA(dst, b, h) do { _Pragma("unroll") for (int m = 0; m < 4; ++m) _Pragma("unroll") for (int k = 0; k < 2; ++k) dst[m][k] = *(const PG8_LAS bf16x8*)(lds + PG8_SA(b, h) + aoff + m * 2048 + k * 1024); } while (0)
#define PG8_LDB(dst, b, h) do { _Pragma("unroll") for (int n = 0; n < 2; ++n) _Pragma("unroll") for (int k = 0; k < 2; ++k) dst[n][k] = *(const PG8_LAS bf16x8*)(lds + PG8_SB(b, h) + boff + n * 2048 + k * 1024); } while (0)
#define PG8_MMA(ai, bj, At, Bt) do { __builtin_amdgcn_s_setprio(1); _Pragma("unroll") for (int m = 0; m < 4; ++m) _Pragma("unroll") for (int n = 0; n < 2; ++n) _Pragma("unroll") for (int k = 0; k < 2; ++k) \
        acc[ai][bj][m][n] = __builtin_amdgcn_mfma_f32_16x16x32_bf16(Bt[n][k], At[m][k], acc[ai][bj][m][n], 0, 0, 0); __builtin_amdgcn_s_setprio(0); } while (0)
#define PG8_WAIT_V(n) asm volatile("s_waitcnt vmcnt(" #n ")" ::: "memory")
#define PG8_WAIT_L(n) asm volatile("s_waitcnt lgkmcnt(" #n ")" ::: "memory")
#define PG8_BAR __builtin_amdgcn_s_barrier()
#define PG8_SCHED __builtin_amdgcn_sched_barrier(0)
    Unit cur, nxt; int ui = 0;
    if (!S.next(0, cur)) return;
    f32x4 acc[2][2][4][2];
#pragma unroll
    for (int a = 0; a < 2; ++a)
#pragma unroll
        for (int b = 0; b < 2; ++b)
#pragma unroll
            for (int m = 0; m < 4; ++m)
#pragma unroll
                for (int n = 0; n < 2; ++n) acc[a][b][m][n] = (f32x4){0.f, 0.f, 0.f, 0.f};
    bf16x8 At[4][2], B0[2][2], B1[2][2];
    const char* cA = (const char*)g.A + (size_t)cur.pm * tstep; const char* cB = (const char*)g.Bt + (size_t)cur.pn * tstep;
    S.a_ready(cur);
    if constexpr (SP2) {
        PG8_STAGE(PG8_SB(0, 0), cB, voffB); PG8_STAGE(PG8_SB(0, 1), cB + hstep, voffB); PG8_STAGE(PG8_SA(0, 0), cA, voffA); PG8_STAGE(PG8_SA(0, 1), cA + hstep, voffA);
        if (wr == 1) PG8_BAR;
        PG8_WAIT_V(2); PG8_BAR;
        PG8_STAGE(PG8_SB(1, 0), cB + kstep, voffB); PG8_STAGE(PG8_SA(1, 0), cA + kstep, voffA); PG8_STAGE(PG8_SB(1, 1), cB + hstep + kstep, voffB);
        PG8_WAIT_V(6); PG8_BAR;
    } else {
        PG8_STAGE(PG8_SB(0, 0), cB, voffB); PG8_STAGE(PG8_SA(0, 0), cA, voffA); PG8_STAGE(PG8_SB(0, 1), cB + hstep, voffB); PG8_STAGE(PG8_SA(0, 1), cA + hstep, voffA);
        if (wr == 1) PG8_BAR;
        PG8_WAIT_V(4); PG8_BAR;
        PG8_STAGE(PG8_SB(1, 0), cB + kstep, voffB); PG8_STAGE(PG8_SA(1, 0), cA + kstep, voffA); PG8_STAGE(PG8_SB(1, 1), cB + hstep + kstep, voffB);
        PG8_WAIT_V(6); PG8_BAR;
    }
    for (;;) {
        const bool has_next = S.next(ui + 1, nxt);
        const char* nA = has_next ? (const char*)g.A + (size_t)nxt.pm * tstep : cA; const char* nB = has_next ? (const char*)g.Bt + (size_t)nxt.pn * tstep : cB;
        for (int t = 0; t < nt; t += 2) {
            const bool last = (t == nt - 2);
            const char* a1 = cA + (size_t)(t + 1) * kstep;
            const char* a2 = last ? nA : cA + (size_t)(t + 2) * kstep; const char* b2 = last ? nB : cB + (size_t)(t + 2) * kstep;
            const char* a3 = a2 + kstep; const char* b3 = b2 + kstep;
            if (last && has_next) S.a_ready(nxt);
            if constexpr (SP2) {
            PG8_LDB(B0, 0, 0); PG8_LDB(B1, 0, 1); PG8_SCHED; PG8_LDA(At, 0, 0); PG8_STAGE(PG8_SA(1, 1), a1 + hstep, voffA);
            PG8_WAIT_V(8); PG8_WAIT_L(0); PG8_BAR; PG8_MMA(0, 0, At, B0); PG8_MMA(0, 1, At, B1); PG8_BAR; PG8_SCHED;
            PG8_LDA(At, 0, 1); PG8_STAGE(PG8_SB(0, 0), b2, voffB); PG8_STAGE(PG8_SB(0, 1), b2 + hstep, voffB); PG8_STAGE(PG8_SA(0, 0), a2, voffA);
            PG8_WAIT_V(8); PG8_WAIT_L(0); PG8_BAR; PG8_MMA(1, 0, At, B0); PG8_MMA(1, 1, At, B1); PG8_BAR; PG8_SCHED;
            PG8_LDB(B0, 1, 0); PG8_LDB(B1, 1, 1); PG8_SCHED; PG8_LDA(At, 1, 0); PG8_STAGE(PG8_SA(0, 1), a2 + hstep, voffA);
            PG8_WAIT_V(8); PG8_WAIT_L(0); PG8_BAR; PG8_MMA(0, 0, At, B0); PG8_MMA(0, 1, At, B1); PG8_BAR; PG8_SCHED;
            PG8_LDA(At, 1, 1); PG8_STAGE(PG8_SB(1, 0), b3, voffB); PG8_STAGE(PG8_SB(1, 1), b3 + hstep, voffB); PG8_STAGE(PG8_SA(1, 0), a3, voffA);
            PG8_WAIT_V(8); PG8_WAIT_L(0); PG8_BAR; PG8_MMA(1, 0, At, B0); PG8_MMA(1, 1, At, B1); PG8_BAR; PG8_SCHED;
            } else {
            PG8_LDB(B0, 0, 0); PG8_SCHED; PG8_LDA(At, 0, 0); PG8_STAGE(PG8_SA(1, 1), a1 + hstep, voffA);
            PG8_WAIT_L(8); PG8_BAR; PG8_WAIT_L(0); PG8_MMA(0, 0, At, B0); PG8_BAR; PG8_SCHED;
            PG8_LDB(B1, 0, 1); PG8_STAGE(PG8_SB(0, 0), b2, voffB);
            PG8_BAR; PG8_WAIT_L(0); PG8_MMA(0, 1, At, B1); PG8_BAR;
            PG8_LDA(At, 0, 1); PG8_STAGE(PG8_SA(0, 0), a2, voffA);
            PG8_BAR; PG8_WAIT_L(0); PG8_MMA(1, 0, At, B0); PG8_BAR; PG8_SCHED;
            PG8_STAGE(PG8_SB(0, 1), b2 + hstep, voffB);
            PG8_WAIT_V(6); PG8_BAR; PG8_MMA(1, 1, At, B1); PG8_BAR;
            PG8_LDB(B0, 1, 0); PG8_SCHED; PG8_LDA(At, 1, 0); PG8_STAGE(PG8_SA(0, 1), a2 + hstep, voffA);
            PG8_WAIT_L(8); PG8_BAR; PG8_WAIT_L(0); PG8_MMA(0, 0, At, B0); PG8_BAR; PG8_SCHED;
            PG8_LDB(B1, 1, 1); PG8_STAGE(PG8_SB(1, 0), b3, voffB);
            PG8_BAR; PG8_WAIT_L(0); PG8_MMA(0, 1, At, B1); PG8_BAR;
            PG8_LDA(At, 1, 1); PG8_STAGE(PG8_SA(1, 0), a3, voffA);
            PG8_BAR; PG8_WAIT_L(0); PG8_MMA(1, 0, At, B0); PG8_BAR; PG8_SCHED;
            PG8_STAGE(PG8_SB(1, 1), b3 + hstep, voffB);
            PG8_WAIT_V(6); PG8_BAR; PG8_MMA(1, 1, At, B1); PG8_BAR;
            }
        }
        if constexpr (ALIGN_EPI) { if (wr == 0) PG8_BAR; }
        if constexpr (!Epi::AFTER_DRAIN) { E(acc, cur, wr, wc, fr, fq); S.done(cur); }
        if (!has_next) break;
#pragma unroll
        for (int a = 0; a < 2; ++a)
#pragma unroll
            for (int b = 0; b < 2; ++b)
#pragma unroll
                for (int m = 0; m < 4; ++m)
#pragma unroll
                    for (int n = 0; n < 2; ++n) acc[a][b][m][n] = (f32x4){0.f, 0.f, 0.f, 0.f};
        cur = nxt; cA = nA; cB = nB; ++ui;
        if constexpr (ALIGN_EPI) { if (wr == 1) PG8_BAR; }
    }
    PG8_WAIT_V(0);
    if constexpr (!ALIGN_EPI) { if (wr == 0) PG8_BAR; }
    PG8_BAR;
    if constexpr (Epi::AFTER_DRAIN) { E.fused(acc, cur, wr, wc, fr, fq, lds, wid, lane); S.done(cur); }
#undef PG8_SA
#undef PG8_SB
#undef PG8_STAGE
#undef PG8_LDA
#undef PG8_LDB
#undef PG8_MMA
#undef PG8_WAIT_V
#undef PG8_WAIT_L
#undef PG8_BAR
#undef PG8_SCHED
}
}

#define LAS __attribute__((address_space(3)))
typedef unsigned short bf16_t;
typedef short bf16x8 __attribute__((ext_vector_type(8)));
typedef float f32x4 __attribute__((ext_vector_type(4)));
typedef unsigned u32x4 __attribute__((ext_vector_type(4)));
typedef unsigned u32x2 __attribute__((ext_vector_type(2)));
using pg8::cvt_pk_bf16; using pg8::bflo; using pg8::bfhi;

constexpr int M = 16384, DM = 1024, NIN = 7592, NPAD = 7680, FF = 4096, DEPTH = 4;
constexpr int C_GQ = 0, C_GK = 512, C_GV = 1024, C_GA = 1536, C_GR = 1552, C_SQ = 2064, C_SK = 2576, C_SV = 3088, C_NQ = 3600, C_NKC = 4112, C_NVC = 4176,
              C_NKS = 4240, C_NVS = 4304, C_NKW = 4368, C_NVW = 4432, C_NGATE = 4496, C_MGATE = 4520;
constexpr size_t MiB = 1u << 20;
constexpr size_t WS_PROJ = 0, WS_HID = 0, WS_HN = 240 * MiB, WS_OGLA = 272 * MiB, WS_OSB = 288 * MiB, WS_ONSA = 304 * MiB;
constexpr size_t WS_WIN = 320 * MiB, WS_WUP = 335 * MiB, WS_WDN = 343 * MiB, WS_WOUT = 351 * MiB, WS_WBR = 353 * MiB, WS_WK1 = 356 * MiB, WS_WV1 = 357 * MiB,
                 WS_WK2 = 358 * MiB, WS_WV2 = 358 * MiB + 65536, WS_CB = 358 * MiB + 131072, WS_LUT = 358 * MiB + 196608;
constexpr size_t WS_GST = 360 * MiB, WS_GDC = 424 * MiB, WS_SVT = 425 * MiB, WS_QN = 441 * MiB, WS_KSN = 457 * MiB, WS_KWN = 459 * MiB, WS_VST = 461 * MiB, WS_VWT = 463 * MiB,
                 WS_KCMP = 465 * MiB, WS_VCMPT = 465 * MiB + 131072, WS_END = 466 * MiB;
constexpr int LDS_BYTES = 133120;
constexpr float LOG2E = 1.4426950408889634f;

struct KArgs { const float* in[22]; float* out; unsigned char* ws; };

__device__ __forceinline__ float bf2f(bf16_t v) { return __uint_as_float(((unsigned)v) << 16); }
__device__ __forceinline__ bf16_t f2bf(float f) { unsigned u = __float_as_uint(f); return (bf16_t)((u + 0x7fffu + ((u >> 16) & 1u)) >> 16); }
__device__ __forceinline__ f32x4 mfma16(bf16x8 a, bf16x8 b, f32x4 c) { return __builtin_amdgcn_mfma_f32_16x16x32_bf16(a, b, c, 0, 0, 0); }
__device__ __forceinline__ float wave_sum(float v) {
#pragma unroll
    for (int o = 1; o < 64; o <<= 1) v += __shfl_xor(v, o);
    return v;
}
#define LDS_FENCE() asm volatile("s_waitcnt lgkmcnt(0)" ::: "memory")
__device__ __forceinline__ void unpack8(const u32x4 w, float (&f)[8]) { f[0] = bflo(w.x); f[1] = bfhi(w.x); f[2] = bflo(w.y); f[3] = bfhi(w.y); f[4] = bflo(w.z); f[5] = bfhi(w.z); f[6] = bflo(w.w); f[7] = bfhi(w.w); }
__device__ __forceinline__ u32x4 pack8(const float (&r)[8]) { u32x4 w; w.x = cvt_pk_bf16(r[0], r[1]); w.y = cvt_pk_bf16(r[2], r[3]); w.z = cvt_pk_bf16(r[4], r[5]); w.w = cvt_pk_bf16(r[6], r[7]); return w; }

__device__ __forceinline__ void transpose_item(const float* W, int K, int N, int Npad, bf16_t* WT, LAS float* scr, int item, int lane) {
    const int nblk = Npad / 32, kb = item / nblk, nb = item % nblk, k0 = 64 * kb, n0 = 32 * nb;
    const int nn = n0 + (lane & 31);
#pragma unroll 8
    for (int i = 0; i < 32; ++i) { const int kk = 2 * i + (lane >> 5); scr[kk * 33 + (lane & 31)] = (nn < N) ? W[(size_t)(k0 + kk) * N + nn] : 0.f; }
    LDS_FENCE();
    const int c = lane & 7;
#pragma unroll
    for (int j = 0; j < 4; ++j) { const int n = (lane >> 3) + 8 * j; const LAS float* s = scr + (8 * c) * 33 + n;
        u32x4 o; o.x = cvt_pk_bf16(s[0 * 33], s[1 * 33]); o.y = cvt_pk_bf16(s[2 * 33], s[3 * 33]); o.z = cvt_pk_bf16(s[4 * 33], s[5 * 33]); o.w = cvt_pk_bf16(s[6 * 33], s[7 * 33]);
        *(u32x4*)(WT + (size_t)(n0 + n) * K + k0 + 8 * c) = o; }
    LDS_FENCE();
}
__device__ __forceinline__ int rel_bucket(int n) {
    if (n < 16) return n;
    int large = 16 + (int)(logf((float)n / 16.f) / 4.1588830833596715f * 16.f);
    return large < 31 ? large : 31;
}
__device__ __forceinline__ void rms_row(const float* xrow, const float* g, bf16_t* orow, int lane) {
    const f32x4* xr = (const f32x4*)xrow + lane; f32x4 v[4]; float s = 0.f;
#pragma unroll
    for (int j = 0; j < 4; ++j) { v[j] = xr[64 * j]; s += (v[j].x * v[j].x + v[j].y * v[j].y) + (v[j].z * v[j].z + v[j].w * v[j].w); }
    const float rinv = rsqrtf(wave_sum(s) * (1.f / 1024.f) + 1e-6f);
    u32x2* o8 = (u32x2*)orow + lane;
#pragma unroll
    for (int j = 0; j < 4; ++j) { const f32x4 gg = ((const f32x4*)g)[lane + 64 * j]; u32x2 w; w.x = cvt_pk_bf16(v[j].x * rinv * gg.x, v[j].y * rinv * gg.y); w.y = cvt_pk_bf16(v[j].z * rinv * gg.z, v[j].w * rinv * gg.w); o8[64 * j] = w; }
}
__device__ __forceinline__ void phase_convert(const KArgs& a, int l, LAS unsigned char* lds, int gw, int NGW, int wave, int lane) {
    unsigned char* ws = a.ws;
    LAS float* scr = (LAS float*)(lds + wave * 8704);
    constexpr int I0 = 16 * 240, I1 = 16 * 128, I2 = 64 * 32, I3 = 16 * 32, I4 = 8 * 32, I7 = 32 * 8, I9 = 4 * 2, IB = 128, IL = 128;
    constexpr int NIT = I0 + I1 + I2 + I3 + 3 * I4 + 2 * I7 + 2 * I9 + IB + IL;
    for (int it = gw; it < NIT; it += NGW) {
        int r = it;
        if (r < I0) { transpose_item(a.in[3] + (size_t)l * DM * NIN, DM, NIN, NPAD, (bf16_t*)(ws + WS_WIN), scr, r, lane); continue; } r -= I0;
        if (r < I1) { transpose_item(a.in[20] + (size_t)l * DM * FF, DM, FF, FF, (bf16_t*)(ws + WS_WUP), scr, r, lane); continue; } r -= I1;
        if (r < I2) { transpose_item(a.in[21] + (size_t)l * FF * DM, FF, DM, DM, (bf16_t*)(ws + WS_WDN), scr, r, lane); continue; } r -= I2;
        if (r < I3) { transpose_item(a.in[19] + (size_t)l * DM * DM, DM, DM, DM, (bf16_t*)(ws + WS_WOUT), scr, r, lane); continue; } r -= I3;
        if (r < 3 * I4) { const int b = r / I4; transpose_item(a.in[16 + b] + (size_t)l * 512 * DM, 512, DM, DM, (bf16_t*)(ws + WS_WBR + b * MiB), scr, r % I4, lane); continue; } r -= 3 * I4;
        if (r < I7) { transpose_item(a.in[11] + (size_t)l * 2048 * 256, 2048, 256, 256, (bf16_t*)(ws + WS_WK1), scr, r, lane); continue; } r -= I7;
        if (r < I7) { transpose_item(a.in[13] + (size_t)l * 2048 * 256, 2048, 256, 256, (bf16_t*)(ws + WS_WV1), scr, r, lane); continue; } r -= I7;
        if (r < I9) { transpose_item(a.in[12] + (size_t)l * 256 * 64, 256, 64, 64, (bf16_t*)(ws + WS_WK2), scr, r, lane); continue; } r -= I9;
        if (r < I9) { transpose_item(a.in[14] + (size_t)l * 256 * 64, 256, 64, 64, (bf16_t*)(ws + WS_WV2), scr, r, lane); continue; } r -= I9;
        if (r < IB) {
            const int p = r >> 3, which = (r >> 2) & 1, col = (r & 3) * 64 + lane;
            const float* pe = a.in[which ? 10 : 9] + (size_t)l * 2048; const float* w1 = a.in[which ? 13 : 11] + (size_t)l * 2048 * 256;
            float s = 0.f;
#pragma unroll 1
            for (int k0 = 128 * p; k0 < 128 * p + 128; k0 += 16) { float wv[16];
#pragma unroll
                for (int i = 0; i < 16; ++i) wv[i] = w1[(size_t)(k0 + i) * 256 + col];
#pragma unroll
                for (int i = 0; i < 16; ++i) s += pe[k0 + i] * wv[i]; }
            ((float*)(ws + WS_CB))[p * 512 + which * 256 + col] = s; continue; } r -= IB;
        {
            const int idx = r * 64 + lane; const int d = idx >> 3, h = idx & 7;
            ((float*)(ws + WS_LUT))[idx] = a.in[15][rel_bucket(d) * 8 + h] * LOG2E; }
    }
}
__device__ __forceinline__ void phase_rms(const float* x, const float* g, bf16_t* hn, int gw, int NGW, int lane) {
    for (int m = gw; m < M; m += NGW) rms_row(x + (size_t)m * DM, g, hn + (size_t)m * DM, lane);
}

__device__ __forceinline__ void rms64_to(const bf16_t* src, const float* g, float scale, bf16_t* dst) {
    u32x4 w[8]; float ss = 0.f;
#pragma unroll
    for (int i = 0; i < 8; ++i) { w[i] = ((const u32x4*)src)[i]; float f[8]; unpack8(w[i], f);
#pragma unroll
        for (int e = 0; e < 8; ++e) ss += f[e] * f[e]; }
    const float rinv = rsqrtf(ss * (1.f / 64.f) + 1e-6f) * scale;
#pragma unroll
    for (int i = 0; i < 8; ++i) { float f[8]; unpack8(w[i], f); float r[8];
#pragma unroll
        for (int e = 0; e < 8; ++e) r[e] = f[e] * rinv * g[8 * i + e];
        ((u32x4*)dst)[i] = pack8(r); }
}
__device__ __forceinline__ void pre_item(const KArgs& a, int l, LAS unsigned char* lds, int item, int tid) {
    unsigned char* ws = a.ws; const bf16_t* proj = (const bf16_t*)(ws + WS_PROJ);
    const int t0 = item * 64;
    {
        const int tl = tid >> 3, h = tid & 7;
        rms64_to(proj + (size_t)(t0 + tl) * NPAD + C_NQ + h * 64, a.in[7] + l * 64, 0.125f * LOG2E, (bf16_t*)(ws + WS_QN) + (size_t)(t0 + tl) * 512 + h * 64);
    }
    if (tid < 128) {
        const int tl = tid >> 1, which = tid & 1;
        rms64_to(proj + (size_t)(t0 + tl) * NPAD + (which ? C_NKW : C_NKS), a.in[8] + l * 64, 1.f, (bf16_t*)(ws + (which ? WS_KWN : WS_KSN)) + (size_t)(t0 + tl) * 64);
    }
    LAS bf16_t* T = (LAS bf16_t*)lds;
    for (int idx = tid; idx < 64 * 80; idx += 512) { const int t = idx / 80, p = idx % 80; const int col = p < 64 ? C_SV + 8 * p : (p < 72 ? C_NVS + 8 * (p - 64) : C_NVW + 8 * (p - 72));
        const u32x4 w = *(const u32x4*)(proj + (size_t)(t0 + t) * NPAD + col);
        LAS unsigned* d = (LAS unsigned*)(T + t * 648 + 8 * p); d[0] = w.x; d[1] = w.y; d[2] = w.z; d[3] = w.w; }
    __syncthreads();
    for (int idx = tid; idx < 640 * 8; idx += 512) { const int c = idx >> 3, p = idx & 7;
        unsigned short e[8];
#pragma unroll
        for (int j = 0; j < 8; ++j) e[j] = T[(8 * p + j) * 648 + c];
        u32x4 w; w.x = e[0] | ((unsigned)e[1] << 16); w.y = e[2] | ((unsigned)e[3] << 16); w.z = e[4] | ((unsigned)e[5] << 16); w.w = e[6] | ((unsigned)e[7] << 16);
        const int tk = t0 + 8 * p;
        if (c < 512) *(u32x4*)((bf16_t*)(ws + WS_SVT) + ((size_t)(((c >> 7) * 256 + (tk >> 6)) * 128 + (c & 127))) * 64 + (tk & 63)) = w;
        else { const int d = (c - 512) & 63; bf16_t* vb = (bf16_t*)(ws + (c < 576 ? WS_VST : WS_VWT)); *(u32x4*)(vb + ((size_t)((tk >> 5) * 64 + d)) * 32 + (tk & 31)) = w; } }
    __syncthreads();
}
__device__ __forceinline__ void cmp_item(const KArgs& a, int l, LAS unsigned char* lds, int item, int tid, int wave, int lane) {
    unsigned char* ws = a.ws; const bf16_t* proj = (const bf16_t*)(ws + WS_PROJ);
    const int which = item & 1, grp = item >> 1, i0 = 16 * grp;
    const int srcoff = which ? C_NVC : C_NKC;
    const bf16_t* w1T = (const bf16_t*)(ws + (which ? WS_WV1 : WS_WK1)); const bf16_t* w2T = (const bf16_t*)(ws + (which ? WS_WV2 : WS_WK2));
    LAS bf16_t* hidL = (LAS bf16_t*)lds;
    LAS float* outL = (LAS float*)(lds + 16384);
    LAS float* rinvL = (LAS float*)(lds + 24576);
    const int r = lane & 15, g = lane >> 4;
    int irow = i0 + r; if (irow > 1022) irow = 1022;
    const bf16_t* arow = proj + (size_t)(16 * irow) * NPAD + srcoff;
    f32x4 acc[2] = {(f32x4){0.f, 0.f, 0.f, 0.f}, (f32x4){0.f, 0.f, 0.f, 0.f}};
    const bf16_t* b0 = w1T + (size_t)(32 * wave + r) * 2048 + 8 * g; const bf16_t* b1 = b0 + 16 * 2048;
#pragma unroll 8
    for (int ks = 0; ks < 64; ++ks) { const int k = 32 * ks + 8 * g;
        const bf16x8 af = *(const bf16x8*)(arow + (size_t)(k >> 6) * NPAD + (k & 63));
        const bf16x8 bf0 = *(const bf16x8*)(b0 + 32 * ks), bf1 = *(const bf16x8*)(b1 + 32 * ks);
        acc[0] = mfma16(af, bf0, acc[0]); acc[1] = mfma16(af, bf1, acc[1]); }
    const float* cb = (const float*)(ws + WS_CB);
#pragma unroll
    for (int nb = 0; nb < 2; ++nb) { const int col = 32 * wave + 16 * nb + r; float bs = 0.f;
#pragma unroll
        for (int p = 0; p < 16; ++p) bs += cb[p * 512 + which * 256 + col];
#pragma unroll
        for (int j = 0; j < 4; ++j) { const float x = acc[nb][j] + bs; const float u = 0.7978845608028654f * (x + 0.044715f * x * x * x);
            const float th = 1.f - 2.f / (__expf(2.f * u) + 1.f); hidL[(4 * g + j) * 264 + col] = f2bf(0.5f * x * (1.f + th)); } }
    __syncthreads();
    if (wave < 4) { f32x4 c2 = (f32x4){0.f, 0.f, 0.f, 0.f};
#pragma unroll
        for (int ks = 0; ks < 8; ++ks) { const bf16x8 af = *(const LAS bf16x8*)(hidL + r * 264 + 32 * ks + 8 * g); const bf16x8 bfr = *(const bf16x8*)(w2T + (size_t)(16 * wave + r) * 256 + 32 * ks + 8 * g); c2 = mfma16(af, bfr, c2); }
#pragma unroll
        for (int j = 0; j < 4; ++j) outL[(4 * g + j) * 65 + 16 * wave + r] = c2[j]; }
    __syncthreads();
    if (tid < 16) { float ss = 0.f; for (int d = 0; d < 64; ++d) { const float v = outL[tid * 65 + d]; ss += v * v; } rinvL[tid] = rsqrtf(ss * (1.f / 64.f) + 1e-6f); }
    __syncthreads();
    const float* kg = a.in[8] + l * 64;
    for (int idx = tid; idx < 1024; idx += 512) { const int row = idx >> 6, d = idx & 63, i = i0 + row; const float v = outL[row * 65 + d];
        if (which == 0) ((bf16_t*)(ws + WS_KCMP))[(size_t)i * 64 + d] = (i <= 1022) ? f2bf(v * rinvL[row] * kg[d]) : (bf16_t)0;
        else ((bf16_t*)(ws + WS_VCMPT))[((size_t)((i >> 5) * 64 + d)) * 32 + (i & 31)] = (i <= 1022) ? f2bf(v) : (bf16_t)0; }
    __syncthreads();
}
__device__ __forceinline__ void gla_decay(const KArgs& a, int l, int c, int h, LAS float* bL, LAS float* aL, int tid) {
    const bf16_t* proj = (const bf16_t*)(a.ws + WS_PROJ);
    LAS float* segL = aL + 512;
    { const int t = tid >> 4, r = tid & 15; aL[tid] = bf2f(proj[(size_t)(32 * c + t) * NPAD + C_GA + r]); }
    __syncthreads();
    const int kk = tid & 127, sg = tid >> 7;
    { const int hk = h * 128 + kk; float w[16];
#pragma unroll
        for (int r = 0; r < 16; ++r) w[r] = a.in[4][(size_t)l * 16 * 512 + r * 512 + hk];
        const float ba = a.in[5][l * 512 + hk]; float cum = 0.f;
#pragma unroll
        for (int tt = 0; tt < 8; ++tt) { const int t = 8 * sg + tt; float x = ba;
#pragma unroll
            for (int r = 0; r < 16; ++r) x += aL[t * 16 + r] * w[r];
            const float ls = fminf(x, 0.f) - __logf(1.f + __expf(-fabsf(x)));
            cum += ls * (1.f / 16.f); bL[t * 128 + kk] = cum; }
        segL[sg * 128 + kk] = cum; }
    __syncthreads();
    { float off = 0.f;
#pragma unroll
        for (int q = 0; q < 3; ++q) if (q < sg) off += segL[q * 128 + kk];
        if (sg > 0) {
#pragma unroll
            for (int tt = 0; tt < 8; ++tt) bL[(8 * sg + tt) * 128 + kk] += off; } }
    __syncthreads();
}
__device__ __forceinline__ void gla_g1_item(const KArgs& a, int l, LAS unsigned char* lds, int item, int tid, int wave, int lane) {
    unsigned char* ws = a.ws; const bf16_t* proj = (const bf16_t*)(ws + WS_PROJ);
    const int c = item >> 2, h = item & 3;
    LAS float* bL = (LAS float*)lds; LAS float* aL = (LAS float*)(lds + 16384);
    LAS bf16_t* kT = (LAS bf16_t*)(lds + 20480);
    LAS bf16_t* vT = (LAS bf16_t*)(lds + 20480 + 10240);
    gla_decay(a, l, c, h, bL, aL, tid);
    for (int idx = tid; idx < 32 * 128; idx += 512) { const int s = idx >> 7, k = idx & 127; const size_t ro = (size_t)(32 * c + s) * NPAD + h * 128 + k;
        kT[k * 40 + s] = f2bf(bf2f(proj[ro + C_GK]) * __expf(bL[31 * 128 + k] - bL[s * 128 + k])); vT[k * 40 + s] = proj[ro + C_GV]; }
    if (tid < 128) ((float*)(ws + WS_GDC))[(size_t)(c * 4 + h) * 128 + tid] = __expf(bL[31 * 128 + tid]);
    __syncthreads();
    const int r = lane & 15, g = lane >> 4;
    const bf16x8 af = *(const LAS bf16x8*)(vT + (16 * wave + r) * 40 + 8 * g);
    bf16_t* dst = (bf16_t*)(ws + WS_GST) + (size_t)(c * 4 + h) * 16384;
#pragma unroll
    for (int kb = 0; kb < 8; ++kb) { const bf16x8 bfr = *(const LAS bf16x8*)(kT + (16 * kb + r) * 40 + 8 * g);
        const f32x4 d = mfma16(af, bfr, (f32x4){0.f, 0.f, 0.f, 0.f});
#pragma unroll
        for (int j = 0; j < 4; ++j) dst[(size_t)(16 * wave + 4 * g + j) * 128 + 16 * kb + r] = f2bf(d[j]); }
    __syncthreads();
}
__device__ __forceinline__ void gla_scan(const KArgs& a, int cid) {
    bf16_t* st = (bf16_t*)(a.ws + WS_GST); const float* dc = (const float*)(a.ws + WS_GDC);
    const int h = cid >> 14, vk = cid & 16383, k = cid & 127;
    float state = 0.f;
    for (int c0 = 0; c0 < 512; c0 += 8) { float kv[8], d[8];
#pragma unroll
        for (int i = 0; i < 8; ++i) { kv[i] = bf2f(st[(size_t)((c0 + i) * 4 + h) * 16384 + vk]); d[i] = dc[(size_t)((c0 + i) * 4 + h) * 128 + k]; }
#pragma unroll
        for (int i = 0; i < 8; ++i) { st[(size_t)((c0 + i) * 4 + h) * 16384 + vk] = f2bf(state); state = state * d[i] + kv[i]; } }
}
__device__ __forceinline__ void gla_g3_item(const KArgs& a, int l, LAS unsigned char* lds, int item, int tid, int wave, int lane) {
    unsigned char* ws = a.ws; const bf16_t* proj = (const bf16_t*)(ws + WS_PROJ);
    const int c = item >> 2, h = item & 3;
    LAS float* bL = (LAS float*)lds; LAS float* aL = (LAS float*)(lds + 16384);
    LAS bf16_t* qL = (LAS bf16_t*)(lds + 20480);
    LAS bf16_t* kL = (LAS bf16_t*)(lds + 20480 + 8704);
    LAS bf16_t* vT = (LAS bf16_t*)(lds + 20480 + 17408);
    LAS bf16_t* scL = (LAS bf16_t*)(lds + 20480 + 27648);
    LAS float* oL = (LAS float*)(lds + 20480 + 30208);
    gla_decay(a, l, c, h, bL, aL, tid);
    for (int idx = tid; idx < 32 * 128; idx += 512) { const int s = idx >> 7, k = idx & 127; const size_t ro = (size_t)(32 * c + s) * NPAD + h * 128 + k; const float b = bL[s * 128 + k];
        qL[s * 136 + k] = f2bf(bf2f(proj[ro + C_GQ]) * __expf(b) * 0.08838834764831845f); kL[s * 136 + k] = f2bf(bf2f(proj[ro + C_GK]) * __expf(-b)); vT[k * 40 + s] = proj[ro + C_GV]; }
    __syncthreads();
    const int r = lane & 15, g = lane >> 4;
    if (wave < 4) { const int mb = wave >> 1, nb = wave & 1; f32x4 d = (f32x4){0.f, 0.f, 0.f, 0.f};
#pragma unroll
        for (int ks = 0; ks < 4; ++ks) d = mfma16(*(const LAS bf16x8*)(qL + (16 * mb + r) * 136 + 32 * ks + 8 * g), *(const LAS bf16x8*)(kL + (16 * nb + r) * 136 + 32 * ks + 8 * g), d);
#pragma unroll
        for (int j = 0; j < 4; ++j) { const int t = 16 * mb + 4 * g + j, s = 16 * nb + r; scL[t * 40 + s] = (s <= t) ? f2bf(d[j]) : (bf16_t)0; } }
    __syncthreads();
    const bf16_t* stT = (const bf16_t*)(ws + WS_GST) + (size_t)(c * 4 + h) * 16384;
#pragma unroll
    for (int mb = 0; mb < 2; ++mb) { f32x4 d = (f32x4){0.f, 0.f, 0.f, 0.f};
#pragma unroll
        for (int ks = 0; ks < 4; ++ks) d = mfma16(*(const LAS bf16x8*)(qL + (16 * mb + r) * 136 + 32 * ks + 8 * g), *(const bf16x8*)(stT + (size_t)(16 * wave + r) * 128 + 32 * ks + 8 * g), d);
        d = mfma16(*(const LAS bf16x8*)(scL + (16 * mb + r) * 40 + 8 * g), *(const LAS bf16x8*)(vT + (16 * wave + r) * 40 + 8 * g), d);
#pragma unroll
        for (int j = 0; j < 4; ++j) oL[(16 * mb + 4 * g + j) * 132 + 16 * wave + r] = d[j]; }
    __syncthreads();
    { const int t = tid >> 4, v0 = (tid & 15) * 8; float o[8]; float ss = 0.f;
#pragma unroll
        for (int e = 0; e < 8; ++e) { o[e] = oL[t * 132 + v0 + e]; ss += o[e] * o[e]; }
        ss += __shfl_xor(ss, 1); ss += __shfl_xor(ss, 2); ss += __shfl_xor(ss, 4); ss += __shfl_xor(ss, 8);
        const float rinv = rsqrtf(ss * (1.f / 128.f) + 1e-6f);
        const u32x4 rw = *(const u32x4*)(proj + (size_t)(32 * c + t) * NPAD + C_GR + h * 128 + v0); float rr[8]; unpack8(rw, rr);
        const float* ng = a.in[6] + l * 128 + v0; float res[8];
#pragma unroll
        for (int e = 0; e < 8; ++e) { const float on = o[e] * rinv * ng[e]; const float si = rr[e] / (1.f + __expf(-rr[e])); res[e] = on * si; }
        *(u32x4*)((bf16_t*)(ws + WS_OGLA) + (size_t)(32 * c + t) * 512 + h * 128 + v0) = pack8(res); }
    __syncthreads();
}

__device__ __forceinline__ float xor16f(float t, int g) { const auto r = __builtin_amdgcn_permlane16_swap(__float_as_uint(t), __float_as_uint(t), false, false); return __uint_as_float(r[0] == __float_as_uint(t) ? r[1] : r[0]); }
__device__ __forceinline__ float xor32f(float t, int g) { const auto r = __builtin_amdgcn_permlane32_swap(__float_as_uint(t), __float_as_uint(t), false, false); return __uint_as_float(r[0] == __float_as_uint(t) ? r[1] : r[0]); }
#define SCHED_FENCE() __builtin_amdgcn_sched_barrier(0)
template <bool DIAG>
__device__ __forceinline__ void sb_weights(const f32x4 (&S)[2], bf16x8& pf, float& carry, int g, int cc, int krel) {
    float e[8], P[8];
#pragma unroll
    for (int j = 0; j < 8; ++j) { int zi = __float_as_int(S[j >> 2][j & 3]); zi = zi < 0x41700000 ? zi : 0x41700000;
        float z = __int_as_float(zi);
        if (DIAG) { if (32 * cc + 8 * g + j >= krel) z = -1e30f; }
        e[j] = __builtin_amdgcn_exp2f(z); }
    P[0] = 1.f;
#pragma unroll
    for (int j = 1; j < 8; ++j) P[j] = P[j - 1] * (1.f + e[j - 1]);
    const float Tg = __builtin_amdgcn_rcpf(P[7] * (1.f + e[7]));
    const float t1 = __shfl_xor(Tg, 16);
    const float pp = Tg * t1;
    const float t23 = __shfl_xor(pp, 32);
    const float gex = ((g & 1) ? 1.f : t1) * ((g & 2) ? 1.f : t23);
    const float cf = Tg * gex * carry;
    carry = carry * (pp * t23);
    float w[8];
#pragma unroll
    for (int j = 0; j < 8; ++j) w[j] = (e[j] * P[j]) * cf;
    const u32x4 pw = pack8(w); __builtin_memcpy(&pf, &pw, 16);
}
template <bool DIAG>
__device__ __forceinline__ void sb_tile(const LAS bf16_t* Kt, const LAS bf16_t* Vt, const bf16x8 (&qf)[4], f32x4 (&O)[8], float& carry, int n, int g, int krel  ) {
    bf16x8 kf[2][2][4];
#pragma unroll
    for (int cc = 1; cc >= 0; --cc)
#pragma unroll
        for (int pb = 0; pb < 2; ++pb)
#pragma unroll
            for (int ks = 0; ks < 4; ++ks) kf[cc][pb][ks] = *(const LAS bf16x8*)(Kt + (32 * cc + 16 * pb + n) * 128 + (((4 * ks + g) ^ n) << 3));
    SCHED_FENCE();
    f32x4 S[2][2];
#pragma unroll
    for (int cc = 1; cc >= 0; --cc)
#pragma unroll
        for (int pb = 0; pb < 2; ++pb) { f32x4 sv = (f32x4){0.f, 0.f, 0.f, 0.f};
#pragma unroll
            for (int ks = 0; ks < 4; ++ks) sv = mfma16(kf[cc][pb][ks], qf[ks], sv);
            S[cc][pb] = sv; }
    SCHED_FENCE();
    bf16x8 vf1[8], vf0[8], pf1, pf0;
#pragma unroll
    for (int db = 0; db < 8; ++db) vf1[db] = *(const LAS bf16x8*)(Vt + (16 * db + n) * 64 + (((4 + g) ^ (n >> 1)) << 3));
    SCHED_FENCE();
    sb_weights<DIAG>(S[1], pf1, carry, g, 1, krel);
    SCHED_FENCE();
#pragma unroll
    for (int db = 0; db < 8; ++db) vf0[db] = *(const LAS bf16x8*)(Vt + (16 * db + n) * 64 + ((g ^ (n >> 1)) << 3));
    SCHED_FENCE();
#pragma unroll
    for (int db = 0; db < 8; ++db) O[db] = mfma16(vf1[db], pf1, O[db]);
    SCHED_FENCE();
    sb_weights<DIAG>(S[0], pf0, carry, g, 0, krel);
    SCHED_FENCE();
#pragma unroll
    for (int db = 0; db < 8; ++db) O[db] = mfma16(vf0[db], pf0, O[db]);
    SCHED_FENCE();
}
__device__ __forceinline__ void sb_unit(const KArgs& a, LAS unsigned char* lds, int h, int qb, int tid, int wave, int lane) {
    unsigned char* ws = a.ws; const bf16_t* proj = (const bf16_t*)(ws + WS_PROJ);
    constexpr int KT_B = 64 * 256, BUF_B = 32768;
    const int n = lane & 15, g = lane >> 4;
    const int tq = 128 * qb + 16 * wave + n;
    const float SC = 0.08838834764831845f * LOG2E;
    bf16x8 qf[4];
#pragma unroll
    for (int ks = 0; ks < 4; ++ks) { const u32x4 w = *(const u32x4*)(proj + (size_t)tq * NPAD + C_SQ + h * 128 + 32 * ks + 8 * g); float f[8]; unpack8(w, f);
#pragma unroll
        for (int e = 0; e < 8; ++e) f[e] *= SC;
        const u32x4 pw = pack8(f); __builtin_memcpy(&qf[ks], &pw, 16); }
    f32x4 O[8];
#pragma unroll
    for (int i = 0; i < 8; ++i) O[i] = (f32x4){0.f, 0.f, 0.f, 0.f};
    float carry = 1.f;
    const int ntiles = 2 * qb + 2;
    unsigned koff[2], voff[2];
#pragma unroll
    for (int i = 0; i < 2; ++i) { const int p = i * 512 + wave * 64 + lane;
        const int rho = p >> 4, c = (p & 15) ^ (rho & 15), k = (rho & 32) | ((rho & 16) >> 2) | ((rho & 12) << 1) | (rho & 3);
        koff[i] = (unsigned)(k * NPAD + 8 * c) * 2u;
        const int d = p >> 3, cv = (p & 7) ^ ((d >> 1) & 7);
        voff[i] = (unsigned)(d * 64 + 8 * cv) * 2u; }
    const char* kbase = (const char*)(proj + C_SK + h * 128); const char* vbase = (const char*)((const bf16_t*)(ws + WS_SVT) + (size_t)h * 256 * 8192);
    auto issue = [&](int T, int buf) {
        const char* kt = kbase + (size_t)(64 * T) * NPAD * 2; const char* vt = vbase + (size_t)T * 16384;
#pragma unroll
        for (int i = 0; i < 2; ++i) {
            __builtin_amdgcn_global_load_lds((const unsigned*)(kt + koff[i]), (LAS unsigned*)(lds + buf * BUF_B + (i * 512 + wave * 64) * 16), 16, 0, 0);
            __builtin_amdgcn_global_load_lds((const unsigned*)(vt + voff[i]), (LAS unsigned*)(lds + buf * BUF_B + KT_B + (i * 512 + wave * 64) * 16), 16, 0, 0); } };
    issue(ntiles - 1, 0);
    issue(ntiles - 2, 1);
    asm volatile("s_waitcnt vmcnt(4)" ::: "memory"); __builtin_amdgcn_s_barrier(); asm volatile("" ::: "memory");
    const int wq_lo = 128 * qb + 16 * wave;
    int buf = 0;
    for (int it = 0; it < ntiles; ++it) { const int T = ntiles - 1 - it;
        int b2 = buf + 2; if (b2 >= 3) b2 -= 3;
        const bool more = (it + 2 < ntiles);
        if (more) issue(T - 2, b2);
        if (64 * T < wq_lo + 15) {
            const LAS bf16_t* Kt = (const LAS bf16_t*)(lds + buf * BUF_B); const LAS bf16_t* Vt = (const LAS bf16_t*)(lds + buf * BUF_B + KT_B);
            if (64 * T + 63 >= wq_lo) sb_tile<true>(Kt, Vt, qf, O, carry, n, g, tq - 64 * T);
            else sb_tile<false>(Kt, Vt, qf, O, carry, n, g, 0);
        }
        if (more) asm volatile("s_waitcnt vmcnt(4) lgkmcnt(0)" ::: "memory"); else asm volatile("s_waitcnt vmcnt(0) lgkmcnt(0)" ::: "memory");
        __builtin_amdgcn_s_barrier(); asm volatile("" ::: "memory");
        buf = buf + 1; if (buf >= 3) buf = 0;
    }
    bf16_t* orow = (bf16_t*)(ws + WS_OSB) + (size_t)tq * 512 + h * 128;
#pragma unroll
    for (int db = 0; db < 8; ++db) { u32x2 w; w.x = cvt_pk_bf16(O[db][0], O[db][1]); w.y = cvt_pk_bf16(O[db][2], O[db][3]); *(u32x2*)(orow + 16 * db + 4 * g) = w; }
}

struct NFrag { bf16x8 k[4]; bf16x8 v[4]; };
template <bool LV> __device__ __forceinline__ void nsa_load(NFrag& f, const bf16_t* Kb, const bf16_t* VB, int kb, int n, int g) {
    const bf16_t* kp = Kb + (size_t)(kb + 8 * (n >> 2) + (n & 3)) * 64 + 8 * g;
    f.k[0] = *(const bf16x8*)kp; f.k[1] = *(const bf16x8*)(kp + 32); f.k[2] = *(const bf16x8*)(kp + 256); f.k[3] = *(const bf16x8*)(kp + 288);
    if (LV) { const bf16_t* vp = VB + ((size_t)(kb >> 5) * 64 + n) * 32 + 8 * g;
#pragma unroll
        for (int db = 0; db < 4; ++db) f.v[db] = *(const bf16x8*)(vp + db * 512); }
}
template <int MODE>
__device__ __forceinline__ void nsa_compute(const NFrag& f, int kb, const bf16x8 (&qf)[2], const LAS float* LUTh, LAS float* impq,
                                            int tq, int h, int g, int qs, int qsel, float inv, float& lsum, f32x4 (&O)[4]) {
    f32x4 S[2];
#pragma unroll
    for (int pb = 0; pb < 2; ++pb) { f32x4 sv = mfma16(f.k[2 * pb], qf[0], (f32x4){0.f, 0.f, 0.f, 0.f}); S[pb] = mfma16(f.k[2 * pb + 1], qf[1], sv); }
    float p[8];
    const int dbase = (MODE <= 1) ? (tq - 31 - 16 * (kb + 8 * g)) : (tq - kb - 8 * g);
    const bool colok = (MODE == 2) ? (qs == qsel) : true;
    float bias[8];
#pragma unroll
    for (int j = 0; j < 8; ++j) { const int dist = (MODE <= 1) ? dbase - 16 * j : dbase - j; const unsigned di = min((unsigned)dist, 1023u); bias[j] = LUTh[di * 8]; }
#pragma unroll
    for (int j = 0; j < 8; ++j) asm volatile("" : "+v"(bias[j]));
#pragma unroll
    for (int j = 0; j < 8; ++j) { const int dist = (MODE <= 1) ? dbase - 16 * j : dbase - j;
        const bool valid = (MODE == 3) ? ((unsigned)dist < 512u) : (dist >= 0 && colok);
        const float ex = __builtin_amdgcn_exp2f(S[j >> 2][j & 3] + bias[j]);
        float pv = valid ? ex : 0.f;
        if (MODE == 1) pv *= inv;
        p[j] = pv; if (MODE != 1) lsum += pv; }
    if (MODE == 0) return;
    if (MODE == 1) {
#pragma unroll
        for (int j = 0; j < 8; ++j) { float v = p[j]; v += __shfl_xor(v, 1); v += __shfl_xor(v, 2); v += __shfl_xor(v, 4); if (h == 0) impq[kb + 8 * g + j] = v; } }
    const u32x4 pw = pack8(p); bf16x8 pf; __builtin_memcpy(&pf, &pw, 16);
#pragma unroll
    for (int db = 0; db < 4; ++db) O[db] = mfma16(f.v[db], pf, O[db]);
}
template <int MODE, class KBF, class QSF>
__device__ __forceinline__ void nsa_run(int niter, const bf16_t* Kb, const bf16_t* VB, KBF kbf, QSF qsf, const bf16x8 (&qf)[2], const LAS float* LUTh, LAS float* impq,
                                        int tq, int h, int n, int g, int qs, float inv, float& lsum, f32x4 (&O)[4]) {
    if (niter <= 0) return;
    NFrag A, C; const int last = niter - 1;
    nsa_load<MODE != 0>(A, Kb, VB, kbf(0), n, g);
    for (int i = 0; i < niter; i += 2) {
        nsa_load<MODE != 0>(C, Kb, VB, kbf(i + 1 < last ? i + 1 : last), n, g);
        SCHED_FENCE();
        nsa_compute<MODE>(A, kbf(i), qf, LUTh, impq, tq, h, g, qs, qsf(i), inv, lsum, O);
        SCHED_FENCE();
        if (i + 1 >= niter) break;
        nsa_load<MODE != 0>(A, Kb, VB, kbf(i + 2 < last ? i + 2 : last), n, g);
        SCHED_FENCE();
        nsa_compute<MODE>(C, kbf(i + 1), qf, LUTh, impq, tq, h, g, qs, qsf(i + 1), inv, lsum, O);
        SCHED_FENCE();
    }
}
__device__ __forceinline__ float lred(float l) { l += __shfl_xor(l, 16); l += __shfl_xor(l, 32); return l; }
__device__ __forceinline__ void nsa_unit(const KArgs& a, LAS unsigned char* lds, int unit, int wave, int lane) {
    unsigned char* ws = a.ws; const bf16_t* proj = (const bf16_t*)(ws + WS_PROJ);
    LAS float* imp = (LAS float*)(lds + 32768 + wave * 8192);
    LAS int* selL = (LAS int*)(lds + 98304 + wave * 128);
    const int t0 = 2 * unit, n = lane & 15, g = lane >> 4, qs = n >> 3, h = n & 7, tq = t0 + qs;
    const LAS float* LUT = (const LAS float*)lds + h;
    bf16x8 qf[2];
    qf[0] = *(const bf16x8*)((const bf16_t*)(ws + WS_QN) + (size_t)tq * 512 + h * 64 + 8 * g); qf[1] = *(const bf16x8*)((const bf16_t*)(ws + WS_QN) + (size_t)tq * 512 + h * 64 + 32 + 8 * g);
    const bf16_t* gp = proj + (size_t)tq * NPAD + C_NGATE + h * 3;
    const float g0 = 1.f / (1.f + __expf(-bf2f(gp[0]))), g1 = 1.f / (1.f + __expf(-bf2f(gp[1]))), g2 = 1.f / (1.f + __expf(-bf2f(gp[2])));
    f32x4 Ot[4], Ob[4];
#pragma unroll
    for (int i = 0; i < 4; ++i) { Ot[i] = (f32x4){0.f, 0.f, 0.f, 0.f}; Ob[i] = (f32x4){0.f, 0.f, 0.f, 0.f}; }
    const int nvmax = (t0 + 1 >= 31) ? (((t0 + 1 - 31) >> 4) + 1) : 0; const int nch = (nvmax + 31) >> 5;
    const bf16_t* KC = (const bf16_t*)(ws + WS_KCMP); const bf16_t* VCT = (const bf16_t*)(ws + WS_VCMPT);
    auto kb_lin = [](int i) { return 32 * i; }; auto qs_zero = [](int) { return 0; };
    float lsum = 0.f;
    nsa_run<0>(nch, KC, VCT, kb_lin, qs_zero, qf, LUT, imp + qs * 1024, tq, h, n, g, qs, 0.f, lsum, Ob);
    { const float l = lred(lsum); const float inv = l > 0.f ? 1.f / l : 0.f; float dummy = 0.f;
      nsa_run<1>(nch, KC, VCT, kb_lin, qs_zero, qf, LUT, imp + qs * 1024, tq, h, n, g, qs, inv, dummy, Ob); }
#pragma unroll
    for (int i = 0; i < 4; ++i) { Ot[i] += Ob[i] * g0; Ob[i] = (f32x4){0.f, 0.f, 0.f, 0.f}; }
    LDS_FENCE();
    int cnts[2];
#pragma unroll
    for (int q2 = 0; q2 < 2; ++q2) { const int tqq = t0 + q2, cur = tqq >> 6; const LAS float* iq = imp + q2 * 1024;
        float val[4];
#pragma unroll
        for (int r = 0; r < 4; ++r) { const int b = lane + 64 * r; float v = -1.f;
            if (b >= 1 && b <= cur - 2) { v = 0.f;
#pragma unroll
                for (int i = 0; i < 5; ++i) v += iq[4 * b - 1 + i]; }
            val[r] = v; }
        int cnt = 0;
        if (lane == 0) { selL[q2 * 8 + 0] = 0; if (cur >= 1) selL[q2 * 8 + 1] = cur; if (cur >= 2) selL[q2 * 8 + 2] = cur - 1; }
        cnt = 1 + (cur >= 1) + (cur >= 2);
        int ncand = cur - 2; if (ncand < 0) ncand = 0; const int npick = ncand < 5 ? ncand : 5;
        for (int rd = 0; rd < npick; ++rd) { float bv = val[0]; int bi = lane;
#pragma unroll
            for (int r = 1; r < 4; ++r) if (val[r] > bv) { bv = val[r]; bi = lane + 64 * r; }
#pragma unroll
            for (int o = 1; o < 64; o <<= 1) { const float ov = __shfl_xor(bv, o); const int oi = __shfl_xor(bi, o); if (ov > bv || (ov == bv && oi < bi)) { bv = ov; bi = oi; } }
            if (lane == 0) selL[q2 * 8 + cnt] = bi; ++cnt;
#pragma unroll
            for (int r = 0; r < 4; ++r) if (bi == lane + 64 * r) val[r] = -2.f; }
        cnts[q2] = cnt; }
    LDS_FENCE();
    lsum = 0.f;
    { const int c0 = cnts[0], c1 = cnts[1];
      auto kbf = [&](int i) { const int bidx = i >> 1; const int slot = bidx < c0 ? bidx : 8 + (bidx - c0); return 64 * __builtin_amdgcn_readfirstlane(selL[slot]) + 32 * (i & 1); };
      auto qsf = [&](int i) { return ((i >> 1) < c0) ? 0 : 1; };
      nsa_run<2>(2 * (c0 + c1), (const bf16_t*)(ws + WS_KSN), (const bf16_t*)(ws + WS_VST), kbf, qsf, qf, LUT, imp, tq, h, n, g, qs, 0.f, lsum, Ob); }
    { const float l = lred(lsum); const float sc = l > 0.f ? g1 / l : 0.f;
#pragma unroll
      for (int i = 0; i < 4; ++i) { Ot[i] += Ob[i] * sc; Ob[i] = (f32x4){0.f, 0.f, 0.f, 0.f}; } }
    lsum = 0.f;
    { int lo = t0 - 511; if (lo < 0) lo = 0; lo &= ~31; const int nw = ((t0 + 1 - lo) >> 5) + 1;
      auto kbf = [&](int i) { return lo + 32 * i; };
      nsa_run<3>(nw, (const bf16_t*)(ws + WS_KWN), (const bf16_t*)(ws + WS_VWT), kbf, qs_zero, qf, LUT, imp, tq, h, n, g, qs, 0.f, lsum, Ob);
      const float l = lred(lsum); const float sc = l > 0.f ? g2 / l : 0.f;
#pragma unroll
      for (int i = 0; i < 4; ++i) Ot[i] += Ob[i] * sc; }
    bf16_t* orow = (bf16_t*)(ws + WS_ONSA) + (size_t)tq * 512 + h * 64;
#pragma unroll
    for (int db = 0; db < 4; ++db) { u32x2 w; w.x = cvt_pk_bf16(Ot[db][0], Ot[db][1]); w.y = cvt_pk_bf16(Ot[db][2], Ot[db][3]); *(u32x2*)(orow + 16 * db + 4 * g) = w; }
}

#define GSYNC() cg::this_grid().sync()
__global__ void __launch_bounds__(512) __attribute__((amdgpu_waves_per_eu(2, 2))) fwd_mega(KArgs a) {
    extern __shared__ __attribute__((aligned(16))) unsigned char lds_raw[];
    LAS unsigned char* lds = (LAS unsigned char*)lds_raw;
    const int G = gridDim.x, bid = blockIdx.x, NGW = G * 8;
#define IDS() int tid = threadIdx.x; asm volatile("" : "+v"(tid)); const int lane = tid & 63, wave = __builtin_amdgcn_readfirstlane(tid >> 6); const int gw = bid * 8 + wave; (void)lane; (void)gw;
    unsigned char* ws = a.ws;
    bf16_t* PROJ = (bf16_t*)(ws + WS_PROJ); bf16_t* HN = (bf16_t*)(ws + WS_HN); bf16_t* HID = (bf16_t*)(ws + WS_HID);
#pragma unroll 1
    for (int l = 0; l < DEPTH; ++l) {
        const float* xsrc = (l == 0) ? a.in[0] : a.out;
        { IDS(); phase_convert(a, l, lds, gw, NGW, wave, lane);
          phase_rms(xsrc, a.in[1] + l * DM, HN, gw, NGW, lane); }
        GSYNC();
        { pg8::Gemm g{HN, (const bf16_t*)(ws + WS_WIN), M, NPAD, DM}; pg8::StaticOrder S; S.init(M, NPAD, G, bid);
          pg8::EpiBf16<0> E{PROJ, NPAD};
          pg8::gemm_phase<pg8::EpiBf16<0>, pg8::StaticOrder, true, true>(lds, g, S, E); }
        GSYNC();
        { IDS(); for (int it = bid; it < 256; it += G) pre_item(a, l, lds, it, tid); }
        { IDS(); for (int it = bid; it < 128; it += G) cmp_item(a, l, lds, it, tid, wave, lane); }
        { IDS(); for (int it = bid; it < 2048; it += G) gla_g1_item(a, l, lds, it, tid, wave, lane); }
        GSYNC();
        {   IDS();
            { const float* lg = (const float*)(ws + WS_LUT); LAS float* LUT = (LAS float*)lds; for (int i = tid; i < 8192; i += 512) LUT[i] = lg[i]; }
            LAS int* ctr = (LAS int*)(lds + 99328);
            if (tid == 0) *ctr = 0;
            __syncthreads();
            if (wave < 4) for (int c0 = (bid * 4 + wave) * 64; c0 < 65536; c0 += G * 256) gla_scan(a, c0 + lane);
            const int nper = (8192 + G - 1) / G;
            for (;;) { int idx = 0; if (lane == 0) idx = atomicAdd((int*)ctr, 1); idx = __builtin_amdgcn_readfirstlane(idx);
                if (idx >= nper) break; const int hn = nper >> 1; const int unit = (idx < hn) ? (8192 - hn * (bid + 1) + idx) : (hn * bid + (idx - hn)); if (unit >= 0 && unit < 8192) nsa_unit(a, lds, unit, wave, lane); }
            __syncthreads();
        }
        GSYNC();
        { IDS(); for (int idx = bid; idx < 512; idx += G) { int h, qb; if (idx < 256) { h = idx & 3; qb = 127 - (idx >> 2); } else { const int j = idx - 256; h = j & 3; qb = j >> 2; }
            sb_unit(a, lds, h, qb, tid, wave, lane); } }
        { IDS(); for (int it = bid; it < 2048; it += G) gla_g3_item(a, l, lds, it, tid, wave, lane); }
        GSYNC();
        for (int b = 0; b < 3; ++b) {
            pg8::Gemm g{(const bf16_t*)(ws + WS_OGLA + b * 16 * MiB), (const bf16_t*)(ws + WS_WBR + b * MiB), M, DM, 512}; pg8::StaticOrder S; S.init(M, DM, G, bid);
            pg8::EpiGate E{HN, PROJ + C_MGATE + b * DM, NPAD, b == 0 ? 1 : 0};
            pg8::gemm_phase<pg8::EpiGate, pg8::StaticOrder, true, true>(lds, g, S, E); }
        GSYNC();
        { pg8::Gemm g{HN, (const bf16_t*)(ws + WS_WOUT), M, DM, DM}; pg8::StaticOrder S; S.init(M, DM, G, bid);
          pg8::EpiRes E{xsrc, a.out};
          pg8::gemm_phase<pg8::EpiRes, pg8::StaticOrder, true, true>(lds, g, S, E); }
        GSYNC();
        { IDS(); phase_rms(a.out, a.in[2] + l * DM, HN, gw, NGW, lane); }
        GSYNC();
        { pg8::Gemm g{HN, (const bf16_t*)(ws + WS_WUP), M, FF, DM}; pg8::StaticOrder S; S.init(M, FF, G, bid);
          pg8::EpiBf16<2> E{HID, FF};
          pg8::gemm_phase<pg8::EpiBf16<2>, pg8::StaticOrder, true, true>(lds, g, S, E); }
        GSYNC();
        { pg8::Gemm g{HID, (const bf16_t*)(ws + WS_WDN), M, DM, FF}; pg8::StaticOrder S; S.init(M, DM, G, bid);
          pg8::EpiRes E{a.out, a.out};
          pg8::gemm_phase<pg8::EpiRes, pg8::StaticOrder, true, true>(lds, g, S, E); }
        GSYNC();
    }
}

extern "C" void kernel_launch(void* const* d_in, const int* in_sizes, int n_in, void* d_out, int out_size, void* d_ws, size_t ws_size, hipStream_t stream) {
    static int grid = 0;
    if (grid == 0) {
        if (n_in != 22 || ws_size < WS_END) { fprintf(stderr, "kernel_launch: unexpected n_in %d or ws_size %zu (< %zu)\n", n_in, ws_size, (size_t)WS_END); grid = -1; return; }
        int dev = 0, cus = 0, per_cu = 0;
        hipGetDevice(&dev); hipDeviceGetAttribute(&cus, hipDeviceAttributeMultiprocessorCount, dev);
        hipFuncSetAttribute((const void*)fwd_mega, hipFuncAttributeMaxDynamicSharedMemorySize, LDS_BYTES);
        hipOccupancyMaxActiveBlocksPerMultiprocessor(&per_cu, (const void*)fwd_mega, 512, LDS_BYTES);
        if (per_cu < 1) { fprintf(stderr, "kernel_launch: occupancy query says %d blocks/CU\n", per_cu); per_cu = 1; }
        (void)hipGetLastError();
        grid = cus * 1;
    }
    if (grid < 0) return;
    KArgs a{};
    for (int i = 0; i < 22; ++i) a.in[i] = (const float*)d_in[i];
    a.out = (float*)d_out; a.ws = (unsigned char*)d_ws;
    void* args[] = {&a};
    hipError_t e = hipLaunchCooperativeKernel((const void*)fwd_mega, dim3(grid), dim3(512), args, LDS_BYTES, stream);
    if (e != hipSuccess) fprintf(stderr, "cooperative launch failed: %s (grid %d)\n", hipGetErrorString(e), grid);
}
```

```cpp
#include <hip/hip_runtime.h>
#include <hip/hip_cooperative_groups.h>
#include <cstdio>
#include <cstdint>
namespace cg = cooperative_groups;
namespace pg8 {
#define PG8_LAS __attribute__((address_space(3)))
typedef unsigned short bf16_t;
typedef short bf16x8 __attribute__((ext_vector_type(8)));
typedef float f32x4 __attribute__((ext_vector_type(4)));
typedef unsigned u32x4 __attribute__((ext_vector_type(4)));
constexpr int BM = 256, BK = 64, HALF = 128, HTB = HALF * BK * 2  , STAGE_BYTES = 8 * HTB, NXCD = 8, WGM = 8;

__host__ __device__ __forceinline__ int lds_byte(int r, int c) { const int st = (r >> 4) * 2 + (c >> 5), rr = r & 15, cc = c & 31, ob = rr * 64 + cc * 2; return st * 1024 + (ob ^ (((ob >> 9) & 1) << 5)); }
__host__ __device__ __forceinline__ void stage_rc(int b, int& R, int& C) { const int st = b / 1024, sb = b % 1024, swz = sb ^ (((sb >> 9) & 1) << 5); R = (st >> 1) * 16 + swz / 64; C = (st & 1) * 32 + (swz % 64) / 2; }
__host__ __device__ __forceinline__ int perm32(int rho) { const int n = rho >> 4, i = rho & 15; return 8 * (i >> 2) + 4 * n + (i & 3); }

struct Unit { int pm, pn; };
struct Gemm { const bf16_t* A; const bf16_t* Bt; int M, N, K; };

struct StaticOrder {
    int nM, nN, nwg, G, c;
    __host__ __device__ void init(int M, int N, int G_, int c_) { nM = M / BM; nN = N / BM; nwg = nM * nN; G = G_; c = c_; }
    __host__ __device__ bool next(int i, Unit& u) const {
        const long L = (long)i * G + c; if (L >= nwg) return false;
        int wgid = (int)L; { const int q = nwg / NXCD, r = nwg % NXCD, xcd = wgid % NXCD, off = wgid / NXCD; wgid = (xcd < r ? xcd * (q + 1) : r * (q + 1) + (xcd - r) * q) + off; }
        const int nig = WGM * nN, gid = wgid / nig, fm = gid * WGM, gsz = (nM - fm) < WGM ? (nM - fm) : WGM;
        u.pm = fm + ((wgid % nig) % gsz); u.pn = (wgid % nig) / gsz; return true;
    }
    __device__ __forceinline__ void a_ready(const Unit&) const {}
    __device__ __forceinline__ void done(const Unit&) const {}
};

__device__ __forceinline__ unsigned cvt_pk_bf16(float lo, float hi) { unsigned r; asm("v_cvt_pk_bf16_f32 %0, %1, %2" : "=v"(r) : "v"(lo), "v"(hi)); return r; }
__device__ __forceinline__ float bflo(unsigned w) { return __uint_as_float(w << 16); }
__device__ __forceinline__ float bfhi(unsigned w) { return __uint_as_float(w & 0xffff0000u); }
template <int ACT> struct EpiBf16 {
    static constexpr bool PERM = true, AFTER_DRAIN = false;
    bf16_t* O; int ldc;
    __device__ __forceinline__ void operator()(const f32x4 (&acc)[2][2][4][2], const Unit& u, int wr, int wc, int fr, int fq) const {
        const int row0 = u.pm * BM + wr * 64 + fr; const int col0 = u.pn * BM + wc * 32 + 8 * fq;
#pragma unroll
        for (int ai = 0; ai < 2; ++ai)
#pragma unroll
            for (int m = 0; m < 4; ++m) { bf16_t* rowp = O + (size_t)(row0 + ai * HALF + m * 16) * ldc + col0;
#pragma unroll
                for (int bj = 0; bj < 2; ++bj) { f32x4 v0 = acc[ai][bj][m][0], v1 = acc[ai][bj][m][1];
                    if (ACT == 2) {
#pragma unroll
                        for (int e = 0; e < 4; ++e) { float a = fmaxf(v0[e], 0.f), b = fmaxf(v1[e], 0.f); v0[e] = a * a; v1[e] = b * b; } }
                    u32x4 w; w.x = cvt_pk_bf16(v0[0], v0[1]); w.y = cvt_pk_bf16(v0[2], v0[3]); w.z = cvt_pk_bf16(v1[0], v1[1]); w.w = cvt_pk_bf16(v1[2], v1[3]);
                    *(u32x4*)(rowp + bj * HALF) = w; } }
    }
};
struct EpiGate {
    static constexpr bool PERM = true, AFTER_DRAIN = false;
    bf16_t* O; const bf16_t* gate; int gld; int first;
    __device__ __forceinline__ void operator()(const f32x4 (&acc)[2][2][4][2], const Unit& u, int wr, int wc, int fr, int fq) const {
        const int row0 = u.pm * BM + wr * 64 + fr; const int col0 = u.pn * BM + wc * 32 + 8 * fq;
#pragma unroll
        for (int ai = 0; ai < 2; ++ai)
#pragma unroll
            for (int m = 0; m < 4; ++m) { const int row = row0 + ai * HALF + m * 16; bf16_t* rowp = O + (size_t)row * 1024 + col0; const bf16_t* gp = gate + (size_t)row * gld + col0;
#pragma unroll
                for (int bj = 0; bj < 2; ++bj) { const f32x4 v0 = acc[ai][bj][m][0], v1 = acc[ai][bj][m][1];
                    const u32x4 gw = *(const u32x4*)(gp + bj * HALF);
                    u32x4 ow = (u32x4){0u, 0u, 0u, 0u}; if (!first) ow = *(const u32x4*)(rowp + bj * HALF);
                    float gv[8] = {bflo(gw.x), bfhi(gw.x), bflo(gw.y), bfhi(gw.y), bflo(gw.z), bfhi(gw.z), bflo(gw.w), bfhi(gw.w)};
                    float ov[8] = {bflo(ow.x), bfhi(ow.x), bflo(ow.y), bfhi(ow.y), bflo(ow.z), bfhi(ow.z), bflo(ow.w), bfhi(ow.w)};
                    float av[8] = {v0[0], v0[1], v0[2], v0[3], v1[0], v1[1], v1[2], v1[3]};
                    float r[8];
#pragma unroll
                    for (int e = 0; e < 8; ++e) { const float s = 1.f / (1.f + __expf(-gv[e])); r[e] = ov[e] + s * av[e]; }
                    u32x4 w; w.x = cvt_pk_bf16(r[0], r[1]); w.y = cvt_pk_bf16(r[2], r[3]); w.z = cvt_pk_bf16(r[4], r[5]); w.w = cvt_pk_bf16(r[6], r[7]);
                    *(u32x4*)(rowp + bj * HALF) = w; } }
    }
};
struct EpiRes {
    static constexpr bool PERM = false, AFTER_DRAIN = false;
    const float* src; float* out;
    __device__ __forceinline__ void operator()(const f32x4 (&acc)[2][2][4][2], const Unit& u, int wr, int wc, int fr, int fq) const {
        const int col0 = u.pn * BM + wc * 32 + 4 * fq;
#pragma unroll
        for (int ai = 0; ai < 2; ++ai)
#pragma unroll
            for (int m = 0; m < 4; ++m) { const size_t off = (size_t)(u.pm * BM + ai * HALF + wr * 64 + m * 16 + fr) * 1024 + col0;
#pragma unroll
                for (int bj = 0; bj < 2; ++bj)
#pragma unroll
                    for (int n = 0; n < 2; ++n) { const f32x4 bs = *(const f32x4*)(src + off + bj * HALF + n * 16); *(f32x4*)(out + off + bj * HALF + n * 16) = bs + acc[ai][bj][m][n]; } }
    }
};
template <class Epi, class Sched, bool ALIGN_EPI = false, bool SP2 = false>
__device__ __forceinline__ void gemm_phase(PG8_LAS unsigned char* lds, const Gemm g, const Sched& S, const Epi& E) {
    int tid_ = threadIdx.x; asm volatile("" : "+v"(tid_));
    const int tid = tid_, wid = __builtin_amdgcn_readfirstlane(tid >> 6), lane = tid & 63, wr = wid >> 2, wc = wid & 3, fr = lane & 15, fq = lane >> 4;
    const int K = g.K, nt = K / BK;
    unsigned voffA[2], voffB[2];
#pragma unroll
    for (int i = 0; i < 2; ++i) { int R, C; stage_rc(tid * 16 + i * 8192, R, C); const int Rb = Epi::PERM ? ((R & ~31) + perm32(R & 31)) : R;
        voffA[i] = (unsigned)(R * K + C) * 2u; voffB[i] = (unsigned)(Rb * K + C) * 2u; }
    const size_t kstep = (size_t)(BK * 2);
    const size_t hstep = (size_t)HALF * K * 2;
    const size_t tstep = 2 * hstep;
    const unsigned ldsw = (unsigned)wid * 1024u;
    const int aoff = lds_byte(wr * 64 + fr, fq * 8), boff = lds_byte(wc * 32 + fr, fq * 8);
#define PG8_SA(b, h) (((b) * 2 + (h)) * HTB)
#define PG8_SB(b, h) ((4 + (b) * 2 + (h)) * HTB)
#define PG8_STAGE(bufoff, gbase, voff) do { _Pragma("unroll") for (int _i = 0; _i < 2; ++_i) \
        __builtin_amdgcn_global_load_lds((const unsigned*)((const char*)(gbase) + (voff)[_i]), (PG8_LAS unsigned*)(lds + (bufoff) + ldsw + _i * 8192), 16, 0, 0); } while (0)
#define PG8_LDA(dst, b, h) do { _Pragma("unroll") for (int m = 0; m < 4; ++m) _Pragma("unroll") for (int k = 0; k < 2; ++k) dst[m][k] = *(const PG8_LAS bf16x8*)(lds + PG8_SA(b, h) + aoff + m * 2048 + k * 1024); } while (0)
#define PG8_LDB(dst, b, h) do { _Pragma("unroll") for (int n = 0; n < 2; ++n) _Pragma("unroll") for (int k = 0; k < 2; ++k) dst[n][k] = *(const PG8_LAS bf16x8*)(lds + PG8_SB(b, h) + boff + n * 2048 + k * 1024); } while (0)
#define PG8_MMA(ai, bj, At, Bt) do { __builtin_amdgcn_s_setprio(1); _Pragma("unroll") for (int m = 0; m < 4; ++m) _Pragma("unroll") for (int n = 0; n < 2; ++n) _Pragma("unroll") for (int k = 0; k < 2; ++k) \
        acc[ai][bj][m][n] = __builtin_amdgcn_mfma_f32_16x16x32_bf16(Bt[n][k], At[m][k], acc[ai][bj][m][n], 0, 0, 0); __builtin_amdgcn_s_setprio(0); } while (0)
#define PG8_WAIT_V(n) asm volatile("s_waitcnt vmcnt(" #n ")" ::: "memory")
#define PG8_WAIT_L(n) asm volatile("s_waitcnt lgkmcnt(" #n ")" ::: "memory")
#define PG8_BAR __builtin_amdgcn_s_barrier()
#define PG8_SCHED __builtin_amdgcn_sched_barrier(0)
    Unit cur, nxt; int ui = 0;
    if (!S.next(0, cur)) return;
    f32x4 acc[2][2][4][2];
#pragma unroll
    for (int a = 0; a < 2; ++a)
#pragma unroll
        for (int b = 0; b < 2; ++b)
#pragma unroll
            for (int m = 0; m < 4; ++m)
#pragma unroll
                for (int n = 0; n < 2; ++n) acc[a][b][m][n] = (f32x4){0.f, 0.f, 0.f, 0.f};
    bf16x8 At[4][2], B0[2][2], B1[2][2];
    const char* cA = (const char*)g.A + (size_t)cur.pm * tstep; const char* cB = (const char*)g.Bt + (size_t)cur.pn * tstep;
    S.a_ready(cur);
    if constexpr (SP2) {
        PG8_STAGE(PG8_SB(0, 0), cB, voffB); PG8_STAGE(PG8_SB(0, 1), cB + hstep, voffB); PG8_STAGE(PG8_SA(0, 0), cA, voffA); PG8_STAGE(PG8_SA(0, 1), cA + hstep, voffA);
        if (wr == 1) PG8_BAR;
        PG8_WAIT_V(2); PG8_BAR;
        PG8_STAGE(PG8_SB(1, 0), cB + kstep, voffB); PG8_STAGE(PG8_SA(1, 0), cA + kstep, voffA); PG8_STAGE(PG8_SB(1, 1), cB + hstep + kstep, voffB);
        PG8_WAIT_V(6); PG8_BAR;
    } else {
        PG8_STAGE(PG8_SB(0, 0), cB, voffB); PG8_STAGE(PG8_SA(0, 0), cA, voffA); PG8_STAGE(PG8_SB(0, 1), cB + hstep, voffB); PG8_STAGE(PG8_SA(0, 1), cA + hstep, voffA);
        if (wr == 1) PG8_BAR;
        PG8_WAIT_V(4); PG8_BAR;
        PG8_STAGE(PG8_SB(1, 0), cB + kstep, voffB); PG8_STAGE(PG8_SA(1, 0), cA + kstep, voffA); PG8_STAGE(PG8_SB(1, 1), cB + hstep + kstep, voffB);
        PG8_WAIT_V(6); PG8_BAR;
    }
    for (;;) {
        const bool has_next = S.next(ui + 1, nxt);
        const char* nA = has_next ? (const char*)g.A + (size_t)nxt.pm * tstep : cA; const char* nB = has_next ? (const char*)g.Bt + (size_t)nxt.pn * tstep : cB;
        for (int t = 0; t < nt; t += 2) {
            const bool last = (t == nt - 2);
            const char* a1 = cA + (size_t)(t + 1) * kstep;
            const char* a2 = last ? nA : cA + (size_t)(t + 2) * kstep; const char* b2 = last ? nB : cB + (size_t)(t + 2) * kstep;
            const char* a3 = a2 + kstep; const char* b3 = b2 + kstep;
            if (last && has_next) S.a_ready(nxt);
            if constexpr (SP2) {
            PG8_LDB(B0, 0, 0); PG8_LDB(B1, 0, 1); PG8_SCHED; PG8_LDA(At, 0, 0); PG8_STAGE(PG8_SA(1, 1), a1 + hstep, voffA);
            PG8_WAIT_V(8); PG8_WAIT_L(0); PG8_BAR; PG8_MMA(0, 0, At, B0); PG8_MMA(0, 1, At, B1); PG8_BAR; PG8_SCHED;
            PG8_LDA(At, 0, 1); PG8_STAGE(PG8_SB(0, 0), b2, voffB); PG8_STAGE(PG8_SB(0, 1), b2 + hstep, voffB); PG8_STAGE(PG8_SA(0, 0), a2, voffA);
            PG8_WAIT_V(8); PG8_WAIT_L(0); PG8_BAR; PG8_MMA(1, 0, At, B0); PG8_MMA(1, 1, At, B1); PG8_BAR; PG8_SCHED;
            PG8_LDB(B0, 1, 0); PG8_LDB(B1, 1, 1); PG8_SCHED; PG8_LDA(At, 1, 0); PG8_STAGE(PG8_SA(0, 1), a2 + hstep, voffA);
            PG8_WAIT_V(8); PG8_WAIT_L(0); PG8_BAR; PG8_MMA(0, 0, At, B0); PG8_MMA(0, 1, At, B1); PG8_BAR; PG8_SCHED;
            PG8_LDA(At, 1, 1); PG8_STAGE(PG8_SB(1, 0), b3, voffB); PG8_STAGE(PG8_SB(1, 1), b3 + hstep, voffB); PG8_STAGE(PG8_SA(1, 0), a3, voffA);
            PG8_WAIT_V(8); PG8_WAIT_L(0); PG8_BAR; PG8_MMA(1, 0, At, B0); PG8_MMA(1, 1, At, B1); PG8_BAR; PG8_SCHED;
            } else {
            PG8_LDB(B0, 0, 0); PG8_SCHED; PG8_LDA(At, 0, 0); PG8_STAGE(PG8_SA(1, 1), a1 + hstep, voffA);
            PG8_WAIT_L(8); PG8_BAR; PG8_WAIT_L(0); PG8_MMA(0, 0, At, B0); PG8_BAR; PG8_SCHED;
            PG8_LDB(B1, 0, 1); PG8_STAGE(PG8_SB(0, 0), b2, voffB);
            PG8_BAR; PG8_WAIT_L(0); PG8_MMA(0, 1, At, B1); PG8_BAR;
            PG8_LDA(At, 0, 1); PG8_STAGE(PG8_SA(0, 0), a2, voffA);
            PG8_BAR; PG8_WAIT_L(0); PG8_MMA(1, 0, At, B0); PG8_BAR; PG8_SCHED;
            PG8_STAGE(PG8_SB(0, 1), b2 + hstep, voffB);
            PG8_WAIT_V(6); PG8_BAR; PG8_MMA(1, 1, At, B1); PG8_BAR;
            PG8_LDB(B0, 1, 0); PG8_SCHED; PG8_LDA(At, 1, 0); PG8_STAGE(PG8_SA(0, 1), a2 + hstep, voffA);
            PG8_WAIT_L(8); PG8_BAR; PG8_WAIT_L(0); PG8_MMA(0, 0, At, B0); PG8_BAR; PG8_SCHED;
            PG8_LDB(B1, 1, 1); PG8_STAGE(PG8_SB(1, 0), b3, voffB);
            PG8_BAR; PG8_WAIT_L(0); PG8_MMA(0, 1, At, B1); PG8_BAR;
            PG8_LDA(At, 1, 1); PG8_STAGE(PG8_SA(1, 0), a3, voffA);
            PG8_BAR; PG8_WAIT_L(0); PG8_MMA(1, 0, At, B0); PG8_BAR; PG8_SCHED;
            PG8_STAGE(PG8_SB(1, 1), b3 + hstep, voffB);
            PG8_WAIT_V(6); PG8_BAR; PG8_MMA(1, 1, At, B1); PG8_BAR;
            }
        }
        if constexpr (ALIGN_EPI) { if (wr == 0) PG8_BAR; }
        if constexpr (!Epi::AFTER_DRAIN) { E(acc, cur, wr, wc, fr, fq); S.done(cur); }
        if (!has_next) break;
#pragma unroll
        for (int a = 0; a < 2; ++a)
#pragma unroll
            for (int b = 0; b < 2; ++b)
#pragma unroll
                for (int m = 0; m < 4; ++m)
#pragma unroll
                    for (int n = 0; n < 2; ++n) acc[a][b][m][n] = (f32x4){0.f, 0.f, 0.f, 0.f};
        cur = nxt; cA = nA; cB = nB; ++ui;
        if constexpr (ALIGN_EPI) { if (wr == 1) PG8_BAR; }
    }
    PG8_WAIT_V(0);
    if constexpr (!ALIGN_EPI) { if (wr == 0) PG8_BAR; }
    PG8_BAR;
    if constexpr (Epi::AFTER_DRAIN) { E.fused(acc, cur, wr, wc, fr, fq, lds, wid, lane); S.done(cur); }
#undef PG8_SA
#undef PG8_SB
#undef PG8_STAGE
#undef PG8_LDA
#undef PG8_LDB
#undef PG8_MMA
#undef PG8_WAIT_V
#undef PG8_WAIT_L
#undef PG8_BAR
#undef PG8_SCHED
}
}

#define LAS __attribute__((address_space(3)))
typedef unsigned short bf16_t;
typedef short bf16x8 __attribute__((ext_vector_type(8)));
typedef float f32x4 __attribute__((ext_vector_type(4)));
typedef unsigned u32x4 __attribute__((ext_vector_type(4)));
typedef unsigned u32x2 __attribute__((ext_vector_type(2)));
using pg8::cvt_pk_bf16; using pg8::bflo; using pg8::bfhi;

constexpr int M = 16384, DM = 1024, NIN = 7592, NPAD = 7680, FF = 4096, DEPTH = 4;
constexpr int C_GQ = 0, C_GK = 512, C_GV = 1024, C_GA = 1536, C_GR = 1552, C_SQ = 2064, C_SK = 2576, C_SV = 3088, C_NQ = 3600, C_NKC = 4112, C_NVC = 4176,
              C_NKS = 4240, C_NVS = 4304, C_NKW = 4368, C_NVW = 4432, C_NGATE = 4496, C_MGATE = 4520;
constexpr size_t MiB = 1u << 20;
constexpr size_t WS_PROJ = 0, WS_HID = 0, WS_HN = 240 * MiB, WS_OGLA = 272 * MiB, WS_OSB = 288 * MiB, WS_ONSA = 304 * MiB;
constexpr size_t WS_WIN = 320 * MiB, WS_WUP = 335 * MiB, WS_WDN = 343 * MiB, WS_WOUT = 351 * MiB, WS_WBR = 353 * MiB, WS_WK1 = 356 * MiB, WS_WV1 = 357 * MiB,
                 WS_WK2 = 358 * MiB, WS_WV2 = 358 * MiB + 65536, WS_CB = 358 * MiB + 131072, WS_LUT = 358 * MiB + 196608;
constexpr size_t WS_GST = 360 * MiB, WS_GDC = 424 * MiB, WS_SVT = 425 * MiB, WS_QN = 441 * MiB, WS_KSN = 457 * MiB, WS_KWN = 459 * MiB, WS_VST = 461 * MiB, WS_VWT = 463 * MiB,
                 WS_KCMP = 465 * MiB, WS_VCMPT = 465 * MiB + 131072, WS_END = 466 * MiB, WS_CTL = 466 * MiB;
constexpr int LDS_BYTES = 133120;
constexpr float LOG2E = 1.4426950408889634f;

struct KArgs { const float* in[22]; float* out; unsigned char* ws; };

__device__ __forceinline__ float bf2f(bf16_t v) { return __uint_as_float(((unsigned)v) << 16); }
__device__ __forceinline__ bf16_t f2bf(float f) { unsigned u = __float_as_uint(f); return (bf16_t)((u + 0x7fffu + ((u >> 16) & 1u)) >> 16); }
__device__ __forceinline__ f32x4 mfma16(bf16x8 a, bf16x8 b, f32x4 c) { return __builtin_amdgcn_mfma_f32_16x16x32_bf16(a, b, c, 0, 0, 0); }
__device__ __forceinline__ float wave_sum(float v) {
#pragma unroll
    for (int o = 1; o < 64; o <<= 1) v += __shfl_xor(v, o);
    return v;
}
#define LDS_FENCE() asm volatile("s_waitcnt lgkmcnt(0)" ::: "memory")
#define SCHED_FENCE_G() __builtin_amdgcn_sched_barrier(0)
__device__ __forceinline__ void unpack8(const u32x4 w, float (&f)[8]) { f[0] = bflo(w.x); f[1] = bfhi(w.x); f[2] = bflo(w.y); f[3] = bfhi(w.y); f[4] = bflo(w.z); f[5] = bfhi(w.z); f[6] = bflo(w.w); f[7] = bfhi(w.w); }
__device__ __forceinline__ u32x4 pack8(const float (&r)[8]) { u32x4 w; w.x = cvt_pk_bf16(r[0], r[1]); w.y = cvt_pk_bf16(r[2], r[3]); w.z = cvt_pk_bf16(r[4], r[5]); w.w = cvt_pk_bf16(r[6], r[7]); return w; }

__device__ __forceinline__ void transpose_item(const float* W, int K, int N, int Npad, bf16_t* WT, LAS float* scr, int item, int lane) {
    const int nblk = Npad / 32, kb = item / nblk, nb = item % nblk, k0 = 64 * kb, n0 = 32 * nb;
    const int nn = n0 + (lane & 31);
    float tv[32];
#pragma unroll
    for (int i = 0; i < 32; ++i) { const int kk = 2 * i + (lane >> 5); tv[i] = (nn < N) ? W[(size_t)(k0 + kk) * N + nn] : 0.f; }
#pragma unroll
    for (int i = 0; i < 32; ++i) { const int kk = 2 * i + (lane >> 5); scr[kk * 33 + (lane & 31)] = tv[i]; }
    LDS_FENCE();
    const int c = lane & 7;
#pragma unroll
    for (int j = 0; j < 4; ++j) { const int n = (lane >> 3) + 8 * j; const LAS float* s = scr + (8 * c) * 33 + n;
        u32x4 o; o.x = cvt_pk_bf16(s[0 * 33], s[1 * 33]); o.y = cvt_pk_bf16(s[2 * 33], s[3 * 33]); o.z = cvt_pk_bf16(s[4 * 33], s[5 * 33]); o.w = cvt_pk_bf16(s[6 * 33], s[7 * 33]);
        *(u32x4*)(WT + (size_t)(n0 + n) * K + k0 + 8 * c) = o; }
    LDS_FENCE();
}
__device__ __forceinline__ int rel_bucket(int n) {
    if (n < 16) return n;
    int large = 16 + (int)(logf((float)n / 16.f) / 4.1588830833596715f * 16.f);
    return large < 31 ? large : 31;
}
__device__ __forceinline__ void rms_row(const float* xrow, const float* g, bf16_t* orow, int lane) {
    const f32x4* xr = (const f32x4*)xrow + lane; f32x4 v[4]; float s = 0.f;
#pragma unroll
    for (int j = 0; j < 4; ++j) { v[j] = xr[64 * j]; s += (v[j].x * v[j].x + v[j].y * v[j].y) + (v[j].z * v[j].z + v[j].w * v[j].w); }
    const float rinv = rsqrtf(wave_sum(s) * (1.f / 1024.f) + 1e-6f);
    u32x2* o8 = (u32x2*)orow + lane;
#pragma unroll
    for (int j = 0; j < 4; ++j) { const f32x4 gg = ((const f32x4*)g)[lane + 64 * j]; u32x2 w; w.x = cvt_pk_bf16(v[j].x * rinv * gg.x, v[j].y * rinv * gg.y); w.y = cvt_pk_bf16(v[j].z * rinv * gg.z, v[j].w * rinv * gg.w); o8[64 * j] = w; }
}
__device__ __forceinline__ void phase_convert(const KArgs& a, int l, LAS unsigned char* lds, int gw, int NGW, int wave, int lane) {
    unsigned char* ws = a.ws;
    LAS float* scr = (LAS float*)(lds + wave * 8704);
    constexpr int I0 = 16 * 240, I1 = 16 * 128, I2 = 64 * 32, I3 = 16 * 32, I4 = 8 * 32, I7 = 32 * 8, I9 = 4 * 2, IB = 128, IL = 128;
    constexpr int NIT = I0 + I1 + I2 + I3 + 3 * I4 + 2 * I7 + 2 * I9 + IB + IL;
    for (int it = gw; it < NIT; it += NGW) {
        int r = it;
        if (r < I0) { transpose_item(a.in[3] + (size_t)l * DM * NIN, DM, NIN, NPAD, (bf16_t*)(ws + WS_WIN), scr, r, lane); continue; } r -= I0;
        if (r < I1) { transpose_item(a.in[20] + (size_t)l * DM * FF, DM, FF, FF, (bf16_t*)(ws + WS_WUP), scr, r, lane); continue; } r -= I1;
        if (r < I2) { transpose_item(a.in[21] + (size_t)l * FF * DM, FF, DM, DM, (bf16_t*)(ws + WS_WDN), scr, r, lane); continue; } r -= I2;
        if (r < I3) { transpose_item(a.in[19] + (size_t)l * DM * DM, DM, DM, DM, (bf16_t*)(ws + WS_WOUT), scr, r, lane); continue; } r -= I3;
        if (r < 3 * I4) { const int b = r / I4; transpose_item(a.in[16 + b] + (size_t)l * 512 * DM, 512, DM, DM, (bf16_t*)(ws + WS_WBR + b * MiB), scr, r % I4, lane); continue; } r -= 3 * I4;
        if (r < I7) { transpose_item(a.in[11] + (size_t)l * 2048 * 256, 2048, 256, 256, (bf16_t*)(ws + WS_WK1), scr, r, lane); continue; } r -= I7;
        if (r < I7) { transpose_item(a.in[13] + (size_t)l * 2048 * 256, 2048, 256, 256, (bf16_t*)(ws + WS_WV1), scr, r, lane); continue; } r -= I7;
        if (r < I9) { transpose_item(a.in[12] + (size_t)l * 256 * 64, 256, 64, 64, (bf16_t*)(ws + WS_WK2), scr, r, lane); continue; } r -= I9;
        if (r < I9) { transpose_item(a.in[14] + (size_t)l * 256 * 64, 256, 64, 64, (bf16_t*)(ws + WS_WV2), scr, r, lane); continue; } r -= I9;
        if (r < IB) {
            const int p = r >> 3, which = (r >> 2) & 1, col = (r & 3) * 64 + lane;
            const float* pe = a.in[which ? 10 : 9] + (size_t)l * 2048; const float* w1 = a.in[which ? 13 : 11] + (size_t)l * 2048 * 256;
            float s = 0.f;
#pragma unroll 1
            for (int k0 = 128 * p; k0 < 128 * p + 128; k0 += 16) { float wv[16];
#pragma unroll
                for (int i = 0; i < 16; ++i) wv[i] = w1[(size_t)(k0 + i) * 256 + col];
#pragma unroll
                for (int i = 0; i < 16; ++i) s += pe[k0 + i] * wv[i]; }
            ((float*)(ws + WS_CB))[p * 512 + which * 256 + col] = s; continue; } r -= IB;
        {
            const int idx = r * 64 + lane; const int d = idx >> 3, h = idx & 7;
            ((float*)(ws + WS_LUT))[idx] = a.in[15][rel_bucket(d) * 8 + h] * LOG2E; }
    }
}
__device__ __forceinline__ void phase_rms(const float* x, const float* g, bf16_t* hn, int gw, int NGW, int lane) {
    f32x4 gg[4];
#pragma unroll
    for (int j = 0; j < 4; ++j) gg[j] = ((const f32x4*)g)[lane + 64 * j];
    for (int m = gw; m < M; m += 2 * NGW) { const int m2 = (m + NGW < M) ? m + NGW : m;
        const f32x4* xa = (const f32x4*)(x + (size_t)m * DM) + lane; const f32x4* xb = (const f32x4*)(x + (size_t)m2 * DM) + lane;
        f32x4 va[4], vb[4]; float sa = 0.f, sb = 0.f;
#pragma unroll
        for (int j = 0; j < 4; ++j) { va[j] = xa[64 * j]; vb[j] = xb[64 * j]; }
#pragma unroll
        for (int j = 0; j < 4; ++j) { sa += (va[j].x * va[j].x + va[j].y * va[j].y) + (va[j].z * va[j].z + va[j].w * va[j].w); sb += (vb[j].x * vb[j].x + vb[j].y * vb[j].y) + (vb[j].z * vb[j].z + vb[j].w * vb[j].w); }
#pragma unroll
        for (int o = 1; o < 64; o <<= 1) { sa += __shfl_xor(sa, o); sb += __shfl_xor(sb, o); }
        const float ra = rsqrtf(sa * (1.f / 1024.f) + 1e-6f), rb = rsqrtf(sb * (1.f / 1024.f) + 1e-6f);
        u32x2* oa = (u32x2*)(hn + (size_t)m * DM) + lane; u32x2* ob = (u32x2*)(hn + (size_t)m2 * DM) + lane;
#pragma unroll
        for (int j = 0; j < 4; ++j) { u32x2 w; w.x = cvt_pk_bf16(va[j].x * ra * gg[j].x, va[j].y * ra * gg[j].y); w.y = cvt_pk_bf16(va[j].z * ra * gg[j].z, va[j].w * ra * gg[j].w); oa[64 * j] = w;
            u32x2 w2; w2.x = cvt_pk_bf16(vb[j].x * rb * gg[j].x, vb[j].y * rb * gg[j].y); w2.y = cvt_pk_bf16(vb[j].z * rb * gg[j].z, vb[j].w * rb * gg[j].w); ob[64 * j] = w2; } }
}

__device__ __forceinline__ void rms64_to(const bf16_t* src, const float* g, float scale, bf16_t* dst) {
    u32x4 w[8]; float ss = 0.f;
#pragma unroll
    for (int i = 0; i < 8; ++i) { w[i] = ((const u32x4*)src)[i]; float f[8]; unpack8(w[i], f);
#pragma unroll
        for (int e = 0; e < 8; ++e) ss += f[e] * f[e]; }
    const float rinv = rsqrtf(ss * (1.f / 64.f) + 1e-6f) * scale;
#pragma unroll
    for (int i = 0; i < 8; ++i) { float f[8]; unpack8(w[i], f); float r[8];
#pragma unroll
        for (int e = 0; e < 8; ++e) r[e] = f[e] * rinv * g[8 * i + e];
        ((u32x4*)dst)[i] = pack8(r); }
}
__device__ __forceinline__ void pre_item(const KArgs& a, int l, LAS unsigned char* lds, int item, int tid) {
    unsigned char* ws = a.ws; const bf16_t* proj = (const bf16_t*)(ws + WS_PROJ);
    const int t0 = item * 64;
    {
        const int tl = tid >> 3, h = tid & 7;
        rms64_to(proj + (size_t)(t0 + tl) * NPAD + C_NQ + h * 64, a.in[7] + l * 64, 0.125f * LOG2E, (bf16_t*)(ws + WS_QN) + (size_t)(t0 + tl) * 512 + h * 64);
    }
    if (tid < 128) {
        const int tl = tid >> 1, which = tid & 1;
        rms64_to(proj + (size_t)(t0 + tl) * NPAD + (which ? C_NKW : C_NKS), a.in[8] + l * 64, 1.f, (bf16_t*)(ws + (which ? WS_KWN : WS_KSN)) + (size_t)(t0 + tl) * 64);
    }
    LAS bf16_t* T = (LAS bf16_t*)lds;
    for (int idx = tid; idx < 64 * 80; idx += 512) { const int t = idx / 80, p = idx % 80; const int col = p < 64 ? C_SV + 8 * p : (p < 72 ? C_NVS + 8 * (p - 64) : C_NVW + 8 * (p - 72));
        const u32x4 w = *(const u32x4*)(proj + (size_t)(t0 + t) * NPAD + col);
        LAS unsigned* d = (LAS unsigned*)(T + t * 648 + 8 * p); d[0] = w.x; d[1] = w.y; d[2] = w.z; d[3] = w.w; }
    __syncthreads();
    for (int idx = tid; idx < 640 * 8; idx += 512) { const int c = idx >> 3, p = idx & 7;
        unsigned short e[8];
#pragma unroll
        for (int j = 0; j < 8; ++j) e[j] = T[(8 * p + j) * 648 + c];
        u32x4 w; w.x = e[0] | ((unsigned)e[1] << 16); w.y = e[2] | ((unsigned)e[3] << 16); w.z = e[4] | ((unsigned)e[5] << 16); w.w = e[6] | ((unsigned)e[7] << 16);
        const int tk = t0 + 8 * p;
        if (c < 512) *(u32x4*)((bf16_t*)(ws + WS_SVT) + ((size_t)(((c >> 7) * 256 + (tk >> 6)) * 128 + (c & 127))) * 64 + (tk & 63)) = w;
        else { const int d = (c - 512) & 63; bf16_t* vb = (bf16_t*)(ws + (c < 576 ? WS_VST : WS_VWT)); *(u32x4*)(vb + ((size_t)((tk >> 5) * 64 + d)) * 32 + (tk & 31)) = w; } }
    __syncthreads();
}
__device__ __forceinline__ void cmp_item(const KArgs& a, int l, LAS unsigned char* lds, int item, int tid, int wave, int lane) {
    unsigned char* ws = a.ws; const bf16_t* proj = (const bf16_t*)(ws + WS_PROJ);
    const int which = item & 1, grp = item >> 1, i0 = 16 * grp;
    const int srcoff = which ? C_NVC : C_NKC;
    const bf16_t* w1T = (const bf16_t*)(ws + (which ? WS_WV1 : WS_WK1)); const bf16_t* w2T = (const bf16_t*)(ws + (which ? WS_WV2 : WS_WK2));
    LAS bf16_t* hidL = (LAS bf16_t*)lds;
    LAS float* outL = (LAS float*)(lds + 16384);
    LAS float* rinvL = (LAS float*)(lds + 24576);
    const int r = lane & 15, g = lane >> 4;
    int irow = i0 + r; if (irow > 1022) irow = 1022;
    const bf16_t* arow = proj + (size_t)(16 * irow) * NPAD + srcoff;
    f32x4 acc[2] = {(f32x4){0.f, 0.f, 0.f, 0.f}, (f32x4){0.f, 0.f, 0.f, 0.f}};
    const bf16_t* b0 = w1T + (size_t)(32 * wave + r) * 2048 + 8 * g; const bf16_t* b1 = b0 + 16 * 2048;
#pragma unroll 8
    for (int ks = 0; ks < 64; ++ks) { const int k = 32 * ks + 8 * g;
        const bf16x8 af = *(const bf16x8*)(arow + (size_t)(k >> 6) * NPAD + (k & 63));
        const bf16x8 bf0 = *(const bf16x8*)(b0 + 32 * ks), bf1 = *(const bf16x8*)(b1 + 32 * ks);
        acc[0] = mfma16(af, bf0, acc[0]); acc[1] = mfma16(af, bf1, acc[1]); }
    const float* cb = (const float*)(ws + WS_CB);
#pragma unroll
    for (int nb = 0; nb < 2; ++nb) { const int col = 32 * wave + 16 * nb + r; float bs = 0.f;
#pragma unroll
        for (int p = 0; p < 16; ++p) bs += cb[p * 512 + which * 256 + col];
#pragma unroll
        for (int j = 0; j < 4; ++j) { const float x = acc[nb][j] + bs; const float u = 0.7978845608028654f * (x + 0.044715f * x * x * x);
            const float th = 1.f - 2.f / (__expf(2.f * u) + 1.f); hidL[(4 * g + j) * 264 + col] = f2bf(0.5f * x * (1.f + th)); } }
    __syncthreads();
    if (wave < 4) { f32x4 c2 = (f32x4){0.f, 0.f, 0.f, 0.f};
#pragma unroll
        for (int ks = 0; ks < 8; ++ks) { const bf16x8 af = *(const LAS bf16x8*)(hidL + r * 264 + 32 * ks + 8 * g); const bf16x8 bfr = *(const bf16x8*)(w2T + (size_t)(16 * wave + r) * 256 + 32 * ks + 8 * g); c2 = mfma16(af, bfr, c2); }
#pragma unroll
        for (int j = 0; j < 4; ++j) outL[(4 * g + j) * 65 + 16 * wave + r] = c2[j]; }
    __syncthreads();
    if (tid < 16) { float ss = 0.f; for (int d = 0; d < 64; ++d) { const float v = outL[tid * 65 + d]; ss += v * v; } rinvL[tid] = rsqrtf(ss * (1.f / 64.f) + 1e-6f); }
    __syncthreads();
    const float* kg = a.in[8] + l * 64;
    for (int idx = tid; idx < 1024; idx += 512) { const int row = idx >> 6, d = idx & 63, i = i0 + row; const float v = outL[row * 65 + d];
        if (which == 0) ((bf16_t*)(ws + WS_KCMP))[(size_t)i * 64 + d] = (i <= 1022) ? f2bf(v * rinvL[row] * kg[d]) : (bf16_t)0;
        else ((bf16_t*)(ws + WS_VCMPT))[((size_t)((i >> 5) * 64 + d)) * 32 + (i & 31)] = (i <= 1022) ? f2bf(v) : (bf16_t)0; }
    __syncthreads();
}
__device__ __forceinline__ void gla_decay(const KArgs& a, int l, int c, int h, LAS float* bL, LAS float* aL, int tid) {
    const bf16_t* proj = (const bf16_t*)(a.ws + WS_PROJ);
    LAS float* segL = aL + 512;
    { const int t = tid >> 4, r = tid & 15; aL[tid] = bf2f(proj[(size_t)(32 * c + t) * NPAD + C_GA + r]); }
    __syncthreads();
    const int kk = tid & 127, sg = tid >> 7;
    { const int hk = h * 128 + kk; float w[16];
#pragma unroll
        for (int r = 0; r < 16; ++r) w[r] = a.in[4][(size_t)l * 16 * 512 + r * 512 + hk];
        const float ba = a.in[5][l * 512 + hk]; float cum = 0.f;
#pragma unroll
        for (int tt = 0; tt < 8; ++tt) { const int t = 8 * sg + tt; float x = ba;
#pragma unroll
            for (int r = 0; r < 16; ++r) x += aL[t * 16 + r] * w[r];
            const float ls = fminf(x, 0.f) - __logf(1.f + __expf(-fabsf(x)));
            cum += ls * (1.f / 16.f); bL[t * 128 + kk] = cum; }
        segL[sg * 128 + kk] = cum; }
    __syncthreads();
    { float off = 0.f;
#pragma unroll
        for (int q = 0; q < 3; ++q) if (q < sg) off += segL[q * 128 + kk];
        if (sg > 0) {
#pragma unroll
            for (int tt = 0; tt < 8; ++tt) bL[(8 * sg + tt) * 128 + kk] += off; } }
    __syncthreads();
}
__device__ __forceinline__ void gla_g1_item(const KArgs& a, int l, LAS unsigned char* lds, int item, int tid, int wave, int lane) {
    unsigned char* ws = a.ws; const bf16_t* proj = (const bf16_t*)(ws + WS_PROJ);
    const int c = item >> 2, h = item & 3;
    LAS float* bL = (LAS float*)lds; LAS float* aL = (LAS float*)(lds + 16384);
    LAS bf16_t* kT = (LAS bf16_t*)(lds + 20480);
    LAS bf16_t* vT = (LAS bf16_t*)(lds + 20480 + 10240);
    gla_decay(a, l, c, h, bL, aL, tid);
    for (int idx = tid; idx < 32 * 128; idx += 512) { const int s = idx >> 7, k = idx & 127; const size_t ro = (size_t)(32 * c + s) * NPAD + h * 128 + k;
        kT[k * 40 + s] = f2bf(bf2f(proj[ro + C_GK]) * __expf(bL[31 * 128 + k] - bL[s * 128 + k])); vT[k * 40 + s] = proj[ro + C_GV]; }
    if (tid < 128) ((float*)(ws + WS_GDC))[(size_t)(c * 4 + h) * 128 + tid] = __expf(bL[31 * 128 + tid]);
    __syncthreads();
    const int r = lane & 15, g = lane >> 4;
    const bf16x8 af = *(const LAS bf16x8*)(vT + (16 * wave + r) * 40 + 8 * g);
    bf16_t* dst = (bf16_t*)(ws + WS_GST) + (size_t)(c * 4 + h) * 16384;
#pragma unroll
    for (int kb = 0; kb < 8; ++kb) { const bf16x8 bfr = *(const LAS bf16x8*)(kT + (16 * kb + r) * 40 + 8 * g);
        const f32x4 d = mfma16(af, bfr, (f32x4){0.f, 0.f, 0.f, 0.f});
#pragma unroll
        for (int j = 0; j < 4; ++j) dst[(size_t)(16 * wave + 4 * g + j) * 128 + 16 * kb + r] = f2bf(d[j]); }
    __syncthreads();
}
__device__ __forceinline__ void gla_scan(const KArgs& a, int cid) {
    bf16_t* st = (bf16_t*)(a.ws + WS_GST); const float* dc = (const float*)(a.ws + WS_GDC);
    const int h = cid >> 14, vk = cid & 16383, k = cid & 127;
    bf16_t* sp = st + (size_t)h * 16384 + vk; const float* dp = dc + (size_t)h * 128 + k;
    float state = 0.f;
    unsigned short kva[8], kvb[8]; float da[8], db[8];
#pragma unroll
    for (int i = 0; i < 8; ++i) { kva[i] = sp[(size_t)i * 65536]; da[i] = dp[(size_t)i * 512]; }
    for (int c0 = 0; c0 < 512; c0 += 16) {
#pragma unroll
        for (int i = 0; i < 8; ++i) { kvb[i] = sp[(size_t)(c0 + 8 + i) * 65536]; db[i] = dp[(size_t)(c0 + 8 + i) * 512]; }
        SCHED_FENCE_G();
#pragma unroll
        for (int i = 0; i < 8; ++i) { sp[(size_t)(c0 + i) * 65536] = f2bf(state); state = state * da[i] + bf2f(kva[i]); }
        SCHED_FENCE_G();
        if (c0 + 16 < 512) {
#pragma unroll
            for (int i = 0; i < 8; ++i) { kva[i] = sp[(size_t)(c0 + 16 + i) * 65536]; da[i] = dp[(size_t)(c0 + 16 + i) * 512]; } }
        SCHED_FENCE_G();
#pragma unroll
        for (int i = 0; i < 8; ++i) { sp[(size_t)(c0 + 8 + i) * 65536] = f2bf(state); state = state * db[i] + bf2f(kvb[i]); }
        SCHED_FENCE_G();
    }
}
__device__ __forceinline__ void gla_g3_item(const KArgs& a, int l, LAS unsigned char* lds, int item, int tid, int wave, int lane) {
    unsigned char* ws = a.ws; const bf16_t* proj = (const bf16_t*)(ws + WS_PROJ);
    const int c = item >> 2, h = item & 3;
    LAS float* bL = (LAS float*)lds; LAS float* aL = (LAS float*)(lds + 16384);
    LAS bf16_t* qL = (LAS bf16_t*)(lds + 20480);
    LAS bf16_t* kL = (LAS bf16_t*)(lds + 20480 + 8704);
    LAS bf16_t* vT = (LAS bf16_t*)(lds + 20480 + 17408);
    LAS bf16_t* scL = (LAS bf16_t*)(lds + 20480 + 27648);
    LAS float* oL = (LAS float*)(lds + 20480 + 30208);
    gla_decay(a, l, c, h, bL, aL, tid);
    for (int idx = tid; idx < 32 * 128; idx += 512) { const int s = idx >> 7, k = idx & 127; const size_t ro = (size_t)(32 * c + s) * NPAD + h * 128 + k; const float b = bL[s * 128 + k];
        qL[s * 136 + k] = f2bf(bf2f(proj[ro + C_GQ]) * __expf(b) * 0.08838834764831845f); kL[s * 136 + k] = f2bf(bf2f(proj[ro + C_GK]) * __expf(-b)); vT[k * 40 + s] = proj[ro + C_GV]; }
    __syncthreads();
    const int r = lane & 15, g = lane >> 4;
    if (wave < 4) { const int mb = wave >> 1, nb = wave & 1; f32x4 d = (f32x4){0.f, 0.f, 0.f, 0.f};
#pragma unroll
        for (int ks = 0; ks < 4; ++ks) d = mfma16(*(const LAS bf16x8*)(qL + (16 * mb + r) * 136 + 32 * ks + 8 * g), *(const LAS bf16x8*)(kL + (16 * nb + r) * 136 + 32 * ks + 8 * g), d);
#pragma unroll
        for (int j = 0; j < 4; ++j) { const int t = 16 * mb + 4 * g + j, s = 16 * nb + r; scL[t * 40 + s] = (s <= t) ? f2bf(d[j]) : (bf16_t)0; } }
    __syncthreads();
    const bf16_t* stT = (const bf16_t*)(ws + WS_GST) + (size_t)(c * 4 + h) * 16384;
#pragma unroll
    for (int mb = 0; mb < 2; ++mb) { f32x4 d = (f32x4){0.f, 0.f, 0.f, 0.f};
#pragma unroll
        for (int ks = 0; ks < 4; ++ks) d = mfma16(*(const LAS bf16x8*)(qL + (16 * mb + r) * 136 + 32 * ks + 8 * g), *(const bf16x8*)(stT + (size_t)(16 * wave + r) * 128 + 32 * ks + 8 * g), d);
        d = mfma16(*(const LAS bf16x8*)(scL + (16 * mb + r) * 40 + 8 * g), *(const LAS bf16x8*)(vT + (16 * wave + r) * 40 + 8 * g), d);
#pragma unroll
        for (int j = 0; j < 4; ++j) oL[(16 * mb + 4 * g + j) * 132 + 16 * wave + r] = d[j]; }
    __syncthreads();
    { const int t = tid >> 4, v0 = (tid & 15) * 8; float o[8]; float ss = 0.f;
#pragma unroll
        for (int e = 0; e < 8; ++e) { o[e] = oL[t * 132 + v0 + e]; ss += o[e] * o[e]; }
        ss += __shfl_xor(ss, 1); ss += __shfl_xor(ss, 2); ss += __shfl_xor(ss, 4); ss += __shfl_xor(ss, 8);
        const float rinv = rsqrtf(ss * (1.f / 128.f) + 1e-6f);
        const u32x4 rw = *(const u32x4*)(proj + (size_t)(32 * c + t) * NPAD + C_GR + h * 128 + v0); float rr[8]; unpack8(rw, rr);
        const float* ng = a.in[6] + l * 128 + v0; float res[8];
#pragma unroll
        for (int e = 0; e < 8; ++e) { const float on = o[e] * rinv * ng[e]; const float si = rr[e] / (1.f + __expf(-rr[e])); res[e] = on * si; }
        *(u32x4*)((bf16_t*)(ws + WS_OGLA) + (size_t)(32 * c + t) * 512 + h * 128 + v0) = pack8(res); }
    __syncthreads();
}

__device__ __forceinline__ float xor16f(float t, int g) { const auto r = __builtin_amdgcn_permlane16_swap(__float_as_uint(t), __float_as_uint(t), false, false); return __uint_as_float(r[0] == __float_as_uint(t) ? r[1] : r[0]); }
__device__ __forceinline__ float xor32f(float t, int g) { const auto r = __builtin_amdgcn_permlane32_swap(__float_as_uint(t), __float_as_uint(t), false, false); return __uint_as_float(r[0] == __float_as_uint(t) ? r[1] : r[0]); }
#define SCHED_FENCE() __builtin_amdgcn_sched_barrier(0)
template <bool DIAG>
__device__ __forceinline__ void sb_weights(const f32x4 (&S)[2], bf16x8& pf, float& carry, int g, int cc, int krel) {
    float e[8], P[8];
#pragma unroll
    for (int j = 0; j < 8; ++j) { int zi = __float_as_int(S[j >> 2][j & 3]); zi = zi < 0x41700000 ? zi : 0x41700000;
        float z = __int_as_float(zi);
        if (DIAG) { if (32 * cc + 8 * g + j >= krel) z = -1e30f; }
        e[j] = __builtin_amdgcn_exp2f(z); }
    P[0] = 1.f;
#pragma unroll
    for (int j = 1; j < 8; ++j) P[j] = P[j - 1] * (1.f + e[j - 1]);
    const float Tg = __builtin_amdgcn_rcpf(P[7] * (1.f + e[7]));
    const float t1 = __shfl_xor(Tg, 16);
    const float pp = Tg * t1;
    const float t23 = __shfl_xor(pp, 32);
    const float gex = ((g & 1) ? 1.f : t1) * ((g & 2) ? 1.f : t23);
    const float cf = Tg * gex * carry;
    carry = carry * (pp * t23);
    float w[8];
#pragma unroll
    for (int j = 0; j < 8; ++j) w[j] = (e[j] * P[j]) * cf;
    const u32x4 pw = pack8(w); __builtin_memcpy(&pf, &pw, 16);
}
template <bool DIAG>
__device__ __forceinline__ void sb_tile(const LAS bf16_t* Kt, const LAS bf16_t* Vt, const bf16x8 (&qf)[4], f32x4 (&O)[8], float& carry, int n, int g, int krel  ) {
    bf16x8 kf[2][2][4];
#pragma unroll
    for (int cc = 1; cc >= 0; --cc)
#pragma unroll
        for (int pb = 0; pb < 2; ++pb)
#pragma unroll
            for (int ks = 0; ks < 4; ++ks) kf[cc][pb][ks] = *(const LAS bf16x8*)(Kt + (32 * cc + 16 * pb + n) * 128 + (((4 * ks + g) ^ n) << 3));
    SCHED_FENCE();
    f32x4 S[2][2];
#pragma unroll
    for (int cc = 1; cc >= 0; --cc)
#pragma unroll
        for (int pb = 0; pb < 2; ++pb) { f32x4 sv = (f32x4){0.f, 0.f, 0.f, 0.f};
#pragma unroll
            for (int ks = 0; ks < 4; ++ks) sv = mfma16(kf[cc][pb][ks], qf[ks], sv);
            S[cc][pb] = sv; }
    SCHED_FENCE();
    bf16x8 vf1[8], vf0[8], pf1, pf0;
#pragma unroll
    for (int db = 0; db < 8; ++db) vf1[db] = *(const LAS bf16x8*)(Vt + (16 * db + n) * 64 + (((4 + g) ^ (n >> 1)) << 3));
    SCHED_FENCE();
    sb_weights<DIAG>(S[1], pf1, carry, g, 1, krel);
    SCHED_FENCE();
#pragma unroll
    for (int db = 0; db < 8; ++db) vf0[db] = *(const LAS bf16x8*)(Vt + (16 * db + n) * 64 + ((g ^ (n >> 1)) << 3));
    SCHED_FENCE();
#pragma unroll
    for (int db = 0; db < 8; ++db) O[db] = mfma16(vf1[db], pf1, O[db]);
    SCHED_FENCE();
    sb_weights<DIAG>(S[0], pf0, carry, g, 0, krel);
    SCHED_FENCE();
#pragma unroll
    for (int db = 0; db < 8; ++db) O[db] = mfma16(vf0[db], pf0, O[db]);
    SCHED_FENCE();
}
__device__ __forceinline__ void sb_unit(const KArgs& a, LAS unsigned char* lds, int h, int qb, int tid, int wave, int lane) {
    unsigned char* ws = a.ws; const bf16_t* proj = (const bf16_t*)(ws + WS_PROJ);
    constexpr int KT_B = 64 * 256, BUF_B = 32768;
    const int n = lane & 15, g = lane >> 4;
    const int tq = 128 * qb + 16 * wave + n;
    const float SC = 0.08838834764831845f * LOG2E;
    bf16x8 qf[4];
#pragma unroll
    for (int ks = 0; ks < 4; ++ks) { const u32x4 w = *(const u32x4*)(proj + (size_t)tq * NPAD + C_SQ + h * 128 + 32 * ks + 8 * g); float f[8]; unpack8(w, f);
#pragma unroll
        for (int e = 0; e < 8; ++e) f[e] *= SC;
        const u32x4 pw = pack8(f); __builtin_memcpy(&qf[ks], &pw, 16); }
    f32x4 O[8];
#pragma unroll
    for (int i = 0; i < 8; ++i) O[i] = (f32x4){0.f, 0.f, 0.f, 0.f};
    float carry = 1.f;
    const int ntiles = 2 * qb + 2;
    unsigned koff[2], voff[2];
#pragma unroll
    for (int i = 0; i < 2; ++i) { const int p = i * 512 + wave * 64 + lane;
        const int rho = p >> 4, c = (p & 15) ^ (rho & 15), k = (rho & 32) | ((rho & 16) >> 2) | ((rho & 12) << 1) | (rho & 3);
        koff[i] = (unsigned)(k * NPAD + 8 * c) * 2u;
        const int d = p >> 3, cv = (p & 7) ^ ((d >> 1) & 7);
        voff[i] = (unsigned)(d * 64 + 8 * cv) * 2u; }
    const char* kbase = (const char*)(proj + C_SK + h * 128); const char* vbase = (const char*)((const bf16_t*)(ws + WS_SVT) + (size_t)h * 256 * 8192);
    auto issue = [&](int T, int buf) {
        const char* kt = kbase + (size_t)(64 * T) * NPAD * 2; const char* vt = vbase + (size_t)T * 16384;
#pragma unroll
        for (int i = 0; i < 2; ++i) {
            __builtin_amdgcn_global_load_lds((const unsigned*)(kt + koff[i]), (LAS unsigned*)(lds + buf * BUF_B + (i * 512 + wave * 64) * 16), 16, 0, 0);
            __builtin_amdgcn_global_load_lds((const unsigned*)(vt + voff[i]), (LAS unsigned*)(lds + buf * BUF_B + KT_B + (i * 512 + wave * 64) * 16), 16, 0, 0); } };
    issue(ntiles - 1, 0);
    issue(ntiles - 2, 1);
    asm volatile("s_waitcnt vmcnt(4)" ::: "memory"); __builtin_amdgcn_s_barrier(); asm volatile("" ::: "memory");
    const int wq_lo = 128 * qb + 16 * wave;
    int buf = 0;
    for (int it = 0; it < ntiles; ++it) { const int T = ntiles - 1 - it;
        int b2 = buf + 2; if (b2 >= 3) b2 -= 3;
        const bool more = (it + 2 < ntiles);
        if (more) issue(T - 2, b2);
        if (64 * T < wq_lo + 15) {
            const LAS bf16_t* Kt = (const LAS bf16_t*)(lds + buf * BUF_B); const LAS bf16_t* Vt = (const LAS bf16_t*)(lds + buf * BUF_B + KT_B);
            if (64 * T + 63 >= wq_lo) sb_tile<true>(Kt, Vt, qf, O, carry, n, g, tq - 64 * T);
            else sb_tile<false>(Kt, Vt, qf, O, carry, n, g, 0);
        }
        if (more) asm volatile("s_waitcnt vmcnt(4) lgkmcnt(0)" ::: "memory"); else asm volatile("s_waitcnt vmcnt(0) lgkmcnt(0)" ::: "memory");
        __builtin_amdgcn_s_barrier(); asm volatile("" ::: "memory");
        buf = buf + 1; if (buf >= 3) buf = 0;
    }
    bf16_t* orow = (bf16_t*)(ws + WS_OSB) + (size_t)tq * 512 + h * 128;
#pragma unroll
    for (int db = 0; db < 8; ++db) { u32x2 w; w.x = cvt_pk_bf16(O[db][0], O[db][1]); w.y = cvt_pk_bf16(O[db][2], O[db][3]); *(u32x2*)(orow + 16 * db + 4 * g) = w; }
}

struct NFrag { bf16x8 k[4]; bf16x8 v[4]; };
template <bool LV> __device__ __forceinline__ void nsa_load(NFrag& f, const bf16_t* Kb, const bf16_t* VB, int kb, int n, int g) {
    const bf16_t* kp = Kb + (size_t)(kb + 8 * (n >> 2) + (n & 3)) * 64 + 8 * g;
    f.k[0] = *(const bf16x8*)kp; f.k[1] = *(const bf16x8*)(kp + 32); f.k[2] = *(const bf16x8*)(kp + 256); f.k[3] = *(const bf16x8*)(kp + 288);
    if (LV) { const bf16_t* vp = VB + ((size_t)(kb >> 5) * 64 + n) * 32 + 8 * g;
#pragma unroll
        for (int db = 0; db < 4; ++db) f.v[db] = *(const bf16x8*)(vp + db * 512); }
}
template <int MODE>
__device__ __forceinline__ void nsa_compute(const NFrag& f, int kb, const bf16x8 (&qf)[2], const LAS float* LUTh, LAS float* impq,
                                            int tq, int h, int g, int qs, int qsel, float inv, float& lsum, f32x4 (&O)[4]) {
    f32x4 S[2];
#pragma unroll
    for (int pb = 0; pb < 2; ++pb) { f32x4 sv = mfma16(f.k[2 * pb], qf[0], (f32x4){0.f, 0.f, 0.f, 0.f}); S[pb] = mfma16(f.k[2 * pb + 1], qf[1], sv); }
    float p[8];
    const int dbase = (MODE <= 1) ? (tq - 31 - 16 * (kb + 8 * g)) : (tq - kb - 8 * g);
    const bool colok = (MODE == 2) ? (qs == qsel) : true;
    float bias[8];
#pragma unroll
    for (int j = 0; j < 8; ++j) { const int dist = (MODE <= 1) ? dbase - 16 * j : dbase - j; const unsigned di = min((unsigned)dist, 1023u); bias[j] = LUTh[di * 8]; }
#pragma unroll
    for (int j = 0; j < 8; ++j) asm volatile("" : "+v"(bias[j]));
#pragma unroll
    for (int j = 0; j < 8; ++j) { const int dist = (MODE <= 1) ? dbase - 16 * j : dbase - j;
        const bool valid = (MODE == 3) ? ((unsigned)dist < 512u) : (dist >= 0 && colok);
        const float ex = __builtin_amdgcn_exp2f(S[j >> 2][j & 3] + bias[j]);
        float pv = valid ? ex : 0.f;
        if (MODE == 1) pv *= inv;
        p[j] = pv; if (MODE != 1) lsum += pv; }
    if (MODE == 0) return;
    if (MODE == 1) {
#pragma unroll
        for (int j = 0; j < 8; ++j) { float v = p[j]; v += __shfl_xor(v, 1); v += __shfl_xor(v, 2); v += __shfl_xor(v, 4); if (h == 0) impq[kb + 8 * g + j] = v; } }
    const u32x4 pw = pack8(p); bf16x8 pf; __builtin_memcpy(&pf, &pw, 16);
#pragma unroll
    for (int db = 0; db < 4; ++db) O[db] = mfma16(f.v[db], pf, O[db]);
}
template <int MODE, class KBF, class QSF>
__device__ __forceinline__ void nsa_run(int niter, const bf16_t* Kb, const bf16_t* VB, KBF kbf, QSF qsf, const bf16x8 (&qf)[2], const LAS float* LUTh, LAS float* impq,
                                        int tq, int h, int n, int g, int qs, float inv, float& lsum, f32x4 (&O)[4]) {
    if (niter <= 0) return;
    NFrag A, C; const int last = niter - 1;
    nsa_load<MODE != 0>(A, Kb, VB, kbf(0), n, g);
    for (int i = 0; i < niter; i += 2) {
        nsa_load<MODE != 0>(C, Kb, VB, kbf(i + 1 < last ? i + 1 : last), n, g);
        SCHED_FENCE();
        nsa_compute<MODE>(A, kbf(i), qf, LUTh, impq, tq, h, g, qs, qsf(i), inv, lsum, O);
        SCHED_FENCE();
        if (i + 1 >= niter) break;
        nsa_load<MODE != 0>(A, Kb, VB, kbf(i + 2 < last ? i + 2 : last), n, g);
        SCHED_FENCE();
        nsa_compute<MODE>(C, kbf(i + 1), qf, LUTh, impq, tq, h, g, qs, qsf(i + 1), inv, lsum, O);
        SCHED_FENCE();
    }
}
__device__ __forceinline__ float lred(float l) { l += __shfl_xor(l, 16); l += __shfl_xor(l, 32); return l; }
__device__ __forceinline__ void nsa_unit(const KArgs& a, LAS unsigned char* lds, int unit, int wave, int lane) {
    unsigned char* ws = a.ws; const bf16_t* proj = (const bf16_t*)(ws + WS_PROJ);
    LAS float* imp = (LAS float*)(lds + 32768 + wave * 8192);
    LAS int* selL = (LAS int*)(lds + 98304 + wave * 128);
    const int t0 = 2 * unit, n = lane & 15, g = lane >> 4, qs = n >> 3, h = n & 7, tq = t0 + qs;
    const LAS float* LUT = (const LAS float*)lds + h;
    bf16x8 qf[2];
    qf[0] = *(const bf16x8*)((const bf16_t*)(ws + WS_QN) + (size_t)tq * 512 + h * 64 + 8 * g); qf[1] = *(const bf16x8*)((const bf16_t*)(ws + WS_QN) + (size_t)tq * 512 + h * 64 + 32 + 8 * g);
    const bf16_t* gp = proj + (size_t)tq * NPAD + C_NGATE + h * 3;
    const float g0 = 1.f / (1.f + __expf(-bf2f(gp[0]))), g1 = 1.f / (1.f + __expf(-bf2f(gp[1]))), g2 = 1.f / (1.f + __expf(-bf2f(gp[2])));
    f32x4 Ot[4], Ob[4];
#pragma unroll
    for (int i = 0; i < 4; ++i) { Ot[i] = (f32x4){0.f, 0.f, 0.f, 0.f}; Ob[i] = (f32x4){0.f, 0.f, 0.f, 0.f}; }
    const int nvmax = (t0 + 1 >= 31) ? (((t0 + 1 - 31) >> 4) + 1) : 0; const int nch = (nvmax + 31) >> 5;
    const bf16_t* KC = (const bf16_t*)(ws + WS_KCMP); const bf16_t* VCT = (const bf16_t*)(ws + WS_VCMPT);
    auto kb_lin = [](int i) { return 32 * i; }; auto qs_zero = [](int) { return 0; };
    float lsum = 0.f;
    nsa_run<0>(nch, KC, VCT, kb_lin, qs_zero, qf, LUT, imp + qs * 1024, tq, h, n, g, qs, 0.f, lsum, Ob);
    { const float l = lred(lsum); const float inv = l > 0.f ? 1.f / l : 0.f; float dummy = 0.f;
      nsa_run<1>(nch, KC, VCT, kb_lin, qs_zero, qf, LUT, imp + qs * 1024, tq, h, n, g, qs, inv, dummy, Ob); }
#pragma unroll
    for (int i = 0; i < 4; ++i) { Ot[i] += Ob[i] * g0; Ob[i] = (f32x4){0.f, 0.f, 0.f, 0.f}; }
    LDS_FENCE();
    int cnts[2];
#pragma unroll
    for (int q2 = 0; q2 < 2; ++q2) { const int tqq = t0 + q2, cur = tqq >> 6; const LAS float* iq = imp + q2 * 1024;
        float val[4];
#pragma unroll
        for (int r = 0; r < 4; ++r) { const int b = lane + 64 * r; float v = -1.f;
            if (b >= 1 && b <= cur - 2) { v = 0.f;
#pragma unroll
                for (int i = 0; i < 5; ++i) v += iq[4 * b - 1 + i]; }
            val[r] = v; }
        int cnt = 0;
        if (lane == 0) { selL[q2 * 8 + 0] = 0; if (cur >= 1) selL[q2 * 8 + 1] = cur; if (cur >= 2) selL[q2 * 8 + 2] = cur - 1; }
        cnt = 1 + (cur >= 1) + (cur >= 2);
        int ncand = cur - 2; if (ncand < 0) ncand = 0; const int npick = ncand < 5 ? ncand : 5;
        for (int rd = 0; rd < npick; ++rd) { float bv = val[0]; int bi = lane;
#pragma unroll
            for (int r = 1; r < 4; ++r) if (val[r] > bv) { bv = val[r]; bi = lane + 64 * r; }
#pragma unroll
            for (int o = 1; o < 64; o <<= 1) { const float ov = __shfl_xor(bv, o); const int oi = __shfl_xor(bi, o); if (ov > bv || (ov == bv && oi < bi)) { bv = ov; bi = oi; } }
            if (lane == 0) selL[q2 * 8 + cnt] = bi; ++cnt;
#pragma unroll
            for (int r = 0; r < 4; ++r) if (bi == lane + 64 * r) val[r] = -2.f; }
        cnts[q2] = cnt; }
    LDS_FENCE();
    lsum = 0.f;
    { const int c0 = cnts[0], c1 = cnts[1];
      auto kbf = [&](int i) { const int bidx = i >> 1; const int slot = bidx < c0 ? bidx : 8 + (bidx - c0); return 64 * __builtin_amdgcn_readfirstlane(selL[slot]) + 32 * (i & 1); };
      auto qsf = [&](int i) { return ((i >> 1) < c0) ? 0 : 1; };
      nsa_run<2>(2 * (c0 + c1), (const bf16_t*)(ws + WS_KSN), (const bf16_t*)(ws + WS_VST), kbf, qsf, qf, LUT, imp, tq, h, n, g, qs, 0.f, lsum, Ob); }
    { const float l = lred(lsum); const float sc = l > 0.f ? g1 / l : 0.f;
#pragma unroll
      for (int i = 0; i < 4; ++i) { Ot[i] += Ob[i] * sc; Ob[i] = (f32x4){0.f, 0.f, 0.f, 0.f}; } }
    lsum = 0.f;
    { int lo = t0 - 511; if (lo < 0) lo = 0; lo &= ~31; const int nw = ((t0 + 1 - lo) >> 5) + 1;
      auto kbf = [&](int i) { return lo + 32 * i; };
      nsa_run<3>(nw, (const bf16_t*)(ws + WS_KWN), (const bf16_t*)(ws + WS_VWT), kbf, qs_zero, qf, LUT, imp, tq, h, n, g, qs, 0.f, lsum, Ob);
      const float l = lred(lsum); const float sc = l > 0.f ? g2 / l : 0.f;
#pragma unroll
      for (int i = 0; i < 4; ++i) Ot[i] += Ob[i] * sc; }
    bf16_t* orow = (bf16_t*)(ws + WS_ONSA) + (size_t)tq * 512 + h * 64;
#pragma unroll
    for (int db = 0; db < 4; ++db) { u32x2 w; w.x = cvt_pk_bf16(Ot[db][0], Ot[db][1]); w.y = cvt_pk_bf16(Ot[db][2], Ot[db][3]); *(u32x2*)(orow + 16 * db + 4 * g) = w; }
}


#define RLX_AGENT __ATOMIC_RELAXED, __HIP_MEMORY_SCOPE_AGENT
#define XB_TMO      128
#define XB_XCNT(j)  (256  + 64 * (j))
#define XB_XSUB(j)  (1280 + 64 * (j))
#define XB_XGEN(j)  (2304 + 64 * (j))
#define XB_TOP      3328
#define XB_TOPGEN   3392
#define XCD_BAR_WORDS 3456
#define XB_SPIN_CAP (1u << 18)

__device__ __forceinline__ unsigned xb_ld(unsigned* p)              { return __hip_atomic_load(p, __ATOMIC_RELAXED, __HIP_MEMORY_SCOPE_AGENT); }
__device__ __forceinline__ unsigned xb_add(unsigned* p, unsigned v) { return __hip_atomic_fetch_add(p, v, __ATOMIC_RELAXED, __HIP_MEMORY_SCOPE_AGENT); }
__device__ __forceinline__ unsigned xb_xcc_id() { return (unsigned)__builtin_amdgcn_s_getreg((3 << 11) | 20) & 0xFu; }
#define XB_SPIN(cond, bar) do { unsigned _sp = 0; while (cond) { __builtin_amdgcn_s_sleep(1); \
    if ((++_sp & 255u) == 0u) { if (xb_ld(&(bar)[XB_TMO])) break; if (_sp > XB_SPIN_CAP) { atomicAdd(&(bar)[XB_TMO], 1u); break; } } } } while (0)

struct XcdBarrier {
    unsigned* bar; unsigned x;
    volatile LAS unsigned* st;
};

__device__ __forceinline__ XcdBarrier xcd_barrier_post(unsigned* bar, volatile LAS unsigned* st) {
    XcdBarrier b; b.bar = bar; b.x = xb_xcc_id(); b.st = st;
    if (threadIdx.x == 0) (void)xb_add(&bar[XB_XCNT(b.x)], 1u);
    return b;
}
__device__ __forceinline__ void xcd_barrier_complete(unsigned* bar, unsigned x, unsigned& nloc, unsigned& nx) {
    const unsigned G = gridDim.x * gridDim.y * gridDim.z;
    unsigned sum, cnt, mine, sp = 0u;
    for (;;) {
        sum = 0u; cnt = 0u; mine = 0u;
#pragma unroll
        for (unsigned j = 0; j < 16; ++j) { const unsigned c = xb_ld(&bar[XB_XCNT(j)]); sum += c; cnt += (c > 0u) ? 1u : 0u; mine = (j == x) ? c : mine; }
        if (sum == G) break;
        __builtin_amdgcn_s_sleep(1);
        if ((++sp & 255u) == 0u) { if (xb_ld(&bar[XB_TMO])) break; if (sp > XB_SPIN_CAP) { atomicAdd(&bar[XB_TMO], 1u); break; } }
    }
    nloc = mine > 0u ? mine : 1u; nx = cnt > 0u ? cnt : 1u;
}

__device__ __forceinline__ void xcd_barrier(const XcdBarrier& b) {
    asm volatile("s_waitcnt vmcnt(0)" ::: "memory");
    __syncthreads();
    if (threadIdx.x == 0) {
        unsigned* bar = b.bar;
        __builtin_amdgcn_s_waitcnt(0);
        unsigned nloc = b.st[0], nx = b.st[1];
        if (nloc == 0u) { xcd_barrier_complete(bar, b.x, nloc, nx); b.st[0] = nloc; b.st[1] = nx; }
        const unsigned old = xb_add(&bar[XB_XSUB(b.x)], 1u);
        const unsigned gen = old / nloc;
        if (old + 1u == (gen + 1u) * nloc) {
            __builtin_amdgcn_fence(__ATOMIC_RELEASE, "agent");
            asm volatile("s_waitcnt vmcnt(0)" ::: "memory");
            const unsigned og = xb_add(&bar[XB_TOP], 1u);
            const unsigned tg = og / nx;
            if (og + 1u == (tg + 1u) * nx) xb_add(&bar[XB_TOPGEN], 1u);
            else XB_SPIN(xb_ld(&bar[XB_TOPGEN]) == tg, bar);
            __builtin_amdgcn_fence(__ATOMIC_ACQUIRE, "agent");
            xb_add(&bar[XB_XGEN(b.x)], 1u);
            asm volatile("s_waitcnt vmcnt(0)" ::: "memory");
        } else {
            XB_SPIN(xb_ld(&bar[XB_XGEN(b.x)]) == gen, bar);
            __builtin_amdgcn_fence(__ATOMIC_ACQUIRE, "agent");
            asm volatile("s_waitcnt vmcnt(0)" ::: "memory");
        }
    }
    __syncthreads();
}

#define GSYNC() xcd_barrier(xbar)
__global__ void __launch_bounds__(512) __attribute__((amdgpu_waves_per_eu(2, 2))) fwd_mega(KArgs a) {
    extern __shared__ __attribute__((aligned(16))) unsigned char lds_raw[];
    LAS unsigned char* lds = (LAS unsigned char*)lds_raw;
    const int G = gridDim.x, bid = blockIdx.x, NGW = G * 8;
    { volatile LAS unsigned* stw = (volatile LAS unsigned*)(lds + 132608); if (threadIdx.x < 2) stw[threadIdx.x] = 0u; }
    __syncthreads();
    XcdBarrier xbar = xcd_barrier_post((unsigned*)(a.ws + WS_CTL), (volatile LAS unsigned*)(lds + 132608));
    cg::this_grid().sync();
#define IDS() int tid = threadIdx.x; asm volatile("" : "+v"(tid)); const int lane = tid & 63, wave = __builtin_amdgcn_readfirstlane(tid >> 6); const int gw = bid * 8 + wave; (void)lane; (void)gw;
    unsigned char* ws = a.ws;
    bf16_t* PROJ = (bf16_t*)(ws + WS_PROJ); bf16_t* HN = (bf16_t*)(ws + WS_HN); bf16_t* HID = (bf16_t*)(ws + WS_HID);
#pragma unroll 1
    for (int l = 0; l < DEPTH; ++l) {
        const float* xsrc = (l == 0) ? a.in[0] : a.out;
        { IDS(); phase_convert(a, l, lds, gw, NGW, wave, lane);
          phase_rms(xsrc, a.in[1] + l * DM, HN, gw, NGW, lane); }
        GSYNC();
        { pg8::Gemm g{HN, (const bf16_t*)(ws + WS_WIN), M, NPAD, DM}; pg8::StaticOrder S; S.init(M, NPAD, G, bid);
          pg8::EpiBf16<0> E{PROJ, NPAD};
          pg8::gemm_phase<pg8::EpiBf16<0>, pg8::StaticOrder, true, true>(lds, g, S, E); }
        GSYNC();
        { IDS(); for (int it = bid; it < 256; it += G) pre_item(a, l, lds, it, tid); }
        { IDS(); for (int it = bid; it < 128; it += G) cmp_item(a, l, lds, it, tid, wave, lane); }
        { IDS(); for (int it = bid; it < 2048; it += G) gla_g1_item(a, l, lds, it, tid, wave, lane); }
        GSYNC();
        {   IDS();
            { const float* lg = (const float*)(ws + WS_LUT); LAS float* LUT = (LAS float*)lds; for (int i = tid; i < 8192; i += 512) LUT[i] = lg[i]; }
            LAS int* ctr = (LAS int*)(lds + 99328);
            if (tid == 0) *ctr = 0;
            __syncthreads();
            if (wave < 4) for (int c0 = (bid * 4 + wave) * 64; c0 < 65536; c0 += G * 256) gla_scan(a, c0 + lane);
            const int nper = (8192 + G - 1) / G;
            for (;;) { int idx = 0; if (lane == 0) idx = atomicAdd((int*)ctr, 1); idx = __builtin_amdgcn_readfirstlane(idx);
                if (idx >= nper) break; const int hn = nper >> 1; const int unit = (idx < hn) ? (8192 - hn * (bid + 1) + idx) : (hn * bid + (idx - hn)); if (unit >= 0 && unit < 8192) nsa_unit(a, lds, unit, wave, lane); }
            __syncthreads();
        }
        GSYNC();
        { IDS(); for (int idx = bid; idx < 512; idx += G) { int h, qb; if (idx < 256) { h = idx & 3; qb = 127 - (idx >> 2); } else { const int j = idx - 256; h = j & 3; qb = j >> 2; }
            sb_unit(a, lds, h, qb, tid, wave, lane); } }
        { IDS(); for (int it = bid; it < 2048; it += G) gla_g3_item(a, l, lds, it, tid, wave, lane); }
        GSYNC();
        for (int b = 0; b < 3; ++b) {
            pg8::Gemm g{(const bf16_t*)(ws + WS_OGLA + b * 16 * MiB), (const bf16_t*)(ws + WS_WBR + b * MiB), M, DM, 512}; pg8::StaticOrder S; S.init(M, DM, G, bid);
            pg8::EpiGate E{HN, PROJ + C_MGATE + b * DM, NPAD, b == 0 ? 1 : 0};
            pg8::gemm_phase<pg8::EpiGate, pg8::StaticOrder, true, true>(lds, g, S, E); }
        GSYNC();
        { pg8::Gemm g{HN, (const bf16_t*)(ws + WS_WOUT), M, DM, DM}; pg8::StaticOrder S; S.init(M, DM, G, bid);
          pg8::EpiRes E{xsrc, a.out};
          pg8::gemm_phase<pg8::EpiRes, pg8::StaticOrder, true, true>(lds, g, S, E); }
        GSYNC();
        { IDS(); phase_rms(a.out, a.in[2] + l * DM, HN, gw, NGW, lane); }
        GSYNC();
        { pg8::Gemm g{HN, (const bf16_t*)(ws + WS_WUP), M, FF, DM}; pg8::StaticOrder S; S.init(M, FF, G, bid);
          pg8::EpiBf16<2> E{HID, FF};
          pg8::gemm_phase<pg8::EpiBf16<2>, pg8::StaticOrder, true, true>(lds, g, S, E); }
        GSYNC();
        { pg8::Gemm g{HID, (const bf16_t*)(ws + WS_WDN), M, DM, FF}; pg8::StaticOrder S; S.init(M, DM, G, bid);
          pg8::EpiRes E{a.out, a.out};
          pg8::gemm_phase<pg8::EpiRes, pg8::StaticOrder, true, true>(lds, g, S, E); }
        GSYNC();
    }
}

extern "C" void kernel_launch(void* const* d_in, const int* in_sizes, int n_in, void* d_out, int out_size, void* d_ws, size_t ws_size, hipStream_t stream) {
    static int grid = 0;
    if (grid == 0) {
        if (n_in != 22 || ws_size < WS_END + 65536) { fprintf(stderr, "kernel_launch: unexpected n_in %d or ws_size %zu (< %zu)\n", n_in, ws_size, (size_t)WS_END); grid = -1; return; }
        int dev = 0, cus = 0, per_cu = 0;
        hipGetDevice(&dev); hipDeviceGetAttribute(&cus, hipDeviceAttributeMultiprocessorCount, dev);
        hipFuncSetAttribute((const void*)fwd_mega, hipFuncAttributeMaxDynamicSharedMemorySize, LDS_BYTES);
        hipOccupancyMaxActiveBlocksPerMultiprocessor(&per_cu, (const void*)fwd_mega, 512, LDS_BYTES);
        if (per_cu < 1) { fprintf(stderr, "kernel_launch: occupancy query says %d blocks/CU\n", per_cu); per_cu = 1; }
        (void)hipGetLastError();
        grid = cus * 1;
    }
    if (grid < 0) return;
    if (hipMemsetAsync((char*)d_ws + WS_CTL, 0, 65536, stream) != hipSuccess) { fprintf(stderr, "kernel_launch: memset of barrier words failed\n"); return; }
    KArgs a{};
    for (int i = 0; i < 22; ++i) a.in[i] = (const float*)d_in[i];
    a.out = (float*)d_out; a.ws = (unsigned char*)d_ws;
    void* args[] = {&a};
    hipError_t e = hipLaunchCooperativeKernel((const void*)fwd_mega, dim3(grid), dim3(512), args, LDS_BYTES, stream);
    if (e != hipSuccess) fprintf(stderr, "cooperative launch failed: %s (grid %d)\n", hipGetErrorString(e), grid);
}
```

```cpp
#include <hip/hip_runtime.h>
#include <hip/hip_cooperative_groups.h>
#include <cstdio>
#include <cstdint>
namespace cg = cooperative_groups;
namespace pg8 {
#define PG8_LAS __attribute__((address_space(3)))
typedef unsigned short bf16_t;
typedef short bf16x8 __attribute__((ext_vector_type(8)));
typedef float f32x4 __attribute__((ext_vector_type(4)));
typedef unsigned u32x4 __attribute__((ext_vector_type(4)));
constexpr int BM = 256, BK = 64, HALF = 128, HTB = HALF * BK * 2  , STAGE_BYTES = 8 * HTB, NXCD = 8, WGM = 8;

__host__ __device__ __forceinline__ int lds_byte(int r, int c) { const int st = (r >> 4) * 2 + (c >> 5), rr = r & 15, cc = c & 31, ob = rr * 64 + cc * 2; return st * 1024 + (ob ^ (((ob >> 9) & 1) << 5)); }
__host__ __device__ __forceinline__ void stage_rc(int b, int& R, int& C) { const int st = b / 1024, sb = b % 1024, swz = sb ^ (((sb >> 9) & 1) << 5); R = (st >> 1) * 16 + swz / 64; C = (st & 1) * 32 + (swz % 64) / 2; }
__host__ __device__ __forceinline__ int perm32(int rho) { const int n = rho >> 4, i = rho & 15; return 8 * (i >> 2) + 4 * n + (i & 3); }

struct Unit { int pm, pn; };
struct Gemm { const bf16_t* A; const bf16_t* Bt; int M, N, K; };

struct StaticOrder {
    int nM, nN, nwg, G, c;
    __host__ __device__ void init(int M, int N, int G_, int c_) { nM = M / BM; nN = N / BM; nwg = nM * nN; G = G_; c = c_; }
    __host__ __device__ bool next(int i, Unit& u) const {
        const long L = (long)i * G + c; if (L >= nwg) return false;
        int wgid = (int)L; { const int q = nwg / NXCD, r = nwg % NXCD, xcd = wgid % NXCD, off = wgid / NXCD; wgid = (xcd < r ? xcd * (q + 1) : r * (q + 1) + (xcd - r) * q) + off; }
        const int nig = WGM * nN, gid = wgid / nig, fm = gid * WGM, gsz = (nM - fm) < WGM ? (nM - fm) : WGM;
        u.pm = fm + ((wgid % nig) % gsz); u.pn = (wgid % nig) / gsz; return true;
    }
    __device__ __forceinline__ void a_ready(const Unit&) const {}
    __device__ __forceinline__ void done(const Unit&) const {}
};

__device__ __forceinline__ unsigned cvt_pk_bf16(float lo, float hi) { unsigned r; asm("v_cvt_pk_bf16_f32 %0, %1, %2" : "=v"(r) : "v"(lo), "v"(hi)); return r; }
__device__ __forceinline__ float bflo(unsigned w) { return __uint_as_float(w << 16); }
__device__ __forceinline__ float bfhi(unsigned w) { return __uint_as_float(w & 0xffff0000u); }
template <int ACT> struct EpiBf16 {
    static constexpr bool PERM = true, AFTER_DRAIN = false;
    bf16_t* O; int ldc;
    __device__ __forceinline__ void operator()(const f32x4 (&acc)[2][2][4][2], const Unit& u, int wr, int wc, int fr, int fq) const {
        const int row0 = u.pm * BM + wr * 64 + fr; const int col0 = u.pn * BM + wc * 32 + 8 * fq;
#pragma unroll
        for (int ai = 0; ai < 2; ++ai)
#pragma unroll
            for (int m = 0; m < 4; ++m) { bf16_t* rowp = O + (size_t)(row0 + ai * HALF + m * 16) * ldc + col0;
#pragma unroll
                for (int bj = 0; bj < 2; ++bj) { f32x4 v0 = acc[ai][bj][m][0], v1 = acc[ai][bj][m][1];
                    if (ACT == 2) {
#pragma unroll
                        for (int e = 0; e < 4; ++e) { float a = fmaxf(v0[e], 0.f), b = fmaxf(v1[e], 0.f); v0[e] = a * a; v1[e] = b * b; } }
                    u32x4 w; w.x = cvt_pk_bf16(v0[0], v0[1]); w.y = cvt_pk_bf16(v0[2], v0[3]); w.z = cvt_pk_bf16(v1[0], v1[1]); w.w = cvt_pk_bf16(v1[2], v1[3]);
                    *(u32x4*)(rowp + bj * HALF) = w; } }
    }
};
struct EpiGate {
    static constexpr bool PERM = true, AFTER_DRAIN = false;
    bf16_t* O; const bf16_t* gate; int gld; int first;
    __device__ __forceinline__ void operator()(const f32x4 (&acc)[2][2][4][2], const Unit& u, int wr, int wc, int fr, int fq) const {
        const int row0 = u.pm * BM + wr * 64 + fr; const int col0 = u.pn * BM + wc * 32 + 8 * fq;
#pragma unroll
        for (int ai = 0; ai < 2; ++ai)
#pragma unroll
            for (int m = 0; m < 4; ++m) { const int row = row0 + ai * HALF + m * 16; bf16_t* rowp = O + (size_t)row * 1024 + col0; const bf16_t* gp = gate + (size_t)row * gld + col0;
#pragma unroll
                for (int bj = 0; bj < 2; ++bj) { const f32x4 v0 = acc[ai][bj][m][0], v1 = acc[ai][bj][m][1];
                    const u32x4 gw = *(const u32x4*)(gp + bj * HALF);
                    u32x4 ow = (u32x4){0u, 0u, 0u, 0u}; if (!first) ow = *(const u32x4*)(rowp + bj * HALF);
                    float gv[8] = {bflo(gw.x), bfhi(gw.x), bflo(gw.y), bfhi(gw.y), bflo(gw.z), bfhi(gw.z), bflo(gw.w), bfhi(gw.w)};
                    float ov[8] = {bflo(ow.x), bfhi(ow.x), bflo(ow.y), bfhi(ow.y), bflo(ow.z), bfhi(ow.z), bflo(ow.w), bfhi(ow.w)};
                    float av[8] = {v0[0], v0[1], v0[2], v0[3], v1[0], v1[1], v1[2], v1[3]};
                    float r[8];
#pragma unroll
                    for (int e = 0; e < 8; ++e) { const float s = 1.f / (1.f + __expf(-gv[e])); r[e] = ov[e] + s * av[e]; }
                    u32x4 w; w.x = cvt_pk_bf16(r[0], r[1]); w.y = cvt_pk_bf16(r[2], r[3]); w.z = cvt_pk_bf16(r[4], r[5]); w.w = cvt_pk_bf16(r[6], r[7]);
                    *(u32x4*)(rowp + bj * HALF) = w; } }
    }
};
struct EpiRes {
    static constexpr bool PERM = false, AFTER_DRAIN = false;
    const float* src; float* out;
    __device__ __forceinline__ void operator()(const f32x4 (&acc)[2][2][4][2], const Unit& u, int wr, int wc, int fr, int fq) const {
        const int col0 = u.pn * BM + wc * 32 + 4 * fq;
#pragma unroll
        for (int ai = 0; ai < 2; ++ai)
#pragma unroll
            for (int m = 0; m < 4; ++m) { const size_t off = (size_t)(u.pm * BM + ai * HALF + wr * 64 + m * 16 + fr) * 1024 + col0;
#pragma unroll
                for (int bj = 0; bj < 2; ++bj)
#pragma unroll
                    for (int n = 0; n < 2; ++n) { const f32x4 bs = *(const f32x4*)(src + off + bj * HALF + n * 16); *(f32x4*)(out + off + bj * HALF + n * 16) = bs + acc[ai][bj][m][n]; } }
    }
};
template <class Epi, class Sched, bool ALIGN_EPI = false, bool SP2 = false>
__device__ __forceinline__ void gemm_phase(PG8_LAS unsigned char* lds, const Gemm g, const Sched& S, const Epi& E) {
    int tid_ = threadIdx.x; asm volatile("" : "+v"(tid_));
    const int tid = tid_, wid = __builtin_amdgcn_readfirstlane(tid >> 6), lane = tid & 63, wr = wid >> 2, wc = wid & 3, fr = lane & 15, fq = lane >> 4;
    const int K = g.K, nt = K / BK;
    unsigned voffA[2], voffB[2];
#pragma unroll
    for (int i = 0; i < 2; ++i) { int R, C; stage_rc(tid * 16 + i * 8192, R, C); const int Rb = Epi::PERM ? ((R & ~31) + perm32(R & 31)) : R;
        voffA[i] = (unsigned)(R * K + C) * 2u; voffB[i] = (unsigned)(Rb * K + C) * 2u; }
    const size_t kstep = (size_t)(BK * 2);
    const size_t hstep = (size_t)HALF * K * 2;
    const size_t tstep = 2 * hstep;
    const unsigned ldsw = (unsigned)wid * 1024u;
    const int aoff = lds_byte(wr * 64 + fr, fq * 8), boff = lds_byte(wc * 32 + fr, fq * 8);
#define PG8_SA(b, h) (((b) * 2 + (h)) * HTB)
#define PG8_SB(b, h) ((4 + (b) * 2 + (h)) * HTB)
#define PG8_STAGE(bufoff, gbase, voff) do { _Pragma("unroll") for (int _i = 0; _i < 2; ++_i) \
        __builtin_amdgcn_global_load_lds((const unsigned*)((const char*)(gbase) + (voff)[_i]), (PG8_LAS unsigned*)(lds + (bufoff) + ldsw + _i * 8192), 16, 0, 0); } while (0)
#define PG8_LDA(dst, b, h) do { _Pragma("unroll") for (int m = 0; m < 4; ++m) _Pragma("unroll") for (int k = 0; k < 2; ++k) dst[m][k] = *(const PG8_LAS bf16x8*)(lds + PG8_SA(b, h) + aoff + m * 2048 + k * 1024); } while (0)
#define PG8_LDB(dst, b, h) do { _Pragma("unroll") for (int n = 0; n < 2; ++n) _Pragma("unroll") for (int k = 0; k < 2; ++k) dst[n][k] = *(const PG8_LAS bf16x8*)(lds + PG8_SB(b, h) + boff + n * 2048 + k * 1024); } while (0)
#define PG8_MMA(ai, bj, At, Bt) do { __builtin_amdgcn_s_setprio(1); _Pragma("unroll") for (int m = 0; m < 4; ++m) _Pragma("unroll") for (int n = 0; n < 2; ++n) _Pragma("unroll") for (int k = 0; k < 2; ++k) \
        acc[ai][bj][m][n] = __builtin_amdgcn_mfma_f32_16x16x32_bf16(Bt[n][k], At[m][k], acc[ai][bj][m][n], 0, 0, 0); __builtin_amdgcn_s_setprio(0); } while (0)
#define PG8_WAIT_V(n) asm volatile("s_waitcnt vmcnt(" #n ")" ::: "memory")
#define PG8_WAIT_L(n) asm volatile("s_waitcnt lgkmcnt(" #n ")" ::: "memory")
#define PG8_BAR __builtin_amdgcn_s_barrier()
#define PG8_SCHED __builtin_amdgcn_sched_barrier(0)
    Unit cur, nxt; int ui = 0;
    if (!S.next(0, cur)) return;
    f32x4 acc[2][2][4][2];
#pragma unroll
    for (int a = 0; a < 2; ++a)
#pragma unroll
        for (int b = 0; b < 2; ++b)
#pragma unroll
            for (int m = 0; m < 4; ++m)
#pragma unroll
                for (int n = 0; n < 2; ++n) acc[a][b][m][n] = (f32x4){0.f, 0.f, 0.f, 0.f};
    bf16x8 At[4][2], B0[2][2], B1[2][2];
    const char* cA = (const char*)g.A + (size_t)cur.pm * tstep; const char* cB = (const char*)g.Bt + (size_t)cur.pn * tstep;
    S.a_ready(cur);
    if constexpr (SP2) {
        PG8_STAGE(PG8_SB(0, 0), cB, voffB); PG8_STAGE(PG8_SB(0, 1), cB + hstep, voffB); PG8_STAGE(PG8_SA(0, 0), cA, voffA); PG8_STAGE(PG8_SA(0, 1), cA + hstep, voffA);
        if (wr == 1) PG8_BAR;
        PG8_WAIT_V(2); PG8_BAR;
        PG8_STAGE(PG8_SB(1, 0), cB + kstep, voffB); PG8_STAGE(PG8_SA(1, 0), cA + kstep, voffA); PG8_STAGE(PG8_SB(1, 1), cB + hstep + kstep, voffB);
        PG8_WAIT_V(6); PG8_BAR;
    } else {
        PG8_STAGE(PG8_SB(0, 0), cB, voffB); PG8_STAGE(PG8_SA(0, 0), cA, voffA); PG8_STAGE(PG8_SB(0, 1), cB + hstep, voffB); PG8_STAGE(PG8_SA(0, 1), cA + hstep, voffA);
        if (wr == 1) PG8_BAR;
        PG8_WAIT_V(4); PG8_BAR;
        PG8_STAGE(PG8_SB(1, 0), cB + kstep, voffB); PG8_STAGE(PG8_SA(1, 0), cA + kstep, voffA); PG8_STAGE(PG8_SB(1, 1), cB + hstep + kstep, voffB);
        PG8_WAIT_V(6); PG8_BAR;
    }
    for (;;) {
        const bool has_next = S.next(ui + 1, nxt);
        const char* nA = has_next ? (const char*)g.A + (size_t)nxt.pm * tstep : cA; const char* nB = has_next ? (const char*)g.Bt + (size_t)nxt.pn * tstep : cB;
        for (int t = 0; t < nt; t += 2) {
            const bool last = (t == nt - 2);
            const char* a1 = cA + (size_t)(t + 1) * kstep;
            const char* a2 = last ? nA : cA + (size_t)(t + 2) * kstep; const char* b2 = last ? nB : cB + (size_t)(t + 2) * kstep;
            const char* a3 = a2 + kstep; const char* b3 = b2 + kstep;
            if (last && has_next) S.a_ready(nxt);
            if constexpr (SP2) {
            PG8_LDB(B0, 0, 0); PG8_LDB(B1, 0, 1); PG8_SCHED; PG8_LDA(At, 0, 0); PG8_STAGE(PG8_SA(1, 1), a1 + hstep, voffA);
            PG8_WAIT_V(8); PG8_WAIT_L(0); PG8_BAR; PG8_MMA(0, 0, At, B0); PG8_MMA(0, 1, At, B1); PG8_BAR; PG8_SCHED;
            PG8_LDA(At, 0, 1); PG8_STAGE(PG8_SB(0, 0), b2, voffB); PG8_STAGE(PG8_SB(0, 1), b2 + hstep, voffB); PG8_STAGE(PG8_SA(0, 0), a2, voffA);
            PG8_WAIT_V(8); PG8_WAIT_L(0); PG8_BAR; PG8_MMA(1, 0, At, B0); PG8_MMA(1, 1, At, B1); PG8_BAR; PG8_SCHED;
            PG8_LDB(B0, 1, 0); PG8_LDB(B1, 1, 1); PG8_SCHED; PG8_LDA(At, 1, 0); PG8_STAGE(PG8_SA(0, 1), a2 + hstep, voffA);
            PG8_WAIT_V(8); PG8_WAIT_L(0); PG8_BAR; PG8_MMA(0, 0, At, B0); PG8_MMA(0, 1, At, B1); PG8_BAR; PG8_SCHED;
            PG8_LDA(At, 1, 1); PG8_STAGE(PG8_SB(1, 0), b3, voffB); PG8_STAGE(PG8_SB(1, 1), b3 + hstep, voffB); PG8_STAGE(PG8_SA(1, 0), a3, voffA);
            PG8_WAIT_V(8); PG8_WAIT_L(0); PG8_BAR; PG8_MMA(1, 0, At, B0); PG8_MMA(1, 1, At, B1); PG8_BAR; PG8_SCHED;
            } else {
            PG8_LDB(B0, 0, 0); PG8_SCHED; PG8_LDA(At, 0, 0); PG8_STAGE(PG8_SA(1, 1), a1 + hstep, voffA);
            PG8_WAIT_L(8); PG8_BAR; PG8_WAIT_L(0); PG8_MMA(0, 0, At, B0); PG8_BAR; PG8_SCHED;
            PG8_LDB(B1, 0, 1); PG8_STAGE(PG8_SB(0, 0), b2, voffB);
            PG8_BAR; PG8_WAIT_L(0); PG8_MMA(0, 1, At, B1); PG8_BAR;
            PG8_LDA(At, 0, 1); PG8_STAGE(PG8_SA(0, 0), a2, voffA);
            PG8_BAR; PG8_WAIT_L(0); PG8_MMA(1, 0, At, B0); PG8_BAR; PG8_SCHED;
            PG8_STAGE(PG8_SB(0, 1), b2 + hstep, voffB);
            PG8_WAIT_V(6); PG8_BAR; PG8_MMA(1, 1, At, B1); PG8_BAR;
            PG8_LDB(B0, 1, 0); PG8_SCHED; PG8_LDA(At, 1, 0); PG8_STAGE(PG8_SA(0, 1), a2 + hstep, voffA);
            PG8_WAIT_L(8); PG8_BAR; PG8_WAIT_L(0); PG8_MMA(0, 0, At, B0); PG8_BAR; PG8_SCHED;
            PG8_LDB(B1, 1, 1); PG8_STAGE(PG8_SB(1, 0), b3, voffB);
            PG8_BAR; PG8_WAIT_L(0); PG8_MMA(0, 1, At, B1); PG8_BAR;
            PG8_LDA(At, 1, 1); PG8_STAGE(PG8_SA(1, 0), a3, voffA);
            PG8_BAR; PG8_WAIT_L(0); PG8_MMA(1, 0, At, B0); PG8_BAR; PG8_SCHED;
            PG8_STAGE(PG8_SB(1, 1), b3 + hstep, voffB);
            PG8_WAIT_V(6); PG8_BAR; PG8_MMA(1, 1, At, B1); PG8_BAR;
            }
        }
        if constexpr (ALIGN_EPI) { if (wr == 0) PG8_BAR; }
        if constexpr (!Epi::AFTER_DRAIN) { E(acc, cur, wr, wc, fr, fq); S.done(cur); }
        if (!has_next) break;
#pragma unroll
        for (int a = 0; a < 2; ++a)
#pragma unroll
            for (int b = 0; b < 2; ++b)
#pragma unroll
                for (int m = 0; m < 4; ++m)
#pragma unroll
                    for (int n = 0; n < 2; ++n) acc[a][b][m][n] = (f32x4){0.f, 0.f, 0.f, 0.f};
        cur = nxt; cA = nA; cB = nB; ++ui;
        if constexpr (ALIGN_EPI) { if (wr == 1) PG8_BAR; }
    }
    PG8_WAIT_V(0);
    if constexpr (!ALIGN_EPI) { if (wr == 0) PG8_BAR; }
    PG8_BAR;
    if constexpr (Epi::AFTER_DRAIN) { E.fused(acc, cur, wr, wc, fr, fq, lds, wid, lane); S.done(cur); }
#undef PG8_SA
#undef PG8_SB
#undef PG8_STAGE
#undef PG8_LDA
#undef PG8_LDB
#undef PG8_MMA
#undef PG8_WAIT_V
#undef PG8_WAIT_L
#undef PG8_BAR
#undef PG8_SCHED
}
}

#define LAS __attribute__((address_space(3)))
typedef unsigned short bf16_t;
typedef short bf16x8 __attribute__((ext_vector_type(8)));
typedef float f32x4 __attribute__((ext_vector_type(4)));
typedef unsigned u32x4 __attribute__((ext_vector_type(4)));
typedef unsigned u32x2 __attribute__((ext_vector_type(2)));
using pg8::cvt_pk_bf16; using pg8::bflo; using pg8::bfhi;

constexpr int M = 16384, DM = 1024, NIN = 7592, NPAD = 7680, FF = 4096, DEPTH = 4;
constexpr int C_GQ = 0, C_GK = 512, C_GV = 1024, C_GA = 1536, C_GR = 1552, C_SQ = 2064, C_SK = 2576, C_SV = 3088, C_NQ = 3600, C_NKC = 4112, C_NVC = 4176,
              C_NKS = 4240, C_NVS = 4304, C_NKW = 4368, C_NVW = 4432, C_NGATE = 4496, C_MGATE = 4520;
constexpr size_t MiB = 1u << 20;
constexpr size_t WS_PROJ = 0, WS_HID = 0, WS_HN = 240 * MiB, WS_OGLA = 272 * MiB, WS_OSB = 288 * MiB, WS_ONSA = 304 * MiB;
constexpr size_t WS_WIN = 320 * MiB, WS_WUP = 335 * MiB, WS_WDN = 343 * MiB, WS_WOUT = 351 * MiB, WS_WBR = 353 * MiB, WS_WK1 = 356 * MiB, WS_WV1 = 357 * MiB,
                 WS_WK2 = 358 * MiB, WS_WV2 = 358 * MiB + 65536, WS_CB = 358 * MiB + 131072, WS_LUT = 358 * MiB + 196608;
constexpr size_t WS_GST = 360 * MiB, WS_GDC = 424 * MiB, WS_SVT = 425 * MiB, WS_QN = 441 * MiB, WS_KSN = 457 * MiB, WS_KWN = 459 * MiB, WS_VST = 461 * MiB, WS_VWT = 463 * MiB,
                 WS_KCMP = 465 * MiB, WS_VCMPT = 465 * MiB + 131072, WS_END = 466 * MiB, WS_CTL = 466 * MiB;
constexpr int LDS_BYTES = 133120;
constexpr float LOG2E = 1.4426950408889634f;

struct KArgs { const float* in[22]; float* out; unsigned char* ws; };

__device__ __forceinline__ float bf2f(bf16_t v) { return __uint_as_float(((unsigned)v) << 16); }
__device__ __forceinline__ bf16_t f2bf(float f) { unsigned u = __float_as_uint(f); return (bf16_t)((u + 0x7fffu + ((u >> 16) & 1u)) >> 16); }
__device__ __forceinline__ f32x4 mfma16(bf16x8 a, bf16x8 b, f32x4 c) { return __builtin_amdgcn_mfma_f32_16x16x32_bf16(a, b, c, 0, 0, 0); }
__device__ __forceinline__ float wave_sum(float v) {
#pragma unroll
    for (int o = 1; o < 64; o <<= 1) v += __shfl_xor(v, o);
    return v;
}
#define LDS_FENCE() asm volatile("s_waitcnt lgkmcnt(0)" ::: "memory")
#define SCHED_FENCE_G() __builtin_amdgcn_sched_barrier(0)
__device__ __forceinline__ void unpack8(const u32x4 w, float (&f)[8]) { f[0] = bflo(w.x); f[1] = bfhi(w.x); f[2] = bflo(w.y); f[3] = bfhi(w.y); f[4] = bflo(w.z); f[5] = bfhi(w.z); f[6] = bflo(w.w); f[7] = bfhi(w.w); }
__device__ __forceinline__ u32x4 pack8(const float (&r)[8]) { u32x4 w; w.x = cvt_pk_bf16(r[0], r[1]); w.y = cvt_pk_bf16(r[2], r[3]); w.z = cvt_pk_bf16(r[4], r[5]); w.w = cvt_pk_bf16(r[6], r[7]); return w; }

__device__ __forceinline__ void transpose_item(const float* W, int K, int N, int Npad, bf16_t* WT, LAS float* scr, int item, int lane) {
    const int nblk = Npad / 32, kb = item / nblk, nb = item % nblk, k0 = 64 * kb, n0 = 32 * nb;
    const int nn = n0 + (lane & 31);
    float tv[32];
#pragma unroll
    for (int i = 0; i < 32; ++i) { const int kk = 2 * i + (lane >> 5); tv[i] = (nn < N) ? W[(size_t)(k0 + kk) * N + nn] : 0.f; }
#pragma unroll
    for (int i = 0; i < 32; ++i) { const int kk = 2 * i + (lane >> 5); scr[kk * 33 + (lane & 31)] = tv[i]; }
    LDS_FENCE();
    const int c = lane & 7;
#pragma unroll
    for (int j = 0; j < 4; ++j) { const int n = (lane >> 3) + 8 * j; const LAS float* s = scr + (8 * c) * 33 + n;
        u32x4 o; o.x = cvt_pk_bf16(s[0 * 33], s[1 * 33]); o.y = cvt_pk_bf16(s[2 * 33], s[3 * 33]); o.z = cvt_pk_bf16(s[4 * 33], s[5 * 33]); o.w = cvt_pk_bf16(s[6 * 33], s[7 * 33]);
        *(u32x4*)(WT + (size_t)(n0 + n) * K + k0 + 8 * c) = o; }
    LDS_FENCE();
}
__device__ __forceinline__ int rel_bucket(int n) {
    if (n < 16) return n;
    int large = 16 + (int)(logf((float)n / 16.f) / 4.1588830833596715f * 16.f);
    return large < 31 ? large : 31;
}
__device__ __forceinline__ void rms_row(const float* xrow, const float* g, bf16_t* orow, int lane) {
    const f32x4* xr = (const f32x4*)xrow + lane; f32x4 v[4]; float s = 0.f;
#pragma unroll
    for (int j = 0; j < 4; ++j) { v[j] = xr[64 * j]; s += (v[j].x * v[j].x + v[j].y * v[j].y) + (v[j].z * v[j].z + v[j].w * v[j].w); }
    const float rinv = rsqrtf(wave_sum(s) * (1.f / 1024.f) + 1e-6f);
    u32x2* o8 = (u32x2*)orow + lane;
#pragma unroll
    for (int j = 0; j < 4; ++j) { const f32x4 gg = ((const f32x4*)g)[lane + 64 * j]; u32x2 w; w.x = cvt_pk_bf16(v[j].x * rinv * gg.x, v[j].y * rinv * gg.y); w.y = cvt_pk_bf16(v[j].z * rinv * gg.z, v[j].w * rinv * gg.w); o8[64 * j] = w; }
}
__device__ __forceinline__ void phase_convert(const KArgs& a, int l, LAS unsigned char* lds, int gw, int NGW, int wave, int lane) {
    unsigned char* ws = a.ws;
    LAS float* scr = (LAS float*)(lds + wave * 8704);
    constexpr int I0 = 16 * 240, I1 = 16 * 128, I2 = 64 * 32, I3 = 16 * 32, I4 = 8 * 32, I7 = 32 * 8, I9 = 4 * 2, IB = 128, IL = 128;
    constexpr int NIT = I0 + I1 + I2 + I3 + 3 * I4 + 2 * I7 + 2 * I9 + IB + IL;
    for (int it = gw; it < NIT; it += NGW) {
        int r = it;
        if (r < I0) { transpose_item(a.in[3] + (size_t)l * DM * NIN, DM, NIN, NPAD, (bf16_t*)(ws + WS_WIN), scr, r, lane); continue; } r -= I0;
        if (r < I1) { transpose_item(a.in[20] + (size_t)l * DM * FF, DM, FF, FF, (bf16_t*)(ws + WS_WUP), scr, r, lane); continue; } r -= I1;
        if (r < I2) { transpose_item(a.in[21] + (size_t)l * FF * DM, FF, DM, DM, (bf16_t*)(ws + WS_WDN), scr, r, lane); continue; } r -= I2;
        if (r < I3) { transpose_item(a.in[19] + (size_t)l * DM * DM, DM, DM, DM, (bf16_t*)(ws + WS_WOUT), scr, r, lane); continue; } r -= I3;
        if (r < 3 * I4) { const int b = r / I4; transpose_item(a.in[16 + b] + (size_t)l * 512 * DM, 512, DM, DM, (bf16_t*)(ws + WS_WBR + b * MiB), scr, r % I4, lane); continue; } r -= 3 * I4;
        if (r < I7) { transpose_item(a.in[11] + (size_t)l * 2048 * 256, 2048, 256, 256, (bf16_t*)(ws + WS_WK1), scr, r, lane); continue; } r -= I7;
        if (r < I7) { transpose_item(a.in[13] + (size_t)l * 2048 * 256, 2048, 256, 256, (bf16_t*)(ws + WS_WV1), scr, r, lane); continue; } r -= I7;
        if (r < I9) { transpose_item(a.in[12] + (size_t)l * 256 * 64, 256, 64, 64, (bf16_t*)(ws + WS_WK2), scr, r, lane); continue; } r -= I9;
        if (r < I9) { transpose_item(a.in[14] + (size_t)l * 256 * 64, 256, 64, 64, (bf16_t*)(ws + WS_WV2), scr, r, lane); continue; } r -= I9;
        if (r < IB) {
            const int p = r >> 3, which = (r >> 2) & 1, col = (r & 3) * 64 + lane;
            const float* pe = a.in[which ? 10 : 9] + (size_t)l * 2048; const float* w1 = a.in[which ? 13 : 11] + (size_t)l * 2048 * 256;
            float s = 0.f;
#pragma unroll 1
            for (int k0 = 128 * p; k0 < 128 * p + 128; k0 += 16) { float wv[16];
#pragma unroll
                for (int i = 0; i < 16; ++i) wv[i] = w1[(size_t)(k0 + i) * 256 + col];
#pragma unroll
                for (int i = 0; i < 16; ++i) s += pe[k0 + i] * wv[i]; }
            ((float*)(ws + WS_CB))[p * 512 + which * 256 + col] = s; continue; } r -= IB;
        {
            const int idx = r * 64 + lane; const int d = idx >> 3, h = idx & 7;
            ((float*)(ws + WS_LUT))[idx] = a.in[15][rel_bucket(d) * 8 + h] * LOG2E; }
    }
}
__device__ __forceinline__ void phase_rms(const float* x, const float* g, bf16_t* hn, int gw, int NGW, int lane) {
    f32x4 gg[4];
#pragma unroll
    for (int j = 0; j < 4; ++j) gg[j] = ((const f32x4*)g)[lane + 64 * j];
    for (int m = gw; m < M; m += 2 * NGW) { const int m2 = (m + NGW < M) ? m + NGW : m;
        const f32x4* xa = (const f32x4*)(x + (size_t)m * DM) + lane; const f32x4* xb = (const f32x4*)(x + (size_t)m2 * DM) + lane;
        f32x4 va[4], vb[4]; float sa = 0.f, sb = 0.f;
#pragma unroll
        for (int j = 0; j < 4; ++j) { va[j] = xa[64 * j]; vb[j] = xb[64 * j]; }
#pragma unroll
        for (int j = 0; j < 4; ++j) { sa += (va[j].x * va[j].x + va[j].y * va[j].y) + (va[j].z * va[j].z + va[j].w * va[j].w); sb += (vb[j].x * vb[j].x + vb[j].y * vb[j].y) + (vb[j].z * vb[j].z + vb[j].w * vb[j].w); }
#pragma unroll
        for (int o = 1; o < 64; o <<= 1) { sa += __shfl_xor(sa, o); sb += __shfl_xor(sb, o); }
        const float ra = rsqrtf(sa * (1.f / 1024.f) + 1e-6f), rb = rsqrtf(sb * (1.f / 1024.f) + 1e-6f);
        u32x2* oa = (u32x2*)(hn + (size_t)m * DM) + lane; u32x2* ob = (u32x2*)(hn + (size_t)m2 * DM) + lane;
#pragma unroll
        for (int j = 0; j < 4; ++j) { u32x2 w; w.x = cvt_pk_bf16(va[j].x * ra * gg[j].x, va[j].y * ra * gg[j].y); w.y = cvt_pk_bf16(va[j].z * ra * gg[j].z, va[j].w * ra * gg[j].w); oa[64 * j] = w;
            u32x2 w2; w2.x = cvt_pk_bf16(vb[j].x * rb * gg[j].x, vb[j].y * rb * gg[j].y); w2.y = cvt_pk_bf16(vb[j].z * rb * gg[j].z, vb[j].w * rb * gg[j].w); ob[64 * j] = w2; } }
}

__device__ __forceinline__ void rms64_to(const bf16_t* src, const float* g, float scale, bf16_t* dst) {
    u32x4 w[8]; float ss = 0.f;
#pragma unroll
    for (int i = 0; i < 8; ++i) { w[i] = ((const u32x4*)src)[i]; float f[8]; unpack8(w[i], f);
#pragma unroll
        for (int e = 0; e < 8; ++e) ss += f[e] * f[e]; }
    const float rinv = rsqrtf(ss * (1.f / 64.f) + 1e-6f) * scale;
#pragma unroll
    for (int i = 0; i < 8; ++i) { float f[8]; unpack8(w[i], f); float r[8];
#pragma unroll
        for (int e = 0; e < 8; ++e) r[e] = f[e] * rinv * g[8 * i + e];
        ((u32x4*)dst)[i] = pack8(r); }
}
__device__ __forceinline__ void pre_item(const KArgs& a, int l, LAS unsigned char* lds, int item, int tid) {
    unsigned char* ws = a.ws; const bf16_t* proj = (const bf16_t*)(ws + WS_PROJ);
    const int t0 = item * 64;
    {
        const int tl = tid >> 3, h = tid & 7;
        rms64_to(proj + (size_t)(t0 + tl) * NPAD + C_NQ + h * 64, a.in[7] + l * 64, 0.125f * LOG2E, (bf16_t*)(ws + WS_QN) + (size_t)(t0 + tl) * 512 + h * 64);
    }
    if (tid < 128) {
        const int tl = tid >> 1, which = tid & 1;
        rms64_to(proj + (size_t)(t0 + tl) * NPAD + (which ? C_NKW : C_NKS), a.in[8] + l * 64, 1.f, (bf16_t*)(ws + (which ? WS_KWN : WS_KSN)) + (size_t)(t0 + tl) * 64);
    }
    LAS bf16_t* T = (LAS bf16_t*)lds;
    for (int idx = tid; idx < 64 * 80; idx += 512) { const int t = idx / 80, p = idx % 80; const int col = p < 64 ? C_SV + 8 * p : (p < 72 ? C_NVS + 8 * (p - 64) : C_NVW + 8 * (p - 72));
        const u32x4 w = *(const u32x4*)(proj + (size_t)(t0 + t) * NPAD + col);
        LAS unsigned* d = (LAS unsigned*)(T + t * 648 + 8 * p); d[0] = w.x; d[1] = w.y; d[2] = w.z; d[3] = w.w; }
    __syncthreads();
    for (int idx = tid; idx < 640 * 8; idx += 512) { const int c = idx >> 3, p = idx & 7;
        unsigned short e[8];
#pragma unroll
        for (int j = 0; j < 8; ++j) e[j] = T[(8 * p + j) * 648 + c];
        u32x4 w; w.x = e[0] | ((unsigned)e[1] << 16); w.y = e[2] | ((unsigned)e[3] << 16); w.z = e[4] | ((unsigned)e[5] << 16); w.w = e[6] | ((unsigned)e[7] << 16);
        const int tk = t0 + 8 * p;
        if (c < 512) *(u32x4*)((bf16_t*)(ws + WS_SVT) + ((size_t)(((c >> 7) * 256 + (tk >> 6)) * 128 + (c & 127))) * 64 + (tk & 63)) = w;
        else { const int d = (c - 512) & 63; bf16_t* vb = (bf16_t*)(ws + (c < 576 ? WS_VST : WS_VWT)); *(u32x4*)(vb + ((size_t)((tk >> 5) * 64 + d)) * 32 + (tk & 31)) = w; } }
    __syncthreads();
}
__device__ __forceinline__ void cmp_item(const KArgs& a, int l, LAS unsigned char* lds, int item, int tid, int wave, int lane) {
    unsigned char* ws = a.ws; const bf16_t* proj = (const bf16_t*)(ws + WS_PROJ);
    const int which = item & 1, grp = item >> 1, i0 = 16 * grp;
    const int srcoff = which ? C_NVC : C_NKC;
    const bf16_t* w1T = (const bf16_t*)(ws + (which ? WS_WV1 : WS_WK1)); const bf16_t* w2T = (const bf16_t*)(ws + (which ? WS_WV2 : WS_WK2));
    LAS bf16_t* hidL = (LAS bf16_t*)lds;
    LAS float* outL = (LAS float*)(lds + 16384);
    LAS float* rinvL = (LAS float*)(lds + 24576);
    const int r = lane & 15, g = lane >> 4;
    int irow = i0 + r; if (irow > 1022) irow = 1022;
    const bf16_t* arow = proj + (size_t)(16 * irow) * NPAD + srcoff;
    f32x4 acc[2] = {(f32x4){0.f, 0.f, 0.f, 0.f}, (f32x4){0.f, 0.f, 0.f, 0.f}};
    const bf16_t* b0 = w1T + (size_t)(32 * wave + r) * 2048 + 8 * g; const bf16_t* b1 = b0 + 16 * 2048;
#pragma unroll 8
    for (int ks = 0; ks < 64; ++ks) { const int k = 32 * ks + 8 * g;
        const bf16x8 af = *(const bf16x8*)(arow + (size_t)(k >> 6) * NPAD + (k & 63));
        const bf16x8 bf0 = *(const bf16x8*)(b0 + 32 * ks), bf1 = *(const bf16x8*)(b1 + 32 * ks);
        acc[0] = mfma16(af, bf0, acc[0]); acc[1] = mfma16(af, bf1, acc[1]); }
    const float* cb = (const float*)(ws + WS_CB);
#pragma unroll
    for (int nb = 0; nb < 2; ++nb) { const int col = 32 * wave + 16 * nb + r; float bs = 0.f;
#pragma unroll
        for (int p = 0; p < 16; ++p) bs += cb[p * 512 + which * 256 + col];
#pragma unroll
        for (int j = 0; j < 4; ++j) { const float x = acc[nb][j] + bs; const float u = 0.7978845608028654f * (x + 0.044715f * x * x * x);
            const float th = 1.f - 2.f / (__expf(2.f * u) + 1.f); hidL[(4 * g + j) * 264 + col] = f2bf(0.5f * x * (1.f + th)); } }
    __syncthreads();
    if (wave < 4) { f32x4 c2 = (f32x4){0.f, 0.f, 0.f, 0.f};
#pragma unroll
        for (int ks = 0; ks < 8; ++ks) { const bf16x8 af = *(const LAS bf16x8*)(hidL + r * 264 + 32 * ks + 8 * g); const bf16x8 bfr = *(const bf16x8*)(w2T + (size_t)(16 * wave + r) * 256 + 32 * ks + 8 * g); c2 = mfma16(af, bfr, c2); }
#pragma unroll
        for (int j = 0; j < 4; ++j) outL[(4 * g + j) * 65 + 16 * wave + r] = c2[j]; }
    __syncthreads();
    if (tid < 16) { float ss = 0.f; for (int d = 0; d < 64; ++d) { const float v = outL[tid * 65 + d]; ss += v * v; } rinvL[tid] = rsqrtf(ss * (1.f / 64.f) + 1e-6f); }
    __syncthreads();
    const float* kg = a.in[8] + l * 64;
    for (int idx = tid; idx < 1024; idx += 512) { const int row = idx >> 6, d = idx & 63, i = i0 + row; const float v = outL[row * 65 + d];
        if (which == 0) ((bf16_t*)(ws + WS_KCMP))[(size_t)i * 64 + d] = (i <= 1022) ? f2bf(v * rinvL[row] * kg[d]) : (bf16_t)0;
        else ((bf16_t*)(ws + WS_VCMPT))[((size_t)((i >> 5) * 64 + d)) * 32 + (i & 31)] = (i <= 1022) ? f2bf(v) : (bf16_t)0; }
    __syncthreads();
}
struct GlaPre { float asrc; float w[16]; float ba; };
__device__ __forceinline__ void gla_preload(GlaPre& p, const KArgs& a, int l, int c, int h, int tid) {
    const bf16_t* proj = (const bf16_t*)(a.ws + WS_PROJ);
    p.asrc = bf2f(proj[(size_t)(32 * c + (tid >> 4)) * NPAD + C_GA + (tid & 15)]);
    const int hk = h * 128 + (tid & 127);
#pragma unroll
    for (int r = 0; r < 16; ++r) p.w[r] = a.in[4][(size_t)l * 16 * 512 + r * 512 + hk];
    p.ba = a.in[5][l * 512 + hk];
}
__device__ __forceinline__ void gla_decay(const GlaPre& p, LAS float* bL, LAS float* aL, int tid) {
    LAS float* segL = aL + 512;
    aL[tid] = p.asrc;
    __syncthreads();
    const int kk = tid & 127, sg = tid >> 7;
    { float cum = 0.f;
#pragma unroll
        for (int tt = 0; tt < 8; ++tt) { const int t = 8 * sg + tt; float x = p.ba;
#pragma unroll
            for (int r = 0; r < 16; ++r) x += aL[t * 16 + r] * p.w[r];
            const float ls = fminf(x, 0.f) - __logf(1.f + __expf(-fabsf(x)));
            cum += ls * (1.f / 16.f); bL[t * 128 + kk] = cum; }
        segL[sg * 128 + kk] = cum; }
    __syncthreads();
    { float off = 0.f;
#pragma unroll
        for (int q = 0; q < 3; ++q) if (q < sg) off += segL[q * 128 + kk];
        if (sg > 0) {
#pragma unroll
            for (int tt = 0; tt < 8; ++tt) bL[(8 * sg + tt) * 128 + kk] += off; } }
    __syncthreads();
}
__device__ __forceinline__ void gla_g1_item(const KArgs& a, int l, LAS unsigned char* lds, int item, int tid, int wave, int lane) {
    unsigned char* ws = a.ws; const bf16_t* proj = (const bf16_t*)(ws + WS_PROJ);
    const int c = item >> 2, h = item & 3;
    LAS float* bL = (LAS float*)lds; LAS float* aL = (LAS float*)(lds + 16384);
    LAS bf16_t* kT = (LAS bf16_t*)(lds + 20480);
    LAS bf16_t* vT = (LAS bf16_t*)(lds + 20480 + 10240);
    GlaPre pre; gla_preload(pre, a, l, c, h, tid);
    const int s = tid >> 4, k0 = (tid & 15) * 8;
    const size_t ro = (size_t)(32 * c + s) * NPAD + h * 128 + k0;
    const u32x4 kraw = *(const u32x4*)(proj + ro + C_GK), vraw = *(const u32x4*)(proj + ro + C_GV);
    gla_decay(pre, bL, aL, tid);
    { float kf[8]; unpack8(kraw, kf);
      const unsigned vw[4] = {vraw.x, vraw.y, vraw.z, vraw.w};
#pragma unroll
      for (int e = 0; e < 8; ++e) { const int k = k0 + e; kT[k * 40 + s] = f2bf(kf[e] * __expf(bL[31 * 128 + k] - bL[s * 128 + k])); vT[k * 40 + s] = (bf16_t)((vw[e >> 1] >> (16 * (e & 1))) & 0xffffu); } }
    if (tid < 128) ((float*)(ws + WS_GDC))[(size_t)(c * 4 + h) * 128 + tid] = __expf(bL[31 * 128 + tid]);
    __syncthreads();
    const int r = lane & 15, g = lane >> 4;
    const bf16x8 af = *(const LAS bf16x8*)(vT + (16 * wave + r) * 40 + 8 * g);
    bf16_t* dst = (bf16_t*)(ws + WS_GST) + (size_t)(c * 4 + h) * 16384;
#pragma unroll
    for (int kb = 0; kb < 8; ++kb) { const bf16x8 bfr = *(const LAS bf16x8*)(kT + (16 * kb + r) * 40 + 8 * g);
        const f32x4 d = mfma16(af, bfr, (f32x4){0.f, 0.f, 0.f, 0.f});
#pragma unroll
        for (int j = 0; j < 4; ++j) dst[(size_t)(16 * wave + 4 * g + j) * 128 + 16 * kb + r] = f2bf(d[j]); }
    __syncthreads();
}
__device__ __forceinline__ void gla_scan(const KArgs& a, int cid) {
    bf16_t* st = (bf16_t*)(a.ws + WS_GST); const float* dc = (const float*)(a.ws + WS_GDC);
    const int h = cid >> 14, vk = cid & 16383, k = cid & 127;
    bf16_t* sp = st + (size_t)h * 16384 + vk; const float* dp = dc + (size_t)h * 128 + k;
    float state = 0.f;
    unsigned short kva[8], kvb[8]; float da[8], db[8];
#pragma unroll
    for (int i = 0; i < 8; ++i) { kva[i] = sp[(size_t)i * 65536]; da[i] = dp[(size_t)i * 512]; }
    for (int c0 = 0; c0 < 512; c0 += 16) {
#pragma unroll
        for (int i = 0; i < 8; ++i) { kvb[i] = sp[(size_t)(c0 + 8 + i) * 65536]; db[i] = dp[(size_t)(c0 + 8 + i) * 512]; }
        SCHED_FENCE_G();
#pragma unroll
        for (int i = 0; i < 8; ++i) { sp[(size_t)(c0 + i) * 65536] = f2bf(state); state = state * da[i] + bf2f(kva[i]); }
        SCHED_FENCE_G();
        if (c0 + 16 < 512) {
#pragma unroll
            for (int i = 0; i < 8; ++i) { kva[i] = sp[(size_t)(c0 + 16 + i) * 65536]; da[i] = dp[(size_t)(c0 + 16 + i) * 512]; } }
        SCHED_FENCE_G();
#pragma unroll
        for (int i = 0; i < 8; ++i) { sp[(size_t)(c0 + 8 + i) * 65536] = f2bf(state); state = state * db[i] + bf2f(kvb[i]); }
        SCHED_FENCE_G();
    }
}
__device__ __forceinline__ void gla_g3_item(const KArgs& a, int l, LAS unsigned char* lds, int item, int tid, int wave, int lane) {
    unsigned char* ws = a.ws; const bf16_t* proj = (const bf16_t*)(ws + WS_PROJ);
    const int c = item >> 2, h = item & 3;
    LAS float* bL = (LAS float*)lds; LAS float* aL = (LAS float*)(lds + 16384);
    LAS bf16_t* qL = (LAS bf16_t*)(lds + 20480);
    LAS bf16_t* kL = (LAS bf16_t*)(lds + 20480 + 8704);
    LAS bf16_t* vT = (LAS bf16_t*)(lds + 20480 + 17408);
    LAS bf16_t* scL = (LAS bf16_t*)(lds + 20480 + 27648);
    LAS float* oL = (LAS float*)(lds + 20480 + 30208);
    const int r = lane & 15, g = lane >> 4;
    GlaPre pre; gla_preload(pre, a, l, c, h, tid);
    const int s = tid >> 4, k0 = (tid & 15) * 8;
    const size_t ro = (size_t)(32 * c + s) * NPAD + h * 128 + k0;
    const u32x4 qraw = *(const u32x4*)(proj + ro + C_GQ), kraw = *(const u32x4*)(proj + ro + C_GK), vraw = *(const u32x4*)(proj + ro + C_GV), rraw = *(const u32x4*)(proj + ro + C_GR);
    const bf16_t* stT = (const bf16_t*)(ws + WS_GST) + (size_t)(c * 4 + h) * 16384;
    bf16x8 stf[4];
#pragma unroll
    for (int ks = 0; ks < 4; ++ks) stf[ks] = *(const bf16x8*)(stT + (size_t)(16 * wave + r) * 128 + 32 * ks + 8 * g);
    float ng[8];
#pragma unroll
    for (int e = 0; e < 8; ++e) ng[e] = a.in[6][l * 128 + k0 + e];
    gla_decay(pre, bL, aL, tid);
    { float qf[8], kf[8]; unpack8(qraw, qf); unpack8(kraw, kf); float qo[8], ko[8];
      const unsigned vw[4] = {vraw.x, vraw.y, vraw.z, vraw.w};
#pragma unroll
      for (int e = 0; e < 8; ++e) { const float b = bL[s * 128 + k0 + e]; qo[e] = qf[e] * __expf(b) * 0.08838834764831845f; ko[e] = kf[e] * __expf(-b); vT[(k0 + e) * 40 + s] = (bf16_t)((vw[e >> 1] >> (16 * (e & 1))) & 0xffffu); }
      *(LAS u32x4*)(qL + s * 136 + k0) = pack8(qo); *(LAS u32x4*)(kL + s * 136 + k0) = pack8(ko); }
    __syncthreads();
    if (wave < 4) { const int mb = wave >> 1, nb = wave & 1; f32x4 d = (f32x4){0.f, 0.f, 0.f, 0.f};
#pragma unroll
        for (int ks = 0; ks < 4; ++ks) d = mfma16(*(const LAS bf16x8*)(qL + (16 * mb + r) * 136 + 32 * ks + 8 * g), *(const LAS bf16x8*)(kL + (16 * nb + r) * 136 + 32 * ks + 8 * g), d);
#pragma unroll
        for (int j = 0; j < 4; ++j) { const int t = 16 * mb + 4 * g + j, sq = 16 * nb + r; scL[t * 40 + sq] = (sq <= t) ? f2bf(d[j]) : (bf16_t)0; } }
    __syncthreads();
#pragma unroll
    for (int mb = 0; mb < 2; ++mb) { f32x4 d = (f32x4){0.f, 0.f, 0.f, 0.f};
#pragma unroll
        for (int ks = 0; ks < 4; ++ks) d = mfma16(*(const LAS bf16x8*)(qL + (16 * mb + r) * 136 + 32 * ks + 8 * g), stf[ks], d);
        d = mfma16(*(const LAS bf16x8*)(scL + (16 * mb + r) * 40 + 8 * g), *(const LAS bf16x8*)(vT + (16 * wave + r) * 40 + 8 * g), d);
#pragma unroll
        for (int j = 0; j < 4; ++j) oL[(16 * mb + 4 * g + j) * 132 + 16 * wave + r] = d[j]; }
    __syncthreads();
    { float o[8]; float ss = 0.f;
#pragma unroll
        for (int e = 0; e < 8; ++e) { o[e] = oL[s * 132 + k0 + e]; ss += o[e] * o[e]; }
        ss += __shfl_xor(ss, 1); ss += __shfl_xor(ss, 2); ss += __shfl_xor(ss, 4); ss += __shfl_xor(ss, 8);
        const float rinv = rsqrtf(ss * (1.f / 128.f) + 1e-6f);
        float rr[8]; unpack8(rraw, rr); float res[8];
#pragma unroll
        for (int e = 0; e < 8; ++e) { const float on = o[e] * rinv * ng[e]; const float si = rr[e] / (1.f + __expf(-rr[e])); res[e] = on * si; }
        *(u32x4*)((bf16_t*)(ws + WS_OGLA) + (size_t)(32 * c + s) * 512 + h * 128 + k0) = pack8(res); }
    __syncthreads();
}

__device__ __forceinline__ float xor16f(float t, int g) { const auto r = __builtin_amdgcn_permlane16_swap(__float_as_uint(t), __float_as_uint(t), false, false); return __uint_as_float(r[0] == __float_as_uint(t) ? r[1] : r[0]); }
__device__ __forceinline__ float xor32f(float t, int g) { const auto r = __builtin_amdgcn_permlane32_swap(__float_as_uint(t), __float_as_uint(t), false, false); return __uint_as_float(r[0] == __float_as_uint(t) ? r[1] : r[0]); }
#define SCHED_FENCE() __builtin_amdgcn_sched_barrier(0)
template <bool DIAG>
__device__ __forceinline__ void sb_weights(const f32x4 (&S)[2], bf16x8& pf, float& carry, int g, int cc, int krel) {
    float e[8], P[8];
#pragma unroll
    for (int j = 0; j < 8; ++j) { int zi = __float_as_int(S[j >> 2][j & 3]); zi = zi < 0x41700000 ? zi : 0x41700000;
        float z = __int_as_float(zi);
        if (DIAG) { if (32 * cc + 8 * g + j >= krel) z = -1e30f; }
        e[j] = __builtin_amdgcn_exp2f(z); }
    P[0] = 1.f;
#pragma unroll
    for (int j = 1; j < 8; ++j) P[j] = P[j - 1] * (1.f + e[j - 1]);
    const float Tg = __builtin_amdgcn_rcpf(P[7] * (1.f + e[7]));
    const float t1 = __shfl_xor(Tg, 16);
    const float pp = Tg * t1;
    const float t23 = __shfl_xor(pp, 32);
    const float gex = ((g & 1) ? 1.f : t1) * ((g & 2) ? 1.f : t23);
    const float cf = Tg * gex * carry;
    carry = carry * (pp * t23);
    float w[8];
#pragma unroll
    for (int j = 0; j < 8; ++j) w[j] = (e[j] * P[j]) * cf;
    const u32x4 pw = pack8(w); __builtin_memcpy(&pf, &pw, 16);
}
template <bool DIAG>
__device__ __forceinline__ void sb_tile(const LAS bf16_t* Kt, const LAS bf16_t* Vt, const bf16x8 (&qf)[4], f32x4 (&O)[8], float& carry, int n, int g, int krel  ) {
    f32x4 S[2][2];
#pragma unroll
    for (int cc = 1; cc >= 0; --cc) {
        bf16x8 kf[2][4];
#pragma unroll
        for (int pb = 0; pb < 2; ++pb)
#pragma unroll
            for (int ks = 0; ks < 4; ++ks) kf[pb][ks] = *(const LAS bf16x8*)(Kt + (32 * cc + 16 * pb + n) * 128 + (((4 * ks + g) ^ n) << 3));
        SCHED_FENCE();
#pragma unroll
        for (int pb = 0; pb < 2; ++pb) { f32x4 sv = (f32x4){0.f, 0.f, 0.f, 0.f};
#pragma unroll
            for (int ks = 0; ks < 4; ++ks) sv = mfma16(kf[pb][ks], qf[ks], sv);
            S[cc][pb] = sv; }
        SCHED_FENCE();
    }
    bf16x8 vf[8], pf1, pf0;
#pragma unroll
    for (int db = 0; db < 8; ++db) vf[db] = *(const LAS bf16x8*)(Vt + (16 * db + n) * 64 + (((4 + g) ^ (n >> 1)) << 3));
    SCHED_FENCE();
    sb_weights<DIAG>(S[1], pf1, carry, g, 1, krel);
    SCHED_FENCE();
#pragma unroll
    for (int db = 0; db < 8; ++db) O[db] = mfma16(vf[db], pf1, O[db]);
    SCHED_FENCE();
#pragma unroll
    for (int db = 0; db < 8; ++db) vf[db] = *(const LAS bf16x8*)(Vt + (16 * db + n) * 64 + ((g ^ (n >> 1)) << 3));
    SCHED_FENCE();
    sb_weights<DIAG>(S[0], pf0, carry, g, 0, krel);
    SCHED_FENCE();
#pragma unroll
    for (int db = 0; db < 8; ++db) O[db] = mfma16(vf[db], pf0, O[db]);
    SCHED_FENCE();
}
__device__ __forceinline__ void sb_swbar(LAS unsigned* ctr, unsigned& gen, int lane) {
    asm volatile("s_waitcnt vmcnt(0) lgkmcnt(0)" ::: "memory");
    gen += 4u;
    if (lane == 0) { __hip_atomic_fetch_add(ctr, 1u, __ATOMIC_RELAXED, __HIP_MEMORY_SCOPE_WORKGROUP);
        while (__hip_atomic_load(ctr, __ATOMIC_RELAXED, __HIP_MEMORY_SCOPE_WORKGROUP) < gen) __builtin_amdgcn_s_sleep(1); }
    asm volatile("s_waitcnt lgkmcnt(0)" ::: "memory");
}
__device__ __forceinline__ void sb_unit4(const KArgs& a, LAS unsigned char* sbl, LAS unsigned* ctr, unsigned& gen, int h, int qb, int wave, int lane) {
    unsigned char* ws = a.ws; const bf16_t* proj = (const bf16_t*)(ws + WS_PROJ);
    constexpr int KT_B = 64 * 256, BUF_B = 32768;
    const int n = lane & 15, g = lane >> 4;
    const int tq = 64 * qb + 16 * wave + n;
    const float SC = 0.08838834764831845f * LOG2E;
    bf16x8 qf[4];
#pragma unroll
    for (int ks = 0; ks < 4; ++ks) { const u32x4 w = *(const u32x4*)(proj + (size_t)tq * NPAD + C_SQ + h * 128 + 32 * ks + 8 * g); float f[8]; unpack8(w, f);
#pragma unroll
        for (int e = 0; e < 8; ++e) f[e] *= SC;
        const u32x4 pw = pack8(f); __builtin_memcpy(&qf[ks], &pw, 16); }
    f32x4 O[8];
#pragma unroll
    for (int i = 0; i < 8; ++i) O[i] = (f32x4){0.f, 0.f, 0.f, 0.f};
    float carry = 1.f;
    const int ntiles = qb + 1;
    const char* kbase = (const char*)(proj + C_SK + h * 128); const char* vbase = (const char*)((const bf16_t*)(ws + WS_SVT) + (size_t)h * 256 * 8192);
    auto issue = [&](int T, int buf) {
        const char* kt = kbase + (size_t)(64 * T) * NPAD * 2; const char* vt = vbase + (size_t)T * 16384;
#pragma unroll
        for (int i = 0; i < 4; ++i) { const int p = i * 256 + wave * 64 + lane;
            const int rho = p >> 4, c = (p & 15) ^ (rho & 15), k = (rho & 32) | ((rho & 16) >> 2) | ((rho & 12) << 1) | (rho & 3);
            const unsigned koff = (unsigned)(k * NPAD + 8 * c) * 2u;
            const int d = p >> 3, cv = (p & 7) ^ ((d >> 1) & 7);
            const unsigned voff = (unsigned)(d * 64 + 8 * cv) * 2u;
            __builtin_amdgcn_global_load_lds((const unsigned*)(kt + koff), (LAS unsigned*)(sbl + buf * BUF_B + (i * 256 + wave * 64) * 16), 16, 0, 0);
            __builtin_amdgcn_global_load_lds((const unsigned*)(vt + voff), (LAS unsigned*)(sbl + buf * BUF_B + KT_B + (i * 256 + wave * 64) * 16), 16, 0, 0); } };
    issue(ntiles - 1, 0);
    sb_swbar(ctr, gen, lane);
    for (int it = 0; it < ntiles; ++it) { const int T = ntiles - 1 - it, buf = it & 1;
        if (T > 0) issue(T - 1, buf ^ 1);
        const LAS bf16_t* Kt = (const LAS bf16_t*)(sbl + buf * BUF_B); const LAS bf16_t* Vt = (const LAS bf16_t*)(sbl + buf * BUF_B + KT_B);
        if (it == 0) sb_tile<true>(Kt, Vt, qf, O, carry, n, g, tq - 64 * T);
        else sb_tile<false>(Kt, Vt, qf, O, carry, n, g, 0);
        sb_swbar(ctr, gen, lane);
    }
    bf16_t* orow = (bf16_t*)(ws + WS_OSB) + (size_t)tq * 512 + h * 128;
#pragma unroll
    for (int db = 0; db < 8; ++db) { u32x2 w; w.x = cvt_pk_bf16(O[db][0], O[db][1]); w.y = cvt_pk_bf16(O[db][2], O[db][3]); *(u32x2*)(orow + 16 * db + 4 * g) = w; }
}

struct NFrag { bf16x8 k[4]; bf16x8 v[4]; };
template <bool LV> __device__ __forceinline__ void nsa_load(NFrag& f, const bf16_t* Kb, const bf16_t* VB, int kb, int n, int g) {
    const bf16_t* kp = Kb + (size_t)(kb + 8 * (n >> 2) + (n & 3)) * 64 + 8 * g;
    f.k[0] = *(const bf16x8*)kp; f.k[1] = *(const bf16x8*)(kp + 32); f.k[2] = *(const bf16x8*)(kp + 256); f.k[3] = *(const bf16x8*)(kp + 288);
    if (LV) { const bf16_t* vp = VB + ((size_t)(kb >> 5) * 64 + n) * 32 + 8 * g;
#pragma unroll
        for (int db = 0; db < 4; ++db) f.v[db] = *(const bf16x8*)(vp + db * 512); }
}
template <int MODE>
__device__ __forceinline__ void nsa_compute(const NFrag& f, int kb, const bf16x8 (&qf)[2], const LAS float* LUTh, LAS float* impq,
                                            int tq, int h, int g, int qs, int qsel, float inv, float& lsum, f32x4 (&O)[4]) {
    f32x4 S[2];
#pragma unroll
    for (int pb = 0; pb < 2; ++pb) { f32x4 sv = mfma16(f.k[2 * pb], qf[0], (f32x4){0.f, 0.f, 0.f, 0.f}); S[pb] = mfma16(f.k[2 * pb + 1], qf[1], sv); }
    float p[8];
    const int dbase = (MODE <= 1) ? (tq - 31 - 16 * (kb + 8 * g)) : (tq - kb - 8 * g);
    const bool colok = (MODE == 2) ? (qs == qsel) : true;
    float bias[8];
#pragma unroll
    for (int j = 0; j < 8; ++j) { const int dist = (MODE <= 1) ? dbase - 16 * j : dbase - j; const unsigned di = min((unsigned)dist, 1023u); bias[j] = LUTh[di * 8]; }
#pragma unroll
    for (int j = 0; j < 8; ++j) asm volatile("" : "+v"(bias[j]));
#pragma unroll
    for (int j = 0; j < 8; ++j) { const int dist = (MODE <= 1) ? dbase - 16 * j : dbase - j;
        const bool valid = (MODE == 3) ? ((unsigned)dist < 512u) : (dist >= 0 && colok);
        const float ex = __builtin_amdgcn_exp2f(S[j >> 2][j & 3] + bias[j]);
        float pv = valid ? ex : 0.f;
        if (MODE == 1) pv *= inv;
        p[j] = pv; if (MODE != 1) lsum += pv; }
    if (MODE == 0) return;
    if (MODE == 1) {
#pragma unroll
        for (int j = 0; j < 8; ++j) { float v = p[j]; v += __shfl_xor(v, 1); v += __shfl_xor(v, 2); v += __shfl_xor(v, 4); if (h == 0) impq[kb + 8 * g + j] = v; } }
    const u32x4 pw = pack8(p); bf16x8 pf; __builtin_memcpy(&pf, &pw, 16);
#pragma unroll
    for (int db = 0; db < 4; ++db) O[db] = mfma16(f.v[db], pf, O[db]);
}
template <int MODE, class KBF, class QSF>
__device__ __forceinline__ void nsa_run(int niter, const bf16_t* Kb, const bf16_t* VB, KBF kbf, QSF qsf, const bf16x8 (&qf)[2], const LAS float* LUTh, LAS float* impq,
                                        int tq, int h, int n, int g, int qs, float inv, float& lsum, f32x4 (&O)[4]) {
    if (niter <= 0) return;
    NFrag A, C; const int last = niter - 1;
    nsa_load<MODE != 0>(A, Kb, VB, kbf(0), n, g);
    for (int i = 0; i < niter; i += 2) {
        nsa_load<MODE != 0>(C, Kb, VB, kbf(i + 1 < last ? i + 1 : last), n, g);
        SCHED_FENCE();
        nsa_compute<MODE>(A, kbf(i), qf, LUTh, impq, tq, h, g, qs, qsf(i), inv, lsum, O);
        SCHED_FENCE();
        if (i + 1 >= niter) break;
        nsa_load<MODE != 0>(A, Kb, VB, kbf(i + 2 < last ? i + 2 : last), n, g);
        SCHED_FENCE();
        nsa_compute<MODE>(C, kbf(i + 1), qf, LUTh, impq, tq, h, g, qs, qsf(i + 1), inv, lsum, O);
        SCHED_FENCE();
    }
}
__device__ __forceinline__ float lred(float l) { l += __shfl_xor(l, 16); l += __shfl_xor(l, 32); return l; }
__device__ __forceinline__ void nsa_unit(const KArgs& a, LAS unsigned char* lds, int unit, LAS float* imp, LAS int* selL, int lane) {
    unsigned char* ws = a.ws; const bf16_t* proj = (const bf16_t*)(ws + WS_PROJ);
    const int t0 = 2 * unit, n = lane & 15, g = lane >> 4, qs = n >> 3, h = n & 7, tq = t0 + qs;
    const LAS float* LUT = (const LAS float*)lds + h;
    bf16x8 qf[2];
    qf[0] = *(const bf16x8*)((const bf16_t*)(ws + WS_QN) + (size_t)tq * 512 + h * 64 + 8 * g); qf[1] = *(const bf16x8*)((const bf16_t*)(ws + WS_QN) + (size_t)tq * 512 + h * 64 + 32 + 8 * g);
    const bf16_t* gp = proj + (size_t)tq * NPAD + C_NGATE + h * 3;
    const float g0 = 1.f / (1.f + __expf(-bf2f(gp[0]))), g1 = 1.f / (1.f + __expf(-bf2f(gp[1]))), g2 = 1.f / (1.f + __expf(-bf2f(gp[2])));
    f32x4 Ot[4], Ob[4];
#pragma unroll
    for (int i = 0; i < 4; ++i) { Ot[i] = (f32x4){0.f, 0.f, 0.f, 0.f}; Ob[i] = (f32x4){0.f, 0.f, 0.f, 0.f}; }
    const int nvmax = (t0 + 1 >= 31) ? (((t0 + 1 - 31) >> 4) + 1) : 0; const int nch = (nvmax + 31) >> 5;
    const bf16_t* KC = (const bf16_t*)(ws + WS_KCMP); const bf16_t* VCT = (const bf16_t*)(ws + WS_VCMPT);
    auto kb_lin = [](int i) { return 32 * i; }; auto qs_zero = [](int) { return 0; };
    float lsum = 0.f;
    nsa_run<0>(nch, KC, VCT, kb_lin, qs_zero, qf, LUT, imp + qs * 1024, tq, h, n, g, qs, 0.f, lsum, Ob);
    { const float l = lred(lsum); const float inv = l > 0.f ? 1.f / l : 0.f; float dummy = 0.f;
      nsa_run<1>(nch, KC, VCT, kb_lin, qs_zero, qf, LUT, imp + qs * 1024, tq, h, n, g, qs, inv, dummy, Ob); }
#pragma unroll
    for (int i = 0; i < 4; ++i) { Ot[i] += Ob[i] * g0; Ob[i] = (f32x4){0.f, 0.f, 0.f, 0.f}; }
    LDS_FENCE();
    int cnts[2];
#pragma unroll
    for (int q2 = 0; q2 < 2; ++q2) { const int tqq = t0 + q2, cur = tqq >> 6; const LAS float* iq = imp + q2 * 1024;
        float val[4];
#pragma unroll
        for (int r = 0; r < 4; ++r) { const int b = lane + 64 * r; float v = -1.f;
            if (b >= 1 && b <= cur - 2) { v = 0.f;
#pragma unroll
                for (int i = 0; i < 5; ++i) v += iq[4 * b - 1 + i]; }
            val[r] = v; }
        int cnt = 0;
        if (lane == 0) { selL[q2 * 8 + 0] = 0; if (cur >= 1) selL[q2 * 8 + 1] = cur; if (cur >= 2) selL[q2 * 8 + 2] = cur - 1; }
        cnt = 1 + (cur >= 1) + (cur >= 2);
        int ncand = cur - 2; if (ncand < 0) ncand = 0; const int npick = ncand < 5 ? ncand : 5;
        for (int rd = 0; rd < npick; ++rd) { float bv = val[0]; int bi = lane;
#pragma unroll
            for (int r = 1; r < 4; ++r) if (val[r] > bv) { bv = val[r]; bi = lane + 64 * r; }
#pragma unroll
            for (int o = 1; o < 64; o <<= 1) { const float ov = __shfl_xor(bv, o); const int oi = __shfl_xor(bi, o); if (ov > bv || (ov == bv && oi < bi)) { bv = ov; bi = oi; } }
            if (lane == 0) selL[q2 * 8 + cnt] = bi; ++cnt;
#pragma unroll
            for (int r = 0; r < 4; ++r) if (bi == lane + 64 * r) val[r] = -2.f; }
        cnts[q2] = cnt; }
    LDS_FENCE();
#pragma unroll
    for (int i = 0; i < 4; ++i)
#pragma unroll
        for (int j = 0; j < 4; ++j) imp[(4 * i + j) * 64 + lane] = Ot[i][j];
    lsum = 0.f;
    { const int c0 = cnts[0], c1 = cnts[1];
      auto kbf = [&](int i) { const int bidx = i >> 1; const int slot = bidx < c0 ? bidx : 8 + (bidx - c0); return 64 * __builtin_amdgcn_readfirstlane(selL[slot]) + 32 * (i & 1); };
      auto qsf = [&](int i) { return ((i >> 1) < c0) ? 0 : 1; };
      nsa_run<2>(2 * (c0 + c1), (const bf16_t*)(ws + WS_KSN), (const bf16_t*)(ws + WS_VST), kbf, qsf, qf, LUT, imp, tq, h, n, g, qs, 0.f, lsum, Ob); }
    { const float l = lred(lsum); const float sc = l > 0.f ? g1 / l : 0.f;
#pragma unroll
      for (int i = 0; i < 4; ++i) {
#pragma unroll
          for (int j = 0; j < 4; ++j) imp[(4 * i + j) * 64 + lane] += Ob[i][j] * sc;
          Ob[i] = (f32x4){0.f, 0.f, 0.f, 0.f}; } }
    lsum = 0.f;
    { int lo = t0 - 511; if (lo < 0) lo = 0; lo &= ~31; const int nw = ((t0 + 1 - lo) >> 5) + 1;
      auto kbf = [&](int i) { return lo + 32 * i; };
      nsa_run<3>(nw, (const bf16_t*)(ws + WS_KWN), (const bf16_t*)(ws + WS_VWT), kbf, qs_zero, qf, LUT, imp, tq, h, n, g, qs, 0.f, lsum, Ob);
      const float l = lred(lsum); const float sc = l > 0.f ? g2 / l : 0.f;
#pragma unroll
      for (int i = 0; i < 4; ++i)
#pragma unroll
          for (int j = 0; j < 4; ++j) Ot[i][j] = imp[(4 * i + j) * 64 + lane] + Ob[i][j] * sc; }
    bf16_t* orow = (bf16_t*)(ws + WS_ONSA) + (size_t)tq * 512 + h * 64;
#pragma unroll
    for (int db = 0; db < 4; ++db) { u32x2 w; w.x = cvt_pk_bf16(Ot[db][0], Ot[db][1]); w.y = cvt_pk_bf16(Ot[db][2], Ot[db][3]); *(u32x2*)(orow + 16 * db + 4 * g) = w; }
}


#define RLX_AGENT __ATOMIC_RELAXED, __HIP_MEMORY_SCOPE_AGENT
#define XB_TMO      128
#define XB_XCNT(j)  (256  + 64 * (j))
#define XB_XSUB(j)  (1280 + 64 * (j))
#define XB_XGEN(j)  (2304 + 64 * (j))
#define XB_TOP      3328
#define XB_TOPGEN   3392
#define XCD_BAR_WORDS 3456
#define XB_SPIN_CAP (1u << 18)

__device__ __forceinline__ unsigned xb_ld(unsigned* p)              { return __hip_atomic_load(p, __ATOMIC_RELAXED, __HIP_MEMORY_SCOPE_AGENT); }
__device__ __forceinline__ unsigned xb_add(unsigned* p, unsigned v) { return __hip_atomic_fetch_add(p, v, __ATOMIC_RELAXED, __HIP_MEMORY_SCOPE_AGENT); }
__device__ __forceinline__ unsigned xb_xcc_id() { return (unsigned)__builtin_amdgcn_s_getreg((3 << 11) | 20) & 0xFu; }
#define XB_SPIN(cond, bar) do { unsigned _sp = 0; while (cond) { __builtin_amdgcn_s_sleep(1); \
    if ((++_sp & 255u) == 0u) { if (xb_ld(&(bar)[XB_TMO])) break; if (_sp > XB_SPIN_CAP) { atomicAdd(&(bar)[XB_TMO], 1u); break; } } } } while (0)

struct XcdBarrier {
    unsigned* bar; unsigned x;
    volatile LAS unsigned* st;
};

__device__ __forceinline__ XcdBarrier xcd_barrier_post(unsigned* bar, volatile LAS unsigned* st) {
    XcdBarrier b; b.bar = bar; b.x = xb_xcc_id(); b.st = st;
    if (threadIdx.x == 0) (void)xb_add(&bar[XB_XCNT(b.x)], 1u);
    return b;
}
__device__ __forceinline__ void xcd_barrier_complete(unsigned* bar, unsigned x, unsigned& nloc, unsigned& nx) {
    const unsigned G = gridDim.x * gridDim.y * gridDim.z;
    unsigned sum, cnt, mine, sp = 0u;
    for (;;) {
        sum = 0u; cnt = 0u; mine = 0u;
#pragma unroll
        for (unsigned j = 0; j < 16; ++j) { const unsigned c = xb_ld(&bar[XB_XCNT(j)]); sum += c; cnt += (c > 0u) ? 1u : 0u; mine = (j == x) ? c : mine; }
        if (sum == G) break;
        __builtin_amdgcn_s_sleep(1);
        if ((++sp & 255u) == 0u) { if (xb_ld(&bar[XB_TMO])) break; if (sp > XB_SPIN_CAP) { atomicAdd(&bar[XB_TMO], 1u); break; } }
    }
    nloc = mine > 0u ? mine : 1u; nx = cnt > 0u ? cnt : 1u;
}

__device__ __forceinline__ void xcd_barrier(const XcdBarrier& b) {
    asm volatile("s_waitcnt vmcnt(0)" ::: "memory");
    __syncthreads();
    if (threadIdx.x == 0) {
        unsigned* bar = b.bar;
        __builtin_amdgcn_s_waitcnt(0);
        unsigned nloc = b.st[0], nx = b.st[1];
        if (nloc == 0u) { xcd_barrier_complete(bar, b.x, nloc, nx); b.st[0] = nloc; b.st[1] = nx; }
        const unsigned old = xb_add(&bar[XB_XSUB(b.x)], 1u);
        const unsigned gen = old / nloc;
        if (old + 1u == (gen + 1u) * nloc) {
            __builtin_amdgcn_fence(__ATOMIC_RELEASE, "agent");
            asm volatile("s_waitcnt vmcnt(0)" ::: "memory");
            const unsigned og = xb_add(&bar[XB_TOP], 1u);
            const unsigned tg = og / nx;
            if (og + 1u == (tg + 1u) * nx) xb_add(&bar[XB_TOPGEN], 1u);
            else XB_SPIN(xb_ld(&bar[XB_TOPGEN]) == tg, bar);
            __builtin_amdgcn_fence(__ATOMIC_ACQUIRE, "agent");
            xb_add(&bar[XB_XGEN(b.x)], 1u);
            asm volatile("s_waitcnt vmcnt(0)" ::: "memory");
        } else {
            XB_SPIN(xb_ld(&bar[XB_XGEN(b.x)]) == gen, bar);
            __builtin_amdgcn_fence(__ATOMIC_ACQUIRE, "agent");
            asm volatile("s_waitcnt vmcnt(0)" ::: "memory");
        }
    }
    __syncthreads();
}

#define GSYNC() xcd_barrier(xbar)
__global__ void __launch_bounds__(512) __attribute__((amdgpu_waves_per_eu(2, 2))) fwd_mega(KArgs a) {
    extern __shared__ __attribute__((aligned(16))) unsigned char lds_raw[];
    LAS unsigned char* lds = (LAS unsigned char*)lds_raw;
    const int G = gridDim.x, bid = blockIdx.x, NGW = G * 8;
    { volatile LAS unsigned* stw = (volatile LAS unsigned*)(lds + 132608); if (threadIdx.x < 2) stw[threadIdx.x] = 0u; }
    __syncthreads();
    XcdBarrier xbar = xcd_barrier_post((unsigned*)(a.ws + WS_CTL), (volatile LAS unsigned*)(lds + 132608));
    cg::this_grid().sync();
#define IDS() int tid = threadIdx.x; asm volatile("" : "+v"(tid)); const int lane = tid & 63, wave = __builtin_amdgcn_readfirstlane(tid >> 6); const int gw = bid * 8 + wave; (void)lane; (void)gw;
    unsigned char* ws = a.ws;
    bf16_t* PROJ = (bf16_t*)(ws + WS_PROJ); bf16_t* HN = (bf16_t*)(ws + WS_HN); bf16_t* HID = (bf16_t*)(ws + WS_HID);
#pragma unroll 1
    for (int l = 0; l < DEPTH; ++l) {
        const float* xsrc = (l == 0) ? a.in[0] : a.out;
        { IDS(); phase_convert(a, l, lds, gw, NGW, wave, lane);
          phase_rms(xsrc, a.in[1] + l * DM, HN, gw, NGW, lane); }
        GSYNC();
        { pg8::Gemm g{HN, (const bf16_t*)(ws + WS_WIN), M, NPAD, DM}; pg8::StaticOrder S; S.init(M, NPAD, G, bid);
          pg8::EpiBf16<0> E{PROJ, NPAD};
          pg8::gemm_phase<pg8::EpiBf16<0>, pg8::StaticOrder, true, true>(lds, g, S, E); }
        GSYNC();
        { IDS(); for (int it = bid; it < 256; it += G) pre_item(a, l, lds, it, tid); }
        { IDS(); for (int it = bid; it < 128; it += G) cmp_item(a, l, lds, it, tid, wave, lane); }
        { IDS(); for (int it = bid; it < 2048; it += G) gla_g1_item(a, l, lds, it, tid, wave, lane); }
        GSYNC();
        {   IDS();
            { const float* lg = (const float*)(ws + WS_LUT); LAS float* LUT = (LAS float*)lds; for (int i = tid; i < 8192; i += 512) LUT[i] = lg[i]; }
            LAS int* ctr = (LAS int*)(lds + 132096);
            LAS unsigned* sbc = (LAS unsigned*)(lds + 132112);
            if (tid == 0) { *ctr = 0; *sbc = 0u; }
            __syncthreads();
            if (wave < 4) {
                unsigned gen = 0u;
                for (int pp = bid; pp < 512; pp += G) {
                    const int hh = pp & 3, q = pp >> 2;
                    sb_unit4(a, lds + 65536, sbc, gen, hh, 255 - q, wave, lane);
                    sb_unit4(a, lds + 65536, sbc, gen, hh, q, wave, lane); }
            } else {
                for (int c0 = (bid * 4 + (wave - 4)) * 64; c0 < 65536; c0 += G * 256) gla_scan(a, c0 + lane);
            }
            LAS float* imp = (LAS float*)(lds + (wave < 4 ? 65536 + wave * 8192 : 32768 + (wave - 4) * 8192));
            LAS int* selL = (LAS int*)(lds + 131072 + wave * 128);
            const int nper = (8192 + G - 1) / G;
            for (;;) { int idx = 0; if (lane == 0) idx = atomicAdd((int*)ctr, 1); idx = __builtin_amdgcn_readfirstlane(idx);
                if (idx >= nper) break; const int hn = nper >> 1; const int unit = (idx < hn) ? (8192 - hn * (bid + 1) + idx) : (hn * bid + (idx - hn)); if (unit >= 0 && unit < 8192) nsa_unit(a, lds, unit, imp, selL, lane); }
            __syncthreads();
        }
        GSYNC();
        { IDS(); for (int it = bid; it < 2048; it += G) gla_g3_item(a, l, lds, it, tid, wave, lane); }
        GSYNC();
        for (int b = 0; b < 3; ++b) {
            pg8::Gemm g{(const bf16_t*)(ws + WS_OGLA + b * 16 * MiB), (const bf16_t*)(ws + WS_WBR + b * MiB), M, DM, 512}; pg8::StaticOrder S; S.init(M, DM, G, bid);
            pg8::EpiGate E{HN, PROJ + C_MGATE + b * DM, NPAD, b == 0 ? 1 : 0};
            pg8::gemm_phase<pg8::EpiGate, pg8::StaticOrder, true, true>(lds, g, S, E); }
        GSYNC();
        { pg8::Gemm g{HN, (const bf16_t*)(ws + WS_WOUT), M, DM, DM}; pg8::StaticOrder S; S.init(M, DM, G, bid);
          pg8::EpiRes E{xsrc, a.out};
          pg8::gemm_phase<pg8::EpiRes, pg8::StaticOrder, true, true>(lds, g, S, E); }
        GSYNC();
        { IDS(); phase_rms(a.out, a.in[2] + l * DM, HN, gw, NGW, lane); }
        GSYNC();
        { pg8::Gemm g{HN, (const bf16_t*)(ws + WS_WUP), M, FF, DM}; pg8::StaticOrder S; S.init(M, FF, G, bid);
          pg8::EpiBf16<2> E{HID, FF};
          pg8::gemm_phase<pg8::EpiBf16<2>, pg8::StaticOrder, true, true>(lds, g, S, E); }
        GSYNC();
        { pg8::Gemm g{HID, (const bf16_t*)(ws + WS_WDN), M, DM, FF}; pg8::StaticOrder S; S.init(M, DM, G, bid);
          pg8::EpiRes E{a.out, a.out};
          pg8::gemm_phase<pg8::EpiRes, pg8::StaticOrder, true, true>(lds, g, S, E); }
        GSYNC();
    }
}

extern "C" void kernel_launch(void* const* d_in, const int* in_sizes, int n_in, void* d_out, int out_size, void* d_ws, size_t ws_size, hipStream_t stream) {
    static int grid = 0;
    if (grid == 0) {
        if (n_in != 22 || ws_size < WS_END + 65536) { fprintf(stderr, "kernel_launch: unexpected n_in %d or ws_size %zu (< %zu)\n", n_in, ws_size, (size_t)WS_END); grid = -1; return; }
        int dev = 0, cus = 0, per_cu = 0;
        hipGetDevice(&dev); hipDeviceGetAttribute(&cus, hipDeviceAttributeMultiprocessorCount, dev);
        hipFuncSetAttribute((const void*)fwd_mega, hipFuncAttributeMaxDynamicSharedMemorySize, LDS_BYTES);
        hipOccupancyMaxActiveBlocksPerMultiprocessor(&per_cu, (const void*)fwd_mega, 512, LDS_BYTES);
        if (per_cu < 1) { fprintf(stderr, "kernel_launch: occupancy query says %d blocks/CU\n", per_cu); per_cu = 1; }
        (void)hipGetLastError();
        grid = cus * 1;
    }
    if (grid < 0) return;
    if (hipMemsetAsync((char*)d_ws + WS_CTL, 0, 65536, stream) != hipSuccess) { fprintf(stderr, "kernel_launch: memset of barrier words failed\n"); return; }
    KArgs a{};
    for (int i = 0; i < 22; ++i) a.in[i] = (const float*)d_in[i];
    a.out = (float*)d_out; a.ws = (unsigned char*)d_ws;
    void* args[] = {&a};
    hipError_t e = hipLaunchCooperativeKernel((const void*)fwd_mega, dim3(grid), dim3(512), args, LDS_BYTES, stream);
    if (e != hipSuccess) fprintf(stderr, "cooperative launch failed: %s (grid %d)\n", hipGetErrorString(e), grid);
}
```

```cpp
#include <hip/hip_runtime.h>
#include <hip/hip_cooperative_groups.h>
#include <cstdio>
#include <cstdint>
namespace cg = cooperative_groups;
namespace pg8 {
#define PG8_LAS __attribute__((address_space(3)))
typedef unsigned short bf16_t;
typedef short bf16x8 __attribute__((ext_vector_type(8)));
typedef float f32x4 __attribute__((ext_vector_type(4)));
typedef unsigned u32x4 __attribute__((ext_vector_type(4)));
constexpr int BM = 256, BK = 64, HALF = 128, HTB = HALF * BK * 2  , STAGE_BYTES = 8 * HTB, NXCD = 8, WGM = 8;

__host__ __device__ __forceinline__ int lds_byte(int r, int c) { const int st = (r >> 4) * 2 + (c >> 5), rr = r & 15, cc = c & 31, ob = rr * 64 + cc * 2; return st * 1024 + (ob ^ (((ob >> 9) & 1) << 5)); }
__host__ __device__ __forceinline__ void stage_rc(int b, int& R, int& C) { const int st = b / 1024, sb = b % 1024, swz = sb ^ (((sb >> 9) & 1) << 5); R = (st >> 1) * 16 + swz / 64; C = (st & 1) * 32 + (swz % 64) / 2; }
__host__ __device__ __forceinline__ int perm32(int rho) { const int n = rho >> 4, i = rho & 15; return 8 * (i >> 2) + 4 * n + (i & 3); }

struct Unit { int pm, pn; };
struct Gemm { const bf16_t* A; const bf16_t* Bt; int M, N, K; };

struct StaticOrder {
    int nM, nN, nwg, G, c;
    __host__ __device__ void init(int M, int N, int G_, int c_) { nM = M / BM; nN = N / BM; nwg = nM * nN; G = G_; c = c_; }
    __host__ __device__ bool next(int i, Unit& u) const {
        const long L = (long)i * G + c; if (L >= nwg) return false;
        int wgid = (int)L; { const int q = nwg / NXCD, r = nwg % NXCD, xcd = wgid % NXCD, off = wgid / NXCD; wgid = (xcd < r ? xcd * (q + 1) : r * (q + 1) + (xcd - r) * q) + off; }
        const int nig = WGM * nN, gid = wgid / nig, fm = gid * WGM, gsz = (nM - fm) < WGM ? (nM - fm) : WGM;
        u.pm = fm + ((wgid % nig) % gsz); u.pn = (wgid % nig) / gsz; return true;
    }
    __device__ __forceinline__ void a_ready(const Unit&) const {}
    __device__ __forceinline__ void done(const Unit&) const {}
};

__device__ __forceinline__ unsigned cvt_pk_bf16(float lo, float hi) { unsigned r; asm("v_cvt_pk_bf16_f32 %0, %1, %2" : "=v"(r) : "v"(lo), "v"(hi)); return r; }
__device__ __forceinline__ float bflo(unsigned w) { return __uint_as_float(w << 16); }
__device__ __forceinline__ float bfhi(unsigned w) { return __uint_as_float(w & 0xffff0000u); }
template <int ACT> struct EpiBf16 {
    static constexpr bool PERM = true, AFTER_DRAIN = false;
    bf16_t* O; int ldc;
    __device__ __forceinline__ void operator()(const f32x4 (&acc)[2][2][4][2], const Unit& u, int wr, int wc, int fr, int fq) const {
        const int row0 = u.pm * BM + wr * 64 + fr; const int col0 = u.pn * BM + wc * 32 + 8 * fq;
#pragma unroll
        for (int ai = 0; ai < 2; ++ai)
#pragma unroll
            for (int m = 0; m < 4; ++m) { bf16_t* rowp = O + (size_t)(row0 + ai * HALF + m * 16) * ldc + col0;
#pragma unroll
                for (int bj = 0; bj < 2; ++bj) { f32x4 v0 = acc[ai][bj][m][0], v1 = acc[ai][bj][m][1];
                    if (ACT == 2) {
#pragma unroll
                        for (int e = 0; e < 4; ++e) { float a = fmaxf(v0[e], 0.f), b = fmaxf(v1[e], 0.f); v0[e] = a * a; v1[e] = b * b; } }
                    u32x4 w; w.x = cvt_pk_bf16(v0[0], v0[1]); w.y = cvt_pk_bf16(v0[2], v0[3]); w.z = cvt_pk_bf16(v1[0], v1[1]); w.w = cvt_pk_bf16(v1[2], v1[3]);
                    *(u32x4*)(rowp + bj * HALF) = w; } }
    }
};
struct EpiGate {
    static constexpr bool PERM = true, AFTER_DRAIN = false;
    bf16_t* O; const bf16_t* gate; int gld; int first;
    __device__ __forceinline__ void operator()(const f32x4 (&acc)[2][2][4][2], const Unit& u, int wr, int wc, int fr, int fq) const {
        const int row0 = u.pm * BM + wr * 64 + fr; const int col0 = u.pn * BM + wc * 32 + 8 * fq;
#pragma unroll
        for (int ai = 0; ai < 2; ++ai)
#pragma unroll
            for (int m = 0; m < 4; ++m) { const int row = row0 + ai * HALF + m * 16; bf16_t* rowp = O + (size_t)row * 1024 + col0; const bf16_t* gp = gate + (size_t)row * gld + col0;
#pragma unroll
                for (int bj = 0; bj < 2; ++bj) { const f32x4 v0 = acc[ai][bj][m][0], v1 = acc[ai][bj][m][1];
                    const u32x4 gw = *(const u32x4*)(gp + bj * HALF);
                    u32x4 ow = (u32x4){0u, 0u, 0u, 0u}; if (!first) ow = *(const u32x4*)(rowp + bj * HALF);
                    float gv[8] = {bflo(gw.x), bfhi(gw.x), bflo(gw.y), bfhi(gw.y), bflo(gw.z), bfhi(gw.z), bflo(gw.w), bfhi(gw.w)};
                    float ov[8] = {bflo(ow.x), bfhi(ow.x), bflo(ow.y), bfhi(ow.y), bflo(ow.z), bfhi(ow.z), bflo(ow.w), bfhi(ow.w)};
                    float av[8] = {v0[0], v0[1], v0[2], v0[3], v1[0], v1[1], v1[2], v1[3]};
                    float r[8];
#pragma unroll
                    for (int e = 0; e < 8; ++e) { const float s = 1.f / (1.f + __expf(-gv[e])); r[e] = ov[e] + s * av[e]; }
                    u32x4 w; w.x = cvt_pk_bf16(r[0], r[1]); w.y = cvt_pk_bf16(r[2], r[3]); w.z = cvt_pk_bf16(r[4], r[5]); w.w = cvt_pk_bf16(r[6], r[7]);
                    *(u32x4*)(rowp + bj * HALF) = w; } }
    }
};
struct EpiRes {
    static constexpr bool PERM = false, AFTER_DRAIN = false;
    const float* src; float* out;
    __device__ __forceinline__ void operator()(const f32x4 (&acc)[2][2][4][2], const Unit& u, int wr, int wc, int fr, int fq) const {
        const int col0 = u.pn * BM + wc * 32 + 4 * fq;
#pragma unroll
        for (int ai = 0; ai < 2; ++ai)
#pragma unroll
            for (int m = 0; m < 4; ++m) { const size_t off = (size_t)(u.pm * BM + ai * HALF + wr * 64 + m * 16 + fr) * 1024 + col0;
#pragma unroll
                for (int bj = 0; bj < 2; ++bj)
#pragma unroll
                    for (int n = 0; n < 2; ++n) { const f32x4 bs = *(const f32x4*)(src + off + bj * HALF + n * 16); *(f32x4*)(out + off + bj * HALF + n * 16) = bs + acc[ai][bj][m][n]; } }
    }
};
template <class Epi, class Sched, bool ALIGN_EPI = false, bool SP2 = false>
__device__ __forceinline__ void gemm_phase(PG8_LAS unsigned char* lds, const Gemm g, const Sched& S, const Epi& E) {
    int tid_ = threadIdx.x; asm volatile("" : "+v"(tid_));
    const int tid = tid_, wid = __builtin_amdgcn_readfirstlane(tid >> 6), lane = tid & 63, wr = wid >> 2, wc = wid & 3, fr = lane & 15, fq = lane >> 4;
    const int K = g.K, nt = K / BK;
    unsigned voffA[2], voffB[2];
#pragma unroll
    for (int i = 0; i < 2; ++i) { int R, C; stage_rc(tid * 16 + i * 8192, R, C); const int Rb = Epi::PERM ? ((R & ~31) + perm32(R & 31)) : R;
        voffA[i] = (unsigned)(R * K + C) * 2u; voffB[i] = (unsigned)(Rb * K + C) * 2u; }
    const size_t kstep = (size_t)(BK * 2);
    const size_t hstep = (size_t)HALF * K * 2;
    const size_t tstep = 2 * hstep;
    const unsigned ldsw = (unsigned)wid * 1024u;
    const int aoff = lds_byte(wr * 64 + fr, fq * 8), boff = lds_byte(wc * 32 + fr, fq * 8);
#define PG8_SA(b, h) (((b) * 2 + (h)) * HTB)
#define PG8_SB(b, h) ((4 + (b) * 2 + (h)) * HTB)
#define PG8_STAGE(bufoff, gbase, voff) do { _Pragma("unroll") for (int _i = 0; _i < 2; ++_i) \
        __builtin_amdgcn_global_load_lds((const unsigned*)((const char*)(gbase) + (voff)[_i]), (PG8_LAS unsigned*)(lds + (bufoff) + ldsw + _i * 8192), 16, 0, 0); } while (0)
#define PG8_LDA(dst, b, h) do { _Pragma("unroll") for (int m = 0; m < 4; ++m) _Pragma("unroll") for (int k = 0; k < 2; ++k) dst[m][k] = *(const PG8_LAS bf16x8*)(lds + PG8_SA(b, h) + aoff + m * 2048 + k * 1024); } while (0)
#define PG8_LDB(dst, b, h) do { _Pragma("unroll") for (int n = 0; n < 2; ++n) _Pragma("unroll") for (int k = 0; k < 2; ++k) dst[n][k] = *(const PG8_LAS bf16x8*)(lds + PG8_SB(b, h) + boff + n * 2048 + k * 1024); } while (0)
#define PG8_MMA(ai, bj, At, Bt) do { __builtin_amdgcn_s_setprio(1); _Pragma("unroll") for (int m = 0; m < 4; ++m) _Pragma("unroll") for (int n = 0; n < 2; ++n) _Pragma("unroll") for (int k = 0; k < 2; ++k) \
        acc[ai][bj][m][n] = __builtin_amdgcn_mfma_f32_16x16x32_bf16(Bt[n][k], At[m][k], acc[ai][bj][m][n], 0, 0, 0); __builtin_amdgcn_s_setprio(0); } while (0)
#define PG8_WAIT_V(n) asm volatile("s_waitcnt vmcnt(" #n ")" ::: "memory")
#define PG8_WAIT_L(n) asm volatile("s_waitcnt lgkmcnt(" #n ")" ::: "memory")
#define PG8_BAR __builtin_amdgcn_s_barrier()
#define PG8_SCHED __builtin_amdgcn_sched_barrier(0)
    Unit cur, nxt; int ui = 0;
    if (!S.next(0, cur)) return;
    f32x4 acc[2][2][4][2];
#pragma unroll
    for (int a = 0; a < 2; ++a)
#pragma unroll
        for (int b = 0; b < 2; ++b)
#pragma unroll
            for (int m = 0; m < 4; ++m)
#pragma unroll
                for (int n = 0; n < 2; ++n) acc[a][b][m][n] = (f32x4){0.f, 0.f, 0.f, 0.f};
    bf16x8 At[4][2], B0[2][2], B1[2][2];
    const char* cA = (const char*)g.A + (size_t)cur.pm * tstep; const char* cB = (const char*)g.Bt + (size_t)cur.pn * tstep;
    S.a_ready(cur);
    if constexpr (SP2) {
        PG8_STAGE(PG8_SB(0, 0), cB, voffB); PG8_STAGE(PG8_SB(0, 1), cB + hstep, voffB); PG8_STAGE(PG8_SA(0, 0), cA, voffA); PG8_STAGE(PG8_SA(0, 1), cA + hstep, voffA);
        if (wr == 1) PG8_BAR;
        PG8_WAIT_V(2); PG8_BAR;
        PG8_STAGE(PG8_SB(1, 0), cB + kstep, voffB); PG8_STAGE(PG8_SA(1, 0), cA + kstep, voffA); PG8_STAGE(PG8_SB(1, 1), cB + hstep + kstep, voffB);
        PG8_WAIT_V(6); PG8_BAR;
    } else {
        PG8_STAGE(PG8_SB(0, 0), cB, voffB); PG8_STAGE(PG8_SA(0, 0), cA, voffA); PG8_STAGE(PG8_SB(0, 1), cB + hstep, voffB); PG8_STAGE(PG8_SA(0, 1), cA + hstep, voffA);
        if (wr == 1) PG8_BAR;
        PG8_WAIT_V(4); PG8_BAR;
        PG8_STAGE(PG8_SB(1, 0), cB + kstep, voffB); PG8_STAGE(PG8_SA(1, 0), cA + kstep, voffA); PG8_STAGE(PG8_SB(1, 1), cB + hstep + kstep, voffB);
        PG8_WAIT_V(6); PG8_BAR;
    }
    for (;;) {
        const bool has_next = S.next(ui + 1, nxt);
        const char* nA = has_next ? (const char*)g.A + (size_t)nxt.pm * tstep : cA; const char* nB = has_next ? (const char*)g.Bt + (size_t)nxt.pn * tstep : cB;
        for (int t = 0; t < nt; t += 2) {
            const bool last = (t == nt - 2);
            const char* a1 = cA + (size_t)(t + 1) * kstep;
            const char* a2 = last ? nA : cA + (size_t)(t + 2) * kstep; const char* b2 = last ? nB : cB + (size_t)(t + 2) * kstep;
            const char* a3 = a2 + kstep; const char* b3 = b2 + kstep;
            if (last && has_next) S.a_ready(nxt);
            if constexpr (SP2) {
            PG8_LDB(B0, 0, 0); PG8_LDB(B1, 0, 1); PG8_SCHED; PG8_LDA(At, 0, 0); PG8_STAGE(PG8_SA(1, 1), a1 + hstep, voffA);
            PG8_WAIT_V(8); PG8_WAIT_L(0); PG8_BAR; PG8_MMA(0, 0, At, B0); PG8_MMA(0, 1, At, B1); PG8_BAR; PG8_SCHED;
            PG8_LDA(At, 0, 1); PG8_STAGE(PG8_SB(0, 0), b2, voffB); PG8_STAGE(PG8_SB(0, 1), b2 + hstep, voffB); PG8_STAGE(PG8_SA(0, 0), a2, voffA);
            PG8_WAIT_V(8); PG8_WAIT_L(0); PG8_BAR; PG8_MMA(1, 0, At, B0); PG8_MMA(1, 1, At, B1); PG8_BAR; PG8_SCHED;
            PG8_LDB(B0, 1, 0); PG8_LDB(B1, 1, 1); PG8_SCHED; PG8_LDA(At, 1, 0); PG8_STAGE(PG8_SA(0, 1), a2 + hstep, voffA);
            PG8_WAIT_V(8); PG8_WAIT_L(0); PG8_BAR; PG8_MMA(0, 0, At, B0); PG8_MMA(0, 1, At, B1); PG8_BAR; PG8_SCHED;
            PG8_LDA(At, 1, 1); PG8_STAGE(PG8_SB(1, 0), b3, voffB); PG8_STAGE(PG8_SB(1, 1), b3 + hstep, voffB); PG8_STAGE(PG8_SA(1, 0), a3, voffA);
            PG8_WAIT_V(8); PG8_WAIT_L(0); PG8_BAR; PG8_MMA(1, 0, At, B0); PG8_MMA(1, 1, At, B1); PG8_BAR; PG8_SCHED;
            } else {
            PG8_LDB(B0, 0, 0); PG8_SCHED; PG8_LDA(At, 0, 0); PG8_STAGE(PG8_SA(1, 1), a1 + hstep, voffA);
            PG8_WAIT_L(8); PG8_BAR; PG8_WAIT_L(0); PG8_MMA(0, 0, At, B0); PG8_BAR; PG8_SCHED;
            PG8_LDB(B1, 0, 1); PG8_STAGE(PG8_SB(0, 0), b2, voffB);
            PG8_BAR; PG8_WAIT_L(0); PG8_MMA(0, 1, At, B1); PG8_BAR;
            PG8_LDA(At, 0, 1); PG8_STAGE(PG8_SA(0, 0), a2, voffA);
            PG8_BAR; PG8_WAIT_L(0); PG8_MMA(1, 0, At, B0); PG8_BAR; PG8_SCHED;
            PG8_STAGE(PG8_SB(0, 1), b2 + hstep, voffB);
            PG8_WAIT_V(6); PG8_BAR; PG8_MMA(1, 1, At, B1); PG8_BAR;
            PG8_LDB(B0, 1, 0); PG8_SCHED; PG8_LDA(At, 1, 0); PG8_STAGE(PG8_SA(0, 1), a2 + hstep, voffA);
            PG8_WAIT_L(8); PG8_BAR; PG8_WAIT_L(0); PG8_MMA(0, 0, At, B0); PG8_BAR; PG8_SCHED;
            PG8_LDB(B1, 1, 1); PG8_STAGE(PG8_SB(1, 0), b3, voffB);
            PG8_BAR; PG8_WAIT_L(0); PG8_MMA(0, 1, At, B1); PG8_BAR;
            PG8_LDA(At, 1, 1); PG8_STAGE(PG8_SA(1, 0), a3, voffA);
            PG8_BAR; PG8_WAIT_L(0); PG8_MMA(1, 0, At, B0); PG8_BAR; PG8_SCHED;
            PG8_STAGE(PG8_SB(1, 1), b3 + hstep, voffB);
            PG8_WAIT_V(6); PG8_BAR; PG8_MMA(1, 1, At, B1); PG8_BAR;
            }
        }
        if constexpr (ALIGN_EPI) { if (wr == 0) PG8_BAR; }
        if constexpr (!Epi::AFTER_DRAIN) { E(acc, cur, wr, wc, fr, fq); S.done(cur); }
        if (!has_next) break;
#pragma unroll
        for (int a = 0; a < 2; ++a)
#pragma unroll
            for (int b = 0; b < 2; ++b)
#pragma unroll
                for (int m = 0; m < 4; ++m)
#pragma unroll
                    for (int n = 0; n < 2; ++n) acc[a][b][m][n] = (f32x4){0.f, 0.f, 0.f, 0.f};
        cur = nxt; cA = nA; cB = nB; ++ui;
        if constexpr (ALIGN_EPI) { if (wr == 1) PG8_BAR; }
    }
    PG8_WAIT_V(0);
    if constexpr (!ALIGN_EPI) { if (wr == 0) PG8_BAR; }
    PG8_BAR;
    if constexpr (Epi::AFTER_DRAIN) { E.fused(acc, cur, wr, wc, fr, fq, lds, wid, lane); S.done(cur); }
#undef PG8_SA
#undef PG8_SB
#undef PG8_STAGE
#undef PG8_LDA
#undef PG8_LDB
#undef PG8_MMA
#undef PG8_WAIT_V
#undef PG8_WAIT_L
#undef PG8_BAR
#undef PG8_SCHED
}
}

#define LAS __attribute__((address_space(3)))
typedef unsigned short bf16_t;
typedef short bf16x8 __attribute__((ext_vector_type(8)));
typedef float f32x4 __attribute__((ext_vector_type(4)));
typedef unsigned u32x4 __attribute__((ext_vector_type(4)));
typedef unsigned u32x2 __attribute__((ext_vector_type(2)));
using pg8::cvt_pk_bf16; using pg8::bflo; using pg8::bfhi;

constexpr int M = 16384, DM = 1024, NIN = 7592, NPAD = 7680, FF = 4096, DEPTH = 4;
constexpr int C_GQ = 0, C_GK = 512, C_GV = 1024, C_GA = 1536, C_GR = 1552, C_SQ = 2064, C_SK = 2576, C_SV = 3088, C_NQ = 3600, C_NKC = 4112, C_NVC = 4176,
              C_NKS = 4240, C_NVS = 4304, C_NKW = 4368, C_NVW = 4432, C_NGATE = 4496, C_MGATE = 4520;
constexpr size_t MiB = 1u << 20;
constexpr size_t WS_PROJ = 0, WS_HID = 0, WS_HN = 240 * MiB, WS_OGLA = 272 * MiB, WS_OSB = 288 * MiB, WS_ONSA = 304 * MiB;
constexpr size_t WS_WIN = 320 * MiB, WS_WUP = 335 * MiB, WS_WDN = 343 * MiB, WS_WOUT = 351 * MiB, WS_WBR = 353 * MiB, WS_WK1 = 356 * MiB, WS_WV1 = 357 * MiB,
                 WS_WK2 = 358 * MiB, WS_WV2 = 358 * MiB + 65536, WS_CB = 358 * MiB + 131072, WS_LUT = 358 * MiB + 196608;
constexpr size_t WS_GST = 360 * MiB, WS_GDC = 424 * MiB, WS_SVT = 425 * MiB, WS_QN = 441 * MiB, WS_KSN = 457 * MiB, WS_KWN = 459 * MiB, WS_VST = 461 * MiB, WS_VWT = 463 * MiB,
                 WS_KCMP = 465 * MiB, WS_VCMPT = 465 * MiB + 131072, WS_END = 466 * MiB, WS_CTL = 466 * MiB;
constexpr int LDS_BYTES = 133120;
constexpr float LOG2E = 1.4426950408889634f;

struct KArgs { const float* in[22]; float* out; unsigned char* ws; };

__device__ __forceinline__ float bf2f(bf16_t v) { return __uint_as_float(((unsigned)v) << 16); }
__device__ __forceinline__ bf16_t f2bf(float f) { unsigned u = __float_as_uint(f); return (bf16_t)((u + 0x7fffu + ((u >> 16) & 1u)) >> 16); }
__device__ __forceinline__ f32x4 mfma16(bf16x8 a, bf16x8 b, f32x4 c) { return __builtin_amdgcn_mfma_f32_16x16x32_bf16(a, b, c, 0, 0, 0); }
__device__ __forceinline__ float wave_sum(float v) {
#pragma unroll
    for (int o = 1; o < 64; o <<= 1) v += __shfl_xor(v, o);
    return v;
}
#define LDS_FENCE() asm volatile("s_waitcnt lgkmcnt(0)" ::: "memory")
#define SCHED_FENCE_G() __builtin_amdgcn_sched_barrier(0)
__device__ __forceinline__ void unpack8(const u32x4 w, float (&f)[8]) { f[0] = bflo(w.x); f[1] = bfhi(w.x); f[2] = bflo(w.y); f[3] = bfhi(w.y); f[4] = bflo(w.z); f[5] = bfhi(w.z); f[6] = bflo(w.w); f[7] = bfhi(w.w); }
__device__ __forceinline__ u32x4 pack8(const float (&r)[8]) { u32x4 w; w.x = cvt_pk_bf16(r[0], r[1]); w.y = cvt_pk_bf16(r[2], r[3]); w.z = cvt_pk_bf16(r[4], r[5]); w.w = cvt_pk_bf16(r[6], r[7]); return w; }

__device__ __forceinline__ void transpose_item(const float* W, int K, int N, int Npad, bf16_t* WT, LAS float* scr, int item, int lane) {
    const int nblk = Npad / 32, kb = item / nblk, nb = item % nblk, k0 = 64 * kb, n0 = 32 * nb;
    const int nn = n0 + (lane & 31);
    float tv[32];
#pragma unroll
    for (int i = 0; i < 32; ++i) { const int kk = 2 * i + (lane >> 5); tv[i] = (nn < N) ? W[(size_t)(k0 + kk) * N + nn] : 0.f; }
#pragma unroll
    for (int i = 0; i < 32; ++i) { const int kk = 2 * i + (lane >> 5); scr[kk * 33 + (lane & 31)] = tv[i]; }
    LDS_FENCE();
    const int c = lane & 7;
#pragma unroll
    for (int j = 0; j < 4; ++j) { const int n = (lane >> 3) + 8 * j; const LAS float* s = scr + (8 * c) * 33 + n;
        u32x4 o; o.x = cvt_pk_bf16(s[0 * 33], s[1 * 33]); o.y = cvt_pk_bf16(s[2 * 33], s[3 * 33]); o.z = cvt_pk_bf16(s[4 * 33], s[5 * 33]); o.w = cvt_pk_bf16(s[6 * 33], s[7 * 33]);
        *(u32x4*)(WT + (size_t)(n0 + n) * K + k0 + 8 * c) = o; }
    LDS_FENCE();
}
__device__ __forceinline__ int rel_bucket(int n) {
    if (n < 16) return n;
    int large = 16 + (int)(logf((float)n / 16.f) / 4.1588830833596715f * 16.f);
    return large < 31 ? large : 31;
}
__device__ __forceinline__ void rms_row(const float* xrow, const float* g, bf16_t* orow, int lane) {
    const f32x4* xr = (const f32x4*)xrow + lane; f32x4 v[4]; float s = 0.f;
#pragma unroll
    for (int j = 0; j < 4; ++j) { v[j] = xr[64 * j]; s += (v[j].x * v[j].x + v[j].y * v[j].y) + (v[j].z * v[j].z + v[j].w * v[j].w); }
    const float rinv = rsqrtf(wave_sum(s) * (1.f / 1024.f) + 1e-6f);
    u32x2* o8 = (u32x2*)orow + lane;
#pragma unroll
    for (int j = 0; j < 4; ++j) { const f32x4 gg = ((const f32x4*)g)[lane + 64 * j]; u32x2 w; w.x = cvt_pk_bf16(v[j].x * rinv * gg.x, v[j].y * rinv * gg.y); w.y = cvt_pk_bf16(v[j].z * rinv * gg.z, v[j].w * rinv * gg.w); o8[64 * j] = w; }
}
__device__ __forceinline__ void phase_convert(const KArgs& a, int l, LAS unsigned char* lds, int gw, int NGW, int wave, int lane) {
    unsigned char* ws = a.ws;
    LAS float* scr = (LAS float*)(lds + wave * 8704);
    constexpr int I0 = 16 * 240, I1 = 16 * 128, I2 = 64 * 32, I3 = 16 * 32, I4 = 8 * 32, I7 = 32 * 8, I9 = 4 * 2, IB = 128, IL = 128;
    constexpr int NIT = I0 + I1 + I2 + I3 + 3 * I4 + 2 * I7 + 2 * I9 + IB + IL;
    for (int it = gw; it < NIT; it += NGW) {
        int r = it;
        if (r < I0) { transpose_item(a.in[3] + (size_t)l * DM * NIN, DM, NIN, NPAD, (bf16_t*)(ws + WS_WIN), scr, r, lane); continue; } r -= I0;
        if (r < I1) { transpose_item(a.in[20] + (size_t)l * DM * FF, DM, FF, FF, (bf16_t*)(ws + WS_WUP), scr, r, lane); continue; } r -= I1;
        if (r < I2) { transpose_item(a.in[21] + (size_t)l * FF * DM, FF, DM, DM, (bf16_t*)(ws + WS_WDN), scr, r, lane); continue; } r -= I2;
        if (r < I3) { transpose_item(a.in[19] + (size_t)l * DM * DM, DM, DM, DM, (bf16_t*)(ws + WS_WOUT), scr, r, lane); continue; } r -= I3;
        if (r < 3 * I4) { const int b = r / I4; transpose_item(a.in[16 + b] + (size_t)l * 512 * DM, 512, DM, DM, (bf16_t*)(ws + WS_WBR + b * MiB), scr, r % I4, lane); continue; } r -= 3 * I4;
        if (r < I7) { transpose_item(a.in[11] + (size_t)l * 2048 * 256, 2048, 256, 256, (bf16_t*)(ws + WS_WK1), scr, r, lane); continue; } r -= I7;
        if (r < I7) { transpose_item(a.in[13] + (size_t)l * 2048 * 256, 2048, 256, 256, (bf16_t*)(ws + WS_WV1), scr, r, lane); continue; } r -= I7;
        if (r < I9) { transpose_item(a.in[12] + (size_t)l * 256 * 64, 256, 64, 64, (bf16_t*)(ws + WS_WK2), scr, r, lane); continue; } r -= I9;
        if (r < I9) { transpose_item(a.in[14] + (size_t)l * 256 * 64, 256, 64, 64, (bf16_t*)(ws + WS_WV2), scr, r, lane); continue; } r -= I9;
        if (r < IB) {
            const int p = r >> 3, which = (r >> 2) & 1, col = (r & 3) * 64 + lane;
            const float* pe = a.in[which ? 10 : 9] + (size_t)l * 2048; const float* w1 = a.in[which ? 13 : 11] + (size_t)l * 2048 * 256;
            float s = 0.f;
#pragma unroll 1
            for (int k0 = 128 * p; k0 < 128 * p + 128; k0 += 16) { float wv[16];
#pragma unroll
                for (int i = 0; i < 16; ++i) wv[i] = w1[(size_t)(k0 + i) * 256 + col];
#pragma unroll
                for (int i = 0; i < 16; ++i) s += pe[k0 + i] * wv[i]; }
            ((float*)(ws + WS_CB))[p * 512 + which * 256 + col] = s; continue; } r -= IB;
        {
            const int idx = r * 64 + lane; const int d = idx >> 3, h = idx & 7;
            ((float*)(ws + WS_LUT))[idx] = a.in[15][rel_bucket(d) * 8 + h] * LOG2E; }
    }
}
__device__ __forceinline__ void phase_rms(const float* x, const float* g, bf16_t* hn, int gw, int NGW, int lane) {
    f32x4 gg[4];
#pragma unroll
    for (int j = 0; j < 4; ++j) gg[j] = ((const f32x4*)g)[lane + 64 * j];
    for (int m = gw; m < M; m += 2 * NGW) { const int m2 = (m + NGW < M) ? m + NGW : m;
        const f32x4* xa = (const f32x4*)(x + (size_t)m * DM) + lane; const f32x4* xb = (const f32x4*)(x + (size_t)m2 * DM) + lane;
        f32x4 va[4], vb[4]; float sa = 0.f, sb = 0.f;
#pragma unroll
        for (int j = 0; j < 4; ++j) { va[j] = xa[64 * j]; vb[j] = xb[64 * j]; }
#pragma unroll
        for (int j = 0; j < 4; ++j) { sa += (va[j].x * va[j].x + va[j].y * va[j].y) + (va[j].z * va[j].z + va[j].w * va[j].w); sb += (vb[j].x * vb[j].x + vb[j].y * vb[j].y) + (vb[j].z * vb[j].z + vb[j].w * vb[j].w); }
#pragma unroll
        for (int o = 1; o < 64; o <<= 1) { sa += __shfl_xor(sa, o); sb += __shfl_xor(sb, o); }
        const float ra = rsqrtf(sa * (1.f / 1024.f) + 1e-6f), rb = rsqrtf(sb * (1.f / 1024.f) + 1e-6f);
        u32x2* oa = (u32x2*)(hn + (size_t)m * DM) + lane; u32x2* ob = (u32x2*)(hn + (size_t)m2 * DM) + lane;
#pragma unroll
        for (int j = 0; j < 4; ++j) { u32x2 w; w.x = cvt_pk_bf16(va[j].x * ra * gg[j].x, va[j].y * ra * gg[j].y); w.y = cvt_pk_bf16(va[j].z * ra * gg[j].z, va[j].w * ra * gg[j].w); oa[64 * j] = w;
            u32x2 w2; w2.x = cvt_pk_bf16(vb[j].x * rb * gg[j].x, vb[j].y * rb * gg[j].y); w2.y = cvt_pk_bf16(vb[j].z * rb * gg[j].z, vb[j].w * rb * gg[j].w); ob[64 * j] = w2; } }
}

__device__ __forceinline__ void rms64_to(const bf16_t* src, const float* g, float scale, bf16_t* dst) {
    u32x4 w[8]; float ss = 0.f;
#pragma unroll
    for (int i = 0; i < 8; ++i) { w[i] = ((const u32x4*)src)[i]; float f[8]; unpack8(w[i], f);
#pragma unroll
        for (int e = 0; e < 8; ++e) ss += f[e] * f[e]; }
    const float rinv = rsqrtf(ss * (1.f / 64.f) + 1e-6f) * scale;
#pragma unroll
    for (int i = 0; i < 8; ++i) { float f[8]; unpack8(w[i], f); float r[8];
#pragma unroll
        for (int e = 0; e < 8; ++e) r[e] = f[e] * rinv * g[8 * i + e];
        ((u32x4*)dst)[i] = pack8(r); }
}
__device__ __forceinline__ void pre_item(const KArgs& a, int l, LAS unsigned char* lds, int item, int tid) {
    unsigned char* ws = a.ws; const bf16_t* proj = (const bf16_t*)(ws + WS_PROJ);
    const int t0 = item * 64;
    {
        const int tl = tid >> 3, h = tid & 7;
        rms64_to(proj + (size_t)(t0 + tl) * NPAD + C_NQ + h * 64, a.in[7] + l * 64, 0.125f * LOG2E, (bf16_t*)(ws + WS_QN) + (size_t)(t0 + tl) * 512 + h * 64);
    }
    if (tid < 128) {
        const int tl = tid >> 1, which = tid & 1;
        rms64_to(proj + (size_t)(t0 + tl) * NPAD + (which ? C_NKW : C_NKS), a.in[8] + l * 64, 1.f, (bf16_t*)(ws + (which ? WS_KWN : WS_KSN)) + (size_t)(t0 + tl) * 64);
    }
    LAS bf16_t* T = (LAS bf16_t*)lds;
    for (int idx = tid; idx < 64 * 80; idx += 512) { const int t = idx / 80, p = idx % 80; const int col = p < 64 ? C_SV + 8 * p : (p < 72 ? C_NVS + 8 * (p - 64) : C_NVW + 8 * (p - 72));
        const u32x4 w = *(const u32x4*)(proj + (size_t)(t0 + t) * NPAD + col);
        LAS unsigned* d = (LAS unsigned*)(T + t * 648 + 8 * p); d[0] = w.x; d[1] = w.y; d[2] = w.z; d[3] = w.w; }
    __syncthreads();
    for (int idx = tid; idx < 640 * 8; idx += 512) { const int c = idx >> 3, p = idx & 7;
        unsigned short e[8];
#pragma unroll
        for (int j = 0; j < 8; ++j) e[j] = T[(8 * p + j) * 648 + c];
        u32x4 w; w.x = e[0] | ((unsigned)e[1] << 16); w.y = e[2] | ((unsigned)e[3] << 16); w.z = e[4] | ((unsigned)e[5] << 16); w.w = e[6] | ((unsigned)e[7] << 16);
        const int tk = t0 + 8 * p;
        if (c < 512) *(u32x4*)((bf16_t*)(ws + WS_SVT) + ((size_t)(((c >> 7) * 256 + (tk >> 6)) * 128 + (c & 127))) * 64 + (tk & 63)) = w;
        else { const int d = (c - 512) & 63; bf16_t* vb = (bf16_t*)(ws + (c < 576 ? WS_VST : WS_VWT)); *(u32x4*)(vb + ((size_t)((tk >> 5) * 64 + d)) * 32 + (tk & 31)) = w; } }
    __syncthreads();
}
__device__ __forceinline__ void cmp_item(const KArgs& a, int l, LAS unsigned char* lds, int item, int tid, int wave, int lane) {
    unsigned char* ws = a.ws; const bf16_t* proj = (const bf16_t*)(ws + WS_PROJ);
    const int which = item & 1, grp = item >> 1, i0 = 16 * grp;
    const int srcoff = which ? C_NVC : C_NKC;
    const bf16_t* w1T = (const bf16_t*)(ws + (which ? WS_WV1 : WS_WK1)); const bf16_t* w2T = (const bf16_t*)(ws + (which ? WS_WV2 : WS_WK2));
    LAS bf16_t* hidL = (LAS bf16_t*)lds;
    LAS float* outL = (LAS float*)(lds + 16384);
    LAS float* rinvL = (LAS float*)(lds + 24576);
    const int r = lane & 15, g = lane >> 4;
    int irow = i0 + r; if (irow > 1022) irow = 1022;
    const bf16_t* arow = proj + (size_t)(16 * irow) * NPAD + srcoff;
    f32x4 acc[2] = {(f32x4){0.f, 0.f, 0.f, 0.f}, (f32x4){0.f, 0.f, 0.f, 0.f}};
    const bf16_t* b0 = w1T + (size_t)(32 * wave + r) * 2048 + 8 * g; const bf16_t* b1 = b0 + 16 * 2048;
#pragma unroll 8
    for (int ks = 0; ks < 64; ++ks) { const int k = 32 * ks + 8 * g;
        const bf16x8 af = *(const bf16x8*)(arow + (size_t)(k >> 6) * NPAD + (k & 63));
        const bf16x8 bf0 = *(const bf16x8*)(b0 + 32 * ks), bf1 = *(const bf16x8*)(b1 + 32 * ks);
        acc[0] = mfma16(af, bf0, acc[0]); acc[1] = mfma16(af, bf1, acc[1]); }
    const float* cb = (const float*)(ws + WS_CB);
#pragma unroll
    for (int nb = 0; nb < 2; ++nb) { const int col = 32 * wave + 16 * nb + r; float bs = 0.f;
#pragma unroll
        for (int p = 0; p < 16; ++p) bs += cb[p * 512 + which * 256 + col];
#pragma unroll
        for (int j = 0; j < 4; ++j) { const float x = acc[nb][j] + bs; const float u = 0.7978845608028654f * (x + 0.044715f * x * x * x);
            const float th = 1.f - 2.f / (__expf(2.f * u) + 1.f); hidL[(4 * g + j) * 264 + col] = f2bf(0.5f * x * (1.f + th)); } }
    __syncthreads();
    if (wave < 4) { f32x4 c2 = (f32x4){0.f, 0.f, 0.f, 0.f};
#pragma unroll
        for (int ks = 0; ks < 8; ++ks) { const bf16x8 af = *(const LAS bf16x8*)(hidL + r * 264 + 32 * ks + 8 * g); const bf16x8 bfr = *(const bf16x8*)(w2T + (size_t)(16 * wave + r) * 256 + 32 * ks + 8 * g); c2 = mfma16(af, bfr, c2); }
#pragma unroll
        for (int j = 0; j < 4; ++j) outL[(4 * g + j) * 65 + 16 * wave + r] = c2[j]; }
    __syncthreads();
    if (tid < 16) { float ss = 0.f; for (int d = 0; d < 64; ++d) { const float v = outL[tid * 65 + d]; ss += v * v; } rinvL[tid] = rsqrtf(ss * (1.f / 64.f) + 1e-6f); }
    __syncthreads();
    const float* kg = a.in[8] + l * 64;
    for (int idx = tid; idx < 1024; idx += 512) { const int row = idx >> 6, d = idx & 63, i = i0 + row; const float v = outL[row * 65 + d];
        if (which == 0) ((bf16_t*)(ws + WS_KCMP))[(size_t)i * 64 + d] = (i <= 1022) ? f2bf(v * rinvL[row] * kg[d]) : (bf16_t)0;
        else ((bf16_t*)(ws + WS_VCMPT))[((size_t)((i >> 5) * 64 + d)) * 32 + (i & 31)] = (i <= 1022) ? f2bf(v) : (bf16_t)0; }
    __syncthreads();
}
struct GlaPre { float asrc; float w[16]; float ba; };
__device__ __forceinline__ void gla_preload(GlaPre& p, const KArgs& a, int l, int c, int h, int tid) {
    const bf16_t* proj = (const bf16_t*)(a.ws + WS_PROJ);
    p.asrc = bf2f(proj[(size_t)(32 * c + (tid >> 4)) * NPAD + C_GA + (tid & 15)]);
    const int hk = h * 128 + (tid & 127);
#pragma unroll
    for (int r = 0; r < 16; ++r) p.w[r] = a.in[4][(size_t)l * 16 * 512 + r * 512 + hk];
    p.ba = a.in[5][l * 512 + hk];
}
__device__ __forceinline__ void gla_decay(const GlaPre& p, LAS float* bL, LAS float* aL, int tid) {
    LAS float* segL = aL + 512;
    aL[tid] = p.asrc;
    __syncthreads();
    const int kk = tid & 127, sg = tid >> 7;
    { float cum = 0.f;
#pragma unroll
        for (int tt = 0; tt < 8; ++tt) { const int t = 8 * sg + tt; float x = p.ba;
#pragma unroll
            for (int r = 0; r < 16; ++r) x += aL[t * 16 + r] * p.w[r];
            const float ls = fminf(x, 0.f) - __logf(1.f + __expf(-fabsf(x)));
            cum += ls * (1.f / 16.f); bL[t * 128 + kk] = cum; }
        segL[sg * 128 + kk] = cum; }
    __syncthreads();
    { float off = 0.f;
#pragma unroll
        for (int q = 0; q < 3; ++q) if (q < sg) off += segL[q * 128 + kk];
        if (sg > 0) {
#pragma unroll
            for (int tt = 0; tt < 8; ++tt) bL[(8 * sg + tt) * 128 + kk] += off; } }
    __syncthreads();
}
__device__ __forceinline__ void gla_g1_item(const KArgs& a, int l, LAS unsigned char* lds, int item, int tid, int wave, int lane) {
    unsigned char* ws = a.ws; const bf16_t* proj = (const bf16_t*)(ws + WS_PROJ);
    const int c = item >> 2, h = item & 3;
    LAS float* bL = (LAS float*)lds; LAS float* aL = (LAS float*)(lds + 16384);
    LAS bf16_t* kT = (LAS bf16_t*)(lds + 20480);
    LAS bf16_t* vT = (LAS bf16_t*)(lds + 20480 + 10240);
    GlaPre pre; gla_preload(pre, a, l, c, h, tid);
    const int s = tid >> 4, k0 = (tid & 15) * 8;
    const size_t ro = (size_t)(32 * c + s) * NPAD + h * 128 + k0;
    const u32x4 kraw = *(const u32x4*)(proj + ro + C_GK), vraw = *(const u32x4*)(proj + ro + C_GV);
    gla_decay(pre, bL, aL, tid);
    { float kf[8]; unpack8(kraw, kf);
      const unsigned vw[4] = {vraw.x, vraw.y, vraw.z, vraw.w};
#pragma unroll
      for (int e = 0; e < 8; ++e) { const int k = k0 + e; kT[k * 40 + s] = f2bf(kf[e] * __expf(bL[31 * 128 + k] - bL[s * 128 + k])); vT[k * 40 + s] = (bf16_t)((vw[e >> 1] >> (16 * (e & 1))) & 0xffffu); } }
    if (tid < 128) ((float*)(ws + WS_GDC))[(size_t)(c * 4 + h) * 128 + tid] = __expf(bL[31 * 128 + tid]);
    __syncthreads();
    const int r = lane & 15, g = lane >> 4;
    const bf16x8 af = *(const LAS bf16x8*)(vT + (16 * wave + r) * 40 + 8 * g);
    bf16_t* dst = (bf16_t*)(ws + WS_GST) + (size_t)(c * 4 + h) * 16384;
#pragma unroll
    for (int kb = 0; kb < 8; ++kb) { const bf16x8 bfr = *(const LAS bf16x8*)(kT + (16 * kb + r) * 40 + 8 * g);
        const f32x4 d = mfma16(af, bfr, (f32x4){0.f, 0.f, 0.f, 0.f});
#pragma unroll
        for (int j = 0; j < 4; ++j) dst[(size_t)(16 * wave + 4 * g + j) * 128 + 16 * kb + r] = f2bf(d[j]); }
    __syncthreads();
}
__device__ __forceinline__ void gla_scan(const KArgs& a, int cid) {
    bf16_t* st = (bf16_t*)(a.ws + WS_GST); const float* dc = (const float*)(a.ws + WS_GDC);
    const int h = cid >> 14, vk = cid & 16383, k = cid & 127;
    bf16_t* sp = st + (size_t)h * 16384 + vk; const float* dp = dc + (size_t)h * 128 + k;
    float state = 0.f;
    unsigned short kva[8], kvb[8]; float da[8], db[8];
#pragma unroll
    for (int i = 0; i < 8; ++i) { kva[i] = sp[(size_t)i * 65536]; da[i] = dp[(size_t)i * 512]; }
    for (int c0 = 0; c0 < 512; c0 += 16) {
#pragma unroll
        for (int i = 0; i < 8; ++i) { kvb[i] = sp[(size_t)(c0 + 8 + i) * 65536]; db[i] = dp[(size_t)(c0 + 8 + i) * 512]; }
        SCHED_FENCE_G();
#pragma unroll
        for (int i = 0; i < 8; ++i) { sp[(size_t)(c0 + i) * 65536] = f2bf(state); state = state * da[i] + bf2f(kva[i]); }
        SCHED_FENCE_G();
        if (c0 + 16 < 512) {
#pragma unroll
            for (int i = 0; i < 8; ++i) { kva[i] = sp[(size_t)(c0 + 16 + i) * 65536]; da[i] = dp[(size_t)(c0 + 16 + i) * 512]; } }
        SCHED_FENCE_G();
#pragma unroll
        for (int i = 0; i < 8; ++i) { sp[(size_t)(c0 + 8 + i) * 65536] = f2bf(state); state = state * db[i] + bf2f(kvb[i]); }
        SCHED_FENCE_G();
    }
}
__device__ __forceinline__ void gla_g3_item(const KArgs& a, int l, LAS unsigned char* lds, int item, int tid, int wave, int lane) {
    unsigned char* ws = a.ws; const bf16_t* proj = (const bf16_t*)(ws + WS_PROJ);
    const int c = item >> 2, h = item & 3;
    LAS float* bL = (LAS float*)lds; LAS float* aL = (LAS float*)(lds + 16384);
    LAS bf16_t* qL = (LAS bf16_t*)(lds + 20480);
    LAS bf16_t* kL = (LAS bf16_t*)(lds + 20480 + 8704);
    LAS bf16_t* vT = (LAS bf16_t*)(lds + 20480 + 17408);
    LAS bf16_t* scL = (LAS bf16_t*)(lds + 20480 + 27648);
    LAS float* oL = (LAS float*)(lds + 20480 + 30208);
    const int r = lane & 15, g = lane >> 4;
    GlaPre pre; gla_preload(pre, a, l, c, h, tid);
    const int s = tid >> 4, k0 = (tid & 15) * 8;
    const size_t ro = (size_t)(32 * c + s) * NPAD + h * 128 + k0;
    const u32x4 qraw = *(const u32x4*)(proj + ro + C_GQ), kraw = *(const u32x4*)(proj + ro + C_GK), vraw = *(const u32x4*)(proj + ro + C_GV), rraw = *(const u32x4*)(proj + ro + C_GR);
    const bf16_t* stT = (const bf16_t*)(ws + WS_GST) + (size_t)(c * 4 + h) * 16384;
    bf16x8 stf[4];
#pragma unroll
    for (int ks = 0; ks < 4; ++ks) stf[ks] = *(const bf16x8*)(stT + (size_t)(16 * wave + r) * 128 + 32 * ks + 8 * g);
    float ng[8];
#pragma unroll
    for (int e = 0; e < 8; ++e) ng[e] = a.in[6][l * 128 + k0 + e];
    gla_decay(pre, bL, aL, tid);
    { float qf[8], kf[8]; unpack8(qraw, qf); unpack8(kraw, kf); float qo[8], ko[8];
      const unsigned vw[4] = {vraw.x, vraw.y, vraw.z, vraw.w};
#pragma unroll
      for (int e = 0; e < 8; ++e) { const float b = bL[s * 128 + k0 + e]; qo[e] = qf[e] * __expf(b) * 0.08838834764831845f; ko[e] = kf[e] * __expf(-b); vT[(k0 + e) * 40 + s] = (bf16_t)((vw[e >> 1] >> (16 * (e & 1))) & 0xffffu); }
      *(LAS u32x4*)(qL + s * 136 + k0) = pack8(qo); *(LAS u32x4*)(kL + s * 136 + k0) = pack8(ko); }
    __syncthreads();
    if (wave < 4) { const int mb = wave >> 1, nb = wave & 1; f32x4 d = (f32x4){0.f, 0.f, 0.f, 0.f};
#pragma unroll
        for (int ks = 0; ks < 4; ++ks) d = mfma16(*(const LAS bf16x8*)(qL + (16 * mb + r) * 136 + 32 * ks + 8 * g), *(const LAS bf16x8*)(kL + (16 * nb + r) * 136 + 32 * ks + 8 * g), d);
#pragma unroll
        for (int j = 0; j < 4; ++j) { const int t = 16 * mb + 4 * g + j, sq = 16 * nb + r; scL[t * 40 + sq] = (sq <= t) ? f2bf(d[j]) : (bf16_t)0; } }
    __syncthreads();
#pragma unroll
    for (int mb = 0; mb < 2; ++mb) { f32x4 d = (f32x4){0.f, 0.f, 0.f, 0.f};
#pragma unroll
        for (int ks = 0; ks < 4; ++ks) d = mfma16(*(const LAS bf16x8*)(qL + (16 * mb + r) * 136 + 32 * ks + 8 * g), stf[ks], d);
        d = mfma16(*(const LAS bf16x8*)(scL + (16 * mb + r) * 40 + 8 * g), *(const LAS bf16x8*)(vT + (16 * wave + r) * 40 + 8 * g), d);
#pragma unroll
        for (int j = 0; j < 4; ++j) oL[(16 * mb + 4 * g + j) * 132 + 16 * wave + r] = d[j]; }
    __syncthreads();
    { float o[8]; float ss = 0.f;
#pragma unroll
        for (int e = 0; e < 8; ++e) { o[e] = oL[s * 132 + k0 + e]; ss += o[e] * o[e]; }
        ss += __shfl_xor(ss, 1); ss += __shfl_xor(ss, 2); ss += __shfl_xor(ss, 4); ss += __shfl_xor(ss, 8);
        const float rinv = rsqrtf(ss * (1.f / 128.f) + 1e-6f);
        float rr[8]; unpack8(rraw, rr); float res[8];
#pragma unroll
        for (int e = 0; e < 8; ++e) { const float on = o[e] * rinv * ng[e]; const float si = rr[e] / (1.f + __expf(-rr[e])); res[e] = on * si; }
        *(u32x4*)((bf16_t*)(ws + WS_OGLA) + (size_t)(32 * c + s) * 512 + h * 128 + k0) = pack8(res); }
    __syncthreads();
}

__device__ __forceinline__ float xor16f(float t, int g) { const auto r = __builtin_amdgcn_permlane16_swap(__float_as_uint(t), __float_as_uint(t), false, false); return __uint_as_float(r[0] == __float_as_uint(t) ? r[1] : r[0]); }
__device__ __forceinline__ float xor32f(float t, int g) { const auto r = __builtin_amdgcn_permlane32_swap(__float_as_uint(t), __float_as_uint(t), false, false); return __uint_as_float(r[0] == __float_as_uint(t) ? r[1] : r[0]); }
#define SCHED_FENCE() __builtin_amdgcn_sched_barrier(0)
template <bool DIAG>
__device__ __forceinline__ void sb_weights(const f32x4 (&S)[2], bf16x8& pf, float& carry, int g, int cc, int krel) {
    float e[8], P[8];
#pragma unroll
    for (int j = 0; j < 8; ++j) { int zi = __float_as_int(S[j >> 2][j & 3]); zi = zi < 0x41700000 ? zi : 0x41700000;
        float z = __int_as_float(zi);
        if (DIAG) { if (32 * cc + 8 * g + j >= krel) z = -1e30f; }
        e[j] = __builtin_amdgcn_exp2f(z); }
    P[0] = 1.f;
#pragma unroll
    for (int j = 1; j < 8; ++j) P[j] = P[j - 1] * (1.f + e[j - 1]);
    const float Tg = __builtin_amdgcn_rcpf(P[7] * (1.f + e[7]));
    const float t1 = __shfl_xor(Tg, 16);
    const float pp = Tg * t1;
    const float t23 = __shfl_xor(pp, 32);
    const float gex = ((g & 1) ? 1.f : t1) * ((g & 2) ? 1.f : t23);
    const float cf = Tg * gex * carry;
    carry = carry * (pp * t23);
    float w[8];
#pragma unroll
    for (int j = 0; j < 8; ++j) w[j] = (e[j] * P[j]) * cf;
    const u32x4 pw = pack8(w); __builtin_memcpy(&pf, &pw, 16);
}
template <bool DIAG>
__device__ __forceinline__ void sb_tile(const LAS bf16_t* Kt, const LAS bf16_t* Vt, const bf16x8 (&qf)[4], f32x4 (&O)[8], float& carry, int n, int g, int krel  ) {
    f32x4 S[2][2];
#pragma unroll
    for (int cc = 1; cc >= 0; --cc) {
        bf16x8 kf[2][4];
#pragma unroll
        for (int pb = 0; pb < 2; ++pb)
#pragma unroll
            for (int ks = 0; ks < 4; ++ks) kf[pb][ks] = *(const LAS bf16x8*)(Kt + (32 * cc + 16 * pb + n) * 128 + (((4 * ks + g) ^ n) << 3));
        SCHED_FENCE();
#pragma unroll
        for (int pb = 0; pb < 2; ++pb) { f32x4 sv = (f32x4){0.f, 0.f, 0.f, 0.f};
#pragma unroll
            for (int ks = 0; ks < 4; ++ks) sv = mfma16(kf[pb][ks], qf[ks], sv);
            S[cc][pb] = sv; }
        SCHED_FENCE();
    }
    bf16x8 vf[8], pf1, pf0;
#pragma unroll
    for (int db = 0; db < 8; ++db) vf[db] = *(const LAS bf16x8*)(Vt + (16 * db + n) * 64 + (((4 + g) ^ (n >> 1)) << 3));
    SCHED_FENCE();
    sb_weights<DIAG>(S[1], pf1, carry, g, 1, krel);
    SCHED_FENCE();
#pragma unroll
    for (int db = 0; db < 8; ++db) O[db] = mfma16(vf[db], pf1, O[db]);
    SCHED_FENCE();
#pragma unroll
    for (int db = 0; db < 8; ++db) vf[db] = *(const LAS bf16x8*)(Vt + (16 * db + n) * 64 + ((g ^ (n >> 1)) << 3));
    SCHED_FENCE();
    sb_weights<DIAG>(S[0], pf0, carry, g, 0, krel);
    SCHED_FENCE();
#pragma unroll
    for (int db = 0; db < 8; ++db) O[db] = mfma16(vf[db], pf0, O[db]);
    SCHED_FENCE();
}
__device__ __forceinline__ void sb_swbar(LAS unsigned* ctr, unsigned& gen, int lane) {
    asm volatile("s_waitcnt vmcnt(0) lgkmcnt(0)" ::: "memory");
    gen += 4u;
    if (lane == 0) { __hip_atomic_fetch_add(ctr, 1u, __ATOMIC_RELAXED, __HIP_MEMORY_SCOPE_WORKGROUP);
        while (__hip_atomic_load(ctr, __ATOMIC_RELAXED, __HIP_MEMORY_SCOPE_WORKGROUP) < gen) __builtin_amdgcn_s_sleep(1); }
    asm volatile("s_waitcnt lgkmcnt(0)" ::: "memory");
}
__device__ __forceinline__ void sb_unit4(const KArgs& a, LAS unsigned char* sbl, LAS unsigned* ctr, unsigned& gen, int h, int qb, int wave, int lane) {
    unsigned char* ws = a.ws; const bf16_t* proj = (const bf16_t*)(ws + WS_PROJ);
    constexpr int KT_B = 64 * 256, BUF_B = 32768;
    const int n = lane & 15, g = lane >> 4;
    const int tq = 64 * qb + 16 * wave + n;
    const float SC = 0.08838834764831845f * LOG2E;
    bf16x8 qf[4];
#pragma unroll
    for (int ks = 0; ks < 4; ++ks) { const u32x4 w = *(const u32x4*)(proj + (size_t)tq * NPAD + C_SQ + h * 128 + 32 * ks + 8 * g); float f[8]; unpack8(w, f);
#pragma unroll
        for (int e = 0; e < 8; ++e) f[e] *= SC;
        const u32x4 pw = pack8(f); __builtin_memcpy(&qf[ks], &pw, 16); }
    f32x4 O[8];
#pragma unroll
    for (int i = 0; i < 8; ++i) O[i] = (f32x4){0.f, 0.f, 0.f, 0.f};
    float carry = 1.f;
    volatile LAS unsigned* alive = (volatile LAS unsigned*)(ctr + 8);
    const int ntiles = qb + 1;
    const char* kbase = (const char*)(proj + C_SK + h * 128); const char* vbase = (const char*)((const bf16_t*)(ws + WS_SVT) + (size_t)h * 256 * 8192);
    auto issue = [&](int T, int buf) {
        const char* kt = kbase + (size_t)(64 * T) * NPAD * 2; const char* vt = vbase + (size_t)T * 16384;
#pragma unroll
        for (int i = 0; i < 4; ++i) { const int p = i * 256 + wave * 64 + lane;
            const int rho = p >> 4, c = (p & 15) ^ (rho & 15), k = (rho & 32) | ((rho & 16) >> 2) | ((rho & 12) << 1) | (rho & 3);
            const unsigned koff = (unsigned)(k * NPAD + 8 * c) * 2u;
            const int d = p >> 3, cv = (p & 7) ^ ((d >> 1) & 7);
            const unsigned voff = (unsigned)(d * 64 + 8 * cv) * 2u;
            __builtin_amdgcn_global_load_lds((const unsigned*)(kt + koff), (LAS unsigned*)(sbl + buf * BUF_B + (i * 256 + wave * 64) * 16), 16, 0, 0);
            __builtin_amdgcn_global_load_lds((const unsigned*)(vt + voff), (LAS unsigned*)(sbl + buf * BUF_B + KT_B + (i * 256 + wave * 64) * 16), 16, 0, 0); } };
    issue(ntiles - 1, 0);
    sb_swbar(ctr, gen, lane);
    for (int it = 0; it < ntiles; ++it) { const int T = ntiles - 1 - it, buf = it & 1;
        if (T > 0) issue(T - 1, buf ^ 1);
        const LAS bf16_t* Kt = (const LAS bf16_t*)(sbl + buf * BUF_B); const LAS bf16_t* Vt = (const LAS bf16_t*)(sbl + buf * BUF_B + KT_B);
        if (it == 0) sb_tile<true>(Kt, Vt, qf, O, carry, n, g, tq - 64 * T);
        else sb_tile<false>(Kt, Vt, qf, O, carry, n, g, 0);
        const bool dead = (__ballot(carry != 0.f) == 0ull);
        if (lane == 0) alive[(it & 1) * 4 + wave] = dead ? 0u : 1u;
        sb_swbar(ctr, gen, lane);
        const unsigned any = alive[(it & 1) * 4 + 0] | alive[(it & 1) * 4 + 1] | alive[(it & 1) * 4 + 2] | alive[(it & 1) * 4 + 3];
        if (__builtin_amdgcn_readfirstlane(any) == 0u) break;
    }
    bf16_t* orow = (bf16_t*)(ws + WS_OSB) + (size_t)tq * 512 + h * 128;
#pragma unroll
    for (int db = 0; db < 8; ++db) { u32x2 w; w.x = cvt_pk_bf16(O[db][0], O[db][1]); w.y = cvt_pk_bf16(O[db][2], O[db][3]); *(u32x2*)(orow + 16 * db + 4 * g) = w; }
}

struct NFrag { bf16x8 k[4]; bf16x8 v[4]; };
template <bool LV> __device__ __forceinline__ void nsa_load(NFrag& f, const bf16_t* Kb, const bf16_t* VB, int kb, int n, int g) {
    const bf16_t* kp = Kb + (size_t)(kb + 8 * (n >> 2) + (n & 3)) * 64 + 8 * g;
    f.k[0] = *(const bf16x8*)kp; f.k[1] = *(const bf16x8*)(kp + 32); f.k[2] = *(const bf16x8*)(kp + 256); f.k[3] = *(const bf16x8*)(kp + 288);
    if (LV) { const bf16_t* vp = VB + ((size_t)(kb >> 5) * 64 + n) * 32 + 8 * g;
#pragma unroll
        for (int db = 0; db < 4; ++db) f.v[db] = *(const bf16x8*)(vp + db * 512); }
}
template <int MODE, bool FAST>
__device__ __forceinline__ void nsa_compute(const NFrag& f, int kb, const bf16x8 (&qf)[2], const LAS float* LUTh, LAS float* impq,
                                            int tq, int h, int g, int qs, int qsel, float inv, float& lsum, f32x4 (&O)[4], float bfar) {
    f32x4 S[2];
#pragma unroll
    for (int pb = 0; pb < 2; ++pb) { f32x4 sv = mfma16(f.k[2 * pb], qf[0], (f32x4){0.f, 0.f, 0.f, 0.f}); S[pb] = mfma16(f.k[2 * pb + 1], qf[1], sv); }
    float p[8];
    const int dbase = (MODE <= 1) ? (tq - 31 - 16 * (kb + 8 * g)) : (tq - kb - 8 * g);
    const bool colok = (MODE == 2) ? (qs == qsel) : true;
    if (FAST) {
#pragma unroll
        for (int j = 0; j < 8; ++j) { const float ex = __builtin_amdgcn_exp2f(S[j >> 2][j & 3] + bfar);
            float pv = (MODE == 2) ? (colok ? ex : 0.f) : ex;
            if (MODE == 1) pv *= inv;
            p[j] = pv; if (MODE != 1) lsum += pv; }
    } else {
    float bias[8];
#pragma unroll
    for (int j = 0; j < 8; ++j) { const int dist = (MODE <= 1) ? dbase - 16 * j : dbase - j; const unsigned di = min((unsigned)dist, 1023u); bias[j] = LUTh[di * 8]; }
#pragma unroll
    for (int j = 0; j < 8; ++j) asm volatile("" : "+v"(bias[j]));
#pragma unroll
    for (int j = 0; j < 8; ++j) { const int dist = (MODE <= 1) ? dbase - 16 * j : dbase - j;
        const bool valid = (MODE == 3) ? ((unsigned)dist < 512u) : (dist >= 0 && colok);
        const float ex = __builtin_amdgcn_exp2f(S[j >> 2][j & 3] + bias[j]);
        float pv = valid ? ex : 0.f;
        if (MODE == 1) pv *= inv;
        p[j] = pv; if (MODE != 1) lsum += pv; }
    }
    if (MODE == 0) return;
    if (MODE == 1) {
#pragma unroll
        for (int j = 0; j < 8; ++j) { float v = p[j]; v += __shfl_xor(v, 1); v += __shfl_xor(v, 2); v += __shfl_xor(v, 4); if (h == 0) impq[kb + 8 * g + j] = v; } }
    const u32x4 pw = pack8(p); bf16x8 pf; __builtin_memcpy(&pf, &pw, 16);
#pragma unroll
    for (int db = 0; db < 4; ++db) O[db] = mfma16(f.v[db], pf, O[db]);
}
template <int MODE, class KBF, class QSF>
__device__ __forceinline__ void nsa_run(int niter, const bf16_t* Kb, const bf16_t* VB, KBF kbf, QSF qsf, const bf16x8 (&qf)[2], const LAS float* LUTh, LAS float* impq,
                                        int tq, int h, int n, int g, int qs, float inv, float& lsum, f32x4 (&O)[4], int t0, float bfar) {
    if (niter <= 0) return;
    NFrag A, C; const int last = niter - 1;
    nsa_load<MODE != 0>(A, Kb, VB, kbf(0), n, g);
    for (int i = 0; i < niter; i += 2) {
        nsa_load<MODE != 0>(C, Kb, VB, kbf(i + 1 < last ? i + 1 : last), n, g);
        SCHED_FENCE();
        { const int kb_ = kbf(i); const bool far_ = (MODE <= 1) ? (t0 - 31 - 16 * (kb_ + 31) >= 1023) : ((MODE == 2) ? (t0 - (kb_ + 31) >= 1023) : false);
          if (MODE != 3 && far_) nsa_compute<MODE, true>(A, kb_, qf, LUTh, impq, tq, h, g, qs, qsf(i), inv, lsum, O, bfar); else nsa_compute<MODE, false>(A, kb_, qf, LUTh, impq, tq, h, g, qs, qsf(i), inv, lsum, O, bfar); }
        SCHED_FENCE();
        if (i + 1 >= niter) break;
        nsa_load<MODE != 0>(A, Kb, VB, kbf(i + 2 < last ? i + 2 : last), n, g);
        SCHED_FENCE();
        { const int kb_ = kbf(i + 1); const bool far_ = (MODE <= 1) ? (t0 - 31 - 16 * (kb_ + 31) >= 1023) : ((MODE == 2) ? (t0 - (kb_ + 31) >= 1023) : false);
          if (MODE != 3 && far_) nsa_compute<MODE, true>(C, kb_, qf, LUTh, impq, tq, h, g, qs, qsf(i + 1), inv, lsum, O, bfar); else nsa_compute<MODE, false>(C, kb_, qf, LUTh, impq, tq, h, g, qs, qsf(i + 1), inv, lsum, O, bfar); }
        SCHED_FENCE();
    }
}
__device__ __forceinline__ float lred(float l) { l += __shfl_xor(l, 16); l += __shfl_xor(l, 32); return l; }
__device__ __forceinline__ void nsa_unit(const KArgs& a, LAS unsigned char* lds, int unit, LAS float* imp, LAS int* selL, int lane) {
    unsigned char* ws = a.ws; const bf16_t* proj = (const bf16_t*)(ws + WS_PROJ);
    const int t0 = 2 * unit, n = lane & 15, g = lane >> 4, qs = n >> 3, h = n & 7, tq = t0 + qs;
    const LAS float* LUT = (const LAS float*)lds + h;
    const float bfar = LUT[1023 * 8];
    bf16x8 qf[2];
    qf[0] = *(const bf16x8*)((const bf16_t*)(ws + WS_QN) + (size_t)tq * 512 + h * 64 + 8 * g); qf[1] = *(const bf16x8*)((const bf16_t*)(ws + WS_QN) + (size_t)tq * 512 + h * 64 + 32 + 8 * g);
    const bf16_t* gp = proj + (size_t)tq * NPAD + C_NGATE + h * 3;
    const float g0 = 1.f / (1.f + __expf(-bf2f(gp[0]))), g1 = 1.f / (1.f + __expf(-bf2f(gp[1]))), g2 = 1.f / (1.f + __expf(-bf2f(gp[2])));
    f32x4 Ot[4], Ob[4];
#pragma unroll
    for (int i = 0; i < 4; ++i) { Ot[i] = (f32x4){0.f, 0.f, 0.f, 0.f}; Ob[i] = (f32x4){0.f, 0.f, 0.f, 0.f}; }
    const int nvmax = (t0 + 1 >= 31) ? (((t0 + 1 - 31) >> 4) + 1) : 0; const int nch = (nvmax + 31) >> 5;
    const bf16_t* KC = (const bf16_t*)(ws + WS_KCMP); const bf16_t* VCT = (const bf16_t*)(ws + WS_VCMPT);
    auto kb_lin = [](int i) { return 32 * i; }; auto qs_zero = [](int) { return 0; };
    float lsum = 0.f;
    nsa_run<0>(nch, KC, VCT, kb_lin, qs_zero, qf, LUT, imp + qs * 1024, tq, h, n, g, qs, 0.f, lsum, Ob, t0, bfar);
    { const float l = lred(lsum); const float inv = l > 0.f ? 1.f / l : 0.f; float dummy = 0.f;
      nsa_run<1>(nch, KC, VCT, kb_lin, qs_zero, qf, LUT, imp + qs * 1024, tq, h, n, g, qs, inv, dummy, Ob, t0, bfar); }
#pragma unroll
    for (int i = 0; i < 4; ++i) { Ot[i] += Ob[i] * g0; Ob[i] = (f32x4){0.f, 0.f, 0.f, 0.f}; }
    LDS_FENCE();
    int cnts[2];
#pragma unroll
    for (int q2 = 0; q2 < 2; ++q2) { const int tqq = t0 + q2, cur = tqq >> 6; const LAS float* iq = imp + q2 * 1024;
        float val[4];
#pragma unroll
        for (int r = 0; r < 4; ++r) { const int b = lane + 64 * r; float v = -1.f;
            if (b >= 1 && b <= cur - 2) { v = 0.f;
#pragma unroll
                for (int i = 0; i < 5; ++i) v += iq[4 * b - 1 + i]; }
            val[r] = v; }
        int cnt = 0;
        if (lane == 0) { selL[q2 * 8 + 0] = 0; if (cur >= 1) selL[q2 * 8 + 1] = cur; if (cur >= 2) selL[q2 * 8 + 2] = cur - 1; }
        cnt = 1 + (cur >= 1) + (cur >= 2);
        int ncand = cur - 2; if (ncand < 0) ncand = 0; const int npick = ncand < 5 ? ncand : 5;
        for (int rd = 0; rd < npick; ++rd) { float bv = val[0]; int bi = lane;
#pragma unroll
            for (int r = 1; r < 4; ++r) if (val[r] > bv) { bv = val[r]; bi = lane + 64 * r; }
#pragma unroll
            for (int o = 1; o < 64; o <<= 1) { const float ov = __shfl_xor(bv, o); const int oi = __shfl_xor(bi, o); if (ov > bv || (ov == bv && oi < bi)) { bv = ov; bi = oi; } }
            if (lane == 0) selL[q2 * 8 + cnt] = bi; ++cnt;
#pragma unroll
            for (int r = 0; r < 4; ++r) if (bi == lane + 64 * r) val[r] = -2.f; }
        cnts[q2] = cnt; }
    LDS_FENCE();
#pragma unroll
    for (int i = 0; i < 4; ++i)
#pragma unroll
        for (int j = 0; j < 4; ++j) imp[(4 * i + j) * 64 + lane] = Ot[i][j];
    lsum = 0.f;
    { const int c0 = cnts[0], c1 = cnts[1];
      auto kbf = [&](int i) { const int bidx = i >> 1; const int slot = bidx < c0 ? bidx : 8 + (bidx - c0); return 64 * __builtin_amdgcn_readfirstlane(selL[slot]) + 32 * (i & 1); };
      auto qsf = [&](int i) { return ((i >> 1) < c0) ? 0 : 1; };
      nsa_run<2>(2 * (c0 + c1), (const bf16_t*)(ws + WS_KSN), (const bf16_t*)(ws + WS_VST), kbf, qsf, qf, LUT, imp, tq, h, n, g, qs, 0.f, lsum, Ob, t0, bfar); }
    { const float l = lred(lsum); const float sc = l > 0.f ? g1 / l : 0.f;
#pragma unroll
      for (int i = 0; i < 4; ++i) {
#pragma unroll
          for (int j = 0; j < 4; ++j) imp[(4 * i + j) * 64 + lane] += Ob[i][j] * sc;
          Ob[i] = (f32x4){0.f, 0.f, 0.f, 0.f}; } }
    lsum = 0.f;
    { int lo = t0 - 511; if (lo < 0) lo = 0; lo &= ~31; const int nw = ((t0 + 1 - lo) >> 5) + 1;
      auto kbf = [&](int i) { return lo + 32 * i; };
      nsa_run<3>(nw, (const bf16_t*)(ws + WS_KWN), (const bf16_t*)(ws + WS_VWT), kbf, qs_zero, qf, LUT, imp, tq, h, n, g, qs, 0.f, lsum, Ob, t0, bfar);
      const float l = lred(lsum); const float sc = l > 0.f ? g2 / l : 0.f;
#pragma unroll
      for (int i = 0; i < 4; ++i)
#pragma unroll
          for (int j = 0; j < 4; ++j) Ot[i][j] = imp[(4 * i + j) * 64 + lane] + Ob[i][j] * sc; }
    bf16_t* orow = (bf16_t*)(ws + WS_ONSA) + (size_t)tq * 512 + h * 64;
#pragma unroll
    for (int db = 0; db < 4; ++db) { u32x2 w; w.x = cvt_pk_bf16(Ot[db][0], Ot[db][1]); w.y = cvt_pk_bf16(Ot[db][2], Ot[db][3]); *(u32x2*)(orow + 16 * db + 4 * g) = w; }
}


#define RLX_AGENT __ATOMIC_RELAXED, __HIP_MEMORY_SCOPE_AGENT
#define XB_TMO      128
#define XB_XCNT(j)  (256  + 64 * (j))
#define XB_XSUB(j)  (1280 + 64 * (j))
#define XB_XGEN(j)  (2304 + 64 * (j))
#define XB_TOP      3328
#define XB_TOPGEN   3392
#define XCD_BAR_WORDS 3456
#define XB_SPIN_CAP (1u << 18)

__device__ __forceinline__ unsigned xb_ld(unsigned* p)              { return __hip_atomic_load(p, __ATOMIC_RELAXED, __HIP_MEMORY_SCOPE_AGENT); }
__device__ __forceinline__ unsigned xb_add(unsigned* p, unsigned v) { return __hip_atomic_fetch_add(p, v, __ATOMIC_RELAXED, __HIP_MEMORY_SCOPE_AGENT); }
__device__ __forceinline__ unsigned xb_xcc_id() { return (unsigned)__builtin_amdgcn_s_getreg((3 << 11) | 20) & 0xFu; }
#define XB_SPIN(cond, bar) do { unsigned _sp = 0; while (cond) { __builtin_amdgcn_s_sleep(1); \
    if ((++_sp & 255u) == 0u) { if (xb_ld(&(bar)[XB_TMO])) break; if (_sp > XB_SPIN_CAP) { atomicAdd(&(bar)[XB_TMO], 1u); break; } } } } while (0)

struct XcdBarrier {
    unsigned* bar; unsigned x;
    volatile LAS unsigned* st;
};

__device__ __forceinline__ XcdBarrier xcd_barrier_post(unsigned* bar, volatile LAS unsigned* st) {
    XcdBarrier b; b.bar = bar; b.x = xb_xcc_id(); b.st = st;
    if (threadIdx.x == 0) (void)xb_add(&bar[XB_XCNT(b.x)], 1u);
    return b;
}
__device__ __forceinline__ void xcd_barrier_complete(unsigned* bar, unsigned x, unsigned& nloc, unsigned& nx) {
    const unsigned G = gridDim.x * gridDim.y * gridDim.z;
    unsigned sum, cnt, mine, sp = 0u;
    for (;;) {
        sum = 0u; cnt = 0u; mine = 0u;
#pragma unroll
        for (unsigned j = 0; j < 16; ++j) { const unsigned c = xb_ld(&bar[XB_XCNT(j)]); sum += c; cnt += (c > 0u) ? 1u : 0u; mine = (j == x) ? c : mine; }
        if (sum == G) break;
        __builtin_amdgcn_s_sleep(1);
        if ((++sp & 255u) == 0u) { if (xb_ld(&bar[XB_TMO])) break; if (sp > XB_SPIN_CAP) { atomicAdd(&bar[XB_TMO], 1u); break; } }
    }
    nloc = mine > 0u ? mine : 1u; nx = cnt > 0u ? cnt : 1u;
}

__device__ __forceinline__ void xcd_barrier(const XcdBarrier& b) {
    asm volatile("s_waitcnt vmcnt(0)" ::: "memory");
    __syncthreads();
    if (threadIdx.x == 0) {
        unsigned* bar = b.bar;
        __builtin_amdgcn_s_waitcnt(0);
        unsigned nloc = b.st[0], nx = b.st[1];
        if (nloc == 0u) { xcd_barrier_complete(bar, b.x, nloc, nx); b.st[0] = nloc; b.st[1] = nx; }
        const unsigned old = xb_add(&bar[XB_XSUB(b.x)], 1u);
        const unsigned gen = old / nloc;
        if (old + 1u == (gen + 1u) * nloc) {
            __builtin_amdgcn_fence(__ATOMIC_RELEASE, "agent");
            asm volatile("s_waitcnt vmcnt(0)" ::: "memory");
            const unsigned og = xb_add(&bar[XB_TOP], 1u);
            const unsigned tg = og / nx;
            if (og + 1u == (tg + 1u) * nx) xb_add(&bar[XB_TOPGEN], 1u);
            else XB_SPIN(xb_ld(&bar[XB_TOPGEN]) == tg, bar);
            __builtin_amdgcn_fence(__ATOMIC_ACQUIRE, "agent");
            xb_add(&bar[XB_XGEN(b.x)], 1u);
            asm volatile("s_waitcnt vmcnt(0)" ::: "memory");
        } else {
            XB_SPIN(xb_ld(&bar[XB_XGEN(b.x)]) == gen, bar);
            __builtin_amdgcn_fence(__ATOMIC_ACQUIRE, "agent");
            asm volatile("s_waitcnt vmcnt(0)" ::: "memory");
        }
    }
    __syncthreads();
}

#define GSYNC() xcd_barrier(xbar)
__global__ void __launch_bounds__(512) __attribute__((amdgpu_waves_per_eu(2, 2))) fwd_mega(KArgs a) {
    extern __shared__ __attribute__((aligned(16))) unsigned char lds_raw[];
    LAS unsigned char* lds = (LAS unsigned char*)lds_raw;
    const int G = gridDim.x, bid = blockIdx.x, NGW = G * 8;
    { volatile LAS unsigned* stw = (volatile LAS unsigned*)(lds + 132608); if (threadIdx.x < 2) stw[threadIdx.x] = 0u; }
    __syncthreads();
    XcdBarrier xbar = xcd_barrier_post((unsigned*)(a.ws + WS_CTL), (volatile LAS unsigned*)(lds + 132608));
    cg::this_grid().sync();
#define IDS() int tid = threadIdx.x; asm volatile("" : "+v"(tid)); const int lane = tid & 63, wave = __builtin_amdgcn_readfirstlane(tid >> 6); const int gw = bid * 8 + wave; (void)lane; (void)gw;
    unsigned char* ws = a.ws;
    bf16_t* PROJ = (bf16_t*)(ws + WS_PROJ); bf16_t* HN = (bf16_t*)(ws + WS_HN); bf16_t* HID = (bf16_t*)(ws + WS_HID);
#pragma unroll 1
    for (int l = 0; l < DEPTH; ++l) {
        const float* xsrc = (l == 0) ? a.in[0] : a.out;
        { IDS(); phase_convert(a, l, lds, gw, NGW, wave, lane);
          phase_rms(xsrc, a.in[1] + l * DM, HN, gw, NGW, lane); }
        GSYNC();
        { pg8::Gemm g{HN, (const bf16_t*)(ws + WS_WIN), M, NPAD, DM}; pg8::StaticOrder S; S.init(M, NPAD, G, bid);
          pg8::EpiBf16<0> E{PROJ, NPAD};
          pg8::gemm_phase<pg8::EpiBf16<0>, pg8::StaticOrder, true, true>(lds, g, S, E); }
        GSYNC();
        { IDS(); for (int it = bid; it < 256; it += G) pre_item(a, l, lds, it, tid); }
        { IDS(); for (int it = bid; it < 128; it += G) cmp_item(a, l, lds, it, tid, wave, lane); }
        { IDS(); for (int it = bid; it < 2048; it += G) gla_g1_item(a, l, lds, it, tid, wave, lane); }
        GSYNC();
        {   IDS();
            { const float* lg = (const float*)(ws + WS_LUT); LAS float* LUT = (LAS float*)lds; for (int i = tid; i < 8192; i += 512) LUT[i] = lg[i]; }
            LAS int* ctr = (LAS int*)(lds + 132096);
            LAS unsigned* sbc = (LAS unsigned*)(lds + 132112);
            if (tid == 0) { *ctr = 0; *sbc = 0u; }
            __syncthreads();
            if (wave < 4) {
                unsigned gen = 0u;
                for (int pp = bid; pp < 512; pp += G) {
                    const int hh = pp & 3, q = pp >> 2;
                    sb_unit4(a, lds + 65536, sbc, gen, hh, 255 - q, wave, lane);
                    sb_unit4(a, lds + 65536, sbc, gen, hh, q, wave, lane); }
            } else {
                for (int c0 = (bid * 4 + (wave - 4)) * 64; c0 < 65536; c0 += G * 256) gla_scan(a, c0 + lane);
            }
            LAS float* imp = (LAS float*)(lds + (wave < 4 ? 65536 + wave * 8192 : 32768 + (wave - 4) * 8192));
            LAS int* selL = (LAS int*)(lds + 131072 + wave * 128);
            const int nper = (8192 + G - 1) / G;
            for (;;) { int idx = 0; if (lane == 0) idx = atomicAdd((int*)ctr, 1); idx = __builtin_amdgcn_readfirstlane(idx);
                if (idx >= nper) break; const int hn = nper >> 1; const int unit = (idx < hn) ? (8192 - hn * (bid + 1) + idx) : (hn * bid + (idx - hn)); if (unit >= 0 && unit < 8192) nsa_unit(a, lds, unit, imp, selL, lane); }
            __syncthreads();
        }
        GSYNC();
        { IDS(); for (int it = bid; it < 2048; it += G) gla_g3_item(a, l, lds, it, tid, wave, lane); }
        GSYNC();
        for (int b = 0; b < 3; ++b) {
            pg8::Gemm g{(const bf16_t*)(ws + WS_OGLA + b * 16 * MiB), (const bf16_t*)(ws + WS_WBR + b * MiB), M, DM, 512}; pg8::StaticOrder S; S.init(M, DM, G, bid);
            pg8::EpiGate E{HN, PROJ + C_MGATE + b * DM, NPAD, b == 0 ? 1 : 0};
            pg8::gemm_phase<pg8::EpiGate, pg8::StaticOrder, true, true>(lds, g, S, E); }
        GSYNC();
        { pg8::Gemm g{HN, (const bf16_t*)(ws + WS_WOUT), M, DM, DM}; pg8::StaticOrder S; S.init(M, DM, G, bid);
          pg8::EpiRes E{xsrc, a.out};
          pg8::gemm_phase<pg8::EpiRes, pg8::StaticOrder, true, true>(lds, g, S, E); }
        GSYNC();
        { IDS(); phase_rms(a.out, a.in[2] + l * DM, HN, gw, NGW, lane); }
        GSYNC();
        { pg8::Gemm g{HN, (const bf16_t*)(ws + WS_WUP), M, FF, DM}; pg8::StaticOrder S; S.init(M, FF, G, bid);
          pg8::EpiBf16<2> E{HID, FF};
          pg8::gemm_phase<pg8::EpiBf16<2>, pg8::StaticOrder, true, true>(lds, g, S, E); }
        GSYNC();
        { pg8::Gemm g{HID, (const bf16_t*)(ws + WS_WDN), M, DM, FF}; pg8::StaticOrder S; S.init(M, DM, G, bid);
          pg8::EpiRes E{a.out, a.out};
          pg8::gemm_phase<pg8::EpiRes, pg8::StaticOrder, true, true>(lds, g, S, E); }
        GSYNC();
    }
}

extern "C" void kernel_launch(void* const* d_in, const int* in_sizes, int n_in, void* d_out, int out_size, void* d_ws, size_t ws_size, hipStream_t stream) {
    static int grid = 0;
    if (grid == 0) {
        if (n_in != 22 || ws_size < WS_END + 65536) { fprintf(stderr, "kernel_launch: unexpected n_in %d or ws_size %zu (< %zu)\n", n_in, ws_size, (size_t)WS_END); grid = -1; return; }
        int dev = 0, cus = 0, per_cu = 0;
        hipGetDevice(&dev); hipDeviceGetAttribute(&cus, hipDeviceAttributeMultiprocessorCount, dev);
        hipFuncSetAttribute((const void*)fwd_mega, hipFuncAttributeMaxDynamicSharedMemorySize, LDS_BYTES);
        hipOccupancyMaxActiveBlocksPerMultiprocessor(&per_cu, (const void*)fwd_mega, 512, LDS_BYTES);
        if (per_cu < 1) { fprintf(stderr, "kernel_launch: occupancy query says %d blocks/CU\n", per_cu); per_cu = 1; }
        (void)hipGetLastError();
        grid = cus * 1;
    }
    if (grid < 0) return;
    if (hipMemsetAsync((char*)d_ws + WS_CTL, 0, 65536, stream) != hipSuccess) { fprintf(stderr, "kernel_launch: memset of barrier words failed\n"); return; }
    KArgs a{};
    for (int i = 0; i < 22; ++i) a.in[i] = (const float*)d_in[i];
    a.out = (float*)d_out; a.ws = (unsigned char*)d_ws;
    void* args[] = {&a};
    hipError_t e = hipLaunchCooperativeKernel((const void*)fwd_mega, dim3(grid), dim3(512), args, LDS_BYTES, stream);
    if (e != hipSuccess) fprintf(stderr, "cooperative launch failed: %s (grid %d)\n", hipGetErrorString(e), grid);
}
```

```cpp
#include <hip/hip_runtime.h>
#include <hip/hip_cooperative_groups.h>
#include <cstdio>
#include <cstdint>
namespace cg = cooperative_groups;
namespace pg8 {
#define PG8_LAS __attribute__((address_space(3)))
typedef unsigned short bf16_t;
typedef short bf16x8 __attribute__((ext_vector_type(8)));
typedef float f32x4 __attribute__((ext_vector_type(4)));
typedef unsigned u32x4 __attribute__((ext_vector_type(4)));
constexpr int BM = 256, BK = 64, HALF = 128, HTB = HALF * BK * 2  , STAGE_BYTES = 8 * HTB, NXCD = 8, WGM = 8;

__host__ __device__ __forceinline__ int lds_byte(int r, int c) { const int st = (r >> 4) * 2 + (c >> 5), rr = r & 15, cc = c & 31, ob = rr * 64 + cc * 2; return st * 1024 + (ob ^ (((ob >> 9) & 1) << 5)); }
__host__ __device__ __forceinline__ void stage_rc(int b, int& R, int& C) { const int st = b / 1024, sb = b % 1024, swz = sb ^ (((sb >> 9) & 1) << 5); R = (st >> 1) * 16 + swz / 64; C = (st & 1) * 32 + (swz % 64) / 2; }
__host__ __device__ __forceinline__ int perm32(int rho) { const int n = rho >> 4, i = rho & 15; return 8 * (i >> 2) + 4 * n + (i & 3); }

struct Unit { int pm, pn; };
struct Gemm { const bf16_t* A; const bf16_t* Bt; int M, N, K; };

struct StaticOrder {
    int nM, nN, nwg, G, c;
    __host__ __device__ void init(int M, int N, int G_, int c_) { nM = M / BM; nN = N / BM; nwg = nM * nN; G = G_; c = c_; }
    __host__ __device__ bool next(int i, Unit& u) const {
        const long L = (long)i * G + c; if (L >= nwg) return false;
        int wgid = (int)L; { const int q = nwg / NXCD, r = nwg % NXCD, xcd = wgid % NXCD, off = wgid / NXCD; wgid = (xcd < r ? xcd * (q + 1) : r * (q + 1) + (xcd - r) * q) + off; }
        const int nig = WGM * nN, gid = wgid / nig, fm = gid * WGM, gsz = (nM - fm) < WGM ? (nM - fm) : WGM;
        u.pm = fm + ((wgid % nig) % gsz); u.pn = (wgid % nig) / gsz; return true;
    }
    __device__ __forceinline__ void a_ready(const Unit&) const {}
    __device__ __forceinline__ void done(const Unit&) const {}
};

__device__ __forceinline__ unsigned cvt_pk_bf16(float lo, float hi) { unsigned r; asm("v_cvt_pk_bf16_f32 %0, %1, %2" : "=v"(r) : "v"(lo), "v"(hi)); return r; }
__device__ __forceinline__ float bflo(unsigned w) { return __uint_as_float(w << 16); }
__device__ __forceinline__ float bfhi(unsigned w) { return __uint_as_float(w & 0xffff0000u); }
template <int ACT> struct EpiBf16 {
    static constexpr bool PERM = true, AFTER_DRAIN = false;
    bf16_t* O; int ldc;
    __device__ __forceinline__ void operator()(const f32x4 (&acc)[2][2][4][2], const Unit& u, int wr, int wc, int fr, int fq) const {
        const int row0 = u.pm * BM + wr * 64 + fr; const int col0 = u.pn * BM + wc * 32 + 8 * fq;
#pragma unroll
        for (int ai = 0; ai < 2; ++ai)
#pragma unroll
            for (int m = 0; m < 4; ++m) { bf16_t* rowp = O + (size_t)(row0 + ai * HALF + m * 16) * ldc + col0;
#pragma unroll
                for (int bj = 0; bj < 2; ++bj) { f32x4 v0 = acc[ai][bj][m][0], v1 = acc[ai][bj][m][1];
                    if (ACT == 2) {
#pragma unroll
                        for (int e = 0; e < 4; ++e) { float a = fmaxf(v0[e], 0.f), b = fmaxf(v1[e], 0.f); v0[e] = a * a; v1[e] = b * b; } }
                    u32x4 w; w.x = cvt_pk_bf16(v0[0], v0[1]); w.y = cvt_pk_bf16(v0[2], v0[3]); w.z = cvt_pk_bf16(v1[0], v1[1]); w.w = cvt_pk_bf16(v1[2], v1[3]);
                    *(u32x4*)(rowp + bj * HALF) = w; } }
    }
};
struct EpiGate {
    static constexpr bool PERM = true, AFTER_DRAIN = false;
    bf16_t* O; const bf16_t* gate; int gld; int first;
    __device__ __forceinline__ void operator()(const f32x4 (&acc)[2][2][4][2], const Unit& u, int wr, int wc, int fr, int fq) const {
        const int row0 = u.pm * BM + wr * 64 + fr; const int col0 = u.pn * BM + wc * 32 + 8 * fq;
#pragma unroll
        for (int ai = 0; ai < 2; ++ai)
#pragma unroll
            for (int m = 0; m < 4; ++m) { const int row = row0 + ai * HALF + m * 16; bf16_t* rowp = O + (size_t)row * 1024 + col0; const bf16_t* gp = gate + (size_t)row * gld + col0;
#pragma unroll
                for (int bj = 0; bj < 2; ++bj) { const f32x4 v0 = acc[ai][bj][m][0], v1 = acc[ai][bj][m][1];
                    const u32x4 gw = *(const u32x4*)(gp + bj * HALF);
                    u32x4 ow = (u32x4){0u, 0u, 0u, 0u}; if (!first) ow = *(const u32x4*)(rowp + bj * HALF);
                    float gv[8] = {bflo(gw.x), bfhi(gw.x), bflo(gw.y), bfhi(gw.y), bflo(gw.z), bfhi(gw.z), bflo(gw.w), bfhi(gw.w)};
                    float ov[8] = {bflo(ow.x), bfhi(ow.x), bflo(ow.y), bfhi(ow.y), bflo(ow.z), bfhi(ow.z), bflo(ow.w), bfhi(ow.w)};
                    float av[8] = {v0[0], v0[1], v0[2], v0[3], v1[0], v1[1], v1[2], v1[3]};
                    float r[8];
#pragma unroll
                    for (int e = 0; e < 8; ++e) { const float s = 1.f / (1.f + __expf(-gv[e])); r[e] = ov[e] + s * av[e]; }
                    u32x4 w; w.x = cvt_pk_bf16(r[0], r[1]); w.y = cvt_pk_bf16(r[2], r[3]); w.z = cvt_pk_bf16(r[4], r[5]); w.w = cvt_pk_bf16(r[6], r[7]);
                    *(u32x4*)(rowp + bj * HALF) = w; } }
    }
};
struct EpiRes {
    static constexpr bool PERM = false, AFTER_DRAIN = false;
    const float* src; float* out;
    __device__ __forceinline__ void operator()(const f32x4 (&acc)[2][2][4][2], const Unit& u, int wr, int wc, int fr, int fq) const {
        const int col0 = u.pn * BM + wc * 32 + 4 * fq;
#pragma unroll
        for (int ai = 0; ai < 2; ++ai)
#pragma unroll
            for (int m = 0; m < 4; ++m) { const size_t off = (size_t)(u.pm * BM + ai * HALF + wr * 64 + m * 16 + fr) * 1024 + col0;
#pragma unroll
                for (int bj = 0; bj < 2; ++bj)
#pragma unroll
                    for (int n = 0; n < 2; ++n) { const f32x4 bs = *(const f32x4*)(src + off + bj * HALF + n * 16); *(f32x4*)(out + off + bj * HALF + n * 16) = bs + acc[ai][bj][m][n]; } }
    }
};
template <class Epi, class Sched, bool ALIGN_EPI = false, bool SP2 = false>
__device__ __forceinline__ void gemm_phase(PG8_LAS unsigned char* lds, const Gemm g, const Sched& S, const Epi& E) {
    int tid_ = threadIdx.x; asm volatile("" : "+v"(tid_));
    const int tid = tid_, wid = __builtin_amdgcn_readfirstlane(tid >> 6), lane = tid & 63, wr = wid >> 2, wc = wid & 3, fr = lane & 15, fq = lane >> 4;
    const int K = g.K, nt = K / BK;
    unsigned voffA[2], voffB[2];
#pragma unroll
    for (int i = 0; i < 2; ++i) { int R, C; stage_rc(tid * 16 + i * 8192, R, C); const int Rb = Epi::PERM ? ((R & ~31) + perm32(R & 31)) : R;
        voffA[i] = (unsigned)(R * K + C) * 2u; voffB[i] = (unsigned)(Rb * K + C) * 2u; }
    const size_t kstep = (size_t)(BK * 2);
    const size_t hstep = (size_t)HALF * K * 2;
    const size_t tstep = 2 * hstep;
    const unsigned ldsw = (unsigned)wid * 1024u;
    const int aoff = lds_byte(wr * 64 + fr, fq * 8), boff = lds_byte(wc * 32 + fr, fq * 8);
#define PG8_SA(b, h) (((b) * 2 + (h)) * HTB)
#define PG8_SB(b, h) ((4 + (b) * 2 + (h)) * HTB)
#define PG8_STAGE(bufoff, gbase, voff) do { _Pragma("unroll") for (int _i = 0; _i < 2; ++_i) \
        __builtin_amdgcn_global_load_lds((const unsigned*)((const char*)(gbase) + (voff)[_i]), (PG8_LAS unsigned*)(lds + (bufoff) + ldsw + _i * 8192), 16, 0, 0); } while (0)
#define PG8_LDA(dst, b, h) do { _Pragma("unroll") for (int m = 0; m < 4; ++m) _Pragma("unroll") for (int k = 0; k < 2; ++k) dst[m][k] = *(const PG8_LAS bf16x8*)(lds + PG8_SA(b, h) + aoff + m * 2048 + k * 1024); } while (0)
#define PG8_LDB(dst, b, h) do { _Pragma("unroll") for (int n = 0; n < 2; ++n) _Pragma("unroll") for (int k = 0; k < 2; ++k) dst[n][k] = *(const PG8_LAS bf16x8*)(lds + PG8_SB(b, h) + boff + n * 2048 + k * 1024); } while (0)
#define PG8_MMA(ai, bj, At, Bt) do { __builtin_amdgcn_s_setprio(1); _Pragma("unroll") for (int m = 0; m < 4; ++m) _Pragma("unroll") for (int n = 0; n < 2; ++n) _Pragma("unroll") for (int k = 0; k < 2; ++k) \
        acc[ai][bj][m][n] = __builtin_amdgcn_mfma_f32_16x16x32_bf16(Bt[n][k], At[m][k], acc[ai][bj][m][n], 0, 0, 0); __builtin_amdgcn_s_setprio(0); } while (0)
#define PG8_WAIT_V(n) asm volatile("s_waitcnt vmcnt(" #n ")" ::: "memory")
#define PG8_WAIT_L(n) asm volatile("s_waitcnt lgkmcnt(" #n ")" ::: "memory")
#define PG8_BAR __builtin_amdgcn_s_barrier()
#define PG8_SCHED __builtin_amdgcn_sched_barrier(0)
    Unit cur, nxt; int ui = 0;
    if (!S.next(0, cur)) return;
    f32x4 acc[2][2][4][2];
#pragma unroll
    for (int a = 0; a < 2; ++a)
#pragma unroll
        for (int b = 0; b < 2; ++b)
#pragma unroll
            for (int m = 0; m < 4; ++m)
#pragma unroll
                for (int n = 0; n < 2; ++n) acc[a][b][m][n] = (f32x4){0.f, 0.f, 0.f, 0.f};
    bf16x8 At[4][2], B0[2][2], B1[2][2];
    const char* cA = (const char*)g.A + (size_t)cur.pm * tstep; const char* cB = (const char*)g.Bt + (size_t)cur.pn * tstep;
    S.a_ready(cur);
    if constexpr (SP2) {
        PG8_STAGE(PG8_SB(0, 0), cB, voffB); PG8_STAGE(PG8_SB(0, 1), cB + hstep, voffB); PG8_STAGE(PG8_SA(0, 0), cA, voffA); PG8_STAGE(PG8_SA(0, 1), cA + hstep, voffA);
        if (wr == 1) PG8_BAR;
        PG8_WAIT_V(2); PG8_BAR;
        PG8_STAGE(PG8_SB(1, 0), cB + kstep, voffB); PG8_STAGE(PG8_SA(1, 0), cA + kstep, voffA); PG8_STAGE(PG8_SB(1, 1), cB + hstep + kstep, voffB);
        PG8_WAIT_V(6); PG8_BAR;
    } else {
        PG8_STAGE(PG8_SB(0, 0), cB, voffB); PG8_STAGE(PG8_SA(0, 0), cA, voffA); PG8_STAGE(PG8_SB(0, 1), cB + hstep, voffB); PG8_STAGE(PG8_SA(0, 1), cA + hstep, voffA);
        if (wr == 1) PG8_BAR;
        PG8_WAIT_V(4); PG8_BAR;
        PG8_STAGE(PG8_SB(1, 0), cB + kstep, voffB); PG8_STAGE(PG8_SA(1, 0), cA + kstep, voffA); PG8_STAGE(PG8_SB(1, 1), cB + hstep + kstep, voffB);
        PG8_WAIT_V(6); PG8_BAR;
    }
    for (;;) {
        const bool has_next = S.next(ui + 1, nxt);
        const char* nA = has_next ? (const char*)g.A + (size_t)nxt.pm * tstep : cA; const char* nB = has_next ? (const char*)g.Bt + (size_t)nxt.pn * tstep : cB;
        for (int t = 0; t < nt; t += 2) {
            const bool last = (t == nt - 2);
            const char* a1 = cA + (size_t)(t + 1) * kstep;
            const char* a2 = last ? nA : cA + (size_t)(t + 2) * kstep; const char* b2 = last ? nB : cB + (size_t)(t + 2) * kstep;
            const char* a3 = a2 + kstep; const char* b3 = b2 + kstep;
            if (last && has_next) S.a_ready(nxt);
            if constexpr (SP2) {
            PG8_LDB(B0, 0, 0); PG8_LDB(B1, 0, 1); PG8_SCHED; PG8_LDA(At, 0, 0); PG8_STAGE(PG8_SA(1, 1), a1 + hstep, voffA);
            PG8_WAIT_V(8); PG8_WAIT_L(0); PG8_BAR; PG8_MMA(0, 0, At, B0); PG8_MMA(0, 1, At, B1); PG8_BAR; PG8_SCHED;
            PG8_LDA(At, 0, 1); PG8_STAGE(PG8_SB(0, 0), b2, voffB); PG8_STAGE(PG8_SB(0, 1), b2 + hstep, voffB); PG8_STAGE(PG8_SA(0, 0), a2, voffA);
            PG8_WAIT_V(8); PG8_WAIT_L(0); PG8_BAR; PG8_MMA(1, 0, At, B0); PG8_MMA(1, 1, At, B1); PG8_BAR; PG8_SCHED;
            PG8_LDB(B0, 1, 0); PG8_LDB(B1, 1, 1); PG8_SCHED; PG8_LDA(At, 1, 0); PG8_STAGE(PG8_SA(0, 1), a2 + hstep, voffA);
            PG8_WAIT_V(8); PG8_WAIT_L(0); PG8_BAR; PG8_MMA(0, 0, At, B0); PG8_MMA(0, 1, At, B1); PG8_BAR; PG8_SCHED;
            PG8_LDA(At, 1, 1); PG8_STAGE(PG8_SB(1, 0), b3, voffB); PG8_STAGE(PG8_SB(1, 1), b3 + hstep, voffB); PG8_STAGE(PG8_SA(1, 0), a3, voffA);
            PG8_WAIT_V(8); PG8_WAIT_L(0); PG8_BAR; PG8_MMA(1, 0, At, B0); PG8_MMA(1, 1, At, B1); PG8_BAR; PG8_SCHED;
            } else {
            PG8_LDB(B0, 0, 0); PG8_SCHED; PG8_LDA(At, 0, 0); PG8_STAGE(PG8_SA(1, 1), a1 + hstep, voffA);
            PG8_WAIT_L(8); PG8_BAR; PG8_WAIT_L(0); PG8_MMA(0, 0, At, B0); PG8_BAR; PG8_SCHED;
            PG8_LDB(B1, 0, 1); PG8_STAGE(PG8_SB(0, 0), b2, voffB);
            PG8_BAR; PG8_WAIT_L(0); PG8_MMA(0, 1, At, B1); PG8_BAR;
            PG8_LDA(At, 0, 1); PG8_STAGE(PG8_SA(0, 0), a2, voffA);
            PG8_BAR; PG8_WAIT_L(0); PG8_MMA(1, 0, At, B0); PG8_BAR; PG8_SCHED;
            PG8_STAGE(PG8_SB(0, 1), b2 + hstep, voffB);
            PG8_WAIT_V(6); PG8_BAR; PG8_MMA(1, 1, At, B1); PG8_BAR;
            PG8_LDB(B0, 1, 0); PG8_SCHED; PG8_LDA(At, 1, 0); PG8_STAGE(PG8_SA(0, 1), a2 + hstep, voffA);
            PG8_WAIT_L(8); PG8_BAR; PG8_WAIT_L(0); PG8_MMA(0, 0, At, B0); PG8_BAR; PG8_SCHED;
            PG8_LDB(B1, 1, 1); PG8_STAGE(PG8_SB(1, 0), b3, voffB);
            PG8_BAR; PG8_WAIT_L(0); PG8_MMA(0, 1, At, B1); PG8_BAR;
            PG8_LDA(At, 1, 1); PG8_STAGE(PG8_SA(1, 0), a3, voffA);
            PG8_BAR; PG8_WAIT_L(0); PG8_MMA(1, 0, At, B0); PG8_BAR; PG8_SCHED;
            PG8_STAGE(PG8_SB(1, 1), b3 + hstep, voffB);
            PG8_WAIT_V(6); PG8_BAR; PG8_MMA(1, 1, At, B1); PG8_BAR;
            }
        }
        if constexpr (ALIGN_EPI) { if (wr == 0) PG8_BAR; }
        if constexpr (!Epi::AFTER_DRAIN) { E(acc, cur, wr, wc, fr, fq); S.done(cur); }
        if (!has_next) break;
#pragma unroll
        for (int a = 0; a < 2; ++a)
#pragma unroll
            for (int b = 0; b < 2; ++b)
#pragma unroll
                for (int m = 0; m < 4; ++m)
#pragma unroll
                    for (int n = 0; n < 2; ++n) acc[a][b][m][n] = (f32x4){0.f, 0.f, 0.f, 0.f};
        cur = nxt; cA = nA; cB = nB; ++ui;
        if constexpr (ALIGN_EPI) { if (wr == 1) PG8_BAR; }
    }
    PG8_WAIT_V(0);
    if constexpr (!ALIGN_EPI) { if (wr == 0) PG8_BAR; }
    PG8_BAR;
    if constexpr (Epi::AFTER_DRAIN) { E.fused(acc, cur, wr, wc, fr, fq, lds, wid, lane); S.done(cur); }
#undef PG8_SA
#undef PG8_SB
#undef PG8_STAGE
#undef PG8_LDA
#undef PG8_LDB
#undef PG8_MMA
#undef PG8_WAIT_V
#undef PG8_WAIT_L
#undef PG8_BAR
#undef PG8_SCHED
}
}

#define LAS __attribute__((address_space(3)))
typedef unsigned short bf16_t;
typedef short bf16x8 __attribute__((ext_vector_type(8)));
typedef float f32x4 __attribute__((ext_vector_type(4)));
typedef unsigned u32x4 __attribute__((ext_vector_type(4)));
typedef unsigned u32x2 __attribute__((ext_vector_type(2)));
using pg8::cvt_pk_bf16; using pg8::bflo; using pg8::bfhi;

constexpr int M = 16384, DM = 1024, NIN = 7592, NPAD = 7680, FF = 4096, DEPTH = 4;
constexpr int C_GQ = 0, C_GK = 512, C_GV = 1024, C_GA = 1536, C_GR = 1552, C_SQ = 2064, C_SK = 2576, C_SV = 3088, C_NQ = 3600, C_NKC = 4112, C_NVC = 4176,
              C_NKS = 4240, C_NVS = 4304, C_NKW = 4368, C_NVW = 4432, C_NGATE = 4496, C_MGATE = 4520;
constexpr size_t MiB = 1u << 20;
constexpr size_t WS_PROJ = 0, WS_HID = 0, WS_HN = 240 * MiB, WS_OGLA = 272 * MiB, WS_OSB = 288 * MiB, WS_ONSA = 304 * MiB;
constexpr size_t WS_WIN = 320 * MiB, WS_WUP = 335 * MiB, WS_WDN = 343 * MiB, WS_WOUT = 351 * MiB, WS_WBR = 353 * MiB, WS_WK1 = 356 * MiB, WS_WV1 = 357 * MiB,
                 WS_WK2 = 358 * MiB, WS_WV2 = 358 * MiB + 65536, WS_CB = 358 * MiB + 131072, WS_LUT = 358 * MiB + 196608;
constexpr size_t WS_GST = 360 * MiB, WS_GDC = 424 * MiB, WS_SVT = 425 * MiB, WS_QN = 441 * MiB, WS_KSN = 457 * MiB, WS_KWN = 459 * MiB, WS_VST = 461 * MiB, WS_VWT = 463 * MiB,
                 WS_KCMP = 465 * MiB, WS_VCMPT = 465 * MiB + 131072, WS_END = 466 * MiB, WS_CTL = 466 * MiB;
constexpr int LDS_BYTES = 133120;
constexpr float LOG2E = 1.4426950408889634f;

struct KArgs { const float* in[22]; float* out; unsigned char* ws; };

__device__ __forceinline__ float bf2f(bf16_t v) { return __uint_as_float(((unsigned)v) << 16); }
__device__ __forceinline__ bf16_t f2bf(float f) { unsigned u = __float_as_uint(f); return (bf16_t)((u + 0x7fffu + ((u >> 16) & 1u)) >> 16); }
__device__ __forceinline__ f32x4 mfma16(bf16x8 a, bf16x8 b, f32x4 c) { return __builtin_amdgcn_mfma_f32_16x16x32_bf16(a, b, c, 0, 0, 0); }
__device__ __forceinline__ float wave_sum(float v) {
#pragma unroll
    for (int o = 1; o < 64; o <<= 1) v += __shfl_xor(v, o);
    return v;
}
#define LDS_FENCE() asm volatile("s_waitcnt lgkmcnt(0)" ::: "memory")
#define SCHED_FENCE_G() __builtin_amdgcn_sched_barrier(0)
__device__ __forceinline__ void unpack8(const u32x4 w, float (&f)[8]) { f[0] = bflo(w.x); f[1] = bfhi(w.x); f[2] = bflo(w.y); f[3] = bfhi(w.y); f[4] = bflo(w.z); f[5] = bfhi(w.z); f[6] = bflo(w.w); f[7] = bfhi(w.w); }
__device__ __forceinline__ u32x4 pack8(const float (&r)[8]) { u32x4 w; w.x = cvt_pk_bf16(r[0], r[1]); w.y = cvt_pk_bf16(r[2], r[3]); w.z = cvt_pk_bf16(r[4], r[5]); w.w = cvt_pk_bf16(r[6], r[7]); return w; }

__device__ __forceinline__ void transpose_item(const float* W, int K, int N, int Npad, bf16_t* WT, LAS float* scr, int item, int lane) {
    const int nblk = Npad / 32, kb = item / nblk, nb = item % nblk, k0 = 64 * kb, n0 = 32 * nb;
    const int nn = n0 + (lane & 31);
    float tv[32];
#pragma unroll
    for (int i = 0; i < 32; ++i) { const int kk = 2 * i + (lane >> 5); tv[i] = (nn < N) ? W[(size_t)(k0 + kk) * N + nn] : 0.f; }
#pragma unroll
    for (int i = 0; i < 32; ++i) { const int kk = 2 * i + (lane >> 5); scr[kk * 33 + (lane & 31)] = tv[i]; }
    LDS_FENCE();
    const int c = lane & 7;
#pragma unroll
    for (int j = 0; j < 4; ++j) { const int n = (lane >> 3) + 8 * j; const LAS float* s = scr + (8 * c) * 33 + n;
        u32x4 o; o.x = cvt_pk_bf16(s[0 * 33], s[1 * 33]); o.y = cvt_pk_bf16(s[2 * 33], s[3 * 33]); o.z = cvt_pk_bf16(s[4 * 33], s[5 * 33]); o.w = cvt_pk_bf16(s[6 * 33], s[7 * 33]);
        *(u32x4*)(WT + (size_t)(n0 + n) * K + k0 + 8 * c) = o; }
    LDS_FENCE();
}
__device__ __forceinline__ int rel_bucket(int n) {
    if (n < 16) return n;
    int large = 16 + (int)(logf((float)n / 16.f) / 4.1588830833596715f * 16.f);
    return large < 31 ? large : 31;
}
__device__ __forceinline__ void rms_row(const float* xrow, const float* g, bf16_t* orow, int lane) {
    const f32x4* xr = (const f32x4*)xrow + lane; f32x4 v[4]; float s = 0.f;
#pragma unroll
    for (int j = 0; j < 4; ++j) { v[j] = xr[64 * j]; s += (v[j].x * v[j].x + v[j].y * v[j].y) + (v[j].z * v[j].z + v[j].w * v[j].w); }
    const float rinv = rsqrtf(wave_sum(s) * (1.f / 1024.f) + 1e-6f);
    u32x2* o8 = (u32x2*)orow + lane;
#pragma unroll
    for (int j = 0; j < 4; ++j) { const f32x4 gg = ((const f32x4*)g)[lane + 64 * j]; u32x2 w; w.x = cvt_pk_bf16(v[j].x * rinv * gg.x, v[j].y * rinv * gg.y); w.y = cvt_pk_bf16(v[j].z * rinv * gg.z, v[j].w * rinv * gg.w); o8[64 * j] = w; }
}
__device__ __forceinline__ void phase_convert(const KArgs& a, int l, LAS unsigned char* lds, int gw, int NGW, int wave, int lane) {
    unsigned char* ws = a.ws;
    LAS float* scr = (LAS float*)(lds + wave * 8704);
    constexpr int I0 = 16 * 240, I1 = 16 * 128, I2 = 64 * 32, I3 = 16 * 32, I4 = 8 * 32, I7 = 32 * 8, I9 = 4 * 2, IB = 128, IL = 128;
    constexpr int NIT = I0 + I1 + I2 + I3 + 3 * I4 + 2 * I7 + 2 * I9 + IB + IL;
    for (int it = gw; it < NIT; it += NGW) {
        int r = it;
        if (r < I0) { transpose_item(a.in[3] + (size_t)l * DM * NIN, DM, NIN, NPAD, (bf16_t*)(ws + WS_WIN), scr, r, lane); continue; } r -= I0;
        if (r < I1) { transpose_item(a.in[20] + (size_t)l * DM * FF, DM, FF, FF, (bf16_t*)(ws + WS_WUP), scr, r, lane); continue; } r -= I1;
        if (r < I2) { transpose_item(a.in[21] + (size_t)l * FF * DM, FF, DM, DM, (bf16_t*)(ws + WS_WDN), scr, r, lane); continue; } r -= I2;
        if (r < I3) { transpose_item(a.in[19] + (size_t)l * DM * DM, DM, DM, DM, (bf16_t*)(ws + WS_WOUT), scr, r, lane); continue; } r -= I3;
        if (r < 3 * I4) { const int b = r / I4; transpose_item(a.in[16 + b] + (size_t)l * 512 * DM, 512, DM, DM, (bf16_t*)(ws + WS_WBR + b * MiB), scr, r % I4, lane); continue; } r -= 3 * I4;
        if (r < I7) { transpose_item(a.in[11] + (size_t)l * 2048 * 256, 2048, 256, 256, (bf16_t*)(ws + WS_WK1), scr, r, lane); continue; } r -= I7;
        if (r < I7) { transpose_item(a.in[13] + (size_t)l * 2048 * 256, 2048, 256, 256, (bf16_t*)(ws + WS_WV1), scr, r, lane); continue; } r -= I7;
        if (r < I9) { transpose_item(a.in[12] + (size_t)l * 256 * 64, 256, 64, 64, (bf16_t*)(ws + WS_WK2), scr, r, lane); continue; } r -= I9;
        if (r < I9) { transpose_item(a.in[14] + (size_t)l * 256 * 64, 256, 64, 64, (bf16_t*)(ws + WS_WV2), scr, r, lane); continue; } r -= I9;
        if (r < IB) {
            const int p = r >> 3, which = (r >> 2) & 1, col = (r & 3) * 64 + lane;
            const float* pe = a.in[which ? 10 : 9] + (size_t)l * 2048; const float* w1 = a.in[which ? 13 : 11] + (size_t)l * 2048 * 256;
            float s = 0.f;
#pragma unroll 1
            for (int k0 = 128 * p; k0 < 128 * p + 128; k0 += 16) { float wv[16];
#pragma unroll
                for (int i = 0; i < 16; ++i) wv[i] = w1[(size_t)(k0 + i) * 256 + col];
#pragma unroll
                for (int i = 0; i < 16; ++i) s += pe[k0 + i] * wv[i]; }
            ((float*)(ws + WS_CB))[p * 512 + which * 256 + col] = s; continue; } r -= IB;
        {
            const int idx = r * 64 + lane; const int d = idx >> 3, h = idx & 7;
            ((float*)(ws + WS_LUT))[idx] = a.in[15][rel_bucket(d) * 8 + h] * LOG2E; }
    }
}
__device__ __forceinline__ void phase_rms(const float* x, const float* g, bf16_t* hn, int gw, int NGW, int lane) {
    f32x4 gg[4];
#pragma unroll
    for (int j = 0; j < 4; ++j) gg[j] = ((const f32x4*)g)[lane + 64 * j];
    for (int m = gw; m < M; m += 2 * NGW) { const int m2 = (m + NGW < M) ? m + NGW : m;
        const f32x4* xa = (const f32x4*)(x + (size_t)m * DM) + lane; const f32x4* xb = (const f32x4*)(x + (size_t)m2 * DM) + lane;
        f32x4 va[4], vb[4]; float sa = 0.f, sb = 0.f;
#pragma unroll
        for (int j = 0; j < 4; ++j) { va[j] = xa[64 * j]; vb[j] = xb[64 * j]; }
#pragma unroll
        for (int j = 0; j < 4; ++j) { sa += (va[j].x * va[j].x + va[j].y * va[j].y) + (va[j].z * va[j].z + va[j].w * va[j].w); sb += (vb[j].x * vb[j].x + vb[j].y * vb[j].y) + (vb[j].z * vb[j].z + vb[j].w * vb[j].w); }
#pragma unroll
        for (int o = 1; o < 64; o <<= 1) { sa += __shfl_xor(sa, o); sb += __shfl_xor(sb, o); }
        const float ra = rsqrtf(sa * (1.f / 1024.f) + 1e-6f), rb = rsqrtf(sb * (1.f / 1024.f) + 1e-6f);
        u32x2* oa = (u32x2*)(hn + (size_t)m * DM) + lane; u32x2* ob = (u32x2*)(hn + (size_t)m2 * DM) + lane;
#pragma unroll
        for (int j = 0; j < 4; ++j) { u32x2 w; w.x = cvt_pk_bf16(va[j].x * ra * gg[j].x, va[j].y * ra * gg[j].y); w.y = cvt_pk_bf16(va[j].z * ra * gg[j].z, va[j].w * ra * gg[j].w); oa[64 * j] = w;
            u32x2 w2; w2.x = cvt_pk_bf16(vb[j].x * rb * gg[j].x, vb[j].y * rb * gg[j].y); w2.y = cvt_pk_bf16(vb[j].z * rb * gg[j].z, vb[j].w * rb * gg[j].w); ob[64 * j] = w2; } }
}

__device__ __forceinline__ void rms64_to(const bf16_t* src, const float* g, float scale, bf16_t* dst) {
    u32x4 w[8]; float ss = 0.f;
#pragma unroll
    for (int i = 0; i < 8; ++i) { w[i] = ((const u32x4*)src)[i]; float f[8]; unpack8(w[i], f);
#pragma unroll
        for (int e = 0; e < 8; ++e) ss += f[e] * f[e]; }
    const float rinv = rsqrtf(ss * (1.f / 64.f) + 1e-6f) * scale;
#pragma unroll
    for (int i = 0; i < 8; ++i) { float f[8]; unpack8(w[i], f); float r[8];
#pragma unroll
        for (int e = 0; e < 8; ++e) r[e] = f[e] * rinv * g[8 * i + e];
        ((u32x4*)dst)[i] = pack8(r); }
}
__device__ __forceinline__ void pre_item(const KArgs& a, int l, LAS unsigned char* lds, int item, int tid) {
    unsigned char* ws = a.ws; const bf16_t* proj = (const bf16_t*)(ws + WS_PROJ);
    const int t0 = item * 64;
    {
        const int tl = tid >> 3, h = tid & 7;
        rms64_to(proj + (size_t)(t0 + tl) * NPAD + C_NQ + h * 64, a.in[7] + l * 64, 0.125f * LOG2E, (bf16_t*)(ws + WS_QN) + (size_t)(t0 + tl) * 512 + h * 64);
    }
    if (tid < 128) {
        const int tl = tid >> 1, which = tid & 1;
        rms64_to(proj + (size_t)(t0 + tl) * NPAD + (which ? C_NKW : C_NKS), a.in[8] + l * 64, 1.f, (bf16_t*)(ws + (which ? WS_KWN : WS_KSN)) + (size_t)(t0 + tl) * 64);
    }
    LAS bf16_t* T = (LAS bf16_t*)lds;
    for (int idx = tid; idx < 64 * 80; idx += 512) { const int t = idx / 80, p = idx % 80; const int col = p < 64 ? C_SV + 8 * p : (p < 72 ? C_NVS + 8 * (p - 64) : C_NVW + 8 * (p - 72));
        const u32x4 w = *(const u32x4*)(proj + (size_t)(t0 + t) * NPAD + col);
        LAS unsigned* d = (LAS unsigned*)(T + t * 648 + 8 * p); d[0] = w.x; d[1] = w.y; d[2] = w.z; d[3] = w.w; }
    __syncthreads();
    for (int idx = tid; idx < 640 * 8; idx += 512) { const int c = idx >> 3, p = idx & 7;
        unsigned short e[8];
#pragma unroll
        for (int j = 0; j < 8; ++j) e[j] = T[(8 * p + j) * 648 + c];
        u32x4 w; w.x = e[0] | ((unsigned)e[1] << 16); w.y = e[2] | ((unsigned)e[3] << 16); w.z = e[4] | ((unsigned)e[5] << 16); w.w = e[6] | ((unsigned)e[7] << 16);
        const int tk = t0 + 8 * p;
        if (c < 512) *(u32x4*)((bf16_t*)(ws + WS_SVT) + ((size_t)(((c >> 7) * 256 + (tk >> 6)) * 128 + (c & 127))) * 64 + (tk & 63)) = w;
        else { const int d = (c - 512) & 63; bf16_t* vb = (bf16_t*)(ws + (c < 576 ? WS_VST : WS_VWT)); *(u32x4*)(vb + ((size_t)((tk >> 5) * 64 + d)) * 32 + (tk & 31)) = w; } }
    __syncthreads();
}
__device__ __forceinline__ void cmp_item(const KArgs& a, int l, LAS unsigned char* lds, int item, int tid, int wave, int lane) {
    unsigned char* ws = a.ws; const bf16_t* proj = (const bf16_t*)(ws + WS_PROJ);
    const int which = item & 1, grp = item >> 1, i0 = 16 * grp;
    const int srcoff = which ? C_NVC : C_NKC;
    const bf16_t* w1T = (const bf16_t*)(ws + (which ? WS_WV1 : WS_WK1)); const bf16_t* w2T = (const bf16_t*)(ws + (which ? WS_WV2 : WS_WK2));
    LAS bf16_t* hidL = (LAS bf16_t*)lds;
    LAS float* outL = (LAS float*)(lds + 16384);
    LAS float* rinvL = (LAS float*)(lds + 24576);
    const int r = lane & 15, g = lane >> 4;
    int irow = i0 + r; if (irow > 1022) irow = 1022;
    const bf16_t* arow = proj + (size_t)(16 * irow) * NPAD + srcoff;
    f32x4 acc[2] = {(f32x4){0.f, 0.f, 0.f, 0.f}, (f32x4){0.f, 0.f, 0.f, 0.f}};
    const bf16_t* b0 = w1T + (size_t)(32 * wave + r) * 2048 + 8 * g; const bf16_t* b1 = b0 + 16 * 2048;
#pragma unroll 8
    for (int ks = 0; ks < 64; ++ks) { const int k = 32 * ks + 8 * g;
        const bf16x8 af = *(const bf16x8*)(arow + (size_t)(k >> 6) * NPAD + (k & 63));
        const bf16x8 bf0 = *(const bf16x8*)(b0 + 32 * ks), bf1 = *(const bf16x8*)(b1 + 32 * ks);
        acc[0] = mfma16(af, bf0, acc[0]); acc[1] = mfma16(af, bf1, acc[1]); }
    const float* cb = (const float*)(ws + WS_CB);
#pragma unroll
    for (int nb = 0; nb < 2; ++nb) { const int col = 32 * wave + 16 * nb + r; float bs = 0.f;
#pragma unroll
        for (int p = 0; p < 16; ++p) bs += cb[p * 512 + which * 256 + col];
#pragma unroll
        for (int j = 0; j < 4; ++j) { const float x = acc[nb][j] + bs; const float u = 0.7978845608028654f * (x + 0.044715f * x * x * x);
            const float th = 1.f - 2.f / (__expf(2.f * u) + 1.f); hidL[(4 * g + j) * 264 + col] = f2bf(0.5f * x * (1.f + th)); } }
    __syncthreads();
    if (wave < 4) { f32x4 c2 = (f32x4){0.f, 0.f, 0.f, 0.f};
#pragma unroll
        for (int ks = 0; ks < 8; ++ks) { const bf16x8 af = *(const LAS bf16x8*)(hidL + r * 264 + 32 * ks + 8 * g); const bf16x8 bfr = *(const bf16x8*)(w2T + (size_t)(16 * wave + r) * 256 + 32 * ks + 8 * g); c2 = mfma16(af, bfr, c2); }
#pragma unroll
        for (int j = 0; j < 4; ++j) outL[(4 * g + j) * 65 + 16 * wave + r] = c2[j]; }
    __syncthreads();
    if (tid < 16) { float ss = 0.f; for (int d = 0; d < 64; ++d) { const float v = outL[tid * 65 + d]; ss += v * v; } rinvL[tid] = rsqrtf(ss * (1.f / 64.f) + 1e-6f); }
    __syncthreads();
    const float* kg = a.in[8] + l * 64;
    for (int idx = tid; idx < 1024; idx += 512) { const int row = idx >> 6, d = idx & 63, i = i0 + row; const float v = outL[row * 65 + d];
        if (which == 0) ((bf16_t*)(ws + WS_KCMP))[(size_t)i * 64 + d] = (i <= 1022) ? f2bf(v * rinvL[row] * kg[d]) : (bf16_t)0;
        else ((bf16_t*)(ws + WS_VCMPT))[((size_t)((i >> 5) * 64 + d)) * 32 + (i & 31)] = (i <= 1022) ? f2bf(v) : (bf16_t)0; }
    __syncthreads();
}
struct GlaPre { float asrc; float w[16]; float ba; };
__device__ __forceinline__ void gla_preload(GlaPre& p, const KArgs& a, int l, int c, int h, int tid) {
    const bf16_t* proj = (const bf16_t*)(a.ws + WS_PROJ);
    p.asrc = bf2f(proj[(size_t)(32 * c + (tid >> 4)) * NPAD + C_GA + (tid & 15)]);
    const int hk = h * 128 + (tid & 127);
#pragma unroll
    for (int r = 0; r < 16; ++r) p.w[r] = a.in[4][(size_t)l * 16 * 512 + r * 512 + hk];
    p.ba = a.in[5][l * 512 + hk];
}
__device__ __forceinline__ void gla_decay(const GlaPre& p, LAS float* bL, LAS float* aL, int tid) {
    LAS float* segL = aL + 512;
    aL[tid] = p.asrc;
    __syncthreads();
    const int kk = tid & 127, sg = tid >> 7;
    { float cum = 0.f;
#pragma unroll
        for (int tt = 0; tt < 8; ++tt) { const int t = 8 * sg + tt; float x = p.ba;
#pragma unroll
            for (int r = 0; r < 16; ++r) x += aL[t * 16 + r] * p.w[r];
            const float ls = fminf(x, 0.f) - __logf(1.f + __expf(-fabsf(x)));
            cum += ls * (1.f / 16.f); bL[t * 128 + kk] = cum; }
        segL[sg * 128 + kk] = cum; }
    __syncthreads();
    { float off = 0.f;
#pragma unroll
        for (int q = 0; q < 3; ++q) if (q < sg) off += segL[q * 128 + kk];
        if (sg > 0) {
#pragma unroll
            for (int tt = 0; tt < 8; ++tt) bL[(8 * sg + tt) * 128 + kk] += off; } }
    __syncthreads();
}
__device__ __forceinline__ void gla_g1_item(const KArgs& a, int l, LAS unsigned char* lds, int item, int tid, int wave, int lane) {
    unsigned char* ws = a.ws; const bf16_t* proj = (const bf16_t*)(ws + WS_PROJ);
    const int c = item >> 2, h = item & 3;
    LAS float* bL = (LAS float*)lds; LAS float* aL = (LAS float*)(lds + 16384);
    LAS bf16_t* kT = (LAS bf16_t*)(lds + 20480);
    LAS bf16_t* vT = (LAS bf16_t*)(lds + 20480 + 10240);
    GlaPre pre; gla_preload(pre, a, l, c, h, tid);
    const int s = tid >> 4, k0 = (tid & 15) * 8;
    const size_t ro = (size_t)(32 * c + s) * NPAD + h * 128 + k0;
    const u32x4 kraw = *(const u32x4*)(proj + ro + C_GK), vraw = *(const u32x4*)(proj + ro + C_GV);
    gla_decay(pre, bL, aL, tid);
    { float kf[8]; unpack8(kraw, kf);
      const unsigned vw[4] = {vraw.x, vraw.y, vraw.z, vraw.w};
#pragma unroll
      for (int e = 0; e < 8; ++e) { const int k = k0 + e; kT[k * 40 + s] = f2bf(kf[e] * __expf(bL[31 * 128 + k] - bL[s * 128 + k])); vT[k * 40 + s] = (bf16_t)((vw[e >> 1] >> (16 * (e & 1))) & 0xffffu); } }
    if (tid < 128) ((float*)(ws + WS_GDC))[(size_t)(c * 4 + h) * 128 + tid] = __expf(bL[31 * 128 + tid]);
    __syncthreads();
    const int r = lane & 15, g = lane >> 4;
    const bf16x8 af = *(const LAS bf16x8*)(vT + (16 * wave + r) * 40 + 8 * g);
    bf16_t* dst = (bf16_t*)(ws + WS_GST) + (size_t)(c * 4 + h) * 16384;
#pragma unroll
    for (int kb = 0; kb < 8; ++kb) { const bf16x8 bfr = *(const LAS bf16x8*)(kT + (16 * kb + r) * 40 + 8 * g);
        const f32x4 d = mfma16(af, bfr, (f32x4){0.f, 0.f, 0.f, 0.f});
#pragma unroll
        for (int j = 0; j < 4; ++j) dst[(size_t)(16 * wave + 4 * g + j) * 128 + 16 * kb + r] = f2bf(d[j]); }
    __syncthreads();
}
__device__ __forceinline__ void gla_scan(const KArgs& a, int cid) {
    bf16_t* st = (bf16_t*)(a.ws + WS_GST); const float* dc = (const float*)(a.ws + WS_GDC);
    const int h = cid >> 14, vk = cid & 16383, k = cid & 127;
    bf16_t* sp = st + (size_t)h * 16384 + vk; const float* dp = dc + (size_t)h * 128 + k;
    float state = 0.f;
    unsigned short kva[8], kvb[8]; float da[8], db[8];
#pragma unroll
    for (int i = 0; i < 8; ++i) { kva[i] = sp[(size_t)i * 65536]; da[i] = dp[(size_t)i * 512]; }
    for (int c0 = 0; c0 < 512; c0 += 16) {
#pragma unroll
        for (int i = 0; i < 8; ++i) { kvb[i] = sp[(size_t)(c0 + 8 + i) * 65536]; db[i] = dp[(size_t)(c0 + 8 + i) * 512]; }
        SCHED_FENCE_G();
#pragma unroll
        for (int i = 0; i < 8; ++i) { sp[(size_t)(c0 + i) * 65536] = f2bf(state); state = state * da[i] + bf2f(kva[i]); }
        SCHED_FENCE_G();
        if (c0 + 16 < 512) {
#pragma unroll
            for (int i = 0; i < 8; ++i) { kva[i] = sp[(size_t)(c0 + 16 + i) * 65536]; da[i] = dp[(size_t)(c0 + 16 + i) * 512]; } }
        SCHED_FENCE_G();
#pragma unroll
        for (int i = 0; i < 8; ++i) { sp[(size_t)(c0 + 8 + i) * 65536] = f2bf(state); state = state * db[i] + bf2f(kvb[i]); }
        SCHED_FENCE_G();
    }
}
__device__ __forceinline__ void gla_g3_item(const KArgs& a, int l, LAS unsigned char* lds, int item, int tid, int wave, int lane) {
    unsigned char* ws = a.ws; const bf16_t* proj = (const bf16_t*)(ws + WS_PROJ);
    const int c = item >> 2, h = item & 3;
    LAS float* bL = (LAS float*)lds; LAS float* aL = (LAS float*)(lds + 16384);
    LAS bf16_t* qL = (LAS bf16_t*)(lds + 20480);
    LAS bf16_t* kL = (LAS bf16_t*)(lds + 20480 + 8704);
    LAS bf16_t* vT = (LAS bf16_t*)(lds + 20480 + 17408);
    LAS bf16_t* scL = (LAS bf16_t*)(lds + 20480 + 27648);
    LAS float* oL = (LAS float*)(lds + 20480 + 30208);
    const int r = lane & 15, g = lane >> 4;
    GlaPre pre; gla_preload(pre, a, l, c, h, tid);
    const int s = tid >> 4, k0 = (tid & 15) * 8;
    const size_t ro = (size_t)(32 * c + s) * NPAD + h * 128 + k0;
    const u32x4 qraw = *(const u32x4*)(proj + ro + C_GQ), kraw = *(const u32x4*)(proj + ro + C_GK), vraw = *(const u32x4*)(proj + ro + C_GV), rraw = *(const u32x4*)(proj + ro + C_GR);
    const bf16_t* stT = (const bf16_t*)(ws + WS_GST) + (size_t)(c * 4 + h) * 16384;
    bf16x8 stf[4];
#pragma unroll
    for (int ks = 0; ks < 4; ++ks) stf[ks] = *(const bf16x8*)(stT + (size_t)(16 * wave + r) * 128 + 32 * ks + 8 * g);
    float ng[8];
#pragma unroll
    for (int e = 0; e < 8; ++e) ng[e] = a.in[6][l * 128 + k0 + e];
    gla_decay(pre, bL, aL, tid);
    { float qf[8], kf[8]; unpack8(qraw, qf); unpack8(kraw, kf); float qo[8], ko[8];
      const unsigned vw[4] = {vraw.x, vraw.y, vraw.z, vraw.w};
#pragma unroll
      for (int e = 0; e < 8; ++e) { const float b = bL[s * 128 + k0 + e]; qo[e] = qf[e] * __expf(b) * 0.08838834764831845f; ko[e] = kf[e] * __expf(-b); vT[(k0 + e) * 40 + s] = (bf16_t)((vw[e >> 1] >> (16 * (e & 1))) & 0xffffu); }
      *(LAS u32x4*)(qL + s * 136 + k0) = pack8(qo); *(LAS u32x4*)(kL + s * 136 + k0) = pack8(ko); }
    __syncthreads();
    if (wave < 4) { const int mb = wave >> 1, nb = wave & 1; f32x4 d = (f32x4){0.f, 0.f, 0.f, 0.f};
#pragma unroll
        for (int ks = 0; ks < 4; ++ks) d = mfma16(*(const LAS bf16x8*)(qL + (16 * mb + r) * 136 + 32 * ks + 8 * g), *(const LAS bf16x8*)(kL + (16 * nb + r) * 136 + 32 * ks + 8 * g), d);
#pragma unroll
        for (int j = 0; j < 4; ++j) { const int t = 16 * mb + 4 * g + j, sq = 16 * nb + r; scL[t * 40 + sq] = (sq <= t) ? f2bf(d[j]) : (bf16_t)0; } }
    __syncthreads();
#pragma unroll
    for (int mb = 0; mb < 2; ++mb) { f32x4 d = (f32x4){0.f, 0.f, 0.f, 0.f};
#pragma unroll
        for (int ks = 0; ks < 4; ++ks) d = mfma16(*(const LAS bf16x8*)(qL + (16 * mb + r) * 136 + 32 * ks + 8 * g), stf[ks], d);
        d = mfma16(*(const LAS bf16x8*)(scL + (16 * mb + r) * 40 + 8 * g), *(const LAS bf16x8*)(vT + (16 * wave + r) * 40 + 8 * g), d);
#pragma unroll
        for (int j = 0; j < 4; ++j) oL[(16 * mb + 4 * g + j) * 132 + 16 * wave + r] = d[j]; }
    __syncthreads();
    { float o[8]; float ss = 0.f;
#pragma unroll
        for (int e = 0; e < 8; ++e) { o[e] = oL[s * 132 + k0 + e]; ss += o[e] * o[e]; }
        ss += __shfl_xor(ss, 1); ss += __shfl_xor(ss, 2); ss += __shfl_xor(ss, 4); ss += __shfl_xor(ss, 8);
        const float rinv = rsqrtf(ss * (1.f / 128.f) + 1e-6f);
        float rr[8]; unpack8(rraw, rr); float res[8];
#pragma unroll
        for (int e = 0; e < 8; ++e) { const float on = o[e] * rinv * ng[e]; const float si = rr[e] / (1.f + __expf(-rr[e])); res[e] = on * si; }
        *(u32x4*)((bf16_t*)(ws + WS_OGLA) + (size_t)(32 * c + s) * 512 + h * 128 + k0) = pack8(res); }
    __syncthreads();
}

__device__ __forceinline__ float xor16f(float t, int g) { const auto r = __builtin_amdgcn_permlane16_swap(__float_as_uint(t), __float_as_uint(t), false, false); return __uint_as_float(r[0] == __float_as_uint(t) ? r[1] : r[0]); }
__device__ __forceinline__ float xor32f(float t, int g) { const auto r = __builtin_amdgcn_permlane32_swap(__float_as_uint(t), __float_as_uint(t), false, false); return __uint_as_float(r[0] == __float_as_uint(t) ? r[1] : r[0]); }
#define SCHED_FENCE() __builtin_amdgcn_sched_barrier(0)
template <bool DIAG>
__device__ __forceinline__ void sb_weights(const f32x4 (&S)[2], bf16x8& pf, float& carry, int g, int cc, int krel) {
    float e[8], P[8];
#pragma unroll
    for (int j = 0; j < 8; ++j) { int zi = __float_as_int(S[j >> 2][j & 3]); zi = zi < 0x41700000 ? zi : 0x41700000;
        float z = __int_as_float(zi);
        if (DIAG) { if (32 * cc + 8 * g + j >= krel) z = -1e30f; }
        e[j] = __builtin_amdgcn_exp2f(z); }
    P[0] = 1.f;
#pragma unroll
    for (int j = 1; j < 8; ++j) P[j] = P[j - 1] * (1.f + e[j - 1]);
    const float Tg = __builtin_amdgcn_rcpf(P[7] * (1.f + e[7]));
    const float t1 = __shfl_xor(Tg, 16);
    const float pp = Tg * t1;
    const float t23 = __shfl_xor(pp, 32);
    const float gex = ((g & 1) ? 1.f : t1) * ((g & 2) ? 1.f : t23);
    const float cf = Tg * gex * carry;
    carry = carry * (pp * t23);
    float w[8];
#pragma unroll
    for (int j = 0; j < 8; ++j) w[j] = (e[j] * P[j]) * cf;
    const u32x4 pw = pack8(w); __builtin_memcpy(&pf, &pw, 16);
}
template <bool DIAG>
__device__ __forceinline__ void sb_tile(const LAS bf16_t* Kt, const LAS bf16_t* Vt, const bf16x8 (&qf)[4], f32x4 (&O)[8], float& carry, int n, int g, int krel  ) {
    f32x4 S[2][2];
#pragma unroll
    for (int cc = 1; cc >= 0; --cc) {
        bf16x8 kf[2][4];
#pragma unroll
        for (int pb = 0; pb < 2; ++pb)
#pragma unroll
            for (int ks = 0; ks < 4; ++ks) kf[pb][ks] = *(const LAS bf16x8*)(Kt + (32 * cc + 16 * pb + n) * 128 + (((4 * ks + g) ^ n) << 3));
        SCHED_FENCE();
#pragma unroll
        for (int pb = 0; pb < 2; ++pb) { f32x4 sv = (f32x4){0.f, 0.f, 0.f, 0.f};
#pragma unroll
            for (int ks = 0; ks < 4; ++ks) sv = mfma16(kf[pb][ks], qf[ks], sv);
            S[cc][pb] = sv; }
        SCHED_FENCE();
    }
    bf16x8 vf[8], pf1, pf0;
#pragma unroll
    for (int db = 0; db < 8; ++db) vf[db] = *(const LAS bf16x8*)(Vt + (16 * db + n) * 64 + (((4 + g) ^ (n >> 1)) << 3));
    SCHED_FENCE();
    sb_weights<DIAG>(S[1], pf1, carry, g, 1, krel);
    SCHED_FENCE();
#pragma unroll
    for (int db = 0; db < 8; ++db) O[db] = mfma16(vf[db], pf1, O[db]);
    SCHED_FENCE();
#pragma unroll
    for (int db = 0; db < 8; ++db) vf[db] = *(const LAS bf16x8*)(Vt + (16 * db + n) * 64 + ((g ^ (n >> 1)) << 3));
    SCHED_FENCE();
    sb_weights<DIAG>(S[0], pf0, carry, g, 0, krel);
    SCHED_FENCE();
#pragma unroll
    for (int db = 0; db < 8; ++db) O[db] = mfma16(vf[db], pf0, O[db]);
    SCHED_FENCE();
}
__device__ __forceinline__ void sb_swbar(LAS unsigned* ctr, unsigned& gen, int lane) {
    asm volatile("s_waitcnt vmcnt(0) lgkmcnt(0)" ::: "memory");
    gen += 4u;
    if (lane == 0) { __hip_atomic_fetch_add(ctr, 1u, __ATOMIC_RELAXED, __HIP_MEMORY_SCOPE_WORKGROUP);
        while (__hip_atomic_load(ctr, __ATOMIC_RELAXED, __HIP_MEMORY_SCOPE_WORKGROUP) < gen) __builtin_amdgcn_s_sleep(1); }
    asm volatile("s_waitcnt lgkmcnt(0)" ::: "memory");
}
__device__ __forceinline__ void sb_unit4(const KArgs& a, LAS unsigned char* sbl, LAS unsigned* ctr, unsigned& gen, int h, int qb, int wave, int lane) {
    unsigned char* ws = a.ws; const bf16_t* proj = (const bf16_t*)(ws + WS_PROJ);
    constexpr int KT_B = 64 * 256, BUF_B = 32768;
    const int n = lane & 15, g = lane >> 4;
    const int tq = 64 * qb + 16 * wave + n;
    const float SC = 0.08838834764831845f * LOG2E;
    bf16x8 qf[4];
#pragma unroll
    for (int ks = 0; ks < 4; ++ks) { const u32x4 w = *(const u32x4*)(proj + (size_t)tq * NPAD + C_SQ + h * 128 + 32 * ks + 8 * g); float f[8]; unpack8(w, f);
#pragma unroll
        for (int e = 0; e < 8; ++e) f[e] *= SC;
        const u32x4 pw = pack8(f); __builtin_memcpy(&qf[ks], &pw, 16); }
    f32x4 O[8];
#pragma unroll
    for (int i = 0; i < 8; ++i) O[i] = (f32x4){0.f, 0.f, 0.f, 0.f};
    float carry = 1.f;
    volatile LAS unsigned* alive = (volatile LAS unsigned*)(ctr + 8);
    const int ntiles = qb + 1;
    const char* kbase = (const char*)(proj + C_SK + h * 128); const char* vbase = (const char*)((const bf16_t*)(ws + WS_SVT) + (size_t)h * 256 * 8192);
    auto issue = [&](int T, int buf) {
        const char* kt = kbase + (size_t)(64 * T) * NPAD * 2; const char* vt = vbase + (size_t)T * 16384;
#pragma unroll
        for (int i = 0; i < 4; ++i) { const int p = i * 256 + wave * 64 + lane;
            const int rho = p >> 4, c = (p & 15) ^ (rho & 15), k = (rho & 32) | ((rho & 16) >> 2) | ((rho & 12) << 1) | (rho & 3);
            const unsigned koff = (unsigned)(k * NPAD + 8 * c) * 2u;
            const int d = p >> 3, cv = (p & 7) ^ ((d >> 1) & 7);
            const unsigned voff = (unsigned)(d * 64 + 8 * cv) * 2u;
            __builtin_amdgcn_global_load_lds((const unsigned*)(kt + koff), (LAS unsigned*)(sbl + buf * BUF_B + (i * 256 + wave * 64) * 16), 16, 0, 0);
            __builtin_amdgcn_global_load_lds((const unsigned*)(vt + voff), (LAS unsigned*)(sbl + buf * BUF_B + KT_B + (i * 256 + wave * 64) * 16), 16, 0, 0); } };
    issue(ntiles - 1, 0);
    sb_swbar(ctr, gen, lane);
    for (int it = 0; it < ntiles; ++it) { const int T = ntiles - 1 - it, buf = it & 1;
        if (T > 0) issue(T - 1, buf ^ 1);
        const LAS bf16_t* Kt = (const LAS bf16_t*)(sbl + buf * BUF_B); const LAS bf16_t* Vt = (const LAS bf16_t*)(sbl + buf * BUF_B + KT_B);
        if (it == 0) sb_tile<true>(Kt, Vt, qf, O, carry, n, g, tq - 64 * T);
        else sb_tile<false>(Kt, Vt, qf, O, carry, n, g, 0);
        const bool dead = (__ballot(carry != 0.f) == 0ull);
        if (lane == 0) alive[(it & 1) * 4 + wave] = dead ? 0u : 1u;
        sb_swbar(ctr, gen, lane);
        const unsigned any = alive[(it & 1) * 4 + 0] | alive[(it & 1) * 4 + 1] | alive[(it & 1) * 4 + 2] | alive[(it & 1) * 4 + 3];
        if (__builtin_amdgcn_readfirstlane(any) == 0u) break;
    }
    bf16_t* orow = (bf16_t*)(ws + WS_OSB) + (size_t)tq * 512 + h * 128;
#pragma unroll
    for (int db = 0; db < 8; ++db) { u32x2 w; w.x = cvt_pk_bf16(O[db][0], O[db][1]); w.y = cvt_pk_bf16(O[db][2], O[db][3]); *(u32x2*)(orow + 16 * db + 4 * g) = w; }
}

struct NFrag { bf16x8 k[4]; bf16x8 v[4]; };
template <bool LV> __device__ __forceinline__ void nsa_load(NFrag& f, const bf16_t* Kb, const bf16_t* VB, int kb, int n, int g) {
    const bf16_t* kp = Kb + (size_t)(kb + 8 * (n >> 2) + (n & 3)) * 64 + 8 * g;
    f.k[0] = *(const bf16x8*)kp; f.k[1] = *(const bf16x8*)(kp + 32); f.k[2] = *(const bf16x8*)(kp + 256); f.k[3] = *(const bf16x8*)(kp + 288);
    if (LV) { const bf16_t* vp = VB + ((size_t)(kb >> 5) * 64 + n) * 32 + 8 * g;
#pragma unroll
        for (int db = 0; db < 4; ++db) f.v[db] = *(const bf16x8*)(vp + db * 512); }
}
template <int MODE, bool FAST>
__device__ __forceinline__ void nsa_compute(const NFrag& f, int kb, const bf16x8 (&qf)[2], const LAS float* LUTh, LAS float* impq,
                                            int tq, int h, int g, int qs, int qsel, float inv, float& lsum, f32x4 (&O)[4], float bfar) {
    f32x4 S[2];
#pragma unroll
    for (int pb = 0; pb < 2; ++pb) { f32x4 sv = mfma16(f.k[2 * pb], qf[0], (f32x4){0.f, 0.f, 0.f, 0.f}); S[pb] = mfma16(f.k[2 * pb + 1], qf[1], sv); }
    float p[8];
    const int dbase = (MODE <= 1) ? (tq - 31 - 16 * (kb + 8 * g)) : (tq - kb - 8 * g);
    const bool colok = (MODE == 2) ? (((qsel >> qs) & 1) != 0) : true;
    if (FAST) {
#pragma unroll
        for (int j = 0; j < 8; ++j) { const float ex = __builtin_amdgcn_exp2f(S[j >> 2][j & 3] + bfar);
            float pv = (MODE == 2) ? (colok ? ex : 0.f) : ex;
            if (MODE == 1) pv *= inv;
            p[j] = pv; if (MODE != 1) lsum += pv; }
    } else {
    float bias[8];
#pragma unroll
    for (int j = 0; j < 8; ++j) { const int dist = (MODE <= 1) ? dbase - 16 * j : dbase - j; const unsigned di = min((unsigned)dist, 1023u); bias[j] = LUTh[di * 8]; }
#pragma unroll
    for (int j = 0; j < 8; ++j) asm volatile("" : "+v"(bias[j]));
#pragma unroll
    for (int j = 0; j < 8; ++j) { const int dist = (MODE <= 1) ? dbase - 16 * j : dbase - j;
        const bool valid = (MODE == 3) ? ((unsigned)dist < 512u) : (dist >= 0 && colok);
        const float ex = __builtin_amdgcn_exp2f(S[j >> 2][j & 3] + bias[j]);
        float pv = valid ? ex : 0.f;
        if (MODE == 1) pv *= inv;
        p[j] = pv; if (MODE != 1) lsum += pv; }
    }
    if (MODE == 0) return;
    if (MODE == 1) {
#pragma unroll
        for (int j = 0; j < 8; ++j) { float v = p[j]; v += __shfl_xor(v, 1); v += __shfl_xor(v, 2); v += __shfl_xor(v, 4); if (h == 0) impq[kb + 8 * g + j] = v; } }
    const u32x4 pw = pack8(p); bf16x8 pf; __builtin_memcpy(&pf, &pw, 16);
#pragma unroll
    for (int db = 0; db < 4; ++db) O[db] = mfma16(f.v[db], pf, O[db]);
}
template <int MODE, class KBF, class QSF>
__device__ __forceinline__ void nsa_run(int niter, const bf16_t* Kb, const bf16_t* VB, KBF kbf, QSF qsf, const bf16x8 (&qf)[2], const LAS float* LUTh, LAS float* impq,
                                        int tq, int h, int n, int g, int qs, float inv, float& lsum, f32x4 (&O)[4], int t0, float bfar) {
    if (niter <= 0) return;
    NFrag A, C; const int last = niter - 1;
    nsa_load<MODE != 0>(A, Kb, VB, kbf(0), n, g);
    for (int i = 0; i < niter; i += 2) {
        nsa_load<MODE != 0>(C, Kb, VB, kbf(i + 1 < last ? i + 1 : last), n, g);
        SCHED_FENCE();
        { const int kb_ = kbf(i); const bool far_ = (MODE <= 1) ? (t0 - 31 - 16 * (kb_ + 31) >= 1023) : ((MODE == 2) ? (t0 - (kb_ + 31) >= 1023) : false);
          if (MODE != 3 && far_) nsa_compute<MODE, true>(A, kb_, qf, LUTh, impq, tq, h, g, qs, qsf(i), inv, lsum, O, bfar); else nsa_compute<MODE, false>(A, kb_, qf, LUTh, impq, tq, h, g, qs, qsf(i), inv, lsum, O, bfar); }
        SCHED_FENCE();
        if (i + 1 >= niter) break;
        nsa_load<MODE != 0>(A, Kb, VB, kbf(i + 2 < last ? i + 2 : last), n, g);
        SCHED_FENCE();
        { const int kb_ = kbf(i + 1); const bool far_ = (MODE <= 1) ? (t0 - 31 - 16 * (kb_ + 31) >= 1023) : ((MODE == 2) ? (t0 - (kb_ + 31) >= 1023) : false);
          if (MODE != 3 && far_) nsa_compute<MODE, true>(C, kb_, qf, LUTh, impq, tq, h, g, qs, qsf(i + 1), inv, lsum, O, bfar); else nsa_compute<MODE, false>(C, kb_, qf, LUTh, impq, tq, h, g, qs, qsf(i + 1), inv, lsum, O, bfar); }
        SCHED_FENCE();
    }
}
__device__ __forceinline__ float lred(float l) { l += __shfl_xor(l, 16); l += __shfl_xor(l, 32); return l; }
__device__ __forceinline__ void nsa_unit(const KArgs& a, LAS unsigned char* lds, int unit, LAS float* imp, LAS int* selL, int lane) {
    unsigned char* ws = a.ws; const bf16_t* proj = (const bf16_t*)(ws + WS_PROJ);
    const int t0 = 2 * unit, n = lane & 15, g = lane >> 4, qs = n >> 3, h = n & 7, tq = t0 + qs;
    const LAS float* LUT = (const LAS float*)lds + h;
    const float bfar = LUT[1023 * 8];
    bf16x8 qf[2];
    qf[0] = *(const bf16x8*)((const bf16_t*)(ws + WS_QN) + (size_t)tq * 512 + h * 64 + 8 * g); qf[1] = *(const bf16x8*)((const bf16_t*)(ws + WS_QN) + (size_t)tq * 512 + h * 64 + 32 + 8 * g);
    const bf16_t* gp = proj + (size_t)tq * NPAD + C_NGATE + h * 3;
    const float g0 = 1.f / (1.f + __expf(-bf2f(gp[0]))), g1 = 1.f / (1.f + __expf(-bf2f(gp[1]))), g2 = 1.f / (1.f + __expf(-bf2f(gp[2])));
    f32x4 Ot[4], Ob[4];
#pragma unroll
    for (int i = 0; i < 4; ++i) { Ot[i] = (f32x4){0.f, 0.f, 0.f, 0.f}; Ob[i] = (f32x4){0.f, 0.f, 0.f, 0.f}; }
    const int nvmax = (t0 + 1 >= 31) ? (((t0 + 1 - 31) >> 4) + 1) : 0; const int nch = (nvmax + 31) >> 5;
    const bf16_t* KC = (const bf16_t*)(ws + WS_KCMP); const bf16_t* VCT = (const bf16_t*)(ws + WS_VCMPT);
    auto kb_lin = [](int i) { return 32 * i; }; auto qs_zero = [](int) { return 0; };
    float lsum = 0.f;
    nsa_run<0>(nch, KC, VCT, kb_lin, qs_zero, qf, LUT, imp + qs * 1024, tq, h, n, g, qs, 0.f, lsum, Ob, t0, bfar);
    { const float l = lred(lsum); const float inv = l > 0.f ? 1.f / l : 0.f; float dummy = 0.f;
      nsa_run<1>(nch, KC, VCT, kb_lin, qs_zero, qf, LUT, imp + qs * 1024, tq, h, n, g, qs, inv, dummy, Ob, t0, bfar); }
#pragma unroll
    for (int i = 0; i < 4; ++i) { Ot[i] += Ob[i] * g0; Ob[i] = (f32x4){0.f, 0.f, 0.f, 0.f}; }
    LDS_FENCE();
    int cnts[2];
#pragma unroll
    for (int q2 = 0; q2 < 2; ++q2) { const int tqq = t0 + q2, cur = tqq >> 6; const LAS float* iq = imp + q2 * 1024;
        float val[4];
#pragma unroll
        for (int r = 0; r < 4; ++r) { const int b = lane + 64 * r; float v = -1.f;
            if (b >= 1 && b <= cur - 2) { v = 0.f;
#pragma unroll
                for (int i = 0; i < 5; ++i) v += iq[4 * b - 1 + i]; }
            val[r] = v; }
        int cnt = 0;
        if (lane == 0) { selL[q2 * 8 + 0] = 0; if (cur >= 1) selL[q2 * 8 + 1] = cur; if (cur >= 2) selL[q2 * 8 + 2] = cur - 1; }
        cnt = 1 + (cur >= 1) + (cur >= 2);
        int ncand = cur - 2; if (ncand < 0) ncand = 0; const int npick = ncand < 5 ? ncand : 5;
        for (int rd = 0; rd < npick; ++rd) { float bv = val[0]; int bi = lane;
#pragma unroll
            for (int r = 1; r < 4; ++r) if (val[r] > bv) { bv = val[r]; bi = lane + 64 * r; }
#pragma unroll
            for (int o = 1; o < 64; o <<= 1) { const float ov = __shfl_xor(bv, o); const int oi = __shfl_xor(bi, o); if (ov > bv || (ov == bv && oi < bi)) { bv = ov; bi = oi; } }
            if (lane == 0) selL[q2 * 8 + cnt] = bi; ++cnt;
#pragma unroll
            for (int r = 0; r < 4; ++r) if (bi == lane + 64 * r) val[r] = -2.f; }
        cnts[q2] = cnt; }
    LDS_FENCE();
#pragma unroll
    for (int i = 0; i < 4; ++i)
#pragma unroll
        for (int j = 0; j < 4; ++j) imp[(4 * i + j) * 64 + lane] = Ot[i][j];
    lsum = 0.f;
    { const int c0 = cnts[0], c1 = cnts[1];
      const int b1 = (lane < c1) ? selL[8 + lane] : -1;
      int pos = -1;
      for (int k = 0; k < c0; ++k) if (selL[k] == b1) pos = k;
      LDS_FENCE();
      if (lane < c0) selL[16 + lane] = 1;
      LDS_FENCE();
      const bool fresh = (lane < c1) && (pos < 0);
      if (lane < c1 && pos >= 0) selL[16 + pos] = 3;
      const unsigned long long nb = __ballot(fresh);
      if (fresh) { const int idx = c0 + __popcll(nb & ((1ull << lane) - 1ull)); selL[idx] = b1; selL[16 + idx] = 2; }
      const int tot = c0 + __popcll(nb);
      LDS_FENCE();
      auto kbf = [&](int i) { return 64 * __builtin_amdgcn_readfirstlane(selL[i >> 1]) + 32 * (i & 1); };
      auto qsf = [&](int i) { return __builtin_amdgcn_readfirstlane(selL[16 + (i >> 1)]); };
      nsa_run<2>(2 * tot, (const bf16_t*)(ws + WS_KSN), (const bf16_t*)(ws + WS_VST), kbf, qsf, qf, LUT, imp, tq, h, n, g, qs, 0.f, lsum, Ob, t0, bfar); }
    { const float l = lred(lsum); const float sc = l > 0.f ? g1 / l : 0.f;
#pragma unroll
      for (int i = 0; i < 4; ++i) {
#pragma unroll
          for (int j = 0; j < 4; ++j) imp[(4 * i + j) * 64 + lane] += Ob[i][j] * sc;
          Ob[i] = (f32x4){0.f, 0.f, 0.f, 0.f}; } }
    lsum = 0.f;
    { int lo = t0 - 511; if (lo < 0) lo = 0; lo &= ~31; const int nw = ((t0 + 1 - lo) >> 5) + 1;
      auto kbf = [&](int i) { return lo + 32 * i; };
      nsa_run<3>(nw, (const bf16_t*)(ws + WS_KWN), (const bf16_t*)(ws + WS_VWT), kbf, qs_zero, qf, LUT, imp, tq, h, n, g, qs, 0.f, lsum, Ob, t0, bfar);
      const float l = lred(lsum); const float sc = l > 0.f ? g2 / l : 0.f;
#pragma unroll
      for (int i = 0; i < 4; ++i)
#pragma unroll
          for (int j = 0; j < 4; ++j) Ot[i][j] = imp[(4 * i + j) * 64 + lane] + Ob[i][j] * sc; }
    bf16_t* orow = (bf16_t*)(ws + WS_ONSA) + (size_t)tq * 512 + h * 64;
#pragma unroll
    for (int db = 0; db < 4; ++db) { u32x2 w; w.x = cvt_pk_bf16(Ot[db][0], Ot[db][1]); w.y = cvt_pk_bf16(Ot[db][2], Ot[db][3]); *(u32x2*)(orow + 16 * db + 4 * g) = w; }
}


#define RLX_AGENT __ATOMIC_RELAXED, __HIP_MEMORY_SCOPE_AGENT
#define XB_TMO      128
#define XB_XCNT(j)  (256  + 64 * (j))
#define XB_XSUB(j)  (1280 + 64 * (j))
#define XB_XGEN(j)  (2304 + 64 * (j))
#define XB_TOP      3328
#define XB_TOPGEN   3392
#define XCD_BAR_WORDS 3456
#define XB_SPIN_CAP (1u << 18)

__device__ __forceinline__ unsigned xb_ld(unsigned* p)              { return __hip_atomic_load(p, __ATOMIC_RELAXED, __HIP_MEMORY_SCOPE_AGENT); }
__device__ __forceinline__ unsigned xb_add(unsigned* p, unsigned v) { return __hip_atomic_fetch_add(p, v, __ATOMIC_RELAXED, __HIP_MEMORY_SCOPE_AGENT); }
__device__ __forceinline__ unsigned xb_xcc_id() { return (unsigned)__builtin_amdgcn_s_getreg((3 << 11) | 20) & 0xFu; }
#define XB_SPIN(cond, bar) do { unsigned _sp = 0; while (cond) { __builtin_amdgcn_s_sleep(1); \
    if ((++_sp & 255u) == 0u) { if (xb_ld(&(bar)[XB_TMO])) break; if (_sp > XB_SPIN_CAP) { atomicAdd(&(bar)[XB_TMO], 1u); break; } } } } while (0)

struct XcdBarrier {
    unsigned* bar; unsigned x;
    volatile LAS unsigned* st;
};

__device__ __forceinline__ XcdBarrier xcd_barrier_post(unsigned* bar, volatile LAS unsigned* st) {
    XcdBarrier b; b.bar = bar; b.x = xb_xcc_id(); b.st = st;
    if (threadIdx.x == 0) (void)xb_add(&bar[XB_XCNT(b.x)], 1u);
    return b;
}
__device__ __forceinline__ void xcd_barrier_complete(unsigned* bar, unsigned x, unsigned& nloc, unsigned& nx) {
    const unsigned G = gridDim.x * gridDim.y * gridDim.z;
    unsigned sum, cnt, mine, sp = 0u;
    for (;;) {
        sum = 0u; cnt = 0u; mine = 0u;
#pragma unroll
        for (unsigned j = 0; j < 16; ++j) { const unsigned c = xb_ld(&bar[XB_XCNT(j)]); sum += c; cnt += (c > 0u) ? 1u : 0u; mine = (j == x) ? c : mine; }
        if (sum == G) break;
        __builtin_amdgcn_s_sleep(1);
        if ((++sp & 255u) == 0u) { if (xb_ld(&bar[XB_TMO])) break; if (sp > XB_SPIN_CAP) { atomicAdd(&bar[XB_TMO], 1u); break; } }
    }
    nloc = mine > 0u ? mine : 1u; nx = cnt > 0u ? cnt : 1u;
}

__device__ __forceinline__ void xcd_barrier(const XcdBarrier& b) {
    asm volatile("s_waitcnt vmcnt(0)" ::: "memory");
    __syncthreads();
    if (threadIdx.x == 0) {
        unsigned* bar = b.bar;
        __builtin_amdgcn_s_waitcnt(0);
        unsigned nloc = b.st[0], nx = b.st[1];
        if (nloc == 0u) { xcd_barrier_complete(bar, b.x, nloc, nx); b.st[0] = nloc; b.st[1] = nx; }
        const unsigned old = xb_add(&bar[XB_XSUB(b.x)], 1u);
        const unsigned gen = old / nloc;
        if (old + 1u == (gen + 1u) * nloc) {
            __builtin_amdgcn_fence(__ATOMIC_RELEASE, "agent");
            asm volatile("s_waitcnt vmcnt(0)" ::: "memory");
            const unsigned og = xb_add(&bar[XB_TOP], 1u);
            const unsigned tg = og / nx;
            if (og + 1u == (tg + 1u) * nx) xb_add(&bar[XB_TOPGEN], 1u);
            else XB_SPIN(xb_ld(&bar[XB_TOPGEN]) == tg, bar);
            __builtin_amdgcn_fence(__ATOMIC_ACQUIRE, "agent");
            xb_add(&bar[XB_XGEN(b.x)], 1u);
            asm volatile("s_waitcnt vmcnt(0)" ::: "memory");
        } else {
            XB_SPIN(xb_ld(&bar[XB_XGEN(b.x)]) == gen, bar);
            __builtin_amdgcn_fence(__ATOMIC_ACQUIRE, "agent");
            asm volatile("s_waitcnt vmcnt(0)" ::: "memory");
        }
    }
    __syncthreads();
}

#define GSYNC() xcd_barrier(xbar)
__global__ void __launch_bounds__(512) __attribute__((amdgpu_waves_per_eu(2, 2))) fwd_mega(KArgs a) {
    extern __shared__ __attribute__((aligned(16))) unsigned char lds_raw[];
    LAS unsigned char* lds = (LAS unsigned char*)lds_raw;
    const int G = gridDim.x, bid = blockIdx.x, NGW = G * 8;
    { volatile LAS unsigned* stw = (volatile LAS unsigned*)(lds + 132608); if (threadIdx.x < 2) stw[threadIdx.x] = 0u; }
    __syncthreads();
    XcdBarrier xbar = xcd_barrier_post((unsigned*)(a.ws + WS_CTL), (volatile LAS unsigned*)(lds + 132608));
    cg::this_grid().sync();
#define IDS() int tid = threadIdx.x; asm volatile("" : "+v"(tid)); const int lane = tid & 63, wave = __builtin_amdgcn_readfirstlane(tid >> 6); const int gw = bid * 8 + wave; (void)lane; (void)gw;
    unsigned char* ws = a.ws;
    bf16_t* PROJ = (bf16_t*)(ws + WS_PROJ); bf16_t* HN = (bf16_t*)(ws + WS_HN); bf16_t* HID = (bf16_t*)(ws + WS_HID);
#pragma unroll 1
    for (int l = 0; l < DEPTH; ++l) {
        const float* xsrc = (l == 0) ? a.in[0] : a.out;
        { IDS(); phase_convert(a, l, lds, gw, NGW, wave, lane);
          phase_rms(xsrc, a.in[1] + l * DM, HN, gw, NGW, lane); }
        GSYNC();
        { pg8::Gemm g{HN, (const bf16_t*)(ws + WS_WIN), M, NPAD, DM}; pg8::StaticOrder S; S.init(M, NPAD, G, bid);
          pg8::EpiBf16<0> E{PROJ, NPAD};
          pg8::gemm_phase<pg8::EpiBf16<0>, pg8::StaticOrder, true, true>(lds, g, S, E); }
        GSYNC();
        { IDS(); for (int it = bid; it < 256; it += G) pre_item(a, l, lds, it, tid); }
        { IDS(); for (int it = bid; it < 128; it += G) cmp_item(a, l, lds, it, tid, wave, lane); }
        { IDS(); for (int it = bid; it < 2048; it += G) gla_g1_item(a, l, lds, it, tid, wave, lane); }
        GSYNC();
        {   IDS();
            { const float* lg = (const float*)(ws + WS_LUT); LAS float* LUT = (LAS float*)lds; for (int i = tid; i < 8192; i += 512) LUT[i] = lg[i]; }
            LAS int* ctr = (LAS int*)(lds + 132096);
            LAS unsigned* sbc = (LAS unsigned*)(lds + 132112);
            if (tid == 0) { *ctr = 0; *sbc = 0u; }
            __syncthreads();
            if (wave < 4) {
                unsigned gen = 0u;
                for (int pp = bid; pp < 512; pp += G) {
                    const int hh = pp & 3, q = pp >> 2;
                    sb_unit4(a, lds + 65536, sbc, gen, hh, 255 - q, wave, lane);
                    sb_unit4(a, lds + 65536, sbc, gen, hh, q, wave, lane); }
            } else {
                for (int c0 = (bid * 4 + (wave - 4)) * 64; c0 < 65536; c0 += G * 256) gla_scan(a, c0 + lane);
            }
            LAS float* imp = (LAS float*)(lds + (wave < 4 ? 65536 + wave * 8192 : 32768 + (wave - 4) * 8192));
            LAS int* selL = (LAS int*)(lds + 131072 + wave * 128);
            const int nper = (8192 + G - 1) / G;
            for (;;) { int idx = 0; if (lane == 0) idx = atomicAdd((int*)ctr, 1); idx = __builtin_amdgcn_readfirstlane(idx);
                if (idx >= nper) break; const int hn = nper >> 1; const int unit = (idx < hn) ? (8192 - hn * (bid + 1) + idx) : (hn * bid + (idx - hn)); if (unit >= 0 && unit < 8192) nsa_unit(a, lds, unit, imp, selL, lane); }
            __syncthreads();
        }
        GSYNC();
        { IDS(); for (int it = bid; it < 2048; it += G) gla_g3_item(a, l, lds, it, tid, wave, lane); }
        GSYNC();
        for (int b = 0; b < 3; ++b) {
            pg8::Gemm g{(const bf16_t*)(ws + WS_OGLA + b * 16 * MiB), (const bf16_t*)(ws + WS_WBR + b * MiB), M, DM, 512}; pg8::StaticOrder S; S.init(M, DM, G, bid);
            pg8::EpiGate E{HN, PROJ + C_MGATE + b * DM, NPAD, b == 0 ? 1 : 0};
            pg8::gemm_phase<pg8::EpiGate, pg8::StaticOrder, true, true>(lds, g, S, E); }
        GSYNC();
        { pg8::Gemm g{HN, (const bf16_t*)(ws + WS_WOUT), M, DM, DM}; pg8::StaticOrder S; S.init(M, DM, G, bid);
          pg8::EpiRes E{xsrc, a.out};
          pg8::gemm_phase<pg8::EpiRes, pg8::StaticOrder, true, true>(lds, g, S, E); }
        GSYNC();
        { IDS(); phase_rms(a.out, a.in[2] + l * DM, HN, gw, NGW, lane); }
        GSYNC();
        { pg8::Gemm g{HN, (const bf16_t*)(ws + WS_WUP), M, FF, DM}; pg8::StaticOrder S; S.init(M, FF, G, bid);
          pg8::EpiBf16<2> E{HID, FF};
          pg8::gemm_phase<pg8::EpiBf16<2>, pg8::StaticOrder, true, true>(lds, g, S, E); }
        GSYNC();
        { pg8::Gemm g{HID, (const bf16_t*)(ws + WS_WDN), M, DM, FF}; pg8::StaticOrder S; S.init(M, DM, G, bid);
          pg8::EpiRes E{a.out, a.out};
          pg8::gemm_phase<pg8::EpiRes, pg8::StaticOrder, true, true>(lds, g, S, E); }
        GSYNC();
    }
}

extern "C" void kernel_launch(void* const* d_in, const int* in_sizes, int n_in, void* d_out, int out_size, void* d_ws, size_t ws_size, hipStream_t stream) {
    static int grid = 0;
    if (grid == 0) {
        if (n_in != 22 || ws_size < WS_END + 65536) { fprintf(stderr, "kernel_launch: unexpected n_in %d or ws_size %zu (< %zu)\n", n_in, ws_size, (size_t)WS_END); grid = -1; return; }
        int dev = 0, cus = 0, per_cu = 0;
        hipGetDevice(&dev); hipDeviceGetAttribute(&cus, hipDeviceAttributeMultiprocessorCount, dev);
        hipFuncSetAttribute((const void*)fwd_mega, hipFuncAttributeMaxDynamicSharedMemorySize, LDS_BYTES);
        hipOccupancyMaxActiveBlocksPerMultiprocessor(&per_cu, (const void*)fwd_mega, 512, LDS_BYTES);
        if (per_cu < 1) { fprintf(stderr, "kernel_launch: occupancy query says %d blocks/CU\n", per_cu); per_cu = 1; }
        (void)hipGetLastError();
        grid = cus * 1;
    }
    if (grid < 0) return;
    if (hipMemsetAsync((char*)d_ws + WS_CTL, 0, 65536, stream) != hipSuccess) { fprintf(stderr, "kernel_launch: memset of barrier words failed\n"); return; }
    KArgs a{};
    for (int i = 0; i < 22; ++i) a.in[i] = (const float*)d_in[i];
    a.out = (float*)d_out; a.ws = (unsigned char*)d_ws;
    void* args[] = {&a};
    hipError_t e = hipLaunchCooperativeKernel((const void*)fwd_mega, dim3(grid), dim3(512), args, LDS_BYTES, stream);
    if (e != hipSuccess) fprintf(stderr, "cooperative launch failed: %s (grid %d)\n", hipGetErrorString(e), grid);
}
```

```cpp
#include <hip/hip_runtime.h>
#include <hip/hip_cooperative_groups.h>
#include <cstdio>
#include <cstdint>
namespace cg = cooperative_groups;
namespace pg8 {
#define PG8_LAS __attribute__((address_space(3)))
typedef unsigned short bf16_t;
typedef short bf16x8 __attribute__((ext_vector_type(8)));
typedef float f32x4 __attribute__((ext_vector_type(4)));
typedef unsigned u32x4 __attribute__((ext_vector_type(4)));
constexpr int BM = 256, BK = 64, HALF = 128, HTB = HALF * BK * 2  , STAGE_BYTES = 8 * HTB, NXCD = 8, WGM = 8;

__host__ __device__ __forceinline__ int lds_byte(int r, int c) { const int st = (r >> 4) * 2 + (c >> 5), rr = r & 15, cc = c & 31, ob = rr * 64 + cc * 2; return st * 1024 + (ob ^ (((ob >> 9) & 1) << 5)); }
__host__ __device__ __forceinline__ void stage_rc(int b, int& R, int& C) { const int st = b / 1024, sb = b % 1024, swz = sb ^ (((sb >> 9) & 1) << 5); R = (st >> 1) * 16 + swz / 64; C = (st & 1) * 32 + (swz % 64) / 2; }
__host__ __device__ __forceinline__ int perm32(int rho) { const int n = rho >> 4, i = rho & 15; return 8 * (i >> 2) + 4 * n + (i & 3); }

struct Unit { int pm, pn; };
struct Gemm { const bf16_t* A; const bf16_t* Bt; int M, N, K; };

struct StaticOrder {
    int nM, nN, nwg, G, c;
    __host__ __device__ void init(int M, int N, int G_, int c_) { nM = M / BM; nN = N / BM; nwg = nM * nN; G = G_; c = c_; }
    __host__ __device__ bool next(int i, Unit& u) const {
        const long L = (long)i * G + c; if (L >= nwg) return false;
        int wgid = (int)L; { const int q = nwg / NXCD, r = nwg % NXCD, xcd = wgid % NXCD, off = wgid / NXCD; wgid = (xcd < r ? xcd * (q + 1) : r * (q + 1) + (xcd - r) * q) + off; }
        const int nig = WGM * nN, gid = wgid / nig, fm = gid * WGM, gsz = (nM - fm) < WGM ? (nM - fm) : WGM;
        u.pm = fm + ((wgid % nig) % gsz); u.pn = (wgid % nig) / gsz; return true;
    }
    __device__ __forceinline__ void a_ready(const Unit&) const {}
    __device__ __forceinline__ void done(const Unit&) const {}
};

__device__ __forceinline__ unsigned cvt_pk_bf16(float lo, float hi) { unsigned r; asm("v_cvt_pk_bf16_f32 %0, %1, %2" : "=v"(r) : "v"(lo), "v"(hi)); return r; }
__device__ __forceinline__ float bflo(unsigned w) { return __uint_as_float(w << 16); }
__device__ __forceinline__ float bfhi(unsigned w) { return __uint_as_float(w & 0xffff0000u); }
template <int ACT> struct EpiBf16 {
    static constexpr bool PERM = true, AFTER_DRAIN = false;
    bf16_t* O; int ldc;
    __device__ __forceinline__ void operator()(const f32x4 (&acc)[2][2][4][2], const Unit& u, int wr, int wc, int fr, int fq) const {
        const int row0 = u.pm * BM + wr * 64 + fr; const int col0 = u.pn * BM + wc * 32 + 8 * fq;
#pragma unroll
        for (int ai = 0; ai < 2; ++ai)
#pragma unroll
            for (int m = 0; m < 4; ++m) { bf16_t* rowp = O + (size_t)(row0 + ai * HALF + m * 16) * ldc + col0;
#pragma unroll
                for (int bj = 0; bj < 2; ++bj) { f32x4 v0 = acc[ai][bj][m][0], v1 = acc[ai][bj][m][1];
                    if (ACT == 2) {
#pragma unroll
                        for (int e = 0; e < 4; ++e) { float a = fmaxf(v0[e], 0.f), b = fmaxf(v1[e], 0.f); v0[e] = a * a; v1[e] = b * b; } }
                    u32x4 w; w.x = cvt_pk_bf16(v0[0], v0[1]); w.y = cvt_pk_bf16(v0[2], v0[3]); w.z = cvt_pk_bf16(v1[0], v1[1]); w.w = cvt_pk_bf16(v1[2], v1[3]);
                    *(u32x4*)(rowp + bj * HALF) = w; } }
    }
};
struct EpiGate {
    static constexpr bool PERM = true, AFTER_DRAIN = false;
    bf16_t* O; const bf16_t* gate; int gld; int first;
    __device__ __forceinline__ void operator()(const f32x4 (&acc)[2][2][4][2], const Unit& u, int wr, int wc, int fr, int fq) const {
        const int row0 = u.pm * BM + wr * 64 + fr; const int col0 = u.pn * BM + wc * 32 + 8 * fq;
#pragma unroll
        for (int ai = 0; ai < 2; ++ai)
#pragma unroll
            for (int m = 0; m < 4; ++m) { const int row = row0 + ai * HALF + m * 16; bf16_t* rowp = O + (size_t)row * 1024 + col0; const bf16_t* gp = gate + (size_t)row * gld + col0;
#pragma unroll
                for (int bj = 0; bj < 2; ++bj) { const f32x4 v0 = acc[ai][bj][m][0], v1 = acc[ai][bj][m][1];
                    const u32x4 gw = *(const u32x4*)(gp + bj * HALF);
                    u32x4 ow = (u32x4){0u, 0u, 0u, 0u}; if (!first) ow = *(const u32x4*)(rowp + bj * HALF);
                    float gv[8] = {bflo(gw.x), bfhi(gw.x), bflo(gw.y), bfhi(gw.y), bflo(gw.z), bfhi(gw.z), bflo(gw.w), bfhi(gw.w)};
                    float ov[8] = {bflo(ow.x), bfhi(ow.x), bflo(ow.y), bfhi(ow.y), bflo(ow.z), bfhi(ow.z), bflo(ow.w), bfhi(ow.w)};
                    float av[8] = {v0[0], v0[1], v0[2], v0[3], v1[0], v1[1], v1[2], v1[3]};
                    float r[8];
#pragma unroll
                    for (int e = 0; e < 8; ++e) { const float s = 1.f / (1.f + __expf(-gv[e])); r[e] = ov[e] + s * av[e]; }
                    u32x4 w; w.x = cvt_pk_bf16(r[0], r[1]); w.y = cvt_pk_bf16(r[2], r[3]); w.z = cvt_pk_bf16(r[4], r[5]); w.w = cvt_pk_bf16(r[6], r[7]);
                    *(u32x4*)(rowp + bj * HALF) = w; } }
    }
};
struct EpiRes {
    static constexpr bool PERM = false, AFTER_DRAIN = false;
    const float* src; float* out;
    __device__ __forceinline__ void operator()(const f32x4 (&acc)[2][2][4][2], const Unit& u, int wr, int wc, int fr, int fq) const {
        const int col0 = u.pn * BM + wc * 32 + 4 * fq;
#pragma unroll
        for (int ai = 0; ai < 2; ++ai)
#pragma unroll
            for (int m = 0; m < 4; ++m) { const size_t off = (size_t)(u.pm * BM + ai * HALF + wr * 64 + m * 16 + fr) * 1024 + col0;
#pragma unroll
                for (int bj = 0; bj < 2; ++bj)
#pragma unroll
                    for (int n = 0; n < 2; ++n) { const f32x4 bs = *(const f32x4*)(src + off + bj * HALF + n * 16); *(f32x4*)(out + off + bj * HALF + n * 16) = bs + acc[ai][bj][m][n]; } }
    }
};
template <class Epi, class Sched, bool ALIGN_EPI = false, bool SP2 = false>
__device__ __forceinline__ void gemm_phase(PG8_LAS unsigned char* lds, const Gemm g, const Sched& S, const Epi& E) {
    int tid_ = threadIdx.x; asm volatile("" : "+v"(tid_));
    const int tid = tid_, wid = __builtin_amdgcn_readfirstlane(tid >> 6), lane = tid & 63, wr = wid >> 2, wc = wid & 3, fr = lane & 15, fq = lane >> 4;
    const int K = g.K, nt = K / BK;
    unsigned voffA[2], voffB[2];
#pragma unroll
    for (int i = 0; i < 2; ++i) { int R, C; stage_rc(tid * 16 + i * 8192, R, C); const int Rb = Epi::PERM ? ((R & ~31) + perm32(R & 31)) : R;
        voffA[i] = (unsigned)(R * K + C) * 2u; voffB[i] = (unsigned)(Rb * K + C) * 2u; }
    const size_t kstep = (size_t)(BK * 2);
    const size_t hstep = (size_t)HALF * K * 2;
    const size_t tstep = 2 * hstep;
    const unsigned ldsw = (unsigned)wid * 1024u;
    const int aoff = lds_byte(wr * 64 + fr, fq * 8), boff = lds_byte(wc * 32 + fr, fq * 8);
#define PG8_SA(b, h) (((b) * 2 + (h)) * HTB)
#define PG8_SB(b, h) ((4 + (b) * 2 + (h)) * HTB)
#define PG8_STAGE(bufoff, gbase, voff) do { _Pragma("unroll") for (int _i = 0; _i < 2; ++_i) \
        __builtin_amdgcn_global_load_lds((const unsigned*)((const char*)(gbase) + (voff)[_i]), (PG8_LAS unsigned*)(lds + (bufoff) + ldsw + _i * 8192), 16, 0, 0); } while (0)
#define PG8_LDA(dst, b, h) do { _Pragma("unroll") for (int m = 0; m < 4; ++m) _Pragma("unroll") for (int k = 0; k < 2; ++k) dst[m][k] = *(const PG8_LAS bf16x8*)(lds + PG8_SA(b, h) + aoff + m * 2048 + k * 1024); } while (0)
#define PG8_LDB(dst, b, h) do { _Pragma("unroll") for (int n = 0; n < 2; ++n) _Pragma("unroll") for (int k = 0; k < 2; ++k) dst[n][k] = *(const PG8_LAS bf16x8*)(lds + PG8_SB(b, h) + boff + n * 2048 + k * 1024); } while (0)
#define PG8_MMA(ai, bj, At, Bt) do { __builtin_amdgcn_s_setprio(1); _Pragma("unroll") for (int m = 0; m < 4; ++m) _Pragma("unroll") for (int n = 0; n < 2; ++n) _Pragma("unroll") for (int k = 0; k < 2; ++k) \
        acc[ai][bj][m][n] = __builtin_amdgcn_mfma_f32_16x16x32_bf16(Bt[n][k], At[m][k], acc[ai][bj][m][n], 0, 0, 0); __builtin_amdgcn_s_setprio(0); } while (0)
#define PG8_WAIT_V(n) asm volatile("s_waitcnt vmcnt(" #n ")" ::: "memory")
#define PG8_WAIT_L(n) asm volatile("s_waitcnt lgkmcnt(" #n ")" ::: "memory")
#define PG8_BAR __builtin_amdgcn_s_barrier()
#define PG8_SCHED __builtin_amdgcn_sched_barrier(0)
    Unit cur, nxt; int ui = 0;
    if (!S.next(0, cur)) return;
    f32x4 acc[2][2][4][2];
#pragma unroll
    for (int a = 0; a < 2; ++a)
#pragma unroll
        for (int b = 0; b < 2; ++b)
#pragma unroll
            for (int m = 0; m < 4; ++m)
#pragma unroll
                for (int n = 0; n < 2; ++n) acc[a][b][m][n] = (f32x4){0.f, 0.f, 0.f, 0.f};
    bf16x8 At[4][2], B0[2][2], B1[2][2];
    const char* cA = (const char*)g.A + (size_t)cur.pm * tstep; const char* cB = (const char*)g.Bt + (size_t)cur.pn * tstep;
    S.a_ready(cur);
    if constexpr (SP2) {
        PG8_STAGE(PG8_SB(0, 0), cB, voffB); PG8_STAGE(PG8_SB(0, 1), cB + hstep, voffB); PG8_STAGE(PG8_SA(0, 0), cA, voffA); PG8_STAGE(PG8_SA(0, 1), cA + hstep, voffA);
        if (wr == 1) PG8_BAR;
        PG8_WAIT_V(2); PG8_BAR;
        PG8_STAGE(PG8_SB(1, 0), cB + kstep, voffB); PG8_STAGE(PG8_SA(1, 0), cA + kstep, voffA); PG8_STAGE(PG8_SB(1, 1), cB + hstep + kstep, voffB);
        PG8_WAIT_V(6); PG8_BAR;
    } else {
        PG8_STAGE(PG8_SB(0, 0), cB, voffB); PG8_STAGE(PG8_SA(0, 0), cA, voffA); PG8_STAGE(PG8_SB(0, 1), cB + hstep, voffB); PG8_STAGE(PG8_SA(0, 1), cA + hstep, voffA);
        if (wr == 1) PG8_BAR;
        PG8_WAIT_V(4); PG8_BAR;
        PG8_STAGE(PG8_SB(1, 0), cB + kstep, voffB); PG8_STAGE(PG8_SA(1, 0), cA + kstep, voffA); PG8_STAGE(PG8_SB(1, 1), cB + hstep + kstep, voffB);
        PG8_WAIT_V(6); PG8_BAR;
    }
    for (;;) {
        const bool has_next = S.next(ui + 1, nxt);
        const char* nA = has_next ? (const char*)g.A + (size_t)nxt.pm * tstep : cA; const char* nB = has_next ? (const char*)g.Bt + (size_t)nxt.pn * tstep : cB;
        for (int t = 0; t < nt; t += 2) {
            const bool last = (t == nt - 2);
            const char* a1 = cA + (size_t)(t + 1) * kstep;
            const char* a2 = last ? nA : cA + (size_t)(t + 2) * kstep; const char* b2 = last ? nB : cB + (size_t)(t + 2) * kstep;
            const char* a3 = a2 + kstep; const char* b3 = b2 + kstep;
            if (last && has_next) S.a_ready(nxt);
            if constexpr (SP2) {
            PG8_LDB(B0, 0, 0); PG8_LDB(B1, 0, 1); PG8_SCHED; PG8_LDA(At, 0, 0); PG8_STAGE(PG8_SA(1, 1), a1 + hstep, voffA);
            PG8_WAIT_V(8); PG8_WAIT_L(0); PG8_BAR; PG8_MMA(0, 0, At, B0); PG8_MMA(0, 1, At, B1); PG8_BAR; PG8_SCHED;
            PG8_LDA(At, 0, 1); PG8_STAGE(PG8_SB(0, 0), b2, voffB); PG8_STAGE(PG8_SB(0, 1), b2 + hstep, voffB); PG8_STAGE(PG8_SA(0, 0), a2, voffA);
            PG8_WAIT_V(8); PG8_WAIT_L(0); PG8_BAR; PG8_MMA(1, 0, At, B0); PG8_MMA(1, 1, At, B1); PG8_BAR; PG8_SCHED;
            PG8_LDB(B0, 1, 0); PG8_LDB(B1, 1, 1); PG8_SCHED; PG8_LDA(At, 1, 0); PG8_STAGE(PG8_SA(0, 1), a2 + hstep, voffA);
            PG8_WAIT_V(8); PG8_WAIT_L(0); PG8_BAR; PG8_MMA(0, 0, At, B0); PG8_MMA(0, 1, At, B1); PG8_BAR; PG8_SCHED;
            PG8_LDA(At, 1, 1); PG8_STAGE(PG8_SB(1, 0), b3, voffB); PG8_STAGE(PG8_SB(1, 1), b3 + hstep, voffB); PG8_STAGE(PG8_SA(1, 0), a3, voffA);
            PG8_WAIT_V(8); PG8_WAIT_L(0); PG8_BAR; PG8_MMA(1, 0, At, B0); PG8_MMA(1, 1, At, B1); PG8_BAR; PG8_SCHED;
            } else {
            PG8_LDB(B0, 0, 0); PG8_SCHED; PG8_LDA(At, 0, 0); PG8_STAGE(PG8_SA(1, 1), a1 + hstep, voffA);
            PG8_WAIT_L(8); PG8_BAR; PG8_WAIT_L(0); PG8_MMA(0, 0, At, B0); PG8_BAR; PG8_SCHED;
            PG8_LDB(B1, 0, 1); PG8_STAGE(PG8_SB(0, 0), b2, voffB);
            PG8_BAR; PG8_WAIT_L(0); PG8_MMA(0, 1, At, B1); PG8_BAR;
            PG8_LDA(At, 0, 1); PG8_STAGE(PG8_SA(0, 0), a2, voffA);
            PG8_BAR; PG8_WAIT_L(0); PG8_MMA(1, 0, At, B0); PG8_BAR; PG8_SCHED;
            PG8_STAGE(PG8_SB(0, 1), b2 + hstep, voffB);
            PG8_WAIT_V(6); PG8_BAR; PG8_MMA(1, 1, At, B1); PG8_BAR;
            PG8_LDB(B0, 1, 0); PG8_SCHED; PG8_LDA(At, 1, 0); PG8_STAGE(PG8_SA(0, 1), a2 + hstep, voffA);
            PG8_WAIT_L(8); PG8_BAR; PG8_WAIT_L(0); PG8_MMA(0, 0, At, B0); PG8_BAR; PG8_SCHED;
            PG8_LDB(B1, 1, 1); PG8_STAGE(PG8_SB(1, 0), b3, voffB);
            PG8_BAR; PG8_WAIT_L(0); PG8_MMA(0, 1, At, B1); PG8_BAR;
            PG8_LDA(At, 1, 1); PG8_STAGE(PG8_SA(1, 0), a3, voffA);
            PG8_BAR; PG8_WAIT_L(0); PG8_MMA(1, 0, At, B0); PG8_BAR; PG8_SCHED;
            PG8_STAGE(PG8_SB(1, 1), b3 + hstep, voffB);
            PG8_WAIT_V(6); PG8_BAR; PG8_MMA(1, 1, At, B1); PG8_BAR;
            }
        }
        if constexpr (ALIGN_EPI) { if (wr == 0) PG8_BAR; }
        if constexpr (!Epi::AFTER_DRAIN) { E(acc, cur, wr, wc, fr, fq); S.done(cur); }
        if (!has_next) break;
#pragma unroll
        for (int a = 0; a < 2; ++a)
#pragma unroll
            for (int b = 0; b < 2; ++b)
#pragma unroll
                for (int m = 0; m < 4; ++m)
#pragma unroll
                    for (int n = 0; n < 2; ++n) acc[a][b][m][n] = (f32x4){0.f, 0.f, 0.f, 0.f};
        cur = nxt; cA = nA; cB = nB; ++ui;
        if constexpr (ALIGN_EPI) { if (wr == 1) PG8_BAR; }
    }
    PG8_WAIT_V(0);
    if constexpr (!ALIGN_EPI) { if (wr == 0) PG8_BAR; }
    PG8_BAR;
    if constexpr (Epi::AFTER_DRAIN) { E.fused(acc, cur, wr, wc, fr, fq, lds, wid, lane); S.done(cur); }
#undef PG8_SA
#undef PG8_SB
#undef PG8_STAGE
#undef PG8_LDA
#undef PG8_LDB
#undef PG8_MMA
#undef PG8_WAIT_V
#undef PG8_WAIT_L
#undef PG8_BAR
#undef PG8_SCHED
}
}

#define LAS __attribute__((address_space(3)))
typedef unsigned short bf16_t;
typedef short bf16x8 __attribute__((ext_vector_type(8)));
typedef float f32x4 __attribute__((ext_vector_type(4)));
typedef unsigned u32x4 __attribute__((ext_vector_type(4)));
typedef unsigned u32x2 __attribute__((ext_vector_type(2)));
using pg8::cvt_pk_bf16; using pg8::bflo; using pg8::bfhi;

constexpr int M = 16384, DM = 1024, NIN = 7592, NPAD = 7680, FF = 4096, DEPTH = 4;
constexpr int C_GQ = 0, C_GK = 512, C_GV = 1024, C_GA = 1536, C_GR = 1552, C_SQ = 2064, C_SK = 2576, C_SV = 3088, C_NQ = 3600, C_NKC = 4112, C_NVC = 4176,
              C_NKS = 4240, C_NVS = 4304, C_NKW = 4368, C_NVW = 4432, C_NGATE = 4496, C_MGATE = 4520;
constexpr size_t MiB = 1u << 20;
constexpr size_t WS_PROJ = 0, WS_HID = 0, WS_HN = 240 * MiB, WS_OGLA = 272 * MiB, WS_OSB = 288 * MiB, WS_ONSA = 304 * MiB;
constexpr size_t WS_WIN = 320 * MiB, WS_WUP = 335 * MiB, WS_WDN = 343 * MiB, WS_WOUT = 351 * MiB, WS_WBR = 353 * MiB, WS_WK1 = 356 * MiB, WS_WV1 = 357 * MiB,
                 WS_WK2 = 358 * MiB, WS_WV2 = 358 * MiB + 65536, WS_CB = 358 * MiB + 131072, WS_LUT = 358 * MiB + 196608;
constexpr size_t WS_GST = 360 * MiB, WS_GDC = 424 * MiB, WS_SVT = 425 * MiB, WS_QN = 441 * MiB, WS_KSN = 457 * MiB, WS_KWN = 459 * MiB, WS_VST = 461 * MiB, WS_VWT = 463 * MiB,
                 WS_KCMP = 465 * MiB, WS_VCMPT = 465 * MiB + 131072, WS_END = 466 * MiB, WS_CTL = 466 * MiB;
constexpr int LDS_BYTES = 133120;
constexpr float LOG2E = 1.4426950408889634f;

struct KArgs { const float* in[22]; float* out; unsigned char* ws; };

__device__ __forceinline__ float bf2f(bf16_t v) { return __uint_as_float(((unsigned)v) << 16); }
__device__ __forceinline__ bf16_t f2bf(float f) { unsigned u = __float_as_uint(f); return (bf16_t)((u + 0x7fffu + ((u >> 16) & 1u)) >> 16); }
__device__ __forceinline__ f32x4 mfma16(bf16x8 a, bf16x8 b, f32x4 c) { return __builtin_amdgcn_mfma_f32_16x16x32_bf16(a, b, c, 0, 0, 0); }
__device__ __forceinline__ float wave_sum(float v) {
#pragma unroll
    for (int o = 1; o < 64; o <<= 1) v += __shfl_xor(v, o);
    return v;
}
#define LDS_FENCE() asm volatile("s_waitcnt lgkmcnt(0)" ::: "memory")
#define SCHED_FENCE_G() __builtin_amdgcn_sched_barrier(0)
__device__ __forceinline__ void unpack8(const u32x4 w, float (&f)[8]) { f[0] = bflo(w.x); f[1] = bfhi(w.x); f[2] = bflo(w.y); f[3] = bfhi(w.y); f[4] = bflo(w.z); f[5] = bfhi(w.z); f[6] = bflo(w.w); f[7] = bfhi(w.w); }
__device__ __forceinline__ u32x4 pack8(const float (&r)[8]) { u32x4 w; w.x = cvt_pk_bf16(r[0], r[1]); w.y = cvt_pk_bf16(r[2], r[3]); w.z = cvt_pk_bf16(r[4], r[5]); w.w = cvt_pk_bf16(r[6], r[7]); return w; }

__device__ __forceinline__ void transpose_item(const float* W, int K, int N, int Npad, bf16_t* WT, LAS float* scr, int item, int lane) {
    const int nblk = Npad / 32, kb = item / nblk, nb = item % nblk, k0 = 64 * kb, n0 = 32 * nb;
    const int nn = n0 + (lane & 31);
    float tv[32];
#pragma unroll
    for (int i = 0; i < 32; ++i) { const int kk = 2 * i + (lane >> 5); tv[i] = (nn < N) ? W[(size_t)(k0 + kk) * N + nn] : 0.f; }
#pragma unroll
    for (int i = 0; i < 32; ++i) { const int kk = 2 * i + (lane >> 5); scr[kk * 33 + (lane & 31)] = tv[i]; }
    LDS_FENCE();
    const int c = lane & 7;
#pragma unroll
    for (int j = 0; j < 4; ++j) { const int n = (lane >> 3) + 8 * j; const LAS float* s = scr + (8 * c) * 33 + n;
        u32x4 o; o.x = cvt_pk_bf16(s[0 * 33], s[1 * 33]); o.y = cvt_pk_bf16(s[2 * 33], s[3 * 33]); o.z = cvt_pk_bf16(s[4 * 33], s[5 * 33]); o.w = cvt_pk_bf16(s[6 * 33], s[7 * 33]);
        *(u32x4*)(WT + (size_t)(n0 + n) * K + k0 + 8 * c) = o; }
    LDS_FENCE();
}
__device__ __forceinline__ int rel_bucket(int n) {
    if (n < 16) return n;
    int large = 16 + (int)(logf((float)n / 16.f) / 4.1588830833596715f * 16.f);
    return large < 31 ? large : 31;
}
__device__ __forceinline__ void rms_row(const float* xrow, const float* g, bf16_t* orow, int lane) {
    const f32x4* xr = (const f32x4*)xrow + lane; f32x4 v[4]; float s = 0.f;
#pragma unroll
    for (int j = 0; j < 4; ++j) { v[j] = xr[64 * j]; s += (v[j].x * v[j].x + v[j].y * v[j].y) + (v[j].z * v[j].z + v[j].w * v[j].w); }
    const float rinv = rsqrtf(wave_sum(s) * (1.f / 1024.f) + 1e-6f);
    u32x2* o8 = (u32x2*)orow + lane;
#pragma unroll
    for (int j = 0; j < 4; ++j) { const f32x4 gg = ((const f32x4*)g)[lane + 64 * j]; u32x2 w; w.x = cvt_pk_bf16(v[j].x * rinv * gg.x, v[j].y * rinv * gg.y); w.y = cvt_pk_bf16(v[j].z * rinv * gg.z, v[j].w * rinv * gg.w); o8[64 * j] = w; }
}
__device__ __forceinline__ void phase_convert(const KArgs& a, int l, LAS unsigned char* lds, int gw, int NGW, int wave, int lane) {
    unsigned char* ws = a.ws;
    LAS float* scr = (LAS float*)(lds + wave * 8704);
    constexpr int I0 = 16 * 240, I1 = 16 * 128, I2 = 64 * 32, I3 = 16 * 32, I4 = 8 * 32, I7 = 32 * 8, I9 = 4 * 2, IB = 128, IL = 128;
    constexpr int NIT = I0 + I1 + I2 + I3 + 3 * I4 + 2 * I7 + 2 * I9 + IB + IL;
    for (int it = gw; it < NIT; it += NGW) {
        int r = it;
        if (r < I0) { transpose_item(a.in[3] + (size_t)l * DM * NIN, DM, NIN, NPAD, (bf16_t*)(ws + WS_WIN), scr, r, lane); continue; } r -= I0;
        if (r < I1) { transpose_item(a.in[20] + (size_t)l * DM * FF, DM, FF, FF, (bf16_t*)(ws + WS_WUP), scr, r, lane); continue; } r -= I1;
        if (r < I2) { transpose_item(a.in[21] + (size_t)l * FF * DM, FF, DM, DM, (bf16_t*)(ws + WS_WDN), scr, r, lane); continue; } r -= I2;
        if (r < I3) { transpose_item(a.in[19] + (size_t)l * DM * DM, DM, DM, DM, (bf16_t*)(ws + WS_WOUT), scr, r, lane); continue; } r -= I3;
        if (r < 3 * I4) { const int b = r / I4; transpose_item(a.in[16 + b] + (size_t)l * 512 * DM, 512, DM, DM, (bf16_t*)(ws + WS_WBR + b * MiB), scr, r % I4, lane); continue; } r -= 3 * I4;
        if (r < I7) { transpose_item(a.in[11] + (size_t)l * 2048 * 256, 2048, 256, 256, (bf16_t*)(ws + WS_WK1), scr, r, lane); continue; } r -= I7;
        if (r < I7) { transpose_item(a.in[13] + (size_t)l * 2048 * 256, 2048, 256, 256, (bf16_t*)(ws + WS_WV1), scr, r, lane); continue; } r -= I7;
        if (r < I9) { transpose_item(a.in[12] + (size_t)l * 256 * 64, 256, 64, 64, (bf16_t*)(ws + WS_WK2), scr, r, lane); continue; } r -= I9;
        if (r < I9) { transpose_item(a.in[14] + (size_t)l * 256 * 64, 256, 64, 64, (bf16_t*)(ws + WS_WV2), scr, r, lane); continue; } r -= I9;
        if (r < IB) {
            const int p = r >> 3, which = (r >> 2) & 1, col = (r & 3) * 64 + lane;
            const float* pe = a.in[which ? 10 : 9] + (size_t)l * 2048; const float* w1 = a.in[which ? 13 : 11] + (size_t)l * 2048 * 256;
            float s = 0.f;
#pragma unroll 1
            for (int k0 = 128 * p; k0 < 128 * p + 128; k0 += 16) { float wv[16];
#pragma unroll
                for (int i = 0; i < 16; ++i) wv[i] = w1[(size_t)(k0 + i) * 256 + col];
#pragma unroll
                for (int i = 0; i < 16; ++i) s += pe[k0 + i] * wv[i]; }
            ((float*)(ws + WS_CB))[p * 512 + which * 256 + col] = s; continue; } r -= IB;
        {
            const int idx = r * 64 + lane; const int d = idx >> 3, h = idx & 7;
            ((float*)(ws + WS_LUT))[idx] = a.in[15][rel_bucket(d) * 8 + h] * LOG2E; }
    }
}
__device__ __forceinline__ void phase_rms(const float* x, const float* g, bf16_t* hn, int gw, int NGW, int lane) {
    f32x4 gg[4];
#pragma unroll
    for (int j = 0; j < 4; ++j) gg[j] = ((const f32x4*)g)[lane + 64 * j];
    for (int m = gw; m < M; m += 2 * NGW) { const int m2 = (m + NGW < M) ? m + NGW : m;
        const f32x4* xa = (const f32x4*)(x + (size_t)m * DM) + lane; const f32x4* xb = (const f32x4*)(x + (size_t)m2 * DM) + lane;
        f32x4 va[4], vb[4]; float sa = 0.f, sb = 0.f;
#pragma unroll
        for (int j = 0; j < 4; ++j) { va[j] = xa[64 * j]; vb[j] = xb[64 * j]; }
#pragma unroll
        for (int j = 0; j < 4; ++j) { sa += (va[j].x * va[j].x + va[j].y * va[j].y) + (va[j].z * va[j].z + va[j].w * va[j].w); sb += (vb[j].x * vb[j].x + vb[j].y * vb[j].y) + (vb[j].z * vb[j].z + vb[j].w * vb[j].w); }
#pragma unroll
        for (int o = 1; o < 64; o <<= 1) { sa += __shfl_xor(sa, o); sb += __shfl_xor(sb, o); }
        const float ra = rsqrtf(sa * (1.f / 1024.f) + 1e-6f), rb = rsqrtf(sb * (1.f / 1024.f) + 1e-6f);
        u32x2* oa = (u32x2*)(hn + (size_t)m * DM) + lane; u32x2* ob = (u32x2*)(hn + (size_t)m2 * DM) + lane;
#pragma unroll
        for (int j = 0; j < 4; ++j) { u32x2 w; w.x = cvt_pk_bf16(va[j].x * ra * gg[j].x, va[j].y * ra * gg[j].y); w.y = cvt_pk_bf16(va[j].z * ra * gg[j].z, va[j].w * ra * gg[j].w); oa[64 * j] = w;
            u32x2 w2; w2.x = cvt_pk_bf16(vb[j].x * rb * gg[j].x, vb[j].y * rb * gg[j].y); w2.y = cvt_pk_bf16(vb[j].z * rb * gg[j].z, vb[j].w * rb * gg[j].w); ob[64 * j] = w2; } }
}

__device__ __forceinline__ void rms64_to(const bf16_t* src, const float* g, float scale, bf16_t* dst) {
    u32x4 w[8]; float ss = 0.f;
#pragma unroll
    for (int i = 0; i < 8; ++i) { w[i] = ((const u32x4*)src)[i]; float f[8]; unpack8(w[i], f);
#pragma unroll
        for (int e = 0; e < 8; ++e) ss += f[e] * f[e]; }
    const float rinv = rsqrtf(ss * (1.f / 64.f) + 1e-6f) * scale;
#pragma unroll
    for (int i = 0; i < 8; ++i) { float f[8]; unpack8(w[i], f); float r[8];
#pragma unroll
        for (int e = 0; e < 8; ++e) r[e] = f[e] * rinv * g[8 * i + e];
        ((u32x4*)dst)[i] = pack8(r); }
}
__device__ __forceinline__ void pre_item(const KArgs& a, int l, LAS unsigned char* lds, int item, int tid) {
    unsigned char* ws = a.ws; const bf16_t* proj = (const bf16_t*)(ws + WS_PROJ);
    const int t0 = item * 64;
    {
        const int tl = tid >> 3, h = tid & 7;
        rms64_to(proj + (size_t)(t0 + tl) * NPAD + C_NQ + h * 64, a.in[7] + l * 64, 0.125f * LOG2E, (bf16_t*)(ws + WS_QN) + (size_t)(t0 + tl) * 512 + h * 64);
    }
    if (tid < 128) {
        const int tl = tid >> 1, which = tid & 1;
        rms64_to(proj + (size_t)(t0 + tl) * NPAD + (which ? C_NKW : C_NKS), a.in[8] + l * 64, 1.f, (bf16_t*)(ws + (which ? WS_KWN : WS_KSN)) + (size_t)(t0 + tl) * 64);
    }
    LAS bf16_t* T = (LAS bf16_t*)lds;
    for (int idx = tid; idx < 64 * 80; idx += 512) { const int t = idx / 80, p = idx % 80; const int col = p < 64 ? C_SV + 8 * p : (p < 72 ? C_NVS + 8 * (p - 64) : C_NVW + 8 * (p - 72));
        const u32x4 w = *(const u32x4*)(proj + (size_t)(t0 + t) * NPAD + col);
        LAS unsigned* d = (LAS unsigned*)(T + t * 648 + 8 * p); d[0] = w.x; d[1] = w.y; d[2] = w.z; d[3] = w.w; }
    __syncthreads();
    for (int idx = tid; idx < 640 * 8; idx += 512) { const int c = idx >> 3, p = idx & 7;
        unsigned short e[8];
#pragma unroll
        for (int j = 0; j < 8; ++j) e[j] = T[(8 * p + j) * 648 + c];
        u32x4 w; w.x = e[0] | ((unsigned)e[1] << 16); w.y = e[2] | ((unsigned)e[3] << 16); w.z = e[4] | ((unsigned)e[5] << 16); w.w = e[6] | ((unsigned)e[7] << 16);
        const int tk = t0 + 8 * p;
        if (c < 512) *(u32x4*)((bf16_t*)(ws + WS_SVT) + ((size_t)(((c >> 7) * 256 + (tk >> 6)) * 128 + (c & 127))) * 64 + (tk & 63)) = w;
        else { const int d = (c - 512) & 63; bf16_t* vb = (bf16_t*)(ws + (c < 576 ? WS_VST : WS_VWT)); *(u32x4*)(vb + ((size_t)((tk >> 5) * 64 + d)) * 32 + (tk & 31)) = w; } }
    __syncthreads();
}
__device__ __forceinline__ void cmp_item(const KArgs& a, int l, LAS unsigned char* lds, int item, int tid, int wave, int lane) {
    unsigned char* ws = a.ws; const bf16_t* proj = (const bf16_t*)(ws + WS_PROJ);
    const int which = item & 1, grp = item >> 1, i0 = 16 * grp;
    const int srcoff = which ? C_NVC : C_NKC;
    const bf16_t* w1T = (const bf16_t*)(ws + (which ? WS_WV1 : WS_WK1)); const bf16_t* w2T = (const bf16_t*)(ws + (which ? WS_WV2 : WS_WK2));
    LAS bf16_t* hidL = (LAS bf16_t*)lds;
    LAS float* outL = (LAS float*)(lds + 16384);
    LAS float* rinvL = (LAS float*)(lds + 24576);
    const int r = lane & 15, g = lane >> 4;
    int irow = i0 + r; if (irow > 1022) irow = 1022;
    const bf16_t* arow = proj + (size_t)(16 * irow) * NPAD + srcoff;
    f32x4 acc[2] = {(f32x4){0.f, 0.f, 0.f, 0.f}, (f32x4){0.f, 0.f, 0.f, 0.f}};
    const bf16_t* b0 = w1T + (size_t)(32 * wave + r) * 2048 + 8 * g; const bf16_t* b1 = b0 + 16 * 2048;
#pragma unroll 8
    for (int ks = 0; ks < 64; ++ks) { const int k = 32 * ks + 8 * g;
        const bf16x8 af = *(const bf16x8*)(arow + (size_t)(k >> 6) * NPAD + (k & 63));
        const bf16x8 bf0 = *(const bf16x8*)(b0 + 32 * ks), bf1 = *(const bf16x8*)(b1 + 32 * ks);
        acc[0] = mfma16(af, bf0, acc[0]); acc[1] = mfma16(af, bf1, acc[1]); }
    const float* cb = (const float*)(ws + WS_CB);
#pragma unroll
    for (int nb = 0; nb < 2; ++nb) { const int col = 32 * wave + 16 * nb + r; float bs = 0.f;
#pragma unroll
        for (int p = 0; p < 16; ++p) bs += cb[p * 512 + which * 256 + col];
#pragma unroll
        for (int j = 0; j < 4; ++j) { const float x = acc[nb][j] + bs; const float u = 0.7978845608028654f * (x + 0.044715f * x * x * x);
            const float th = 1.f - 2.f / (__expf(2.f * u) + 1.f); hidL[(4 * g + j) * 264 + col] = f2bf(0.5f * x * (1.f + th)); } }
    __syncthreads();
    if (wave < 4) { f32x4 c2 = (f32x4){0.f, 0.f, 0.f, 0.f};
#pragma unroll
        for (int ks = 0; ks < 8; ++ks) { const bf16x8 af = *(const LAS bf16x8*)(hidL + r * 264 + 32 * ks + 8 * g); const bf16x8 bfr = *(const bf16x8*)(w2T + (size_t)(16 * wave + r) * 256 + 32 * ks + 8 * g); c2 = mfma16(af, bfr, c2); }
#pragma unroll
        for (int j = 0; j < 4; ++j) outL[(4 * g + j) * 65 + 16 * wave + r] = c2[j]; }
    __syncthreads();
    if (tid < 16) { float ss = 0.f; for (int d = 0; d < 64; ++d) { const float v = outL[tid * 65 + d]; ss += v * v; } rinvL[tid] = rsqrtf(ss * (1.f / 64.f) + 1e-6f); }
    __syncthreads();
    const float* kg = a.in[8] + l * 64;
    for (int idx = tid; idx < 1024; idx += 512) { const int row = idx >> 6, d = idx & 63, i = i0 + row; const float v = outL[row * 65 + d];
        if (which == 0) ((bf16_t*)(ws + WS_KCMP))[(size_t)i * 64 + d] = (i <= 1022) ? f2bf(v * rinvL[row] * kg[d]) : (bf16_t)0;
        else ((bf16_t*)(ws + WS_VCMPT))[((size_t)((i >> 5) * 64 + d)) * 32 + (i & 31)] = (i <= 1022) ? f2bf(v) : (bf16_t)0; }
    __syncthreads();
}
struct GlaPre { float asrc; float w[16]; float ba; };
__device__ __forceinline__ void gla_preload(GlaPre& p, const KArgs& a, int l, int c, int h, int tid) {
    const bf16_t* proj = (const bf16_t*)(a.ws + WS_PROJ);
    p.asrc = bf2f(proj[(size_t)(32 * c + (tid >> 4)) * NPAD + C_GA + (tid & 15)]);
    const int hk = h * 128 + (tid & 127);
#pragma unroll
    for (int r = 0; r < 16; ++r) p.w[r] = a.in[4][(size_t)l * 16 * 512 + r * 512 + hk];
    p.ba = a.in[5][l * 512 + hk];
}
__device__ __forceinline__ void gla_decay(const GlaPre& p, LAS float* bL, LAS float* aL, int tid) {
    LAS float* segL = aL + 512;
    aL[tid] = p.asrc;
    __syncthreads();
    const int kk = tid & 127, sg = tid >> 7;
    { float cum = 0.f;
#pragma unroll
        for (int tt = 0; tt < 8; ++tt) { const int t = 8 * sg + tt; float x = p.ba;
#pragma unroll
            for (int r = 0; r < 16; ++r) x += aL[t * 16 + r] * p.w[r];
            const float ls = fminf(x, 0.f) - __logf(1.f + __expf(-fabsf(x)));
            cum += ls * (1.f / 16.f); bL[t * 128 + kk] = cum; }
        segL[sg * 128 + kk] = cum; }
    __syncthreads();
    { float off = 0.f;
#pragma unroll
        for (int q = 0; q < 3; ++q) if (q < sg) off += segL[q * 128 + kk];
        if (sg > 0) {
#pragma unroll
            for (int tt = 0; tt < 8; ++tt) bL[(8 * sg + tt) * 128 + kk] += off; } }
    __syncthreads();
}
__device__ __forceinline__ void gla_g1_item(const KArgs& a, int l, LAS unsigned char* lds, int item, int tid, int wave, int lane) {
    unsigned char* ws = a.ws; const bf16_t* proj = (const bf16_t*)(ws + WS_PROJ);
    const int c = item >> 2, h = item & 3;
    LAS float* bL = (LAS float*)lds; LAS float* aL = (LAS float*)(lds + 16384);
    LAS bf16_t* kT = (LAS bf16_t*)(lds + 20480);
    LAS bf16_t* vT = (LAS bf16_t*)(lds + 20480 + 10240);
    GlaPre pre; gla_preload(pre, a, l, c, h, tid);
    const int s = tid >> 4, k0 = (tid & 15) * 8;
    const size_t ro = (size_t)(32 * c + s) * NPAD + h * 128 + k0;
    const u32x4 kraw = *(const u32x4*)(proj + ro + C_GK), vraw = *(const u32x4*)(proj + ro + C_GV);
    gla_decay(pre, bL, aL, tid);
    { float kf[8]; unpack8(kraw, kf);
      const unsigned vw[4] = {vraw.x, vraw.y, vraw.z, vraw.w};
#pragma unroll
      for (int e = 0; e < 8; ++e) { const int k = k0 + e; kT[k * 40 + s] = f2bf(kf[e] * __expf(bL[31 * 128 + k] - bL[s * 128 + k])); vT[k * 40 + s] = (bf16_t)((vw[e >> 1] >> (16 * (e & 1))) & 0xffffu); } }
    if (tid < 128) ((float*)(ws + WS_GDC))[(size_t)(c * 4 + h) * 128 + tid] = __expf(bL[31 * 128 + tid]);
    __syncthreads();
    const int r = lane & 15, g = lane >> 4;
    const bf16x8 af = *(const LAS bf16x8*)(vT + (16 * wave + r) * 40 + 8 * g);
    bf16_t* dst = (bf16_t*)(ws + WS_GST) + (size_t)(c * 4 + h) * 16384;
#pragma unroll
    for (int kb = 0; kb < 8; ++kb) { const bf16x8 bfr = *(const LAS bf16x8*)(kT + (16 * kb + r) * 40 + 8 * g);
        const f32x4 d = mfma16(af, bfr, (f32x4){0.f, 0.f, 0.f, 0.f});
#pragma unroll
        for (int j = 0; j < 4; ++j) dst[(size_t)(16 * wave + 4 * g + j) * 128 + 16 * kb + r] = f2bf(d[j]); }
    __syncthreads();
}
__device__ __forceinline__ void gla_scan(const KArgs& a, int cid) {
    bf16_t* st = (bf16_t*)(a.ws + WS_GST); const float* dc = (const float*)(a.ws + WS_GDC);
    const int h = cid >> 14, vk = cid & 16383, k = cid & 127;
    bf16_t* sp = st + (size_t)h * 16384 + vk; const float* dp = dc + (size_t)h * 128 + k;
    float state = 0.f;
    unsigned short kva[8], kvb[8]; float da[8], db[8];
#pragma unroll
    for (int i = 0; i < 8; ++i) { kva[i] = sp[(size_t)i * 65536]; da[i] = dp[(size_t)i * 512]; }
    for (int c0 = 0; c0 < 512; c0 += 16) {
#pragma unroll
        for (int i = 0; i < 8; ++i) { kvb[i] = sp[(size_t)(c0 + 8 + i) * 65536]; db[i] = dp[(size_t)(c0 + 8 + i) * 512]; }
        SCHED_FENCE_G();
#pragma unroll
        for (int i = 0; i < 8; ++i) { sp[(size_t)(c0 + i) * 65536] = f2bf(state); state = state * da[i] + bf2f(kva[i]); }
        SCHED_FENCE_G();
        if (c0 + 16 < 512) {
#pragma unroll
            for (int i = 0; i < 8; ++i) { kva[i] = sp[(size_t)(c0 + 16 + i) * 65536]; da[i] = dp[(size_t)(c0 + 16 + i) * 512]; } }
        SCHED_FENCE_G();
#pragma unroll
        for (int i = 0; i < 8; ++i) { sp[(size_t)(c0 + 8 + i) * 65536] = f2bf(state); state = state * db[i] + bf2f(kvb[i]); }
        SCHED_FENCE_G();
    }
}
__device__ __forceinline__ void gla_g3_item(const KArgs& a, int l, LAS unsigned char* lds, int item, int tid, int wave, int lane) {
    unsigned char* ws = a.ws; const bf16_t* proj = (const bf16_t*)(ws + WS_PROJ);
    const int c = item >> 2, h = item & 3;
    LAS float* bL = (LAS float*)lds; LAS float* aL = (LAS float*)(lds + 16384);
    LAS bf16_t* qL = (LAS bf16_t*)(lds + 20480);
    LAS bf16_t* kL = (LAS bf16_t*)(lds + 20480 + 8704);
    LAS bf16_t* vT = (LAS bf16_t*)(lds + 20480 + 17408);
    LAS bf16_t* scL = (LAS bf16_t*)(lds + 20480 + 27648);
    LAS float* oL = (LAS float*)(lds + 20480 + 30208);
    const int r = lane & 15, g = lane >> 4;
    GlaPre pre; gla_preload(pre, a, l, c, h, tid);
    const int s = tid >> 4, k0 = (tid & 15) * 8;
    const size_t ro = (size_t)(32 * c + s) * NPAD + h * 128 + k0;
    const u32x4 qraw = *(const u32x4*)(proj + ro + C_GQ), kraw = *(const u32x4*)(proj + ro + C_GK), vraw = *(const u32x4*)(proj + ro + C_GV), rraw = *(const u32x4*)(proj + ro + C_GR);
    const bf16_t* stT = (const bf16_t*)(ws + WS_GST) + (size_t)(c * 4 + h) * 16384;
    bf16x8 stf[4];
#pragma unroll
    for (int ks = 0; ks < 4; ++ks) stf[ks] = *(const bf16x8*)(stT + (size_t)(16 * wave + r) * 128 + 32 * ks + 8 * g);
    float ng[8];
#pragma unroll
    for (int e = 0; e < 8; ++e) ng[e] = a.in[6][l * 128 + k0 + e];
    gla_decay(pre, bL, aL, tid);
    { float qf[8], kf[8]; unpack8(qraw, qf); unpack8(kraw, kf); float qo[8], ko[8];
      const unsigned vw[4] = {vraw.x, vraw.y, vraw.z, vraw.w};
#pragma unroll
      for (int e = 0; e < 8; ++e) { const float b = bL[s * 128 + k0 + e]; qo[e] = qf[e] * __expf(b) * 0.08838834764831845f; ko[e] = kf[e] * __expf(-b); vT[(k0 + e) * 40 + s] = (bf16_t)((vw[e >> 1] >> (16 * (e & 1))) & 0xffffu); }
      *(LAS u32x4*)(qL + s * 136 + k0) = pack8(qo); *(LAS u32x4*)(kL + s * 136 + k0) = pack8(ko); }
    __syncthreads();
    if (wave < 4) { const int mb = wave >> 1, nb = wave & 1; f32x4 d = (f32x4){0.f, 0.f, 0.f, 0.f};
#pragma unroll
        for (int ks = 0; ks < 4; ++ks) d = mfma16(*(const LAS bf16x8*)(qL + (16 * mb + r) * 136 + 32 * ks + 8 * g), *(const LAS bf16x8*)(kL + (16 * nb + r) * 136 + 32 * ks + 8 * g), d);
#pragma unroll
        for (int j = 0; j < 4; ++j) { const int t = 16 * mb + 4 * g + j, sq = 16 * nb + r; scL[t * 40 + sq] = (sq <= t) ? f2bf(d[j]) : (bf16_t)0; } }
    __syncthreads();
#pragma unroll
    for (int mb = 0; mb < 2; ++mb) { f32x4 d = (f32x4){0.f, 0.f, 0.f, 0.f};
#pragma unroll
        for (int ks = 0; ks < 4; ++ks) d = mfma16(*(const LAS bf16x8*)(qL + (16 * mb + r) * 136 + 32 * ks + 8 * g), stf[ks], d);
        d = mfma16(*(const LAS bf16x8*)(scL + (16 * mb + r) * 40 + 8 * g), *(const LAS bf16x8*)(vT + (16 * wave + r) * 40 + 8 * g), d);
#pragma unroll
        for (int j = 0; j < 4; ++j) oL[(16 * mb + 4 * g + j) * 132 + 16 * wave + r] = d[j]; }
    __syncthreads();
    { float o[8]; float ss = 0.f;
#pragma unroll
        for (int e = 0; e < 8; ++e) { o[e] = oL[s * 132 + k0 + e]; ss += o[e] * o[e]; }
        ss += __shfl_xor(ss, 1); ss += __shfl_xor(ss, 2); ss += __shfl_xor(ss, 4); ss += __shfl_xor(ss, 8);
        const float rinv = rsqrtf(ss * (1.f / 128.f) + 1e-6f);
        float rr[8]; unpack8(rraw, rr); float res[8];
#pragma unroll
        for (int e = 0; e < 8; ++e) { const float on = o[e] * rinv * ng[e]; const float si = rr[e] / (1.f + __expf(-rr[e])); res[e] = on * si; }
        *(u32x4*)((bf16_t*)(ws + WS_OGLA) + (size_t)(32 * c + s) * 512 + h * 128 + k0) = pack8(res); }
    __syncthreads();
}

__device__ __forceinline__ float xor16f(float t, int g) { const auto r = __builtin_amdgcn_permlane16_swap(__float_as_uint(t), __float_as_uint(t), false, false); return __uint_as_float(r[0] == __float_as_uint(t) ? r[1] : r[0]); }
__device__ __forceinline__ float xor32f(float t, int g) { const auto r = __builtin_amdgcn_permlane32_swap(__float_as_uint(t), __float_as_uint(t), false, false); return __uint_as_float(r[0] == __float_as_uint(t) ? r[1] : r[0]); }
#define SCHED_FENCE() __builtin_amdgcn_sched_barrier(0)
template <bool DIAG>
__device__ __forceinline__ void sb_weights(const f32x4 (&S)[2], bf16x8& pf, float& carry, int g, int cc, int krel) {
    float e[8], P[8];
#pragma unroll
    for (int j = 0; j < 8; ++j) { int zi = __float_as_int(S[j >> 2][j & 3]); zi = zi < 0x41700000 ? zi : 0x41700000;
        float z = __int_as_float(zi);
        if (DIAG) { if (32 * cc + 8 * g + j >= krel) z = -1e30f; }
        e[j] = __builtin_amdgcn_exp2f(z); }
    P[0] = 1.f;
#pragma unroll
    for (int j = 1; j < 8; ++j) P[j] = P[j - 1] * (1.f + e[j - 1]);
    const float Tg = __builtin_amdgcn_rcpf(P[7] * (1.f + e[7]));
    const float t1 = __shfl_xor(Tg, 16);
    const float pp = Tg * t1;
    const float t23 = __shfl_xor(pp, 32);
    const float gex = ((g & 1) ? 1.f : t1) * ((g & 2) ? 1.f : t23);
    const float cf = Tg * gex * carry;
    carry = carry * (pp * t23);
    float w[8];
#pragma unroll
    for (int j = 0; j < 8; ++j) w[j] = (e[j] * P[j]) * cf;
    const u32x4 pw = pack8(w); __builtin_memcpy(&pf, &pw, 16);
}
template <bool DIAG>
__device__ __forceinline__ void sb_tile(const LAS bf16_t* Kt, const LAS bf16_t* Vt, const bf16x8 (&qf)[4], f32x4 (&O)[8], float& carry, int n, int g, int krel  ) {
    f32x4 S[2][2];
#pragma unroll
    for (int cc = 1; cc >= 0; --cc) {
        bf16x8 kf[2][4];
#pragma unroll
        for (int pb = 0; pb < 2; ++pb)
#pragma unroll
            for (int ks = 0; ks < 4; ++ks) kf[pb][ks] = *(const LAS bf16x8*)(Kt + (32 * cc + 16 * pb + n) * 128 + (((4 * ks + g) ^ n) << 3));
        SCHED_FENCE();
#pragma unroll
        for (int pb = 0; pb < 2; ++pb) { f32x4 sv = (f32x4){0.f, 0.f, 0.f, 0.f};
#pragma unroll
            for (int ks = 0; ks < 4; ++ks) sv = mfma16(kf[pb][ks], qf[ks], sv);
            S[cc][pb] = sv; }
        SCHED_FENCE();
    }
    bf16x8 vf[8], pf1, pf0;
#pragma unroll
    for (int db = 0; db < 8; ++db) vf[db] = *(const LAS bf16x8*)(Vt + (16 * db + n) * 64 + (((4 + g) ^ (n >> 1)) << 3));
    SCHED_FENCE();
    sb_weights<DIAG>(S[1], pf1, carry, g, 1, krel);
    SCHED_FENCE();
#pragma unroll
    for (int db = 0; db < 8; ++db) O[db] = mfma16(vf[db], pf1, O[db]);
    SCHED_FENCE();
#pragma unroll
    for (int db = 0; db < 8; ++db) vf[db] = *(const LAS bf16x8*)(Vt + (16 * db + n) * 64 + ((g ^ (n >> 1)) << 3));
    SCHED_FENCE();
    sb_weights<DIAG>(S[0], pf0, carry, g, 0, krel);
    SCHED_FENCE();
#pragma unroll
    for (int db = 0; db < 8; ++db) O[db] = mfma16(vf[db], pf0, O[db]);
    SCHED_FENCE();
}
__device__ __forceinline__ void sb_swbar(LAS unsigned* ctr, unsigned& gen, int lane) {
    asm volatile("s_waitcnt vmcnt(0) lgkmcnt(0)" ::: "memory");
    gen += 4u;
    if (lane == 0) { __hip_atomic_fetch_add(ctr, 1u, __ATOMIC_RELAXED, __HIP_MEMORY_SCOPE_WORKGROUP);
        while (__hip_atomic_load(ctr, __ATOMIC_RELAXED, __HIP_MEMORY_SCOPE_WORKGROUP) < gen) __builtin_amdgcn_s_sleep(1); }
    asm volatile("s_waitcnt lgkmcnt(0)" ::: "memory");
}
__device__ __forceinline__ void sb_unit4(const KArgs& a, LAS unsigned char* sbl, LAS unsigned* ctr, unsigned& gen, int h, int qb, int wave, int lane) {
    unsigned char* ws = a.ws; const bf16_t* proj = (const bf16_t*)(ws + WS_PROJ);
    constexpr int KT_B = 64 * 256, BUF_B = 32768;
    const int n = lane & 15, g = lane >> 4;
    const int tq = 64 * qb + 16 * wave + n;
    const float SC = 0.08838834764831845f * LOG2E;
    bf16x8 qf[4];
#pragma unroll
    for (int ks = 0; ks < 4; ++ks) { const u32x4 w = *(const u32x4*)(proj + (size_t)tq * NPAD + C_SQ + h * 128 + 32 * ks + 8 * g); float f[8]; unpack8(w, f);
#pragma unroll
        for (int e = 0; e < 8; ++e) f[e] *= SC;
        const u32x4 pw = pack8(f); __builtin_memcpy(&qf[ks], &pw, 16); }
    f32x4 O[8];
#pragma unroll
    for (int i = 0; i < 8; ++i) O[i] = (f32x4){0.f, 0.f, 0.f, 0.f};
    float carry = 1.f;
    volatile LAS unsigned* alive = (volatile LAS unsigned*)(ctr + 8);
    const int ntiles = qb + 1;
    const char* kbase = (const char*)(proj + C_SK + h * 128); const char* vbase = (const char*)((const bf16_t*)(ws + WS_SVT) + (size_t)h * 256 * 8192);
    auto issue = [&](int T, int buf) {
        const char* kt = kbase + (size_t)(64 * T) * NPAD * 2; const char* vt = vbase + (size_t)T * 16384;
#pragma unroll
        for (int i = 0; i < 4; ++i) { const int p = i * 256 + wave * 64 + lane;
            const int rho = p >> 4, c = (p & 15) ^ (rho & 15), k = (rho & 32) | ((rho & 16) >> 2) | ((rho & 12) << 1) | (rho & 3);
            const unsigned koff = (unsigned)(k * NPAD + 8 * c) * 2u;
            const int d = p >> 3, cv = (p & 7) ^ ((d >> 1) & 7);
            const unsigned voff = (unsigned)(d * 64 + 8 * cv) * 2u;
            __builtin_amdgcn_global_load_lds((const unsigned*)(kt + koff), (LAS unsigned*)(sbl + buf * BUF_B + (i * 256 + wave * 64) * 16), 16, 0, 0);
            __builtin_amdgcn_global_load_lds((const unsigned*)(vt + voff), (LAS unsigned*)(sbl + buf * BUF_B + KT_B + (i * 256 + wave * 64) * 16), 16, 0, 0); } };
    issue(ntiles - 1, 0);
    sb_swbar(ctr, gen, lane);
    for (int it = 0; it < ntiles; ++it) { const int T = ntiles - 1 - it, buf = it & 1;
        if (T > 0) issue(T - 1, buf ^ 1);
        const LAS bf16_t* Kt = (const LAS bf16_t*)(sbl + buf * BUF_B); const LAS bf16_t* Vt = (const LAS bf16_t*)(sbl + buf * BUF_B + KT_B);
        if (it == 0) sb_tile<true>(Kt, Vt, qf, O, carry, n, g, tq - 64 * T);
        else sb_tile<false>(Kt, Vt, qf, O, carry, n, g, 0);
        const bool dead = (__ballot(carry != 0.f) == 0ull);
        if (lane == 0) alive[(it & 1) * 4 + wave] = dead ? 0u : 1u;
        sb_swbar(ctr, gen, lane);
        const unsigned any = alive[(it & 1) * 4 + 0] | alive[(it & 1) * 4 + 1] | alive[(it & 1) * 4 + 2] | alive[(it & 1) * 4 + 3];
        if (__builtin_amdgcn_readfirstlane(any) == 0u) break;
    }
    bf16_t* orow = (bf16_t*)(ws + WS_OSB) + (size_t)tq * 512 + h * 128;
#pragma unroll
    for (int db = 0; db < 8; ++db) { u32x2 w; w.x = cvt_pk_bf16(O[db][0], O[db][1]); w.y = cvt_pk_bf16(O[db][2], O[db][3]); *(u32x2*)(orow + 16 * db + 4 * g) = w; }
}

struct NFrag { bf16x8 k[4]; bf16x8 v[4]; };
template <bool LV> __device__ __forceinline__ void nsa_load(NFrag& f, const bf16_t* Kb, const bf16_t* VB, int kb, int n, int g) {
    const bf16_t* kp = Kb + (size_t)(kb + 8 * (n >> 2) + (n & 3)) * 64 + 8 * g;
    f.k[0] = *(const bf16x8*)kp; f.k[1] = *(const bf16x8*)(kp + 32); f.k[2] = *(const bf16x8*)(kp + 256); f.k[3] = *(const bf16x8*)(kp + 288);
    if (LV) { const bf16_t* vp = VB + ((size_t)(kb >> 5) * 64 + n) * 32 + 8 * g;
#pragma unroll
        for (int db = 0; db < 4; ++db) f.v[db] = *(const bf16x8*)(vp + db * 512); }
}
template <int MODE, bool FAST>
__device__ __forceinline__ void nsa_compute(const NFrag& f, int kb, const bf16x8 (&qf)[2], const LAS float* LUTh, LAS float* impq,
                                            int tq, int h, int g, int qs, int qsel, float inv, float& lsum, f32x4 (&O)[4], float bfar) {
    f32x4 S[2];
#pragma unroll
    for (int pb = 0; pb < 2; ++pb) { f32x4 sv = mfma16(f.k[2 * pb], qf[0], (f32x4){0.f, 0.f, 0.f, 0.f}); S[pb] = mfma16(f.k[2 * pb + 1], qf[1], sv); }
    float p[8];
    const int dbase = (MODE <= 1) ? (tq - 31 - 16 * (kb + 8 * g)) : (tq - kb - 8 * g);
    const bool colok = (MODE == 2) ? (((qsel >> qs) & 1) != 0) : true;
    if (FAST) {
#pragma unroll
        for (int j = 0; j < 8; ++j) { const float ex = __builtin_amdgcn_exp2f(S[j >> 2][j & 3] + bfar);
            float pv = (MODE == 2) ? (colok ? ex : 0.f) : ex;
            if (MODE == 1) pv *= inv;
            p[j] = pv; if (MODE != 1) lsum += pv; }
    } else {
    float bias[8];
#pragma unroll
    for (int j = 0; j < 8; ++j) { const int dist = (MODE <= 1) ? dbase - 16 * j : dbase - j; const unsigned di = min((unsigned)dist, 1023u); bias[j] = LUTh[di * 8]; }
#pragma unroll
    for (int j = 0; j < 8; ++j) asm volatile("" : "+v"(bias[j]));
#pragma unroll
    for (int j = 0; j < 8; ++j) { const int dist = (MODE <= 1) ? dbase - 16 * j : dbase - j;
        const bool valid = (MODE == 3) ? ((unsigned)dist < 512u) : (dist >= 0 && colok);
        const float ex = __builtin_amdgcn_exp2f(S[j >> 2][j & 3] + bias[j]);
        float pv = valid ? ex : 0.f;
        if (MODE == 1) pv *= inv;
        p[j] = pv; if (MODE != 1) lsum += pv; }
    }
    if (MODE == 0) return;
    if (MODE == 1) {
#pragma unroll
        for (int j = 0; j < 8; ++j) { float v = p[j]; v += __shfl_xor(v, 1); v += __shfl_xor(v, 2); v += __shfl_xor(v, 4); if (h == 0) impq[kb + 8 * g + j] = v; } }
    const u32x4 pw = pack8(p); bf16x8 pf; __builtin_memcpy(&pf, &pw, 16);
#pragma unroll
    for (int db = 0; db < 4; ++db) O[db] = mfma16(f.v[db], pf, O[db]);
}
template <int MODE, class KBF, class QSF>
__device__ __forceinline__ void nsa_run(int niter, const bf16_t* Kb, const bf16_t* VB, KBF kbf, QSF qsf, const bf16x8 (&qf)[2], const LAS float* LUTh, LAS float* impq,
                                        int tq, int h, int n, int g, int qs, float inv, float& lsum, f32x4 (&O)[4], int t0, float bfar) {
    if (niter <= 0) return;
    NFrag A, C; const int last = niter - 1;
    nsa_load<MODE != 0>(A, Kb, VB, kbf(0), n, g);
    for (int i = 0; i < niter; i += 2) {
        nsa_load<MODE != 0>(C, Kb, VB, kbf(i + 1 < last ? i + 1 : last), n, g);
        SCHED_FENCE();
        { const int kb_ = kbf(i); const bool far_ = (MODE <= 1) ? (t0 - 31 - 16 * (kb_ + 31) >= 1023) : ((MODE == 2) ? (t0 - (kb_ + 31) >= 1023) : false);
          if (MODE != 3 && far_) nsa_compute<MODE, true>(A, kb_, qf, LUTh, impq, tq, h, g, qs, qsf(i), inv, lsum, O, bfar); else nsa_compute<MODE, false>(A, kb_, qf, LUTh, impq, tq, h, g, qs, qsf(i), inv, lsum, O, bfar); }
        SCHED_FENCE();
        if (i + 1 >= niter) break;
        nsa_load<MODE != 0>(A, Kb, VB, kbf(i + 2 < last ? i + 2 : last), n, g);
        SCHED_FENCE();
        { const int kb_ = kbf(i + 1); const bool far_ = (MODE <= 1) ? (t0 - 31 - 16 * (kb_ + 31) >= 1023) : ((MODE == 2) ? (t0 - (kb_ + 31) >= 1023) : false);
          if (MODE != 3 && far_) nsa_compute<MODE, true>(C, kb_, qf, LUTh, impq, tq, h, g, qs, qsf(i + 1), inv, lsum, O, bfar); else nsa_compute<MODE, false>(C, kb_, qf, LUTh, impq, tq, h, g, qs, qsf(i + 1), inv, lsum, O, bfar); }
        SCHED_FENCE();
    }
}
__device__ __forceinline__ float lred(float l) { l += __shfl_xor(l, 16); l += __shfl_xor(l, 32); return l; }
__device__ __forceinline__ void nsa_unit(const KArgs& a, LAS unsigned char* lds, int unit, LAS float* imp, LAS int* selL, int lane) {
    unsigned char* ws = a.ws; const bf16_t* proj = (const bf16_t*)(ws + WS_PROJ);
    const int t0 = 2 * unit, n = lane & 15, g = lane >> 4, qs = n >> 3, h = n & 7, tq = t0 + qs;
    const LAS float* LUT = (const LAS float*)lds + h;
    const float bfar = LUT[1023 * 8];
    bf16x8 qf[2];
    qf[0] = *(const bf16x8*)((const bf16_t*)(ws + WS_QN) + (size_t)tq * 512 + h * 64 + 8 * g); qf[1] = *(const bf16x8*)((const bf16_t*)(ws + WS_QN) + (size_t)tq * 512 + h * 64 + 32 + 8 * g);
    const bf16_t* gp = proj + (size_t)tq * NPAD + C_NGATE + h * 3;
    const float g0 = 1.f / (1.f + __expf(-bf2f(gp[0]))), g1 = 1.f / (1.f + __expf(-bf2f(gp[1]))), g2 = 1.f / (1.f + __expf(-bf2f(gp[2])));
    f32x4 Ot[4], Ob[4];
#pragma unroll
    for (int i = 0; i < 4; ++i) { Ot[i] = (f32x4){0.f, 0.f, 0.f, 0.f}; Ob[i] = (f32x4){0.f, 0.f, 0.f, 0.f}; }
    const int nvmax = (t0 + 1 >= 31) ? (((t0 + 1 - 31) >> 4) + 1) : 0; const int nch = (nvmax + 31) >> 5;
    const bf16_t* KC = (const bf16_t*)(ws + WS_KCMP); const bf16_t* VCT = (const bf16_t*)(ws + WS_VCMPT);
    auto kb_lin = [](int i) { return 32 * i; }; auto qs_zero = [](int) { return 0; };
    float lsum = 0.f;
    nsa_run<0>(nch, KC, VCT, kb_lin, qs_zero, qf, LUT, imp + qs * 1024, tq, h, n, g, qs, 0.f, lsum, Ob, t0, bfar);
    { const float l = lred(lsum); const float inv = l > 0.f ? 1.f / l : 0.f; float dummy = 0.f;
      nsa_run<1>(nch, KC, VCT, kb_lin, qs_zero, qf, LUT, imp + qs * 1024, tq, h, n, g, qs, inv, dummy, Ob, t0, bfar); }
#pragma unroll
    for (int i = 0; i < 4; ++i) { Ot[i] += Ob[i] * g0; Ob[i] = (f32x4){0.f, 0.f, 0.f, 0.f}; }
    LDS_FENCE();
    int cnts[2];
#pragma unroll
    for (int q2 = 0; q2 < 2; ++q2) { const int tqq = t0 + q2, cur = tqq >> 6; const LAS float* iq = imp + q2 * 1024;
        float val[4];
#pragma unroll
        for (int r = 0; r < 4; ++r) { const int b = lane + 64 * r; float v = -1.f;
            if (b >= 1 && b <= cur - 2) { v = 0.f;
#pragma unroll
                for (int i = 0; i < 5; ++i) v += iq[4 * b - 1 + i]; }
            val[r] = v; }
        int cnt = 0;
        if (lane == 0) { selL[q2 * 8 + 0] = 0; if (cur >= 1) selL[q2 * 8 + 1] = cur; if (cur >= 2) selL[q2 * 8 + 2] = cur - 1; }
        cnt = 1 + (cur >= 1) + (cur >= 2);
        int ncand = cur - 2; if (ncand < 0) ncand = 0; const int npick = ncand < 5 ? ncand : 5;
        for (int rd = 0; rd < npick; ++rd) { float bv = val[0]; int bi = lane;
#pragma unroll
            for (int r = 1; r < 4; ++r) if (val[r] > bv) { bv = val[r]; bi = lane + 64 * r; }
#pragma unroll
            for (int o = 1; o < 64; o <<= 1) { const float ov = __shfl_xor(bv, o); const int oi = __shfl_xor(bi, o); if (ov > bv || (ov == bv && oi < bi)) { bv = ov; bi = oi; } }
            if (lane == 0) selL[q2 * 8 + cnt] = bi; ++cnt;
#pragma unroll
            for (int r = 0; r < 4; ++r) if (bi == lane + 64 * r) val[r] = -2.f; }
        cnts[q2] = cnt; }
    LDS_FENCE();
#pragma unroll
    for (int i = 0; i < 4; ++i)
#pragma unroll
        for (int j = 0; j < 4; ++j) imp[(4 * i + j) * 64 + lane] = Ot[i][j];
    lsum = 0.f;
    { const int c0 = cnts[0], c1 = cnts[1];
      const int b1 = (lane < c1) ? selL[8 + lane] : -1;
      int pos = -1;
      for (int k = 0; k < c0; ++k) if (selL[k] == b1) pos = k;
      LDS_FENCE();
      if (lane < c0) selL[16 + lane] = 1;
      LDS_FENCE();
      const bool fresh = (lane < c1) && (pos < 0);
      if (lane < c1 && pos >= 0) selL[16 + pos] = 3;
      const unsigned long long nb = __ballot(fresh);
      if (fresh) { const int idx = c0 + __popcll(nb & ((1ull << lane) - 1ull)); selL[idx] = b1; selL[16 + idx] = 2; }
      const int tot = c0 + __popcll(nb);
      LDS_FENCE();
      auto kbf = [&](int i) { return 64 * __builtin_amdgcn_readfirstlane(selL[i >> 1]) + 32 * (i & 1); };
      auto qsf = [&](int i) { return __builtin_amdgcn_readfirstlane(selL[16 + (i >> 1)]); };
      nsa_run<2>(2 * tot, (const bf16_t*)(ws + WS_KSN), (const bf16_t*)(ws + WS_VST), kbf, qsf, qf, LUT, imp, tq, h, n, g, qs, 0.f, lsum, Ob, t0, bfar); }
    { const float l = lred(lsum); const float sc = l > 0.f ? g1 / l : 0.f;
#pragma unroll
      for (int i = 0; i < 4; ++i) {
#pragma unroll
          for (int j = 0; j < 4; ++j) imp[(4 * i + j) * 64 + lane] += Ob[i][j] * sc;
          Ob[i] = (f32x4){0.f, 0.f, 0.f, 0.f}; } }
    lsum = 0.f;
    { int lo = t0 - 511; if (lo < 0) lo = 0; lo &= ~31; const int nw = ((t0 + 1 - lo) >> 5) + 1;
      auto kbf = [&](int i) { return lo + 32 * i; };
      nsa_run<3>(nw, (const bf16_t*)(ws + WS_KWN), (const bf16_t*)(ws + WS_VWT), kbf, qs_zero, qf, LUT, imp, tq, h, n, g, qs, 0.f, lsum, Ob, t0, bfar);
      const float l = lred(lsum); const float sc = l > 0.f ? g2 / l : 0.f;
#pragma unroll
      for (int i = 0; i < 4; ++i)
#pragma unroll
          for (int j = 0; j < 4; ++j) Ot[i][j] = imp[(4 * i + j) * 64 + lane] + Ob[i][j] * sc; }
    bf16_t* orow = (bf16_t*)(ws + WS_ONSA) + (size_t)tq * 512 + h * 64;
#pragma unroll
    for (int db = 0; db < 4; ++db) { u32x2 w; w.x = cvt_pk_bf16(Ot[db][0], Ot[db][1]); w.y = cvt_pk_bf16(Ot[db][2], Ot[db][3]); *(u32x2*)(orow + 16 * db + 4 * g) = w; }
}


#define RLX_AGENT __ATOMIC_RELAXED, __HIP_MEMORY_SCOPE_AGENT
#define XB_TMO      128
#define XB_XCNT(j)  (256  + 64 * (j))
#define XB_XSUB(j)  (1280 + 64 * (j))
#define XB_XGEN(j)  (2304 + 64 * (j))
#define XB_TOP      3328
#define XB_TOPGEN   3392
#define XCD_BAR_WORDS 3456
#define XB_SPIN_CAP (1u << 18)

__device__ __forceinline__ unsigned xb_ld(unsigned* p)              { return __hip_atomic_load(p, __ATOMIC_RELAXED, __HIP_MEMORY_SCOPE_AGENT); }
__device__ __forceinline__ unsigned xb_add(unsigned* p, unsigned v) { return __hip_atomic_fetch_add(p, v, __ATOMIC_RELAXED, __HIP_MEMORY_SCOPE_AGENT); }
__device__ __forceinline__ unsigned xb_xcc_id() { return (unsigned)__builtin_amdgcn_s_getreg((3 << 11) | 20) & 0xFu; }
#define XB_SPIN(cond, bar) do { unsigned _sp = 0; while (cond) { __builtin_amdgcn_s_sleep(1); \
    if ((++_sp & 255u) == 0u) { if (xb_ld(&(bar)[XB_TMO])) break; if (_sp > XB_SPIN_CAP) { atomicAdd(&(bar)[XB_TMO], 1u); break; } } } } while (0)

struct XcdBarrier {
    unsigned* bar; unsigned x;
    volatile LAS unsigned* st;
};

__device__ __forceinline__ XcdBarrier xcd_barrier_post(unsigned* bar, volatile LAS unsigned* st) {
    XcdBarrier b; b.bar = bar; b.x = xb_xcc_id(); b.st = st;
    if (threadIdx.x == 0) (void)xb_add(&bar[XB_XCNT(b.x)], 1u);
    return b;
}
__device__ __forceinline__ void xcd_barrier_complete(unsigned* bar, unsigned x, unsigned& nloc, unsigned& nx) {
    const unsigned G = gridDim.x * gridDim.y * gridDim.z;
    unsigned sum, cnt, mine, sp = 0u;
    for (;;) {
        sum = 0u; cnt = 0u; mine = 0u;
#pragma unroll
        for (unsigned j = 0; j < 16; ++j) { const unsigned c = xb_ld(&bar[XB_XCNT(j)]); sum += c; cnt += (c > 0u) ? 1u : 0u; mine = (j == x) ? c : mine; }
        if (sum == G) break;
        __builtin_amdgcn_s_sleep(1);
        if ((++sp & 255u) == 0u) { if (xb_ld(&bar[XB_TMO])) break; if (sp > XB_SPIN_CAP) { atomicAdd(&bar[XB_TMO], 1u); break; } }
    }
    nloc = mine > 0u ? mine : 1u; nx = cnt > 0u ? cnt : 1u;
}

__device__ __forceinline__ void xcd_barrier(const XcdBarrier& b) {
    asm volatile("s_waitcnt vmcnt(0)" ::: "memory");
    __syncthreads();
    if (threadIdx.x == 0) {
        unsigned* bar = b.bar;
        __builtin_amdgcn_s_waitcnt(0);
        unsigned nloc = b.st[0], nx = b.st[1];
        if (nloc == 0u) { xcd_barrier_complete(bar, b.x, nloc, nx); b.st[0] = nloc; b.st[1] = nx; }
        const unsigned old = xb_add(&bar[XB_XSUB(b.x)], 1u);
        const unsigned gen = old / nloc;
        if (old + 1u == (gen + 1u) * nloc) {
            __builtin_amdgcn_fence(__ATOMIC_RELEASE, "agent");
            asm volatile("s_waitcnt vmcnt(0)" ::: "memory");
            const unsigned og = xb_add(&bar[XB_TOP], 1u);
            const unsigned tg = og / nx;
            if (og + 1u == (tg + 1u) * nx) xb_add(&bar[XB_TOPGEN], 1u);
            else XB_SPIN(xb_ld(&bar[XB_TOPGEN]) == tg, bar);
            __builtin_amdgcn_fence(__ATOMIC_ACQUIRE, "agent");
            xb_add(&bar[XB_XGEN(b.x)], 1u);
            asm volatile("s_waitcnt vmcnt(0)" ::: "memory");
        } else {
            XB_SPIN(xb_ld(&bar[XB_XGEN(b.x)]) == gen, bar);
            __builtin_amdgcn_fence(__ATOMIC_ACQUIRE, "agent");
            asm volatile("s_waitcnt vmcnt(0)" ::: "memory");
        }
    }
    __syncthreads();
}

#define GSYNC() xcd_barrier(xbar)
__global__ void __launch_bounds__(512) __attribute__((amdgpu_waves_per_eu(2, 2))) fwd_mega(KArgs a) {
    extern __shared__ __attribute__((aligned(16))) unsigned char lds_raw[];
    LAS unsigned char* lds = (LAS unsigned char*)lds_raw;
    const int G = gridDim.x, bid = blockIdx.x, NGW = G * 8;
    const int vb = (G % 8 == 0) ? (bid % 8) * (G / 8) + bid / 8 : bid;
    { volatile LAS unsigned* stw = (volatile LAS unsigned*)(lds + 132608); if (threadIdx.x < 2) stw[threadIdx.x] = 0u; }
    __syncthreads();
    XcdBarrier xbar = xcd_barrier_post((unsigned*)(a.ws + WS_CTL), (volatile LAS unsigned*)(lds + 132608));
    cg::this_grid().sync();
#define IDS() int tid = threadIdx.x; asm volatile("" : "+v"(tid)); const int lane = tid & 63, wave = __builtin_amdgcn_readfirstlane(tid >> 6); const int gw = bid * 8 + wave; (void)lane; (void)gw;
    unsigned char* ws = a.ws;
    bf16_t* PROJ = (bf16_t*)(ws + WS_PROJ); bf16_t* HN = (bf16_t*)(ws + WS_HN); bf16_t* HID = (bf16_t*)(ws + WS_HID);
#pragma unroll 1
    for (int l = 0; l < DEPTH; ++l) {
        const float* xsrc = (l == 0) ? a.in[0] : a.out;
        { IDS(); phase_convert(a, l, lds, gw, NGW, wave, lane);
          phase_rms(xsrc, a.in[1] + l * DM, HN, gw, NGW, lane); }
        GSYNC();
        { pg8::Gemm g{HN, (const bf16_t*)(ws + WS_WIN), M, NPAD, DM}; pg8::StaticOrder S; S.init(M, NPAD, G, bid);
          pg8::EpiBf16<0> E{PROJ, NPAD};
          pg8::gemm_phase<pg8::EpiBf16<0>, pg8::StaticOrder, true, true>(lds, g, S, E); }
        GSYNC();
        { IDS(); for (int it = bid; it < 256; it += G) pre_item(a, l, lds, it, tid); }
        { IDS(); for (int it = bid; it < 128; it += G) cmp_item(a, l, lds, it, tid, wave, lane); }
        { IDS(); for (int it = bid; it < 2048; it += G) gla_g1_item(a, l, lds, it, tid, wave, lane); }
        GSYNC();
        {   IDS();
            { const float* lg = (const float*)(ws + WS_LUT); LAS float* LUT = (LAS float*)lds; for (int i = tid; i < 8192; i += 512) LUT[i] = lg[i]; }
            LAS int* ctr = (LAS int*)(lds + 132096);
            LAS unsigned* sbc = (LAS unsigned*)(lds + 132112);
            if (tid == 0) { *ctr = 0; *sbc = 0u; }
            __syncthreads();
            if (wave < 4) {
                unsigned gen = 0u;
                for (int pp = vb; pp < 512; pp += G) {
                    const int hh = pp & 3, q = pp >> 2;
                    sb_unit4(a, lds + 65536, sbc, gen, hh, 255 - q, wave, lane);
                    sb_unit4(a, lds + 65536, sbc, gen, hh, q, wave, lane); }
            } else {
                for (int c0 = (bid * 4 + (wave - 4)) * 64; c0 < 65536; c0 += G * 256) gla_scan(a, c0 + lane);
            }
            LAS float* imp = (LAS float*)(lds + (wave < 4 ? 65536 + wave * 8192 : 32768 + (wave - 4) * 8192));
            LAS int* selL = (LAS int*)(lds + 131072 + wave * 128);
            const int nper = (8192 + G - 1) / G;
            for (;;) { int idx = 0; if (lane == 0) idx = atomicAdd((int*)ctr, 1); idx = __builtin_amdgcn_readfirstlane(idx);
                if (idx >= nper) break; const int hn = nper >> 1; const int unit = (idx < hn) ? (8192 - hn * (vb + 1) + idx) : (hn * vb + (idx - hn)); if (unit >= 0 && unit < 8192) nsa_unit(a, lds, unit, imp, selL, lane); }
            __syncthreads();
        }
        GSYNC();
        { IDS(); for (int it = bid; it < 2048; it += G) gla_g3_item(a, l, lds, it, tid, wave, lane); }
        GSYNC();
        for (int b = 0; b < 3; ++b) {
            pg8::Gemm g{(const bf16_t*)(ws + WS_OGLA + b * 16 * MiB), (const bf16_t*)(ws + WS_WBR + b * MiB), M, DM, 512}; pg8::StaticOrder S; S.init(M, DM, G, bid);
            pg8::EpiGate E{HN, PROJ + C_MGATE + b * DM, NPAD, b == 0 ? 1 : 0};
            pg8::gemm_phase<pg8::EpiGate, pg8::StaticOrder, true, true>(lds, g, S, E); }
        GSYNC();
        { pg8::Gemm g{HN, (const bf16_t*)(ws + WS_WOUT), M, DM, DM}; pg8::StaticOrder S; S.init(M, DM, G, bid);
          pg8::EpiRes E{xsrc, a.out};
          pg8::gemm_phase<pg8::EpiRes, pg8::StaticOrder, true, true>(lds, g, S, E); }
        GSYNC();
        { IDS(); phase_rms(a.out, a.in[2] + l * DM, HN, gw, NGW, lane); }
        GSYNC();
        { pg8::Gemm g{HN, (const bf16_t*)(ws + WS_WUP), M, FF, DM}; pg8::StaticOrder S; S.init(M, FF, G, bid);
          pg8::EpiBf16<2> E{HID, FF};
          pg8::gemm_phase<pg8::EpiBf16<2>, pg8::StaticOrder, true, true>(lds, g, S, E); }
        GSYNC();
        { pg8::Gemm g{HID, (const bf16_t*)(ws + WS_WDN), M, DM, FF}; pg8::StaticOrder S; S.init(M, DM, G, bid);
          pg8::EpiRes E{a.out, a.out};
          pg8::gemm_phase<pg8::EpiRes, pg8::StaticOrder, true, true>(lds, g, S, E); }
        GSYNC();
    }
}

extern "C" void kernel_launch(void* const* d_in, const int* in_sizes, int n_in, void* d_out, int out_size, void* d_ws, size_t ws_size, hipStream_t stream) {
    static int grid = 0;
    if (grid == 0) {
        if (n_in != 22 || ws_size < WS_END + 65536) { fprintf(stderr, "kernel_launch: unexpected n_in %d or ws_size %zu (< %zu)\n", n_in, ws_size, (size_t)WS_END); grid = -1; return; }
        int dev = 0, cus = 0, per_cu = 0;
        hipGetDevice(&dev); hipDeviceGetAttribute(&cus, hipDeviceAttributeMultiprocessorCount, dev);
        hipFuncSetAttribute((const void*)fwd_mega, hipFuncAttributeMaxDynamicSharedMemorySize, LDS_BYTES);
        hipOccupancyMaxActiveBlocksPerMultiprocessor(&per_cu, (const void*)fwd_mega, 512, LDS_BYTES);
        if (per_cu < 1) { fprintf(stderr, "kernel_launch: occupancy query says %d blocks/CU\n", per_cu); per_cu = 1; }
        (void)hipGetLastError();
        grid = cus * 1;
    }
    if (grid < 0) return;
    if (hipMemsetAsync((char*)d_ws + WS_CTL, 0, 65536, stream) != hipSuccess) { fprintf(stderr, "kernel_launch: memset of barrier words failed\n"); return; }
    KArgs a{};
    for (int i = 0; i < 22; ++i) a.in[i] = (const float*)d_in[i];
    a.out = (float*)d_out; a.ws = (unsigned char*)d_ws;
    void* args[] = {&a};
    hipError_t e = hipLaunchCooperativeKernel((const void*)fwd_mega, dim3(grid), dim3(512), args, LDS_BYTES, stream);
    if (e != hipSuccess) fprintf(stderr, "cooperative launch failed: %s (grid %d)\n", hipGetErrorString(e), grid);
}
```

```cpp
#include <hip/hip_runtime.h>
#include <hip/hip_cooperative_groups.h>
#include <cstdio>
#include <cstdint>
namespace cg = cooperative_groups;
namespace pg8 {
#define PG8_LAS __attribute__((address_space(3)))
typedef unsigned short bf16_t;
typedef short bf16x8 __attribute__((ext_vector_type(8)));
typedef float f32x4 __attribute__((ext_vector_type(4)));
typedef unsigned u32x4 __attribute__((ext_vector_type(4)));
constexpr int BM = 256, BK = 64, HALF = 128, HTB = HALF * BK * 2  , STAGE_BYTES = 8 * HTB, NXCD = 8, WGM = 8;

__host__ __device__ __forceinline__ int lds_byte(int r, int c) { const int st = (r >> 4) * 2 + (c >> 5), rr = r & 15, cc = c & 31, ob = rr * 64 + cc * 2; return st * 1024 + (ob ^ (((ob >> 9) & 1) << 5)); }
__host__ __device__ __forceinline__ void stage_rc(int b, int& R, int& C) { const int st = b / 1024, sb = b % 1024, swz = sb ^ (((sb >> 9) & 1) << 5); R = (st >> 1) * 16 + swz / 64; C = (st & 1) * 32 + (swz % 64) / 2; }
__host__ __device__ __forceinline__ int perm32(int rho) { const int n = rho >> 4, i = rho & 15; return 8 * (i >> 2) + 4 * n + (i & 3); }

struct Unit { int pm, pn; };
struct Gemm { const bf16_t* A; const bf16_t* Bt; int M, N, K; };

struct StaticOrder {
    int nM, nN, nwg, G, c;
    __host__ __device__ void init(int M, int N, int G_, int c_) { nM = M / BM; nN = N / BM; nwg = nM * nN; G = G_; c = c_; }
    __host__ __device__ bool next(int i, Unit& u) const {
        const long L = (long)i * G + c; if (L >= nwg) return false;
        int wgid = (int)L; { const int q = nwg / NXCD, r = nwg % NXCD, xcd = wgid % NXCD, off = wgid / NXCD; wgid = (xcd < r ? xcd * (q + 1) : r * (q + 1) + (xcd - r) * q) + off; }
        const int nig = WGM * nN, gid = wgid / nig, fm = gid * WGM, gsz = (nM - fm) < WGM ? (nM - fm) : WGM;
        u.pm = fm + ((wgid % nig) % gsz); u.pn = (wgid % nig) / gsz; return true;
    }
    __device__ __forceinline__ void a_ready(const Unit&) const {}
    __device__ __forceinline__ void done(const Unit&) const {}
};

__device__ __forceinline__ unsigned cvt_pk_bf16(float lo, float hi) { unsigned r; asm("v_cvt_pk_bf16_f32 %0, %1, %2" : "=v"(r) : "v"(lo), "v"(hi)); return r; }
__device__ __forceinline__ float bflo(unsigned w) { return __uint_as_float(w << 16); }
__device__ __forceinline__ float bfhi(unsigned w) { return __uint_as_float(w & 0xffff0000u); }
template <int ACT> struct EpiBf16 {
    static constexpr bool PERM = true, AFTER_DRAIN = false;
    bf16_t* O; int ldc;
    __device__ __forceinline__ void operator()(const f32x4 (&acc)[2][2][4][2], const Unit& u, int wr, int wc, int fr, int fq) const {
        const int row0 = u.pm * BM + wr * 64 + fr; const int col0 = u.pn * BM + wc * 32 + 8 * fq;
#pragma unroll
        for (int ai = 0; ai < 2; ++ai)
#pragma unroll
            for (int m = 0; m < 4; ++m) { bf16_t* rowp = O + (size_t)(row0 + ai * HALF + m * 16) * ldc + col0;
#pragma unroll
                for (int bj = 0; bj < 2; ++bj) { f32x4 v0 = acc[ai][bj][m][0], v1 = acc[ai][bj][m][1];
                    if (ACT == 2) {
#pragma unroll
                        for (int e = 0; e < 4; ++e) { float a = fmaxf(v0[e], 0.f), b = fmaxf(v1[e], 0.f); v0[e] = a * a; v1[e] = b * b; } }
                    u32x4 w; w.x = cvt_pk_bf16(v0[0], v0[1]); w.y = cvt_pk_bf16(v0[2], v0[3]); w.z = cvt_pk_bf16(v1[0], v1[1]); w.w = cvt_pk_bf16(v1[2], v1[3]);
                    *(u32x4*)(rowp + bj * HALF) = w; } }
    }
};
struct EpiGate {
    static constexpr bool PERM = true, AFTER_DRAIN = false;
    bf16_t* O; const bf16_t* gate; int gld; int first;
    __device__ __forceinline__ void operator()(const f32x4 (&acc)[2][2][4][2], const Unit& u, int wr, int wc, int fr, int fq) const {
        const int row0 = u.pm * BM + wr * 64 + fr; const int col0 = u.pn * BM + wc * 32 + 8 * fq;
#pragma unroll
        for (int ai = 0; ai < 2; ++ai)
#pragma unroll
            for (int m = 0; m < 4; ++m) { const int row = row0 + ai * HALF + m * 16; bf16_t* rowp = O + (size_t)row * 1024 + col0; const bf16_t* gp = gate + (size_t)row * gld + col0;
#pragma unroll
                for (int bj = 0; bj < 2; ++bj) { const f32x4 v0 = acc[ai][bj][m][0], v1 = acc[ai][bj][m][1];
                    const u32x4 gw = *(const u32x4*)(gp + bj * HALF);
                    u32x4 ow = (u32x4){0u, 0u, 0u, 0u}; if (!first) ow = *(const u32x4*)(rowp + bj * HALF);
                    float gv[8] = {bflo(gw.x), bfhi(gw.x), bflo(gw.y), bfhi(gw.y), bflo(gw.z), bfhi(gw.z), bflo(gw.w), bfhi(gw.w)};
                    float ov[8] = {bflo(ow.x), bfhi(ow.x), bflo(ow.y), bfhi(ow.y), bflo(ow.z), bfhi(ow.z), bflo(ow.w), bfhi(ow.w)};
                    float av[8] = {v0[0], v0[1], v0[2], v0[3], v1[0], v1[1], v1[2], v1[3]};
                    float r[8];
#pragma unroll
                    for (int e = 0; e < 8; ++e) { const float s = 1.f / (1.f + __expf(-gv[e])); r[e] = ov[e] + s * av[e]; }
                    u32x4 w; w.x = cvt_pk_bf16(r[0], r[1]); w.y = cvt_pk_bf16(r[2], r[3]); w.z = cvt_pk_bf16(r[4], r[5]); w.w = cvt_pk_bf16(r[6], r[7]);
                    *(u32x4*)(rowp + bj * HALF) = w; } }
    }
};
struct EpiRes {
    static constexpr bool PERM = false, AFTER_DRAIN = false;
    const float* src; float* out;
    __device__ __forceinline__ void operator()(const f32x4 (&acc)[2][2][4][2], const Unit& u, int wr, int wc, int fr, int fq) const {
        const int col0 = u.pn * BM + wc * 32 + 4 * fq;
#pragma unroll
        for (int ai = 0; ai < 2; ++ai)
#pragma unroll
            for (int m = 0; m < 4; ++m) { const size_t off = (size_t)(u.pm * BM + ai * HALF + wr * 64 + m * 16 + fr) * 1024 + col0;
#pragma unroll
                for (int bj = 0; bj < 2; ++bj)
#pragma unroll
                    for (int n = 0; n < 2; ++n) { const f32x4 bs = *(const f32x4*)(src + off + bj * HALF + n * 16); *(f32x4*)(out + off + bj * HALF + n * 16) = bs + acc[ai][bj][m][n]; } }
    }
};
template <class Epi, class Sched, bool ALIGN_EPI = false, bool SP2 = false>
__device__ __forceinline__ void gemm_phase(PG8_LAS unsigned char* lds, const Gemm g, const Sched& S, const Epi& E) {
    int tid_ = threadIdx.x; asm volatile("" : "+v"(tid_));
    const int tid = tid_, wid = __builtin_amdgcn_readfirstlane(tid >> 6), lane = tid & 63, wr = wid >> 2, wc = wid & 3, fr = lane & 15, fq = lane >> 4;
    const int K = g.K, nt = K / BK;
    unsigned voffA[2], voffB[2];
#pragma unroll
    for (int i = 0; i < 2; ++i) { int R, C; stage_rc(tid * 16 + i * 8192, R, C); const int Rb = Epi::PERM ? ((R & ~31) + perm32(R & 31)) : R;
        voffA[i] = (unsigned)(R * K + C) * 2u; voffB[i] = (unsigned)(Rb * K + C) * 2u; }
    const size_t kstep = (size_t)(BK * 2);
    const size_t hstep = (size_t)HALF * K * 2;
    const size_t tstep = 2 * hstep;
    const unsigned ldsw = (unsigned)wid * 1024u;
    const int aoff = lds_byte(wr * 64 + fr, fq * 8), boff = lds_byte(wc * 32 + fr, fq * 8);
#define PG8_SA(b, h) (((b) * 2 + (h)) * HTB)
#define PG8_SB(b, h) ((4 + (b) * 2 + (h)) * HTB)
#define PG8_STAGE(bufoff, gbase, voff) do { _Pragma("unroll") for (int _i = 0; _i < 2; ++_i) \
        __builtin_amdgcn_global_load_lds((const unsigned*)((const char*)(gbase) + (voff)[_i]), (PG8_LAS unsigned*)(lds + (bufoff) + ldsw + _i * 8192), 16, 0, 0); } while (0)
#define PG8_LDA(dst, b, h) do { _Pragma("unroll") for (int m = 0; m < 4; ++m) _Pragma("unroll") for (int k = 0; k < 2; ++k) dst[m][k] = *(const PG8_LAS bf16x8*)(lds + PG8_SA(b, h) + aoff + m * 2048 + k * 1024); } while (0)
#define PG8_LDB(dst, b, h) do { _Pragma("unroll") for (int n = 0; n < 2; ++n) _Pragma("unroll") for (int k = 0; k < 2; ++k) dst[n][k] = *(const PG8_LAS bf16x8*)(lds + PG8_SB(b, h) + boff + n * 2048 + k * 1024); } while (0)
#define PG8_MMA(ai, bj, At, Bt) do { __builtin_amdgcn_s_setprio(1); _Pragma("unroll") for (int m = 0; m < 4; ++m) _Pragma("unroll") for (int n = 0; n < 2; ++n) _Pragma("unroll") for (int k = 0; k < 2; ++k) \
        acc[ai][bj][m][n] = __builtin_amdgcn_mfma_f32_16x16x32_bf16(Bt[n][k], At[m][k], acc[ai][bj][m][n], 0, 0, 0); __builtin_amdgcn_s_setprio(0); } while (0)
#define PG8_WAIT_V(n) asm volatile("s_waitcnt vmcnt(" #n ")" ::: "memory")
#define PG8_WAIT_L(n) asm volatile("s_waitcnt lgkmcnt(" #n ")" ::: "memory")
#define PG8_BAR __builtin_amdgcn_s_barrier()
#define PG8_SCHED __builtin_amdgcn_sched_barrier(0)
    Unit cur, nxt; int ui = 0;
    if (!S.next(0, cur)) return;
    f32x4 acc[2][2][4][2];
#pragma unroll
    for (int a = 0; a < 2; ++a)
#pragma unroll
        for (int b = 0; b < 2; ++b)
#pragma unroll
            for (int m = 0; m < 4; ++m)
#pragma unroll
                for (int n = 0; n < 2; ++n) acc[a][b][m][n] = (f32x4){0.f, 0.f, 0.f, 0.f};
    bf16x8 At[4][2], B0[2][2], B1[2][2];
    const char* cA = (const char*)g.A + (size_t)cur.pm * tstep; const char* cB = (const char*)g.Bt + (size_t)cur.pn * tstep;
    S.a_ready(cur);
    if constexpr (SP2) {
        PG8_STAGE(PG8_SB(0, 0), cB, voffB); PG8_STAGE(PG8_SB(0, 1), cB + hstep, voffB); PG8_STAGE(PG8_SA(0, 0), cA, voffA); PG8_STAGE(PG8_SA(0, 1), cA + hstep, voffA);
        if (wr == 1) PG8_BAR;
        PG8_WAIT_V(2); PG8_BAR;
        PG8_STAGE(PG8_SB(1, 0), cB + kstep, voffB); PG8_STAGE(PG8_SA(1, 0), cA + kstep, voffA); PG8_STAGE(PG8_SB(1, 1), cB + hstep + kstep, voffB);
        PG8_WAIT_V(6); PG8_BAR;
    } else {
        PG8_STAGE(PG8_SB(0, 0), cB, voffB); PG8_STAGE(PG8_SA(0, 0), cA, voffA); PG8_STAGE(PG8_SB(0, 1), cB + hstep, voffB); PG8_STAGE(PG8_SA(0, 1), cA + hstep, voffA);
        if (wr == 1) PG8_BAR;
        PG8_WAIT_V(4); PG8_BAR;
        PG8_STAGE(PG8_SB(1, 0), cB + kstep, voffB); PG8_STAGE(PG8_SA(1, 0), cA + kstep, voffA); PG8_STAGE(PG8_SB(1, 1), cB + hstep + kstep, voffB);
        PG8_WAIT_V(6); PG8_BAR;
    }
    for (;;) {
        const bool has_next = S.next(ui + 1, nxt);
        const char* nA = has_next ? (const char*)g.A + (size_t)nxt.pm * tstep : cA; const char* nB = has_next ? (const char*)g.Bt + (size_t)nxt.pn * tstep : cB;
        for (int t = 0; t < nt; t += 2) {
            const bool last = (t == nt - 2);
            const char* a1 = cA + (size_t)(t + 1) * kstep;
            const char* a2 = last ? nA : cA + (size_t)(t + 2) * kstep; const char* b2 = last ? nB : cB + (size_t)(t + 2) * kstep;
            const char* a3 = a2 + kstep; const char* b3 = b2 + kstep;
            if (last && has_next) S.a_ready(nxt);
            if constexpr (SP2) {
            PG8_LDB(B0, 0, 0); PG8_LDB(B1, 0, 1); PG8_SCHED; PG8_LDA(At, 0, 0); PG8_STAGE(PG8_SA(1, 1), a1 + hstep, voffA);
            PG8_WAIT_V(8); PG8_WAIT_L(0); PG8_BAR; PG8_MMA(0, 0, At, B0); PG8_MMA(0, 1, At, B1); PG8_BAR; PG8_SCHED;
            PG8_LDA(At, 0, 1); PG8_STAGE(PG8_SB(0, 0), b2, voffB); PG8_STAGE(PG8_SB(0, 1), b2 + hstep, voffB); PG8_STAGE(PG8_SA(0, 0), a2, voffA);
            PG8_WAIT_V(8); PG8_WAIT_L(0); PG8_BAR; PG8_MMA(1, 0, At, B0); PG8_MMA(1, 1, At, B1); PG8_BAR; PG8_SCHED;
            PG8_LDB(B0, 1, 0); PG8_LDB(B1, 1, 1); PG8_SCHED; PG8_LDA(At, 1, 0); PG8_STAGE(PG8_SA(0, 1), a2 + hstep, voffA);
            PG8_WAIT_V(8); PG8_WAIT_L(0); PG8_BAR; PG8_MMA(0, 0, At, B0); PG8_MMA(0, 1, At, B1); PG8_BAR; PG8_SCHED;
            PG8_LDA(At, 1, 1); PG8_STAGE(PG8_SB(1, 0), b3, voffB); PG8_STAGE(PG8_SB(1, 1), b3 + hstep, voffB); PG8_STAGE(PG8_SA(1, 0), a3, voffA);
            PG8_WAIT_V(8); PG8_WAIT_L(0); PG8_BAR; PG8_MMA(1, 0, At, B0); PG8_MMA(1, 1, At, B1); PG8_BAR; PG8_SCHED;
            } else {
            PG8_LDB(B0, 0, 0); PG8_SCHED; PG8_LDA(At, 0, 0); PG8_STAGE(PG8_SA(1, 1), a1 + hstep, voffA);
            PG8_WAIT_L(8); PG8_BAR; PG8_WAIT_L(0); PG8_MMA(0, 0, At, B0); PG8_BAR; PG8_SCHED;
            PG8_LDB(B1, 0, 1); PG8_STAGE(PG8_SB(0, 0), b2, voffB);
            PG8_BAR; PG8_WAIT_L(0); PG8_MMA(0, 1, At, B1); PG8_BAR;
            PG8_LDA(At, 0, 1); PG8_STAGE(PG8_SA(0, 0), a2, voffA);
            PG8_BAR; PG8_WAIT_L(0); PG8_MMA(1, 0, At, B0); PG8_BAR; PG8_SCHED;
            PG8_STAGE(PG8_SB(0, 1), b2 + hstep, voffB);
            PG8_WAIT_V(6); PG8_BAR; PG8_MMA(1, 1, At, B1); PG8_BAR;
            PG8_LDB(B0, 1, 0); PG8_SCHED; PG8_LDA(At, 1, 0); PG8_STAGE(PG8_SA(0, 1), a2 + hstep, voffA);
            PG8_WAIT_L(8); PG8_BAR; PG8_WAIT_L(0); PG8_MMA(0, 0, At, B0); PG8_BAR; PG8_SCHED;
            PG8_LDB(B1, 1, 1); PG8_STAGE(PG8_SB(1, 0), b3, voffB);
            PG8_BAR; PG8_WAIT_L(0); PG8_MMA(0, 1, At, B1); PG8_BAR;
            PG8_LDA(At, 1, 1); PG8_STAGE(PG8_SA(1, 0), a3, voffA);
            PG8_BAR; PG8_WAIT_L(0); PG8_MMA(1, 0, At, B0); PG8_BAR; PG8_SCHED;
            PG8_STAGE(PG8_SB(1, 1), b3 + hstep, voffB);
            PG8_WAIT_V(6); PG8_BAR; PG8_MMA(1, 1, At, B1); PG8_BAR;
            }
        }
        if constexpr (ALIGN_EPI) { if (wr == 0) PG8_BAR; }
        if constexpr (!Epi::AFTER_DRAIN) { E(acc, cur, wr, wc, fr, fq); S.done(cur); }
        if (!has_next) break;
#pragma unroll
        for (int a = 0; a < 2; ++a)
#pragma unroll
            for (int b = 0; b < 2; ++b)
#pragma unroll
                for (int m = 0; m < 4; ++m)
#pragma unroll
                    for (int n = 0; n < 2; ++n) acc[a][b][m][n] = (f32x4){0.f, 0.f, 0.f, 0.f};
        cur = nxt; cA = nA; cB = nB; ++ui;
        if constexpr (ALIGN_EPI) { if (wr == 1) PG8_BAR; }
    }
    PG8_WAIT_V(0);
    if constexpr (!ALIGN_EPI) { if (wr == 0) PG8_BAR; }
    PG8_BAR;
    if constexpr (Epi::AFTER_DRAIN) { E.fused(acc, cur, wr, wc, fr, fq, lds, wid, lane); S.done(cur); }
#undef PG8_SA
#undef PG8_SB
#undef PG8_STAGE
#undef PG8_LDA
#undef PG8_LDB
#undef PG8_MMA
#undef PG8_WAIT_V
#undef PG8_WAIT_L
#undef PG8_BAR
#undef PG8_SCHED
}
}

#define LAS __attribute__((address_space(3)))
typedef unsigned short bf16_t;
typedef short bf16x8 __attribute__((ext_vector_type(8)));
typedef float f32x4 __attribute__((ext_vector_type(4)));
typedef unsigned u32x4 __attribute__((ext_vector_type(4)));
typedef unsigned u32x2 __attribute__((ext_vector_type(2)));
using pg8::cvt_pk_bf16; using pg8::bflo; using pg8::bfhi;

constexpr int M = 16384, DM = 1024, NIN = 7592, NPAD = 7680, FF = 4096, DEPTH = 4;
constexpr int C_GQ = 0, C_GK = 512, C_GV = 1024, C_GA = 1536, C_GR = 1552, C_SQ = 2064, C_SK = 2576, C_SV = 3088, C_NQ = 3600, C_NKC = 4112, C_NVC = 4176,
              C_NKS = 4240, C_NVS = 4304, C_NKW = 4368, C_NVW = 4432, C_NGATE = 4496, C_MGATE = 4520;
constexpr size_t MiB = 1u << 20;
constexpr size_t WS_PROJ = 0, WS_HID = 0, WS_HN = 240 * MiB, WS_OGLA = 272 * MiB, WS_OSB = 288 * MiB, WS_ONSA = 304 * MiB;
constexpr size_t WS_WIN = 320 * MiB, WS_WUP = 335 * MiB, WS_WDN = 343 * MiB, WS_WOUT = 351 * MiB, WS_WBR = 353 * MiB, WS_WK1 = 356 * MiB, WS_WV1 = 357 * MiB,
                 WS_WK2 = 358 * MiB, WS_WV2 = 358 * MiB + 65536, WS_CB = 358 * MiB + 131072, WS_LUT = 358 * MiB + 196608;
constexpr size_t WS_GST = 360 * MiB, WS_GDC = 424 * MiB, WS_SVT = 425 * MiB, WS_QN = 441 * MiB, WS_KSN = 457 * MiB, WS_KWN = 459 * MiB, WS_VST = 461 * MiB, WS_VWT = 463 * MiB,
                 WS_KCMP = 465 * MiB, WS_VCMPT = 465 * MiB + 131072, WS_END = 466 * MiB, WS_CTL = 466 * MiB;
constexpr int LDS_BYTES = 133120;
constexpr float LOG2E = 1.4426950408889634f;

struct KArgs { const float* in[22]; float* out; unsigned char* ws; };

__device__ __forceinline__ float bf2f(bf16_t v) { return __uint_as_float(((unsigned)v) << 16); }
__device__ __forceinline__ bf16_t f2bf(float f) { unsigned u = __float_as_uint(f); return (bf16_t)((u + 0x7fffu + ((u >> 16) & 1u)) >> 16); }
__device__ __forceinline__ f32x4 mfma16(bf16x8 a, bf16x8 b, f32x4 c) { return __builtin_amdgcn_mfma_f32_16x16x32_bf16(a, b, c, 0, 0, 0); }
__device__ __forceinline__ float wave_sum(float v) {
#pragma unroll
    for (int o = 1; o < 64; o <<= 1) v += __shfl_xor(v, o);
    return v;
}
#define LDS_FENCE() asm volatile("s_waitcnt lgkmcnt(0)" ::: "memory")
#define SCHED_FENCE_G() __builtin_amdgcn_sched_barrier(0)
__device__ __forceinline__ void unpack8(const u32x4 w, float (&f)[8]) { f[0] = bflo(w.x); f[1] = bfhi(w.x); f[2] = bflo(w.y); f[3] = bfhi(w.y); f[4] = bflo(w.z); f[5] = bfhi(w.z); f[6] = bflo(w.w); f[7] = bfhi(w.w); }
__device__ __forceinline__ u32x4 pack8(const float (&r)[8]) { u32x4 w; w.x = cvt_pk_bf16(r[0], r[1]); w.y = cvt_pk_bf16(r[2], r[3]); w.z = cvt_pk_bf16(r[4], r[5]); w.w = cvt_pk_bf16(r[6], r[7]); return w; }

__device__ __forceinline__ void transpose_item(const float* W, int K, int N, int Npad, bf16_t* WT, LAS float* scr, int item, int lane) {
    const int nblk = Npad / 32, kb = item / nblk, nb = item % nblk, k0 = 64 * kb, n0 = 32 * nb;
    const int nn = n0 + (lane & 31);
    float tv[32];
#pragma unroll
    for (int i = 0; i < 32; ++i) { const int kk = 2 * i + (lane >> 5); tv[i] = (nn < N) ? W[(size_t)(k0 + kk) * N + nn] : 0.f; }
#pragma unroll
    for (int i = 0; i < 32; ++i) { const int kk = 2 * i + (lane >> 5); scr[kk * 33 + (lane & 31)] = tv[i]; }
    LDS_FENCE();
    const int c = lane & 7;
#pragma unroll
    for (int j = 0; j < 4; ++j) { const int n = (lane >> 3) + 8 * j; const LAS float* s = scr + (8 * c) * 33 + n;
        u32x4 o; o.x = cvt_pk_bf16(s[0 * 33], s[1 * 33]); o.y = cvt_pk_bf16(s[2 * 33], s[3 * 33]); o.z = cvt_pk_bf16(s[4 * 33], s[5 * 33]); o.w = cvt_pk_bf16(s[6 * 33], s[7 * 33]);
        *(u32x4*)(WT + (size_t)(n0 + n) * K + k0 + 8 * c) = o; }
    LDS_FENCE();
}
__device__ __forceinline__ int rel_bucket(int n) {
    if (n < 16) return n;
    int large = 16 + (int)(logf((float)n / 16.f) / 4.1588830833596715f * 16.f);
    return large < 31 ? large : 31;
}
__device__ __forceinline__ void rms_row(const float* xrow, const float* g, bf16_t* orow, int lane) {
    const f32x4* xr = (const f32x4*)xrow + lane; f32x4 v[4]; float s = 0.f;
#pragma unroll
    for (int j = 0; j < 4; ++j) { v[j] = xr[64 * j]; s += (v[j].x * v[j].x + v[j].y * v[j].y) + (v[j].z * v[j].z + v[j].w * v[j].w); }
    const float rinv = rsqrtf(wave_sum(s) * (1.f / 1024.f) + 1e-6f);
    u32x2* o8 = (u32x2*)orow + lane;
#pragma unroll
    for (int j = 0; j < 4; ++j) { const f32x4 gg = ((const f32x4*)g)[lane + 64 * j]; u32x2 w; w.x = cvt_pk_bf16(v[j].x * rinv * gg.x, v[j].y * rinv * gg.y); w.y = cvt_pk_bf16(v[j].z * rinv * gg.z, v[j].w * rinv * gg.w); o8[64 * j] = w; }
}
__device__ __forceinline__ void phase_convert(const KArgs& a, int l, LAS unsigned char* lds, int gw, int NGW, int wave, int lane) {
    unsigned char* ws = a.ws;
    LAS float* scr = (LAS float*)(lds + wave * 8704);
    constexpr int I0 = 16 * 240, I1 = 16 * 128, I2 = 64 * 32, I3 = 16 * 32, I4 = 8 * 32, I7 = 32 * 8, I9 = 4 * 2, IB = 128, IL = 128;
    constexpr int NIT = I0 + I1 + I2 + I3 + 3 * I4 + 2 * I7 + 2 * I9 + IB + IL;
    for (int it = gw; it < NIT; it += NGW) {
        int r = it;
        if (r < I0) { transpose_item(a.in[3] + (size_t)l * DM * NIN, DM, NIN, NPAD, (bf16_t*)(ws + WS_WIN), scr, r, lane); continue; } r -= I0;
        if (r < I1) { transpose_item(a.in[20] + (size_t)l * DM * FF, DM, FF, FF, (bf16_t*)(ws + WS_WUP), scr, r, lane); continue; } r -= I1;
        if (r < I2) { transpose_item(a.in[21] + (size_t)l * FF * DM, FF, DM, DM, (bf16_t*)(ws + WS_WDN), scr, r, lane); continue; } r -= I2;
        if (r < I3) { transpose_item(a.in[19] + (size_t)l * DM * DM, DM, DM, DM, (bf16_t*)(ws + WS_WOUT), scr, r, lane); continue; } r -= I3;
        if (r < 3 * I4) { const int b = r / I4; transpose_item(a.in[16 + b] + (size_t)l * 512 * DM, 512, DM, DM, (bf16_t*)(ws + WS_WBR + b * MiB), scr, r % I4, lane); continue; } r -= 3 * I4;
        if (r < I7) { transpose_item(a.in[11] + (size_t)l * 2048 * 256, 2048, 256, 256, (bf16_t*)(ws + WS_WK1), scr, r, lane); continue; } r -= I7;
        if (r < I7) { transpose_item(a.in[13] + (size_t)l * 2048 * 256, 2048, 256, 256, (bf16_t*)(ws + WS_WV1), scr, r, lane); continue; } r -= I7;
        if (r < I9) { transpose_item(a.in[12] + (size_t)l * 256 * 64, 256, 64, 64, (bf16_t*)(ws + WS_WK2), scr, r, lane); continue; } r -= I9;
        if (r < I9) { transpose_item(a.in[14] + (size_t)l * 256 * 64, 256, 64, 64, (bf16_t*)(ws + WS_WV2), scr, r, lane); continue; } r -= I9;
        if (r < IB) {
            const int p = r >> 3, which = (r >> 2) & 1, col = (r & 3) * 64 + lane;
            const float* pe = a.in[which ? 10 : 9] + (size_t)l * 2048; const float* w1 = a.in[which ? 13 : 11] + (size_t)l * 2048 * 256;
            float s = 0.f;
#pragma unroll 1
            for (int k0 = 128 * p; k0 < 128 * p + 128; k0 += 16) { float wv[16];
#pragma unroll
                for (int i = 0; i < 16; ++i) wv[i] = w1[(size_t)(k0 + i) * 256 + col];
#pragma unroll
                for (int i = 0; i < 16; ++i) s += pe[k0 + i] * wv[i]; }
            ((float*)(ws + WS_CB))[p * 512 + which * 256 + col] = s; continue; } r -= IB;
        {
            const int idx = r * 64 + lane; const int d = idx >> 3, h = idx & 7;
            ((float*)(ws + WS_LUT))[idx] = a.in[15][rel_bucket(d) * 8 + h] * LOG2E; }
    }
}
__device__ __forceinline__ void phase_rms(const float* x, const float* g, bf16_t* hn, int gw, int NGW, int lane) {
    f32x4 gg[4];
#pragma unroll
    for (int j = 0; j < 4; ++j) gg[j] = ((const f32x4*)g)[lane + 64 * j];
    for (int m = gw; m < M; m += 2 * NGW) { const int m2 = (m + NGW < M) ? m + NGW : m;
        const f32x4* xa = (const f32x4*)(x + (size_t)m * DM) + lane; const f32x4* xb = (const f32x4*)(x + (size_t)m2 * DM) + lane;
        f32x4 va[4], vb[4]; float sa = 0.f, sb = 0.f;
#pragma unroll
        for (int j = 0; j < 4; ++j) { va[j] = xa[64 * j]; vb[j] = xb[64 * j]; }
#pragma unroll
        for (int j = 0; j < 4; ++j) { sa += (va[j].x * va[j].x + va[j].y * va[j].y) + (va[j].z * va[j].z + va[j].w * va[j].w); sb += (vb[j].x * vb[j].x + vb[j].y * vb[j].y) + (vb[j].z * vb[j].z + vb[j].w * vb[j].w); }
#pragma unroll
        for (int o = 1; o < 64; o <<= 1) { sa += __shfl_xor(sa, o); sb += __shfl_xor(sb, o); }
        const float ra = rsqrtf(sa * (1.f / 1024.f) + 1e-6f), rb = rsqrtf(sb * (1.f / 1024.f) + 1e-6f);
        u32x2* oa = (u32x2*)(hn + (size_t)m * DM) + lane; u32x2* ob = (u32x2*)(hn + (size_t)m2 * DM) + lane;
#pragma unroll
        for (int j = 0; j < 4; ++j) { u32x2 w; w.x = cvt_pk_bf16(va[j].x * ra * gg[j].x, va[j].y * ra * gg[j].y); w.y = cvt_pk_bf16(va[j].z * ra * gg[j].z, va[j].w * ra * gg[j].w); oa[64 * j] = w;
            u32x2 w2; w2.x = cvt_pk_bf16(vb[j].x * rb * gg[j].x, vb[j].y * rb * gg[j].y); w2.y = cvt_pk_bf16(vb[j].z * rb * gg[j].z, vb[j].w * rb * gg[j].w); ob[64 * j] = w2; } }
}

__device__ __forceinline__ void rms64_to(const bf16_t* src, const float* g, float scale, bf16_t* dst) {
    u32x4 w[8]; float ss = 0.f;
#pragma unroll
    for (int i = 0; i < 8; ++i) { w[i] = ((const u32x4*)src)[i]; float f[8]; unpack8(w[i], f);
#pragma unroll
        for (int e = 0; e < 8; ++e) ss += f[e] * f[e]; }
    const float rinv = rsqrtf(ss * (1.f / 64.f) + 1e-6f) * scale;
#pragma unroll
    for (int i = 0; i < 8; ++i) { float f[8]; unpack8(w[i], f); float r[8];
#pragma unroll
        for (int e = 0; e < 8; ++e) r[e] = f[e] * rinv * g[8 * i + e];
        ((u32x4*)dst)[i] = pack8(r); }
}
__device__ __forceinline__ void pre_item(const KArgs& a, int l, LAS unsigned char* lds, int item, int tid) {
    unsigned char* ws = a.ws; const bf16_t* proj = (const bf16_t*)(ws + WS_PROJ);
    const int t0 = item * 64;
    {
        const int tl = tid >> 3, h = tid & 7;
        rms64_to(proj + (size_t)(t0 + tl) * NPAD + C_NQ + h * 64, a.in[7] + l * 64, 0.125f * LOG2E, (bf16_t*)(ws + WS_QN) + (size_t)(t0 + tl) * 512 + h * 64);
    }
    if (tid < 128) {
        const int tl = tid >> 1, which = tid & 1;
        rms64_to(proj + (size_t)(t0 + tl) * NPAD + (which ? C_NKW : C_NKS), a.in[8] + l * 64, 1.f, (bf16_t*)(ws + (which ? WS_KWN : WS_KSN)) + (size_t)(t0 + tl) * 64);
    }
    LAS bf16_t* T = (LAS bf16_t*)lds;
    for (int idx = tid; idx < 64 * 80; idx += 512) { const int t = idx / 80, p = idx % 80; const int col = p < 64 ? C_SV + 8 * p : (p < 72 ? C_NVS + 8 * (p - 64) : C_NVW + 8 * (p - 72));
        const u32x4 w = *(const u32x4*)(proj + (size_t)(t0 + t) * NPAD + col);
        LAS unsigned* d = (LAS unsigned*)(T + t * 648 + 8 * p); d[0] = w.x; d[1] = w.y; d[2] = w.z; d[3] = w.w; }
    __syncthreads();
    for (int idx = tid; idx < 640 * 8; idx += 512) { const int c = idx >> 3, p = idx & 7;
        unsigned short e[8];
#pragma unroll
        for (int j = 0; j < 8; ++j) e[j] = T[(8 * p + j) * 648 + c];
        u32x4 w; w.x = e[0] | ((unsigned)e[1] << 16); w.y = e[2] | ((unsigned)e[3] << 16); w.z = e[4] | ((unsigned)e[5] << 16); w.w = e[6] | ((unsigned)e[7] << 16);
        const int tk = t0 + 8 * p;
        if (c < 512) *(u32x4*)((bf16_t*)(ws + WS_SVT) + ((size_t)(((c >> 7) * 256 + (tk >> 6)) * 128 + (c & 127))) * 64 + (tk & 63)) = w;
        else { const int d = (c - 512) & 63; bf16_t* vb = (bf16_t*)(ws + (c < 576 ? WS_VST : WS_VWT)); *(u32x4*)(vb + ((size_t)((tk >> 5) * 64 + d)) * 32 + (tk & 31)) = w; } }
    __syncthreads();
}
__device__ __forceinline__ void cmp_item(const KArgs& a, int l, LAS unsigned char* lds, int item, int tid, int wave, int lane) {
    unsigned char* ws = a.ws; const bf16_t* proj = (const bf16_t*)(ws + WS_PROJ);
    const int which = item & 1, grp = item >> 1, i0 = 16 * grp;
    const int srcoff = which ? C_NVC : C_NKC;
    const bf16_t* w1T = (const bf16_t*)(ws + (which ? WS_WV1 : WS_WK1)); const bf16_t* w2T = (const bf16_t*)(ws + (which ? WS_WV2 : WS_WK2));
    LAS bf16_t* hidL = (LAS bf16_t*)lds;
    LAS float* outL = (LAS float*)(lds + 16384);
    LAS float* rinvL = (LAS float*)(lds + 24576);
    const int r = lane & 15, g = lane >> 4;
    int irow = i0 + r; if (irow > 1022) irow = 1022;
    const bf16_t* arow = proj + (size_t)(16 * irow) * NPAD + srcoff;
    f32x4 acc[2] = {(f32x4){0.f, 0.f, 0.f, 0.f}, (f32x4){0.f, 0.f, 0.f, 0.f}};
    const bf16_t* b0 = w1T + (size_t)(32 * wave + r) * 2048 + 8 * g; const bf16_t* b1 = b0 + 16 * 2048;
#pragma unroll 8
    for (int ks = 0; ks < 64; ++ks) { const int k = 32 * ks + 8 * g;
        const bf16x8 af = *(const bf16x8*)(arow + (size_t)(k >> 6) * NPAD + (k & 63));
        const bf16x8 bf0 = *(const bf16x8*)(b0 + 32 * ks), bf1 = *(const bf16x8*)(b1 + 32 * ks);
        acc[0] = mfma16(af, bf0, acc[0]); acc[1] = mfma16(af, bf1, acc[1]); }
    const float* cb = (const float*)(ws + WS_CB);
#pragma unroll
    for (int nb = 0; nb < 2; ++nb) { const int col = 32 * wave + 16 * nb + r; float bs = 0.f;
#pragma unroll
        for (int p = 0; p < 16; ++p) bs += cb[p * 512 + which * 256 + col];
#pragma unroll
        for (int j = 0; j < 4; ++j) { const float x = acc[nb][j] + bs; const float u = 0.7978845608028654f * (x + 0.044715f * x * x * x);
            const float th = 1.f - 2.f / (__expf(2.f * u) + 1.f); hidL[(4 * g + j) * 264 + col] = f2bf(0.5f * x * (1.f + th)); } }
    __syncthreads();
    if (wave < 4) { f32x4 c2 = (f32x4){0.f, 0.f, 0.f, 0.f};
#pragma unroll
        for (int ks = 0; ks < 8; ++ks) { const bf16x8 af = *(const LAS bf16x8*)(hidL + r * 264 + 32 * ks + 8 * g); const bf16x8 bfr = *(const bf16x8*)(w2T + (size_t)(16 * wave + r) * 256 + 32 * ks + 8 * g); c2 = mfma16(af, bfr, c2); }
#pragma unroll
        for (int j = 0; j < 4; ++j) outL[(4 * g + j) * 65 + 16 * wave + r] = c2[j]; }
    __syncthreads();
    if (tid < 16) { float ss = 0.f; for (int d = 0; d < 64; ++d) { const float v = outL[tid * 65 + d]; ss += v * v; } rinvL[tid] = rsqrtf(ss * (1.f / 64.f) + 1e-6f); }
    __syncthreads();
    const float* kg = a.in[8] + l * 64;
    for (int idx = tid; idx < 1024; idx += 512) { const int row = idx >> 6, d = idx & 63, i = i0 + row; const float v = outL[row * 65 + d];
        if (which == 0) ((bf16_t*)(ws + WS_KCMP))[(size_t)i * 64 + d] = (i <= 1022) ? f2bf(v * rinvL[row] * kg[d]) : (bf16_t)0;
        else ((bf16_t*)(ws + WS_VCMPT))[((size_t)((i >> 5) * 64 + d)) * 32 + (i & 31)] = (i <= 1022) ? f2bf(v) : (bf16_t)0; }
    __syncthreads();
}
struct GlaPre { float asrc; float w[16]; float ba; };
__device__ __forceinline__ void gla_preload(GlaPre& p, const KArgs& a, int l, int c, int h, int tid) {
    const bf16_t* proj = (const bf16_t*)(a.ws + WS_PROJ);
    p.asrc = bf2f(proj[(size_t)(32 * c + (tid >> 4)) * NPAD + C_GA + (tid & 15)]);
    const int hk = h * 128 + (tid & 127);
#pragma unroll
    for (int r = 0; r < 16; ++r) p.w[r] = a.in[4][(size_t)l * 16 * 512 + r * 512 + hk];
    p.ba = a.in[5][l * 512 + hk];
}
__device__ __forceinline__ void gla_decay(const GlaPre& p, LAS float* bL, LAS float* aL, int tid) {
    LAS float* segL = aL + 512;
    aL[tid] = p.asrc;
    __syncthreads();
    const int kk = tid & 127, sg = tid >> 7;
    { float cum = 0.f;
#pragma unroll
        for (int tt = 0; tt < 8; ++tt) { const int t = 8 * sg + tt; float x = p.ba;
#pragma unroll
            for (int r = 0; r < 16; ++r) x += aL[t * 16 + r] * p.w[r];
            const float ls = fminf(x, 0.f) - __logf(1.f + __expf(-fabsf(x)));
            cum += ls * (1.f / 16.f); bL[t * 128 + kk] = cum; }
        segL[sg * 128 + kk] = cum; }
    __syncthreads();
    { float off = 0.f;
#pragma unroll
        for (int q = 0; q < 3; ++q) if (q < sg) off += segL[q * 128 + kk];
        if (sg > 0) {
#pragma unroll
            for (int tt = 0; tt < 8; ++tt) bL[(8 * sg + tt) * 128 + kk] += off; } }
    __syncthreads();
}
__device__ __forceinline__ void gla_g1_item(const KArgs& a, int l, LAS unsigned char* lds, int item, int tid, int wave, int lane) {
    unsigned char* ws = a.ws; const bf16_t* proj = (const bf16_t*)(ws + WS_PROJ);
    const int c = item >> 2, h = item & 3;
    LAS float* bL = (LAS float*)lds; LAS float* aL = (LAS float*)(lds + 16384);
    LAS bf16_t* kT = (LAS bf16_t*)(lds + 20480);
    LAS bf16_t* vT = (LAS bf16_t*)(lds + 20480 + 10240);
    GlaPre pre; gla_preload(pre, a, l, c, h, tid);
    const int s = tid >> 4, k0 = (tid & 15) * 8;
    const size_t ro = (size_t)(32 * c + s) * NPAD + h * 128 + k0;
    const u32x4 kraw = *(const u32x4*)(proj + ro + C_GK), vraw = *(const u32x4*)(proj + ro + C_GV);
    gla_decay(pre, bL, aL, tid);
    { float kf[8]; unpack8(kraw, kf);
      const unsigned vw[4] = {vraw.x, vraw.y, vraw.z, vraw.w};
#pragma unroll
      for (int e = 0; e < 8; ++e) { const int k = k0 + e; kT[k * 40 + s] = f2bf(kf[e] * __expf(bL[31 * 128 + k] - bL[s * 128 + k])); vT[k * 40 + s] = (bf16_t)((vw[e >> 1] >> (16 * (e & 1))) & 0xffffu); } }
    if (tid < 128) ((float*)(ws + WS_GDC))[(size_t)(c * 4 + h) * 128 + tid] = __expf(bL[31 * 128 + tid]);
    __syncthreads();
    const int r = lane & 15, g = lane >> 4;
    const bf16x8 af = *(const LAS bf16x8*)(vT + (16 * wave + r) * 40 + 8 * g);
    bf16_t* dst = (bf16_t*)(ws + WS_GST) + (size_t)(c * 4 + h) * 16384;
#pragma unroll
    for (int kb = 0; kb < 8; ++kb) { const bf16x8 bfr = *(const LAS bf16x8*)(kT + (16 * kb + r) * 40 + 8 * g);
        const f32x4 d = mfma16(af, bfr, (f32x4){0.f, 0.f, 0.f, 0.f});
#pragma unroll
        for (int j = 0; j < 4; ++j) dst[(size_t)(16 * wave + 4 * g + j) * 128 + 16 * kb + r] = f2bf(d[j]); }
    __syncthreads();
}
__device__ __forceinline__ void gla_scan(const KArgs& a, int cid) {
    bf16_t* st = (bf16_t*)(a.ws + WS_GST); const float* dc = (const float*)(a.ws + WS_GDC);
    const int h = cid >> 14, vk = cid & 16383, k = cid & 127;
    bf16_t* sp = st + (size_t)h * 16384 + vk; const float* dp = dc + (size_t)h * 128 + k;
    float state = 0.f;
    unsigned short kva[8], kvb[8]; float da[8], db[8];
#pragma unroll
    for (int i = 0; i < 8; ++i) { kva[i] = sp[(size_t)i * 65536]; da[i] = dp[(size_t)i * 512]; }
    for (int c0 = 0; c0 < 512; c0 += 16) {
#pragma unroll
        for (int i = 0; i < 8; ++i) { kvb[i] = sp[(size_t)(c0 + 8 + i) * 65536]; db[i] = dp[(size_t)(c0 + 8 + i) * 512]; }
        SCHED_FENCE_G();
#pragma unroll
        for (int i = 0; i < 8; ++i) { sp[(size_t)(c0 + i) * 65536] = f2bf(state); state = state * da[i] + bf2f(kva[i]); }
        SCHED_FENCE_G();
        if (c0 + 16 < 512) {
#pragma unroll
            for (int i = 0; i < 8; ++i) { kva[i] = sp[(size_t)(c0 + 16 + i) * 65536]; da[i] = dp[(size_t)(c0 + 16 + i) * 512]; } }
        SCHED_FENCE_G();
#pragma unroll
        for (int i = 0; i < 8; ++i) { sp[(size_t)(c0 + 8 + i) * 65536] = f2bf(state); state = state * db[i] + bf2f(kvb[i]); }
        SCHED_FENCE_G();
    }
}
__device__ __forceinline__ void gla_g3_item(const KArgs& a, int l, LAS unsigned char* lds, int item, int tid, int wave, int lane) {
    unsigned char* ws = a.ws; const bf16_t* proj = (const bf16_t*)(ws + WS_PROJ);
    const int c = item >> 2, h = item & 3;
    LAS float* bL = (LAS float*)lds; LAS float* aL = (LAS float*)(lds + 16384);
    LAS bf16_t* qL = (LAS bf16_t*)(lds + 20480);
    LAS bf16_t* kL = (LAS bf16_t*)(lds + 20480 + 8704);
    LAS bf16_t* vT = (LAS bf16_t*)(lds + 20480 + 17408);
    LAS bf16_t* scL = (LAS bf16_t*)(lds + 20480 + 27648);
    LAS float* oL = (LAS float*)(lds + 20480 + 30208);
    const int r = lane & 15, g = lane >> 4;
    GlaPre pre; gla_preload(pre, a, l, c, h, tid);
    const int s = tid >> 4, k0 = (tid & 15) * 8;
    const size_t ro = (size_t)(32 * c + s) * NPAD + h * 128 + k0;
    const u32x4 qraw = *(const u32x4*)(proj + ro + C_GQ), kraw = *(const u32x4*)(proj + ro + C_GK), vraw = *(const u32x4*)(proj + ro + C_GV), rraw = *(const u32x4*)(proj + ro + C_GR);
    const bf16_t* stT = (const bf16_t*)(ws + WS_GST) + (size_t)(c * 4 + h) * 16384;
    bf16x8 stf[4];
#pragma unroll
    for (int ks = 0; ks < 4; ++ks) stf[ks] = *(const bf16x8*)(stT + (size_t)(16 * wave + r) * 128 + 32 * ks + 8 * g);
    float ng[8];
#pragma unroll
    for (int e = 0; e < 8; ++e) ng[e] = a.in[6][l * 128 + k0 + e];
    gla_decay(pre, bL, aL, tid);
    { float qf[8], kf[8]; unpack8(qraw, qf); unpack8(kraw, kf); float qo[8], ko[8];
      const unsigned vw[4] = {vraw.x, vraw.y, vraw.z, vraw.w};
#pragma unroll
      for (int e = 0; e < 8; ++e) { const float b = bL[s * 128 + k0 + e]; qo[e] = qf[e] * __expf(b) * 0.08838834764831845f; ko[e] = kf[e] * __expf(-b); vT[(k0 + e) * 40 + s] = (bf16_t)((vw[e >> 1] >> (16 * (e & 1))) & 0xffffu); }
      *(LAS u32x4*)(qL + s * 136 + k0) = pack8(qo); *(LAS u32x4*)(kL + s * 136 + k0) = pack8(ko); }
    __syncthreads();
    if (wave < 4) { const int mb = wave >> 1, nb = wave & 1; f32x4 d = (f32x4){0.f, 0.f, 0.f, 0.f};
#pragma unroll
        for (int ks = 0; ks < 4; ++ks) d = mfma16(*(const LAS bf16x8*)(qL + (16 * mb + r) * 136 + 32 * ks + 8 * g), *(const LAS bf16x8*)(kL + (16 * nb + r) * 136 + 32 * ks + 8 * g), d);
#pragma unroll
        for (int j = 0; j < 4; ++j) { const int t = 16 * mb + 4 * g + j, sq = 16 * nb + r; scL[t * 40 + sq] = (sq <= t) ? f2bf(d[j]) : (bf16_t)0; } }
    __syncthreads();
#pragma unroll
    for (int mb = 0; mb < 2; ++mb) { f32x4 d = (f32x4){0.f, 0.f, 0.f, 0.f};
#pragma unroll
        for (int ks = 0; ks < 4; ++ks) d = mfma16(*(const LAS bf16x8*)(qL + (16 * mb + r) * 136 + 32 * ks + 8 * g), stf[ks], d);
        d = mfma16(*(const LAS bf16x8*)(scL + (16 * mb + r) * 40 + 8 * g), *(const LAS bf16x8*)(vT + (16 * wave + r) * 40 + 8 * g), d);
#pragma unroll
        for (int j = 0; j < 4; ++j) oL[(16 * mb + 4 * g + j) * 132 + 16 * wave + r] = d[j]; }
    __syncthreads();
    { float o[8]; float ss = 0.f;
#pragma unroll
        for (int e = 0; e < 8; ++e) { o[e] = oL[s * 132 + k0 + e]; ss += o[e] * o[e]; }
        ss += __shfl_xor(ss, 1); ss += __shfl_xor(ss, 2); ss += __shfl_xor(ss, 4); ss += __shfl_xor(ss, 8);
        const float rinv = rsqrtf(ss * (1.f / 128.f) + 1e-6f);
        float rr[8]; unpack8(rraw, rr); float res[8];
#pragma unroll
        for (int e = 0; e < 8; ++e) { const float on = o[e] * rinv * ng[e]; const float si = rr[e] / (1.f + __expf(-rr[e])); res[e] = on * si; }
        *(u32x4*)((bf16_t*)(ws + WS_OGLA) + (size_t)(32 * c + s) * 512 + h * 128 + k0) = pack8(res); }
    __syncthreads();
}

__device__ __forceinline__ float xor16f(float t, int g) { const auto r = __builtin_amdgcn_permlane16_swap(__float_as_uint(t), __float_as_uint(t), false, false); return __uint_as_float(r[0] == __float_as_uint(t) ? r[1] : r[0]); }
__device__ __forceinline__ float xor32f(float t, int g) { const auto r = __builtin_amdgcn_permlane32_swap(__float_as_uint(t), __float_as_uint(t), false, false); return __uint_as_float(r[0] == __float_as_uint(t) ? r[1] : r[0]); }
#define SCHED_FENCE() __builtin_amdgcn_sched_barrier(0)
template <bool DIAG>
__device__ __forceinline__ void sb_weights(const f32x4 (&S)[2], bf16x8& pf, float& carry, int g, int cc, int krel) {
    float e[8], P[8];
#pragma unroll
    for (int j = 0; j < 8; ++j) { int zi = __float_as_int(S[j >> 2][j & 3]); zi = zi < 0x41700000 ? zi : 0x41700000;
        float z = __int_as_float(zi);
        if (DIAG) { if (32 * cc + 8 * g + j >= krel) z = -1e30f; }
        e[j] = __builtin_amdgcn_exp2f(z); }
    P[0] = 1.f;
#pragma unroll
    for (int j = 1; j < 8; ++j) P[j] = P[j - 1] * (1.f + e[j - 1]);
    const float Tg = __builtin_amdgcn_rcpf(P[7] * (1.f + e[7]));
    const float t1 = __shfl_xor(Tg, 16);
    const float pp = Tg * t1;
    const float t23 = __shfl_xor(pp, 32);
    const float gex = ((g & 1) ? 1.f : t1) * ((g & 2) ? 1.f : t23);
    const float cf = Tg * gex * carry;
    carry = carry * (pp * t23);
    float w[8];
#pragma unroll
    for (int j = 0; j < 8; ++j) w[j] = (e[j] * P[j]) * cf;
    const u32x4 pw = pack8(w); __builtin_memcpy(&pf, &pw, 16);
}
template <bool DIAG>
__device__ __forceinline__ void sb_tile(const LAS bf16_t* Kt, const LAS bf16_t* Vt, const bf16x8 (&qf)[4], f32x4 (&O)[8], float& carry, int n, int g, int krel  ) {
    f32x4 S[2][2];
#pragma unroll
    for (int cc = 1; cc >= 0; --cc) {
        bf16x8 kf[2][4];
#pragma unroll
        for (int pb = 0; pb < 2; ++pb)
#pragma unroll
            for (int ks = 0; ks < 4; ++ks) kf[pb][ks] = *(const LAS bf16x8*)(Kt + (32 * cc + 16 * pb + n) * 128 + (((4 * ks + g) ^ n) << 3));
        SCHED_FENCE();
#pragma unroll
        for (int pb = 0; pb < 2; ++pb) { f32x4 sv = (f32x4){0.f, 0.f, 0.f, 0.f};
#pragma unroll
            for (int ks = 0; ks < 4; ++ks) sv = mfma16(kf[pb][ks], qf[ks], sv);
            S[cc][pb] = sv; }
        SCHED_FENCE();
    }
    bf16x8 vf[8], pf1, pf0;
#pragma unroll
    for (int db = 0; db < 8; ++db) vf[db] = *(const LAS bf16x8*)(Vt + (16 * db + n) * 64 + (((4 + g) ^ (n >> 1)) << 3));
    SCHED_FENCE();
    sb_weights<DIAG>(S[1], pf1, carry, g, 1, krel);
    SCHED_FENCE();
#pragma unroll
    for (int db = 0; db < 8; ++db) O[db] = mfma16(vf[db], pf1, O[db]);
    SCHED_FENCE();
#pragma unroll
    for (int db = 0; db < 8; ++db) vf[db] = *(const LAS bf16x8*)(Vt + (16 * db + n) * 64 + ((g ^ (n >> 1)) << 3));
    SCHED_FENCE();
    sb_weights<DIAG>(S[0], pf0, carry, g, 0, krel);
    SCHED_FENCE();
#pragma unroll
    for (int db = 0; db < 8; ++db) O[db] = mfma16(vf[db], pf0, O[db]);
    SCHED_FENCE();
}
__device__ __forceinline__ void sb_swbar(LAS unsigned* ctr, unsigned& gen, int lane) {
    asm volatile("s_waitcnt vmcnt(0) lgkmcnt(0)" ::: "memory");
    gen += 4u;
    if (lane == 0) { __hip_atomic_fetch_add(ctr, 1u, __ATOMIC_RELAXED, __HIP_MEMORY_SCOPE_WORKGROUP);
        while (__hip_atomic_load(ctr, __ATOMIC_RELAXED, __HIP_MEMORY_SCOPE_WORKGROUP) < gen) __builtin_amdgcn_s_sleep(1); }
    asm volatile("s_waitcnt lgkmcnt(0)" ::: "memory");
}
__device__ __forceinline__ void sb_unit4(const KArgs& a, LAS unsigned char* sbl, LAS unsigned* ctr, unsigned& gen, int h, int qb, int wave, int lane) {
    unsigned char* ws = a.ws; const bf16_t* proj = (const bf16_t*)(ws + WS_PROJ);
    constexpr int KT_B = 64 * 256, BUF_B = 32768;
    const int n = lane & 15, g = lane >> 4;
    const int tq = 64 * qb + 16 * wave + n;
    const float SC = 0.08838834764831845f * LOG2E;
    bf16x8 qf[4];
#pragma unroll
    for (int ks = 0; ks < 4; ++ks) { const u32x4 w = *(const u32x4*)(proj + (size_t)tq * NPAD + C_SQ + h * 128 + 32 * ks + 8 * g); float f[8]; unpack8(w, f);
#pragma unroll
        for (int e = 0; e < 8; ++e) f[e] *= SC;
        const u32x4 pw = pack8(f); __builtin_memcpy(&qf[ks], &pw, 16); }
    f32x4 O[8];
#pragma unroll
    for (int i = 0; i < 8; ++i) O[i] = (f32x4){0.f, 0.f, 0.f, 0.f};
    float carry = 1.f;
    volatile LAS unsigned* alive = (volatile LAS unsigned*)(ctr + 8);
    const int ntiles = qb + 1;
    const char* kbase = (const char*)(proj + C_SK + h * 128); const char* vbase = (const char*)((const bf16_t*)(ws + WS_SVT) + (size_t)h * 256 * 8192);
    auto issue = [&](int T, int buf) {
        const char* kt = kbase + (size_t)(64 * T) * NPAD * 2; const char* vt = vbase + (size_t)T * 16384;
#pragma unroll
        for (int i = 0; i < 4; ++i) { const int p = i * 256 + wave * 64 + lane;
            const int rho = p >> 4, c = (p & 15) ^ (rho & 15), k = (rho & 32) | ((rho & 16) >> 2) | ((rho & 12) << 1) | (rho & 3);
            const unsigned koff = (unsigned)(k * NPAD + 8 * c) * 2u;
            const int d = p >> 3, cv = (p & 7) ^ ((d >> 1) & 7);
            const unsigned voff = (unsigned)(d * 64 + 8 * cv) * 2u;
            __builtin_amdgcn_global_load_lds((const unsigned*)(kt + koff), (LAS unsigned*)(sbl + buf * BUF_B + (i * 256 + wave * 64) * 16), 16, 0, 0);
            __builtin_amdgcn_global_load_lds((const unsigned*)(vt + voff), (LAS unsigned*)(sbl + buf * BUF_B + KT_B + (i * 256 + wave * 64) * 16), 16, 0, 0); } };
    issue(ntiles - 1, 0);
    sb_swbar(ctr, gen, lane);
    for (int it = 0; it < ntiles; ++it) { const int T = ntiles - 1 - it, buf = it & 1;
        if (T > 0) issue(T - 1, buf ^ 1);
        const LAS bf16_t* Kt = (const LAS bf16_t*)(sbl + buf * BUF_B); const LAS bf16_t* Vt = (const LAS bf16_t*)(sbl + buf * BUF_B + KT_B);
        if (it == 0) sb_tile<true>(Kt, Vt, qf, O, carry, n, g, tq - 64 * T);
        else sb_tile<false>(Kt, Vt, qf, O, carry, n, g, 0);
        const bool dead = (__ballot(carry != 0.f) == 0ull);
        if (lane == 0) alive[(it & 1) * 4 + wave] = dead ? 0u : 1u;
        sb_swbar(ctr, gen, lane);
        const unsigned any = alive[(it & 1) * 4 + 0] | alive[(it & 1) * 4 + 1] | alive[(it & 1) * 4 + 2] | alive[(it & 1) * 4 + 3];
        if (__builtin_amdgcn_readfirstlane(any) == 0u) break;
    }
    bf16_t* orow = (bf16_t*)(ws + WS_OSB) + (size_t)tq * 512 + h * 128;
#pragma unroll
    for (int db = 0; db < 8; ++db) { u32x2 w; w.x = cvt_pk_bf16(O[db][0], O[db][1]); w.y = cvt_pk_bf16(O[db][2], O[db][3]); *(u32x2*)(orow + 16 * db + 4 * g) = w; }
}

struct NFrag { bf16x8 k[4]; bf16x8 v[4]; };
template <bool LV> __device__ __forceinline__ void nsa_load(NFrag& f, const bf16_t* Kb, const bf16_t* VB, int kb, int n, int g) {
    const bf16_t* kp = Kb + (size_t)(kb + 8 * (n >> 2) + (n & 3)) * 64 + 8 * g;
    f.k[0] = *(const bf16x8*)kp; f.k[1] = *(const bf16x8*)(kp + 32); f.k[2] = *(const bf16x8*)(kp + 256); f.k[3] = *(const bf16x8*)(kp + 288);
    if (LV) { const bf16_t* vp = VB + ((size_t)(kb >> 5) * 64 + n) * 32 + 8 * g;
#pragma unroll
        for (int db = 0; db < 4; ++db) f.v[db] = *(const bf16x8*)(vp + db * 512); }
}
template <int MODE, bool FAST>
__device__ __forceinline__ void nsa_compute(const NFrag& f, int kb, const bf16x8 (&qf)[2], const LAS float* LUTh, LAS float* impq,
                                            int tq, int h, int g, int qs, int qsel, float inv, float& lsum, f32x4 (&O)[4], float bfar) {
    f32x4 S[2];
#pragma unroll
    for (int pb = 0; pb < 2; ++pb) { f32x4 sv = mfma16(f.k[2 * pb], qf[0], (f32x4){0.f, 0.f, 0.f, 0.f}); S[pb] = mfma16(f.k[2 * pb + 1], qf[1], sv); }
    float p[8];
    const int dbase = (MODE <= 1) ? (tq - 31 - 16 * (kb + 8 * g)) : (tq - kb - 8 * g);
    const bool colok = (MODE == 2) ? (((qsel >> qs) & 1) != 0) : true;
    if (FAST) {
#pragma unroll
        for (int j = 0; j < 8; ++j) { const float ex = __builtin_amdgcn_exp2f(S[j >> 2][j & 3] + bfar);
            float pv = (MODE == 2) ? (colok ? ex : 0.f) : ex;
            if (MODE == 1) pv *= inv;
            p[j] = pv; if (MODE != 1) lsum += pv; }
    } else {
    float bias[8];
#pragma unroll
    for (int j = 0; j < 8; ++j) { const int dist = (MODE <= 1) ? dbase - 16 * j : dbase - j; const unsigned di = min((unsigned)dist, 1023u); bias[j] = LUTh[di * 8]; }
#pragma unroll
    for (int j = 0; j < 8; ++j) asm volatile("" : "+v"(bias[j]));
#pragma unroll
    for (int j = 0; j < 8; ++j) { const int dist = (MODE <= 1) ? dbase - 16 * j : dbase - j;
        const bool valid = (MODE == 3) ? ((unsigned)dist < 512u) : (dist >= 0 && colok);
        const float ex = __builtin_amdgcn_exp2f(S[j >> 2][j & 3] + bias[j]);
        float pv = valid ? ex : 0.f;
        if (MODE == 1) pv *= inv;
        p[j] = pv; if (MODE != 1) lsum += pv; }
    }
    if (MODE == 0) return;
    if (MODE == 1) {
#pragma unroll
        for (int j = 0; j < 8; ++j) { float v = p[j]; v += __shfl_xor(v, 1); v += __shfl_xor(v, 2); v += __shfl_xor(v, 4); if (h == 0) impq[kb + 8 * g + j] = v; } }
    const u32x4 pw = pack8(p); bf16x8 pf; __builtin_memcpy(&pf, &pw, 16);
#pragma unroll
    for (int db = 0; db < 4; ++db) O[db] = mfma16(f.v[db], pf, O[db]);
}
template <int MODE, class KBF, class QSF>
__device__ __forceinline__ void nsa_run(int niter, const bf16_t* Kb, const bf16_t* VB, KBF kbf, QSF qsf, const bf16x8 (&qf)[2], const LAS float* LUTh, LAS float* impq,
                                        int tq, int h, int n, int g, int qs, float inv, float& lsum, f32x4 (&O)[4], int t0, float bfar) {
    if (niter <= 0) return;
    NFrag A, C; const int last = niter - 1;
    nsa_load<MODE != 0>(A, Kb, VB, kbf(0), n, g);
    for (int i = 0; i < niter; i += 2) {
        nsa_load<MODE != 0>(C, Kb, VB, kbf(i + 1 < last ? i + 1 : last), n, g);
        SCHED_FENCE();
        { const int kb_ = kbf(i); const bool far_ = (MODE <= 1) ? (t0 - 31 - 16 * (kb_ + 31) >= 1023) : ((MODE == 2) ? (t0 - (kb_ + 31) >= 1023) : false);
          if (MODE != 3 && far_) nsa_compute<MODE, true>(A, kb_, qf, LUTh, impq, tq, h, g, qs, qsf(i), inv, lsum, O, bfar); else nsa_compute<MODE, false>(A, kb_, qf, LUTh, impq, tq, h, g, qs, qsf(i), inv, lsum, O, bfar); }
        SCHED_FENCE();
        if (i + 1 >= niter) break;
        nsa_load<MODE != 0>(A, Kb, VB, kbf(i + 2 < last ? i + 2 : last), n, g);
        SCHED_FENCE();
        { const int kb_ = kbf(i + 1); const bool far_ = (MODE <= 1) ? (t0 - 31 - 16 * (kb_ + 31) >= 1023) : ((MODE == 2) ? (t0 - (kb_ + 31) >= 1023) : false);
          if (MODE != 3 && far_) nsa_compute<MODE, true>(C, kb_, qf, LUTh, impq, tq, h, g, qs, qsf(i + 1), inv, lsum, O, bfar); else nsa_compute<MODE, false>(C, kb_, qf, LUTh, impq, tq, h, g, qs, qsf(i + 1), inv, lsum, O, bfar); }
        SCHED_FENCE();
    }
}
__device__ __forceinline__ float lred(float l) { l += __shfl_xor(l, 16); l += __shfl_xor(l, 32); return l; }
__device__ __forceinline__ void nsa_unit(const KArgs& a, LAS unsigned char* lds, int unit, LAS float* imp, LAS int* selL, int lane) {
    unsigned char* ws = a.ws; const bf16_t* proj = (const bf16_t*)(ws + WS_PROJ);
    const int t0 = 2 * unit, n = lane & 15, g = lane >> 4, qs = n >> 3, h = n & 7, tq = t0 + qs;
    const LAS float* LUT = (const LAS float*)lds + h;
    const float bfar = LUT[1023 * 8];
    bf16x8 qf[2];
    qf[0] = *(const bf16x8*)((const bf16_t*)(ws + WS_QN) + (size_t)tq * 512 + h * 64 + 8 * g); qf[1] = *(const bf16x8*)((const bf16_t*)(ws + WS_QN) + (size_t)tq * 512 + h * 64 + 32 + 8 * g);
    const bf16_t* gp = proj + (size_t)tq * NPAD + C_NGATE + h * 3;
    const float g0 = 1.f / (1.f + __expf(-bf2f(gp[0]))), g1 = 1.f / (1.f + __expf(-bf2f(gp[1]))), g2 = 1.f / (1.f + __expf(-bf2f(gp[2])));
    f32x4 Ot[4], Ob[4];
#pragma unroll
    for (int i = 0; i < 4; ++i) { Ot[i] = (f32x4){0.f, 0.f, 0.f, 0.f}; Ob[i] = (f32x4){0.f, 0.f, 0.f, 0.f}; }
    const int nvmax = (t0 + 1 >= 31) ? (((t0 + 1 - 31) >> 4) + 1) : 0; const int nch = (nvmax + 31) >> 5;
    const bf16_t* KC = (const bf16_t*)(ws + WS_KCMP); const bf16_t* VCT = (const bf16_t*)(ws + WS_VCMPT);
    auto kb_lin = [](int i) { return 32 * i; }; auto qs_zero = [](int) { return 0; };
    float lsum = 0.f;
    nsa_run<0>(nch, KC, VCT, kb_lin, qs_zero, qf, LUT, imp + qs * 1024, tq, h, n, g, qs, 0.f, lsum, Ob, t0, bfar);
    { const float l = lred(lsum); const float inv = l > 0.f ? 1.f / l : 0.f; float dummy = 0.f;
      nsa_run<1>(nch, KC, VCT, kb_lin, qs_zero, qf, LUT, imp + qs * 1024, tq, h, n, g, qs, inv, dummy, Ob, t0, bfar); }
#pragma unroll
    for (int i = 0; i < 4; ++i) { Ot[i] += Ob[i] * g0; Ob[i] = (f32x4){0.f, 0.f, 0.f, 0.f}; }
    LDS_FENCE();
    int cnts[2];
#pragma unroll
    for (int q2 = 0; q2 < 2; ++q2) { const int tqq = t0 + q2, cur = tqq >> 6; const LAS float* iq = imp + q2 * 1024;
        float val[4];
#pragma unroll
        for (int r = 0; r < 4; ++r) { const int b = lane + 64 * r; float v = -1.f;
            if (b >= 1 && b <= cur - 2) { v = 0.f;
#pragma unroll
                for (int i = 0; i < 5; ++i) v += iq[4 * b - 1 + i]; }
            val[r] = v; }
        int cnt = 0;
        if (lane == 0) { selL[q2 * 8 + 0] = 0; if (cur >= 1) selL[q2 * 8 + 1] = cur; if (cur >= 2) selL[q2 * 8 + 2] = cur - 1; }
        cnt = 1 + (cur >= 1) + (cur >= 2);
        int ncand = cur - 2; if (ncand < 0) ncand = 0; const int npick = ncand < 5 ? ncand : 5;
        for (int rd = 0; rd < npick; ++rd) { float bv = val[0]; int bi = lane;
#pragma unroll
            for (int r = 1; r < 4; ++r) if (val[r] > bv) { bv = val[r]; bi = lane + 64 * r; }
#pragma unroll
            for (int o = 1; o < 64; o <<= 1) { const float ov = __shfl_xor(bv, o); const int oi = __shfl_xor(bi, o); if (ov > bv || (ov == bv && oi < bi)) { bv = ov; bi = oi; } }
            if (lane == 0) selL[q2 * 8 + cnt] = bi; ++cnt;
#pragma unroll
            for (int r = 0; r < 4; ++r) if (bi == lane + 64 * r) val[r] = -2.f; }
        cnts[q2] = cnt; }
    LDS_FENCE();
#pragma unroll
    for (int i = 0; i < 4; ++i)
#pragma unroll
        for (int j = 0; j < 4; ++j) imp[(4 * i + j) * 64 + lane] = Ot[i][j];
    lsum = 0.f;
    { const int c0 = cnts[0], c1 = cnts[1];
      const int b1 = (lane < c1) ? selL[8 + lane] : -1;
      int pos = -1;
      for (int k = 0; k < c0; ++k) if (selL[k] == b1) pos = k;
      LDS_FENCE();
      if (lane < c0) selL[16 + lane] = 1;
      LDS_FENCE();
      const bool fresh = (lane < c1) && (pos < 0);
      if (lane < c1 && pos >= 0) selL[16 + pos] = 3;
      const unsigned long long nb = __ballot(fresh);
      if (fresh) { const int idx = c0 + __popcll(nb & ((1ull << lane) - 1ull)); selL[idx] = b1; selL[16 + idx] = 2; }
      const int tot = c0 + __popcll(nb);
      LDS_FENCE();
      auto kbf = [&](int i) { return 64 * __builtin_amdgcn_readfirstlane(selL[i >> 1]) + 32 * (i & 1); };
      auto qsf = [&](int i) { return __builtin_amdgcn_readfirstlane(selL[16 + (i >> 1)]); };
      nsa_run<2>(2 * tot, (const bf16_t*)(ws + WS_KSN), (const bf16_t*)(ws + WS_VST), kbf, qsf, qf, LUT, imp, tq, h, n, g, qs, 0.f, lsum, Ob, t0, bfar); }
    { const float l = lred(lsum); const float sc = l > 0.f ? g1 / l : 0.f;
#pragma unroll
      for (int i = 0; i < 4; ++i) {
#pragma unroll
          for (int j = 0; j < 4; ++j) imp[(4 * i + j) * 64 + lane] += Ob[i][j] * sc;
          Ob[i] = (f32x4){0.f, 0.f, 0.f, 0.f}; } }
    lsum = 0.f;
    { int lo = t0 - 511; if (lo < 0) lo = 0; lo &= ~31; const int nw = ((t0 + 1 - lo) >> 5) + 1;
      auto kbf = [&](int i) { return lo + 32 * i; };
      nsa_run<3>(nw, (const bf16_t*)(ws + WS_KWN), (const bf16_t*)(ws + WS_VWT), kbf, qs_zero, qf, LUT, imp, tq, h, n, g, qs, 0.f, lsum, Ob, t0, bfar);
      const float l = lred(lsum); const float sc = l > 0.f ? g2 / l : 0.f;
#pragma unroll
      for (int i = 0; i < 4; ++i)
#pragma unroll
          for (int j = 0; j < 4; ++j) Ot[i][j] = imp[(4 * i + j) * 64 + lane] + Ob[i][j] * sc; }
    bf16_t* orow = (bf16_t*)(ws + WS_ONSA) + (size_t)tq * 512 + h * 64;
#pragma unroll
    for (int db = 0; db < 4; ++db) { u32x2 w; w.x = cvt_pk_bf16(Ot[db][0], Ot[db][1]); w.y = cvt_pk_bf16(Ot[db][2], Ot[db][3]); *(u32x2*)(orow + 16 * db + 4 * g) = w; }
}


#define RLX_AGENT __ATOMIC_RELAXED, __HIP_MEMORY_SCOPE_AGENT
#define XB_TMO      128
#define XB_XCNT(j)  (256  + 64 * (j))
#define XB_XSUB(j)  (1280 + 64 * (j))
#define XB_XGEN(j)  (2304 + 64 * (j))
#define XB_TOP      3328
#define XB_TOPGEN   3392
#define XCD_BAR_WORDS 3456
#define XB_SPIN_CAP (1u << 18)

__device__ __forceinline__ unsigned xb_ld(unsigned* p)              { return __hip_atomic_load(p, __ATOMIC_RELAXED, __HIP_MEMORY_SCOPE_AGENT); }
__device__ __forceinline__ unsigned xb_add(unsigned* p, unsigned v) { return __hip_atomic_fetch_add(p, v, __ATOMIC_RELAXED, __HIP_MEMORY_SCOPE_AGENT); }
__device__ __forceinline__ unsigned xb_xcc_id() { return (unsigned)__builtin_amdgcn_s_getreg((3 << 11) | 20) & 0xFu; }
#define XB_SPIN(cond, bar) do { unsigned _sp = 0; while (cond) { __builtin_amdgcn_s_sleep(1); \
    if ((++_sp & 255u) == 0u) { if (xb_ld(&(bar)[XB_TMO])) break; if (_sp > XB_SPIN_CAP) { atomicAdd(&(bar)[XB_TMO], 1u); break; } } } } while (0)

struct XcdBarrier {
    unsigned* bar; unsigned x;
    volatile LAS unsigned* st;
};

__device__ __forceinline__ XcdBarrier xcd_barrier_post(unsigned* bar, volatile LAS unsigned* st) {
    XcdBarrier b; b.bar = bar; b.x = xb_xcc_id(); b.st = st;
    if (threadIdx.x == 0) (void)xb_add(&bar[XB_XCNT(b.x)], 1u);
    return b;
}
__device__ __forceinline__ void xcd_barrier_complete(unsigned* bar, unsigned x, unsigned& nloc, unsigned& nx) {
    const unsigned G = gridDim.x * gridDim.y * gridDim.z;
    unsigned sum, cnt, mine, sp = 0u;
    for (;;) {
        sum = 0u; cnt = 0u; mine = 0u;
#pragma unroll
        for (unsigned j = 0; j < 16; ++j) { const unsigned c = xb_ld(&bar[XB_XCNT(j)]); sum += c; cnt += (c > 0u) ? 1u : 0u; mine = (j == x) ? c : mine; }
        if (sum == G) break;
        __builtin_amdgcn_s_sleep(1);
        if ((++sp & 255u) == 0u) { if (xb_ld(&bar[XB_TMO])) break; if (sp > XB_SPIN_CAP) { atomicAdd(&bar[XB_TMO], 1u); break; } }
    }
    nloc = mine > 0u ? mine : 1u; nx = cnt > 0u ? cnt : 1u;
}

__device__ __forceinline__ void xcd_barrier(const XcdBarrier& b) {
    asm volatile("s_waitcnt vmcnt(0)" ::: "memory");
    __syncthreads();
    if (threadIdx.x == 0) {
        unsigned* bar = b.bar;
        __builtin_amdgcn_s_waitcnt(0);
        unsigned nloc = b.st[0], nx = b.st[1];
        if (nloc == 0u) { xcd_barrier_complete(bar, b.x, nloc, nx); b.st[0] = nloc; b.st[1] = nx; }
        const unsigned old = xb_add(&bar[XB_XSUB(b.x)], 1u);
        const unsigned gen = old / nloc;
        if (old + 1u == (gen + 1u) * nloc) {
            __builtin_amdgcn_fence(__ATOMIC_RELEASE, "agent");
            asm volatile("s_waitcnt vmcnt(0)" ::: "memory");
            const unsigned og = xb_add(&bar[XB_TOP], 1u);
            const unsigned tg = og / nx;
            if (og + 1u == (tg + 1u) * nx) xb_add(&bar[XB_TOPGEN], 1u);
            else XB_SPIN(xb_ld(&bar[XB_TOPGEN]) == tg, bar);
            __builtin_amdgcn_fence(__ATOMIC_ACQUIRE, "agent");
            xb_add(&bar[XB_XGEN(b.x)], 1u);
            asm volatile("s_waitcnt vmcnt(0)" ::: "memory");
        } else {
            XB_SPIN(xb_ld(&bar[XB_XGEN(b.x)]) == gen, bar);
            __builtin_amdgcn_fence(__ATOMIC_ACQUIRE, "agent");
            asm volatile("s_waitcnt vmcnt(0)" ::: "memory");
        }
    }
    __syncthreads();
}

#define GSYNC() xcd_barrier(xbar)
__global__ void __launch_bounds__(512) __attribute__((amdgpu_waves_per_eu(2, 2))) fwd_mega(KArgs a) {
    extern __shared__ __attribute__((aligned(16))) unsigned char lds_raw[];
    LAS unsigned char* lds = (LAS unsigned char*)lds_raw;
    const int G = gridDim.x, bid = blockIdx.x, NGW = G * 8;
    const int vb = (G % 8 == 0) ? (bid % 8) * (G / 8) + bid / 8 : bid;
    { volatile LAS unsigned* stw = (volatile LAS unsigned*)(lds + 132608); if (threadIdx.x < 2) stw[threadIdx.x] = 0u; }
    __syncthreads();
    XcdBarrier xbar = xcd_barrier_post((unsigned*)(a.ws + WS_CTL), (volatile LAS unsigned*)(lds + 132608));
    cg::this_grid().sync();
#define IDS() int tid = threadIdx.x; asm volatile("" : "+v"(tid)); const int lane = tid & 63, wave = __builtin_amdgcn_readfirstlane(tid >> 6); const int gw = bid * 8 + wave; (void)lane; (void)gw;
    unsigned char* ws = a.ws;
    bf16_t* PROJ = (bf16_t*)(ws + WS_PROJ); bf16_t* HN = (bf16_t*)(ws + WS_HN); bf16_t* HID = (bf16_t*)(ws + WS_HID);
#pragma unroll 1
    for (int l = 0; l < DEPTH; ++l) {
        const float* xsrc = (l == 0) ? a.in[0] : a.out;
        { IDS(); phase_convert(a, l, lds, gw, NGW, wave, lane);
          phase_rms(xsrc, a.in[1] + l * DM, HN, gw, NGW, lane); }
        GSYNC();
        { pg8::Gemm g{HN, (const bf16_t*)(ws + WS_WIN), M, NPAD, DM}; pg8::StaticOrder S; S.init(M, NPAD, G, bid);
          pg8::EpiBf16<0> E{PROJ, NPAD};
          pg8::gemm_phase<pg8::EpiBf16<0>, pg8::StaticOrder, true, true>(lds, g, S, E); }
        GSYNC();
        { IDS(); for (int it = bid; it < 256; it += G) pre_item(a, l, lds, it, tid); }
        { IDS(); for (int it = bid; it < 128; it += G) cmp_item(a, l, lds, it, tid, wave, lane); }
        { IDS();
          if (G == 256) {
              const int nk = bid < 128 ? 6 : 8;
              for (int k = 0; k < nk; ++k) gla_g1_item(a, l, lds, bid + 256 * k, tid, wave, lane);
              if (bid >= 128) { gla_g1_item(a, l, lds, (bid - 128) + 256 * 6, tid, wave, lane); gla_g1_item(a, l, lds, (bid - 128) + 256 * 7, tid, wave, lane); }
          } else for (int it = bid; it < 2048; it += G) gla_g1_item(a, l, lds, it, tid, wave, lane); }
        GSYNC();
        {   IDS();
            { const float* lg = (const float*)(ws + WS_LUT); LAS float* LUT = (LAS float*)lds; for (int i = tid; i < 8192; i += 512) LUT[i] = lg[i]; }
            LAS int* ctr = (LAS int*)(lds + 132096);
            LAS unsigned* sbc = (LAS unsigned*)(lds + 132112);
            if (tid == 0) { *ctr = 0; *sbc = 0u; }
            __syncthreads();
            if (wave < 4) {
                unsigned gen = 0u;
                for (int pp = vb; pp < 512; pp += G) {
                    const int hh = pp & 3, q = pp >> 2;
                    sb_unit4(a, lds + 65536, sbc, gen, hh, 255 - q, wave, lane);
                    sb_unit4(a, lds + 65536, sbc, gen, hh, q, wave, lane); }
            } else {
                for (int c0 = (bid * 4 + (wave - 4)) * 64; c0 < 65536; c0 += G * 256) gla_scan(a, c0 + lane);
            }
            LAS float* imp = (LAS float*)(lds + (wave < 4 ? 65536 + wave * 8192 : 32768 + (wave - 4) * 8192));
            LAS int* selL = (LAS int*)(lds + 131072 + wave * 128);
            const int nper = (8192 + G - 1) / G;
            for (;;) { int idx = 0; if (lane == 0) idx = atomicAdd((int*)ctr, 1); idx = __builtin_amdgcn_readfirstlane(idx);
                if (idx >= nper) break; const int hn = nper >> 1; const int unit = (idx < hn) ? (8192 - hn * (vb + 1) + idx) : (hn * vb + (idx - hn)); if (unit >= 0 && unit < 8192) nsa_unit(a, lds, unit, imp, selL, lane); }
            __syncthreads();
        }
        GSYNC();
        { IDS(); for (int it = bid; it < 2048; it += G) gla_g3_item(a, l, lds, it, tid, wave, lane); }
        GSYNC();
        for (int b = 0; b < 3; ++b) {
            pg8::Gemm g{(const bf16_t*)(ws + WS_OGLA + b * 16 * MiB), (const bf16_t*)(ws + WS_WBR + b * MiB), M, DM, 512}; pg8::StaticOrder S; S.init(M, DM, G, bid);
            pg8::EpiGate E{HN, PROJ + C_MGATE + b * DM, NPAD, b == 0 ? 1 : 0};
            pg8::gemm_phase<pg8::EpiGate, pg8::StaticOrder, true, true>(lds, g, S, E); }
        GSYNC();
        { pg8::Gemm g{HN, (const bf16_t*)(ws + WS_WOUT), M, DM, DM}; pg8::StaticOrder S; S.init(M, DM, G, bid);
          pg8::EpiRes E{xsrc, a.out};
          pg8::gemm_phase<pg8::EpiRes, pg8::StaticOrder, true, true>(lds, g, S, E); }
        GSYNC();
        { IDS(); phase_rms(a.out, a.in[2] + l * DM, HN, gw, NGW, lane); }
        GSYNC();
        { pg8::Gemm g{HN, (const bf16_t*)(ws + WS_WUP), M, FF, DM}; pg8::StaticOrder S; S.init(M, FF, G, bid);
          pg8::EpiBf16<2> E{HID, FF};
          pg8::gemm_phase<pg8::EpiBf16<2>, pg8::StaticOrder, true, true>(lds, g, S, E); }
        GSYNC();
        { pg8::Gemm g{HID, (const bf16_t*)(ws + WS_WDN), M, DM, FF}; pg8::StaticOrder S; S.init(M, DM, G, bid);
          pg8::EpiRes E{a.out, a.out};
          pg8::gemm_phase<pg8::EpiRes, pg8::StaticOrder, true, true>(lds, g, S, E); }
        GSYNC();
    }
}

extern "C" void kernel_launch(void* const* d_in, const int* in_sizes, int n_in, void* d_out, int out_size, void* d_ws, size_t ws_size, hipStream_t stream) {
    static int grid = 0;
    if (grid == 0) {
        if (n_in != 22 || ws_size < WS_END + 65536) { fprintf(stderr, "kernel_launch: unexpected n_in %d or ws_size %zu (< %zu)\n", n_in, ws_size, (size_t)WS_END); grid = -1; return; }
        int dev = 0, cus = 0, per_cu = 0;
        hipGetDevice(&dev); hipDeviceGetAttribute(&cus, hipDeviceAttributeMultiprocessorCount, dev);
        hipFuncSetAttribute((const void*)fwd_mega, hipFuncAttributeMaxDynamicSharedMemorySize, LDS_BYTES);
        hipOccupancyMaxActiveBlocksPerMultiprocessor(&per_cu, (const void*)fwd_mega, 512, LDS_BYTES);
        if (per_cu < 1) { fprintf(stderr, "kernel_launch: occupancy query says %d blocks/CU\n", per_cu); per_cu = 1; }
        (void)hipGetLastError();
        grid = cus * 1;
    }
    if (grid < 0) return;
    if (hipMemsetAsync((char*)d_ws + WS_CTL, 0, 65536, stream) != hipSuccess) { fprintf(stderr, "kernel_launch: memset of barrier words failed\n"); return; }
    KArgs a{};
    for (int i = 0; i < 22; ++i) a.in[i] = (const float*)d_in[i];
    a.out = (float*)d_out; a.ws = (unsigned char*)d_ws;
    void* args[] = {&a};
    hipError_t e = hipLaunchCooperativeKernel((const void*)fwd_mega, dim3(grid), dim3(512), args, LDS_BYTES, stream);
    if (e != hipSuccess) fprintf(stderr, "cooperative launch failed: %s (grid %d)\n", hipGetErrorString(e), grid);
}
```

```cpp
#include <hip/hip_runtime.h>
#include <hip/hip_cooperative_groups.h>
#include <cstdio>
#include <cstdint>
namespace cg = cooperative_groups;
namespace pg8 {
#define PG8_LAS __attribute__((address_space(3)))
typedef unsigned short bf16_t;
typedef short bf16x8 __attribute__((ext_vector_type(8)));
typedef float f32x4 __attribute__((ext_vector_type(4)));
typedef unsigned u32x4 __attribute__((ext_vector_type(4)));
constexpr int BM = 256, BK = 64, HALF = 128, HTB = HALF * BK * 2  , STAGE_BYTES = 8 * HTB, NXCD = 8, WGM = 8;

__host__ __device__ __forceinline__ int lds_byte(int r, int c) { const int st = (r >> 4) * 2 + (c >> 5), rr = r & 15, cc = c & 31, ob = rr * 64 + cc * 2; return st * 1024 + (ob ^ (((ob >> 9) & 1) << 5)); }
__host__ __device__ __forceinline__ void stage_rc(int b, int& R, int& C) { const int st = b / 1024, sb = b % 1024, swz = sb ^ (((sb >> 9) & 1) << 5); R = (st >> 1) * 16 + swz / 64; C = (st & 1) * 32 + (swz % 64) / 2; }
__host__ __device__ __forceinline__ int perm32(int rho) { const int n = rho >> 4, i = rho & 15; return 8 * (i >> 2) + 4 * n + (i & 3); }

struct Unit { int pm, pn; };
struct Gemm { const bf16_t* A; const bf16_t* Bt; int M, N, K; };

struct StaticOrder {
    int nM, nN, nwg, G, c;
    __host__ __device__ void init(int M, int N, int G_, int c_) { nM = M / BM; nN = N / BM; nwg = nM * nN; G = G_; c = c_; }
    __host__ __device__ bool next(int i, Unit& u) const {
        const long L = (long)i * G + c; if (L >= nwg) return false;
        int wgid = (int)L; { const int q = nwg / NXCD, r = nwg % NXCD, xcd = wgid % NXCD, off = wgid / NXCD; wgid = (xcd < r ? xcd * (q + 1) : r * (q + 1) + (xcd - r) * q) + off; }
        const int nig = WGM * nN, gid = wgid / nig, fm = gid * WGM, gsz = (nM - fm) < WGM ? (nM - fm) : WGM;
        u.pm = fm + ((wgid % nig) % gsz); u.pn = (wgid % nig) / gsz; return true;
    }
    __device__ __forceinline__ void a_ready(const Unit&) const {}
    __device__ __forceinline__ void done(const Unit&) const {}
};

__device__ __forceinline__ unsigned cvt_pk_bf16(float lo, float hi) { unsigned r; asm("v_cvt_pk_bf16_f32 %0, %1, %2" : "=v"(r) : "v"(lo), "v"(hi)); return r; }
__device__ __forceinline__ float bflo(unsigned w) { return __uint_as_float(w << 16); }
__device__ __forceinline__ float bfhi(unsigned w) { return __uint_as_float(w & 0xffff0000u); }
template <int ACT> struct EpiBf16 {
    static constexpr bool PERM = true, AFTER_DRAIN = false;
    bf16_t* O; int ldc;
    __device__ __forceinline__ void operator()(const f32x4 (&acc)[2][2][4][2], const Unit& u, int wr, int wc, int fr, int fq) const {
        const int row0 = u.pm * BM + wr * 64 + fr; const int col0 = u.pn * BM + wc * 32 + 8 * fq;
#pragma unroll
        for (int ai = 0; ai < 2; ++ai)
#pragma unroll
            for (int m = 0; m < 4; ++m) { bf16_t* rowp = O + (size_t)(row0 + ai * HALF + m * 16) * ldc + col0;
#pragma unroll
                for (int bj = 0; bj < 2; ++bj) { f32x4 v0 = acc[ai][bj][m][0], v1 = acc[ai][bj][m][1];
                    if (ACT == 2) {
#pragma unroll
                        for (int e = 0; e < 4; ++e) { float a = fmaxf(v0[e], 0.f), b = fmaxf(v1[e], 0.f); v0[e] = a * a; v1[e] = b * b; } }
                    u32x4 w; w.x = cvt_pk_bf16(v0[0], v0[1]); w.y = cvt_pk_bf16(v0[2], v0[3]); w.z = cvt_pk_bf16(v1[0], v1[1]); w.w = cvt_pk_bf16(v1[2], v1[3]);
                    *(u32x4*)(rowp + bj * HALF) = w; } }
    }
};
struct EpiGate {
    static constexpr bool PERM = true, AFTER_DRAIN = false;
    bf16_t* O; const bf16_t* gate; int gld; int first;
    __device__ __forceinline__ void operator()(const f32x4 (&acc)[2][2][4][2], const Unit& u, int wr, int wc, int fr, int fq) const {
        const int row0 = u.pm * BM + wr * 64 + fr; const int col0 = u.pn * BM + wc * 32 + 8 * fq;
#pragma unroll
        for (int ai = 0; ai < 2; ++ai)
#pragma unroll
            for (int m = 0; m < 4; ++m) { const int row = row0 + ai * HALF + m * 16; bf16_t* rowp = O + (size_t)row * 1024 + col0; const bf16_t* gp = gate + (size_t)row * gld + col0;
#pragma unroll
                for (int bj = 0; bj < 2; ++bj) { const f32x4 v0 = acc[ai][bj][m][0], v1 = acc[ai][bj][m][1];
                    const u32x4 gw = *(const u32x4*)(gp + bj * HALF);
                    u32x4 ow = (u32x4){0u, 0u, 0u, 0u}; if (!first) ow = *(const u32x4*)(rowp + bj * HALF);
                    float gv[8] = {bflo(gw.x), bfhi(gw.x), bflo(gw.y), bfhi(gw.y), bflo(gw.z), bfhi(gw.z), bflo(gw.w), bfhi(gw.w)};
                    float ov[8] = {bflo(ow.x), bfhi(ow.x), bflo(ow.y), bfhi(ow.y), bflo(ow.z), bfhi(ow.z), bflo(ow.w), bfhi(ow.w)};
                    float av[8] = {v0[0], v0[1], v0[2], v0[3], v1[0], v1[1], v1[2], v1[3]};
                    float r[8];
#pragma unroll
                    for (int e = 0; e < 8; ++e) { const float s = 1.f / (1.f + __expf(-gv[e])); r[e] = ov[e] + s * av[e]; }
                    u32x4 w; w.x = cvt_pk_bf16(r[0], r[1]); w.y = cvt_pk_bf16(r[2], r[3]); w.z = cvt_pk_bf16(r[4], r[5]); w.w = cvt_pk_bf16(r[6], r[7]);
                    *(u32x4*)(rowp + bj * HALF) = w; } }
    }
};
struct EpiRes {
    static constexpr bool PERM = false, AFTER_DRAIN = false;
    const float* src; float* out;
    __device__ __forceinline__ void operator()(const f32x4 (&acc)[2][2][4][2], const Unit& u, int wr, int wc, int fr, int fq) const {
        const int col0 = u.pn * BM + wc * 32 + 4 * fq;
#pragma unroll
        for (int ai = 0; ai < 2; ++ai)
#pragma unroll
            for (int m = 0; m < 4; ++m) { const size_t off = (size_t)(u.pm * BM + ai * HALF + wr * 64 + m * 16 + fr) * 1024 + col0;
#pragma unroll
                for (int bj = 0; bj < 2; ++bj)
#pragma unroll
                    for (int n = 0; n < 2; ++n) { const f32x4 bs = *(const f32x4*)(src + off + bj * HALF + n * 16); *(f32x4*)(out + off + bj * HALF + n * 16) = bs + acc[ai][bj][m][n]; } }
    }
};
template <class Epi, class Sched, bool ALIGN_EPI = false, bool SP2 = false>
__device__ __forceinline__ void gemm_phase(PG8_LAS unsigned char* lds, const Gemm g, const Sched& S, const Epi& E) {
    int tid_ = threadIdx.x; asm volatile("" : "+v"(tid_));
    const int tid = tid_, wid = __builtin_amdgcn_readfirstlane(tid >> 6), lane = tid & 63, wr = wid >> 2, wc = wid & 3, fr = lane & 15, fq = lane >> 4;
    const int K = g.K, nt = K / BK;
    unsigned voffA[2], voffB[2];
#pragma unroll
    for (int i = 0; i < 2; ++i) { int R, C; stage_rc(tid * 16 + i * 8192, R, C); const int Rb = Epi::PERM ? ((R & ~31) + perm32(R & 31)) : R;
        voffA[i] = (unsigned)(R * K + C) * 2u; voffB[i] = (unsigned)(Rb * K + C) * 2u; }
    const size_t kstep = (size_t)(BK * 2);
    const size_t hstep = (size_t)HALF * K * 2;
    const size_t tstep = 2 * hstep;
    const unsigned ldsw = (unsigned)wid * 1024u;
    const int aoff = lds_byte(wr * 64 + fr, fq * 8), boff = lds_byte(wc * 32 + fr, fq * 8);
#define PG8_SA(b, h) (((b) * 2 + (h)) * HTB)
#define PG8_SB(b, h) ((4 + (b) * 2 + (h)) * HTB)
#define PG8_STAGE(bufoff, gbase, voff) do { _Pragma("unroll") for (int _i = 0; _i < 2; ++_i) \
        __builtin_amdgcn_global_load_lds((const unsigned*)((const char*)(gbase) + (voff)[_i]), (PG8_LAS unsigned*)(lds + (bufoff) + ldsw + _i * 8192), 16, 0, 0); } while (0)
#define PG8_LDA(dst, b, h) do { _Pragma("unroll") for (int m = 0; m < 4; ++m) _Pragma("unroll") for (int k = 0; k < 2; ++k) dst[m][k] = *(const PG8_LAS bf16x8*)(lds + PG8_SA(b, h) + aoff + m * 2048 + k * 1024); } while (0)
#define PG8_LDB(dst, b, h) do { _Pragma("unroll") for (int n = 0; n < 2; ++n) _Pragma("unroll") for (int k = 0; k < 2; ++k) dst[n][k] = *(const PG8_LAS bf16x8*)(lds + PG8_SB(b, h) + boff + n * 2048 + k * 1024); } while (0)
#define PG8_MMA(ai, bj, At, Bt) do { __builtin_amdgcn_s_setprio(1); _Pragma("unroll") for (int m = 0; m < 4; ++m) _Pragma("unroll") for (int n = 0; n < 2; ++n) _Pragma("unroll") for (int k = 0; k < 2; ++k) \
        acc[ai][bj][m][n] = __builtin_amdgcn_mfma_f32_16x16x32_bf16(Bt[n][k], At[m][k], acc[ai][bj][m][n], 0, 0, 0); __builtin_amdgcn_s_setprio(0); } while (0)
#define PG8_WAIT_V(n) asm volatile("s_waitcnt vmcnt(" #n ")" ::: "memory")
#define PG8_WAIT_L(n) asm volatile("s_waitcnt lgkmcnt(" #n ")" ::: "memory")
#define PG8_BAR __builtin_amdgcn_s_barrier()
#define PG8_SCHED __builtin_amdgcn_sched_barrier(0)
    Unit cur, nxt; int ui = 0;
    if (!S.next(0, cur)) return;
    f32x4 acc[2][2][4][2];
#pragma unroll
    for (int a = 0; a < 2; ++a)
#pragma unroll
        for (int b = 0; b < 2; ++b)
#pragma unroll
            for (int m = 0; m < 4; ++m)
#pragma unroll
                for (int n = 0; n < 2; ++n) acc[a][b][m][n] = (f32x4){0.f, 0.f, 0.f, 0.f};
    bf16x8 At[4][2], B0[2][2], B1[2][2];
    const char* cA = (const char*)g.A + (size_t)cur.pm * tstep; const char* cB = (const char*)g.Bt + (size_t)cur.pn * tstep;
    S.a_ready(cur);
    if constexpr (SP2) {
        PG8_STAGE(PG8_SB(0, 0), cB, voffB); PG8_STAGE(PG8_SB(0, 1), cB + hstep, voffB); PG8_STAGE(PG8_SA(0, 0), cA, voffA); PG8_STAGE(PG8_SA(0, 1), cA + hstep, voffA);
        if (wr == 1) PG8_BAR;
        PG8_WAIT_V(2); PG8_BAR;
        PG8_STAGE(PG8_SB(1, 0), cB + kstep, voffB); PG8_STAGE(PG8_SA(1, 0), cA + kstep, voffA); PG8_STAGE(PG8_SB(1, 1), cB + hstep + kstep, voffB);
        PG8_WAIT_V(6); PG8_BAR;
    } else {
        PG8_STAGE(PG8_SB(0, 0), cB, voffB); PG8_STAGE(PG8_SA(0, 0), cA, voffA); PG8_STAGE(PG8_SB(0, 1), cB + hstep, voffB); PG8_STAGE(PG8_SA(0, 1), cA + hstep, voffA);
        if (wr == 1) PG8_BAR;
        PG8_WAIT_V(4); PG8_BAR;
        PG8_STAGE(PG8_SB(1, 0), cB + kstep, voffB); PG8_STAGE(PG8_SA(1, 0), cA + kstep, voffA); PG8_STAGE(PG8_SB(1, 1), cB + hstep + kstep, voffB);
        PG8_WAIT_V(6); PG8_BAR;
    }
    for (;;) {
        const bool has_next = S.next(ui + 1, nxt);
        const char* nA = has_next ? (const char*)g.A + (size_t)nxt.pm * tstep : cA; const char* nB = has_next ? (const char*)g.Bt + (size_t)nxt.pn * tstep : cB;
        for (int t = 0; t < nt; t += 2) {
            const bool last = (t == nt - 2);
            const char* a1 = cA + (size_t)(t + 1) * kstep;
            const char* a2 = last ? nA : cA + (size_t)(t + 2) * kstep; const char* b2 = last ? nB : cB + (size_t)(t + 2) * kstep;
            const char* a3 = a2 + kstep; const char* b3 = b2 + kstep;
            if (last && has_next) S.a_ready(nxt);
            if constexpr (SP2) {
            PG8_LDB(B0, 0, 0); PG8_LDB(B1, 0, 1); PG8_SCHED; PG8_LDA(At, 0, 0); PG8_STAGE(PG8_SA(1, 1), a1 + hstep, voffA);
            PG8_WAIT_V(8); PG8_WAIT_L(0); PG8_BAR; PG8_MMA(0, 0, At, B0); PG8_MMA(0, 1, At, B1); PG8_BAR; PG8_SCHED;
            PG8_LDA(At, 0, 1); PG8_STAGE(PG8_SB(0, 0), b2, voffB); PG8_STAGE(PG8_SB(0, 1), b2 + hstep, voffB); PG8_STAGE(PG8_SA(0, 0), a2, voffA);
            PG8_WAIT_V(8); PG8_WAIT_L(0); PG8_BAR; PG8_MMA(1, 0, At, B0); PG8_MMA(1, 1, At, B1); PG8_BAR; PG8_SCHED;
            PG8_LDB(B0, 1, 0); PG8_LDB(B1, 1, 1); PG8_SCHED; PG8_LDA(At, 1, 0); PG8_STAGE(PG8_SA(0, 1), a2 + hstep, voffA);
            PG8_WAIT_V(8); PG8_WAIT_L(0); PG8_BAR; PG8_MMA(0, 0, At, B0); PG8_MMA(0, 1, At, B1); PG8_BAR; PG8_SCHED;
            PG8_LDA(At, 1, 1); PG8_STAGE(PG8_SB(1, 0), b3, voffB); PG8_STAGE(PG8_SB(1, 1), b3 + hstep, voffB); PG8_STAGE(PG8_SA(1, 0), a3, voffA);
            PG8_WAIT_V(8); PG8_WAIT_L(0); PG8_BAR; PG8_MMA(1, 0, At, B0); PG8_MMA(1, 1, At, B1); PG8_BAR; PG8_SCHED;
            } else {
            PG8_LDB(B0, 0, 0); PG8_SCHED; PG8_LDA(At, 0, 0); PG8_STAGE(PG8_SA(1, 1), a1 + hstep, voffA);
            PG8_WAIT_L(8); PG8_BAR; PG8_WAIT_L(0); PG8_MMA(0, 0, At, B0); PG8_BAR; PG8_SCHED;
            PG8_LDB(B1, 0, 1); PG8_STAGE(PG8_SB(0, 0), b2, voffB);
            PG8_BAR; PG8_WAIT_L(0); PG8_MMA(0, 1, At, B1); PG8_BAR;
            PG8_LDA(At, 0, 1); PG8_STAGE(PG8_SA(0, 0), a2, voffA);
            PG8_BAR; PG8_WAIT_L(0); PG8_MMA(1, 0, At, B0); PG8_BAR; PG8_SCHED;
            PG8_STAGE(PG8_SB(0, 1), b2 + hstep, voffB);
            PG8_WAIT_V(6); PG8_BAR; PG8_MMA(1, 1, At, B1); PG8_BAR;
            PG8_LDB(B0, 1, 0); PG8_SCHED; PG8_LDA(At, 1, 0); PG8_STAGE(PG8_SA(0, 1), a2 + hstep, voffA);
            PG8_WAIT_L(8); PG8_BAR; PG8_WAIT_L(0); PG8_MMA(0, 0, At, B0); PG8_BAR; PG8_SCHED;
            PG8_LDB(B1, 1, 1); PG8_STAGE(PG8_SB(1, 0), b3, voffB);
            PG8_BAR; PG8_WAIT_L(0); PG8_MMA(0, 1, At, B1); PG8_BAR;
            PG8_LDA(At, 1, 1); PG8_STAGE(PG8_SA(1, 0), a3, voffA);
            PG8_BAR; PG8_WAIT_L(0); PG8_MMA(1, 0, At, B0); PG8_BAR; PG8_SCHED;
            PG8_STAGE(PG8_SB(1, 1), b3 + hstep, voffB);
            PG8_WAIT_V(6); PG8_BAR; PG8_MMA(1, 1, At, B1); PG8_BAR;
            }
        }
        if constexpr (ALIGN_EPI) { if (wr == 0) PG8_BAR; }
        if constexpr (!Epi::AFTER_DRAIN) { E(acc, cur, wr, wc, fr, fq); S.done(cur); }
        if (!has_next) break;
#pragma unroll
        for (int a = 0; a < 2; ++a)
#pragma unroll
            for (int b = 0; b < 2; ++b)
#pragma unroll
                for (int m = 0; m < 4; ++m)
#pragma unroll
                    for (int n = 0; n < 2; ++n) acc[a][b][m][n] = (f32x4){0.f, 0.f, 0.f, 0.f};
        cur = nxt; cA = nA; cB = nB; ++ui;
        if constexpr (ALIGN_EPI) { if (wr == 1) PG8_BAR; }
    }
    PG8_WAIT_V(0);
    if constexpr (!ALIGN_EPI) { if (wr == 0) PG8_BAR; }
    PG8_BAR;
    if constexpr (Epi::AFTER_DRAIN) { E.fused(acc, cur, wr, wc, fr, fq, lds, wid, lane); S.done(cur); }
#undef PG8_SA
#undef PG8_SB
#undef PG8_STAGE
#undef PG8_LDA
#undef PG8_LDB
#undef PG8_MMA
#undef PG8_WAIT_V
#undef PG8_WAIT_L
#undef PG8_BAR
#undef PG8_SCHED
}
}

#define LAS __attribute__((address_space(3)))
typedef unsigned short bf16_t;
typedef short bf16x8 __attribute__((ext_vector_type(8)));
typedef float f32x4 __attribute__((ext_vector_type(4)));
typedef unsigned u32x4 __attribute__((ext_vector_type(4)));
typedef unsigned u32x2 __attribute__((ext_vector_type(2)));
using pg8::cvt_pk_bf16; using pg8::bflo; using pg8::bfhi;

constexpr int M = 16384, DM = 1024, NIN = 7592, NPAD = 7680, FF = 4096, DEPTH = 4;
constexpr int C_GQ = 0, C_GK = 512, C_GV = 1024, C_GA = 1536, C_GR = 1552, C_SQ = 2064, C_SK = 2576, C_SV = 3088, C_NQ = 3600, C_NKC = 4112, C_NVC = 4176,
              C_NKS = 4240, C_NVS = 4304, C_NKW = 4368, C_NVW = 4432, C_NGATE = 4496, C_MGATE = 4520;
constexpr size_t MiB = 1u << 20;
constexpr size_t WS_PROJ = 0, WS_HID = 0, WS_HN = 240 * MiB, WS_OGLA = 272 * MiB, WS_OSB = 288 * MiB, WS_ONSA = 304 * MiB;
constexpr size_t WS_WIN = 320 * MiB, WS_WUP = 335 * MiB, WS_WDN = 343 * MiB, WS_WOUT = 351 * MiB, WS_WBR = 353 * MiB, WS_WK1 = 356 * MiB, WS_WV1 = 357 * MiB,
                 WS_WK2 = 358 * MiB, WS_WV2 = 358 * MiB + 65536, WS_CB = 358 * MiB + 131072, WS_LUT = 358 * MiB + 196608;
constexpr size_t WS_GST = 360 * MiB, WS_GDC = 424 * MiB, WS_SVT = 425 * MiB, WS_QN = 441 * MiB, WS_KSN = 457 * MiB, WS_KWN = 459 * MiB, WS_VST = 461 * MiB, WS_VWT = 463 * MiB,
                 WS_KCMP = 465 * MiB, WS_VCMPT = 465 * MiB + 131072, WS_END = 466 * MiB, WS_CTL = 466 * MiB;
constexpr int LDS_BYTES = 133120;
constexpr float LOG2E = 1.4426950408889634f;

struct KArgs { const float* in[22]; float* out; unsigned char* ws; };

__device__ __forceinline__ float bf2f(bf16_t v) { return __uint_as_float(((unsigned)v) << 16); }
__device__ __forceinline__ bf16_t f2bf(float f) { unsigned u = __float_as_uint(f); return (bf16_t)((u + 0x7fffu + ((u >> 16) & 1u)) >> 16); }
__device__ __forceinline__ f32x4 mfma16(bf16x8 a, bf16x8 b, f32x4 c) { return __builtin_amdgcn_mfma_f32_16x16x32_bf16(a, b, c, 0, 0, 0); }
__device__ __forceinline__ float wave_sum(float v) {
#pragma unroll
    for (int o = 1; o < 64; o <<= 1) v += __shfl_xor(v, o);
    return v;
}
#define LDS_FENCE() asm volatile("s_waitcnt lgkmcnt(0)" ::: "memory")
#define SCHED_FENCE_G() __builtin_amdgcn_sched_barrier(0)
__device__ __forceinline__ void unpack8(const u32x4 w, float (&f)[8]) { f[0] = bflo(w.x); f[1] = bfhi(w.x); f[2] = bflo(w.y); f[3] = bfhi(w.y); f[4] = bflo(w.z); f[5] = bfhi(w.z); f[6] = bflo(w.w); f[7] = bfhi(w.w); }
__device__ __forceinline__ u32x4 pack8(const float (&r)[8]) { u32x4 w; w.x = cvt_pk_bf16(r[0], r[1]); w.y = cvt_pk_bf16(r[2], r[3]); w.z = cvt_pk_bf16(r[4], r[5]); w.w = cvt_pk_bf16(r[6], r[7]); return w; }

__device__ __forceinline__ void transpose_item(const float* W, int K, int N, int Npad, bf16_t* WT, LAS float* scr, int item, int lane) {
    const int nblk = Npad / 32, kb = item / nblk, nb = item % nblk, k0 = 64 * kb, n0 = 32 * nb;
    const int c4 = lane & 7, kr = lane >> 3; const int nn = n0 + 4 * c4;
    f32x4 tv[8];
#pragma unroll
    for (int i = 0; i < 8; ++i) tv[i] = (nn < N) ? *(const f32x4*)(W + (size_t)(k0 + 8 * i + kr) * N + nn) : (f32x4){0.f, 0.f, 0.f, 0.f};
#pragma unroll
    for (int i = 0; i < 8; ++i) { LAS float* d = scr + (8 * i + kr) * 33 + 4 * c4; d[0] = tv[i][0]; d[1] = tv[i][1]; d[2] = tv[i][2]; d[3] = tv[i][3]; }
    LDS_FENCE();
    const int c = lane & 7;
#pragma unroll
    for (int j = 0; j < 4; ++j) { const int n = (lane >> 3) + 8 * j; const LAS float* s = scr + (8 * c) * 33 + n;
        u32x4 o; o.x = cvt_pk_bf16(s[0 * 33], s[1 * 33]); o.y = cvt_pk_bf16(s[2 * 33], s[3 * 33]); o.z = cvt_pk_bf16(s[4 * 33], s[5 * 33]); o.w = cvt_pk_bf16(s[6 * 33], s[7 * 33]);
        *(u32x4*)(WT + (size_t)(n0 + n) * K + k0 + 8 * c) = o; }
    LDS_FENCE();
}
__device__ __forceinline__ int rel_bucket(int n) {
    if (n < 16) return n;
    int large = 16 + (int)(logf((float)n / 16.f) / 4.1588830833596715f * 16.f);
    return large < 31 ? large : 31;
}
__device__ __forceinline__ void rms_row(const float* xrow, const float* g, bf16_t* orow, int lane) {
    const f32x4* xr = (const f32x4*)xrow + lane; f32x4 v[4]; float s = 0.f;
#pragma unroll
    for (int j = 0; j < 4; ++j) { v[j] = xr[64 * j]; s += (v[j].x * v[j].x + v[j].y * v[j].y) + (v[j].z * v[j].z + v[j].w * v[j].w); }
    const float rinv = rsqrtf(wave_sum(s) * (1.f / 1024.f) + 1e-6f);
    u32x2* o8 = (u32x2*)orow + lane;
#pragma unroll
    for (int j = 0; j < 4; ++j) { const f32x4 gg = ((const f32x4*)g)[lane + 64 * j]; u32x2 w; w.x = cvt_pk_bf16(v[j].x * rinv * gg.x, v[j].y * rinv * gg.y); w.y = cvt_pk_bf16(v[j].z * rinv * gg.z, v[j].w * rinv * gg.w); o8[64 * j] = w; }
}
__device__ __forceinline__ void phase_convert(const KArgs& a, int l, LAS unsigned char* lds, int gw, int NGW, int wave, int lane) {
    unsigned char* ws = a.ws;
    LAS float* scr = (LAS float*)(lds + wave * 8704);
    constexpr int I0 = 16 * 240, I1 = 16 * 128, I2 = 64 * 32, I3 = 16 * 32, I4 = 8 * 32, I7 = 32 * 8, I9 = 4 * 2, IB = 128, IL = 128;
    constexpr int NIT = I0 + I1 + I2 + I3 + 3 * I4 + 2 * I7 + 2 * I9 + IB + IL;
    for (int it = gw; it < NIT; it += NGW) {
        int r = it;
        if (r < I0) { transpose_item(a.in[3] + (size_t)l * DM * NIN, DM, NIN, NPAD, (bf16_t*)(ws + WS_WIN), scr, r, lane); continue; } r -= I0;
        if (r < I1) { transpose_item(a.in[20] + (size_t)l * DM * FF, DM, FF, FF, (bf16_t*)(ws + WS_WUP), scr, r, lane); continue; } r -= I1;
        if (r < I2) { transpose_item(a.in[21] + (size_t)l * FF * DM, FF, DM, DM, (bf16_t*)(ws + WS_WDN), scr, r, lane); continue; } r -= I2;
        if (r < I3) { transpose_item(a.in[19] + (size_t)l * DM * DM, DM, DM, DM, (bf16_t*)(ws + WS_WOUT), scr, r, lane); continue; } r -= I3;
        if (r < 3 * I4) { const int b = r / I4; transpose_item(a.in[16 + b] + (size_t)l * 512 * DM, 512, DM, DM, (bf16_t*)(ws + WS_WBR + b * MiB), scr, r % I4, lane); continue; } r -= 3 * I4;
        if (r < I7) { transpose_item(a.in[11] + (size_t)l * 2048 * 256, 2048, 256, 256, (bf16_t*)(ws + WS_WK1), scr, r, lane); continue; } r -= I7;
        if (r < I7) { transpose_item(a.in[13] + (size_t)l * 2048 * 256, 2048, 256, 256, (bf16_t*)(ws + WS_WV1), scr, r, lane); continue; } r -= I7;
        if (r < I9) { transpose_item(a.in[12] + (size_t)l * 256 * 64, 256, 64, 64, (bf16_t*)(ws + WS_WK2), scr, r, lane); continue; } r -= I9;
        if (r < I9) { transpose_item(a.in[14] + (size_t)l * 256 * 64, 256, 64, 64, (bf16_t*)(ws + WS_WV2), scr, r, lane); continue; } r -= I9;
        if (r < IB) {
            const int p = r >> 3, which = (r >> 2) & 1, col = (r & 3) * 64 + lane;
            const float* pe = a.in[which ? 10 : 9] + (size_t)l * 2048; const float* w1 = a.in[which ? 13 : 11] + (size_t)l * 2048 * 256;
            float s = 0.f;
#pragma unroll 1
            for (int k0 = 128 * p; k0 < 128 * p + 128; k0 += 16) { float wv[16];
#pragma unroll
                for (int i = 0; i < 16; ++i) wv[i] = w1[(size_t)(k0 + i) * 256 + col];
#pragma unroll
                for (int i = 0; i < 16; ++i) s += pe[k0 + i] * wv[i]; }
            ((float*)(ws + WS_CB))[p * 512 + which * 256 + col] = s; continue; } r -= IB;
        {
            const int idx = r * 64 + lane; const int d = idx >> 3, h = idx & 7;
            ((float*)(ws + WS_LUT))[idx] = a.in[15][rel_bucket(d) * 8 + h] * LOG2E; }
    }
}
__device__ __forceinline__ void phase_rms(const float* x, const float* g, bf16_t* hn, int gw, int NGW, int lane) {
    f32x4 gg[4];
#pragma unroll
    for (int j = 0; j < 4; ++j) gg[j] = ((const f32x4*)g)[lane + 64 * j];
    for (int m = gw; m < M; m += 2 * NGW) { const int m2 = (m + NGW < M) ? m + NGW : m;
        const f32x4* xa = (const f32x4*)(x + (size_t)m * DM) + lane; const f32x4* xb = (const f32x4*)(x + (size_t)m2 * DM) + lane;
        f32x4 va[4], vb[4]; float sa = 0.f, sb = 0.f;
#pragma unroll
        for (int j = 0; j < 4; ++j) { va[j] = xa[64 * j]; vb[j] = xb[64 * j]; }
#pragma unroll
        for (int j = 0; j < 4; ++j) { sa += (va[j].x * va[j].x + va[j].y * va[j].y) + (va[j].z * va[j].z + va[j].w * va[j].w); sb += (vb[j].x * vb[j].x + vb[j].y * vb[j].y) + (vb[j].z * vb[j].z + vb[j].w * vb[j].w); }
#pragma unroll
        for (int o = 1; o < 64; o <<= 1) { sa += __shfl_xor(sa, o); sb += __shfl_xor(sb, o); }
        const float ra = rsqrtf(sa * (1.f / 1024.f) + 1e-6f), rb = rsqrtf(sb * (1.f / 1024.f) + 1e-6f);
        u32x2* oa = (u32x2*)(hn + (size_t)m * DM) + lane; u32x2* ob = (u32x2*)(hn + (size_t)m2 * DM) + lane;
#pragma unroll
        for (int j = 0; j < 4; ++j) { u32x2 w; w.x = cvt_pk_bf16(va[j].x * ra * gg[j].x, va[j].y * ra * gg[j].y); w.y = cvt_pk_bf16(va[j].z * ra * gg[j].z, va[j].w * ra * gg[j].w); oa[64 * j] = w;
            u32x2 w2; w2.x = cvt_pk_bf16(vb[j].x * rb * gg[j].x, vb[j].y * rb * gg[j].y); w2.y = cvt_pk_bf16(vb[j].z * rb * gg[j].z, vb[j].w * rb * gg[j].w); ob[64 * j] = w2; } }
}

__device__ __forceinline__ void rms64_to(const bf16_t* src, const float* g, float scale, bf16_t* dst) {
    u32x4 w[8]; float ss = 0.f;
#pragma unroll
    for (int i = 0; i < 8; ++i) { w[i] = ((const u32x4*)src)[i]; float f[8]; unpack8(w[i], f);
#pragma unroll
        for (int e = 0; e < 8; ++e) ss += f[e] * f[e]; }
    const float rinv = rsqrtf(ss * (1.f / 64.f) + 1e-6f) * scale;
#pragma unroll
    for (int i = 0; i < 8; ++i) { float f[8]; unpack8(w[i], f); float r[8];
#pragma unroll
        for (int e = 0; e < 8; ++e) r[e] = f[e] * rinv * g[8 * i + e];
        ((u32x4*)dst)[i] = pack8(r); }
}
__device__ __forceinline__ void pre_item(const KArgs& a, int l, LAS unsigned char* lds, int item, int tid) {
    unsigned char* ws = a.ws; const bf16_t* proj = (const bf16_t*)(ws + WS_PROJ);
    const int t0 = item * 64;
    {
        const int tl = tid >> 3, h = tid & 7;
        rms64_to(proj + (size_t)(t0 + tl) * NPAD + C_NQ + h * 64, a.in[7] + l * 64, 0.125f * LOG2E, (bf16_t*)(ws + WS_QN) + (size_t)(t0 + tl) * 512 + h * 64);
    }
    if (tid < 128) {
        const int tl = tid >> 1, which = tid & 1;
        rms64_to(proj + (size_t)(t0 + tl) * NPAD + (which ? C_NKW : C_NKS), a.in[8] + l * 64, 1.f, (bf16_t*)(ws + (which ? WS_KWN : WS_KSN)) + (size_t)(t0 + tl) * 64);
    }
    LAS bf16_t* T = (LAS bf16_t*)lds;
    for (int idx = tid; idx < 64 * 80; idx += 512) { const int t = idx / 80, p = idx % 80; const int col = p < 64 ? C_SV + 8 * p : (p < 72 ? C_NVS + 8 * (p - 64) : C_NVW + 8 * (p - 72));
        const u32x4 w = *(const u32x4*)(proj + (size_t)(t0 + t) * NPAD + col);
        LAS unsigned* d = (LAS unsigned*)(T + t * 648 + 8 * p); d[0] = w.x; d[1] = w.y; d[2] = w.z; d[3] = w.w; }
    __syncthreads();
    for (int idx = tid; idx < 640 * 8; idx += 512) { const int c = idx >> 3, p = idx & 7;
        unsigned short e[8];
#pragma unroll
        for (int j = 0; j < 8; ++j) e[j] = T[(8 * p + j) * 648 + c];
        u32x4 w; w.x = e[0] | ((unsigned)e[1] << 16); w.y = e[2] | ((unsigned)e[3] << 16); w.z = e[4] | ((unsigned)e[5] << 16); w.w = e[6] | ((unsigned)e[7] << 16);
        const int tk = t0 + 8 * p;
        if (c < 512) *(u32x4*)((bf16_t*)(ws + WS_SVT) + ((size_t)(((c >> 7) * 256 + (tk >> 6)) * 128 + (c & 127))) * 64 + (tk & 63)) = w;
        else { const int d = (c - 512) & 63; bf16_t* vb = (bf16_t*)(ws + (c < 576 ? WS_VST : WS_VWT)); *(u32x4*)(vb + ((size_t)((tk >> 5) * 64 + d)) * 32 + (tk & 31)) = w; } }
    __syncthreads();
}
__device__ __forceinline__ void cmp_item(const KArgs& a, int l, LAS unsigned char* lds, int item, int tid, int wave, int lane) {
    unsigned char* ws = a.ws; const bf16_t* proj = (const bf16_t*)(ws + WS_PROJ);
    const int which = item & 1, grp = item >> 1, i0 = 16 * grp;
    const int srcoff = which ? C_NVC : C_NKC;
    const bf16_t* w1T = (const bf16_t*)(ws + (which ? WS_WV1 : WS_WK1)); const bf16_t* w2T = (const bf16_t*)(ws + (which ? WS_WV2 : WS_WK2));
    LAS bf16_t* hidL = (LAS bf16_t*)lds;
    LAS float* outL = (LAS float*)(lds + 16384);
    LAS float* rinvL = (LAS float*)(lds + 24576);
    const int r = lane & 15, g = lane >> 4;
    int irow = i0 + r; if (irow > 1022) irow = 1022;
    const bf16_t* arow = proj + (size_t)(16 * irow) * NPAD + srcoff;
    f32x4 acc[2] = {(f32x4){0.f, 0.f, 0.f, 0.f}, (f32x4){0.f, 0.f, 0.f, 0.f}};
    const bf16_t* b0 = w1T + (size_t)(32 * wave + r) * 2048 + 8 * g; const bf16_t* b1 = b0 + 16 * 2048;
#pragma unroll 8
    for (int ks = 0; ks < 64; ++ks) { const int k = 32 * ks + 8 * g;
        const bf16x8 af = *(const bf16x8*)(arow + (size_t)(k >> 6) * NPAD + (k & 63));
        const bf16x8 bf0 = *(const bf16x8*)(b0 + 32 * ks), bf1 = *(const bf16x8*)(b1 + 32 * ks);
        acc[0] = mfma16(af, bf0, acc[0]); acc[1] = mfma16(af, bf1, acc[1]); }
    const float* cb = (const float*)(ws + WS_CB);
#pragma unroll
    for (int nb = 0; nb < 2; ++nb) { const int col = 32 * wave + 16 * nb + r; float bs = 0.f;
#pragma unroll
        for (int p = 0; p < 16; ++p) bs += cb[p * 512 + which * 256 + col];
#pragma unroll
        for (int j = 0; j < 4; ++j) { const float x = acc[nb][j] + bs; const float u = 0.7978845608028654f * (x + 0.044715f * x * x * x);
            const float th = 1.f - 2.f / (__expf(2.f * u) + 1.f); hidL[(4 * g + j) * 264 + col] = f2bf(0.5f * x * (1.f + th)); } }
    __syncthreads();
    if (wave < 4) { f32x4 c2 = (f32x4){0.f, 0.f, 0.f, 0.f};
#pragma unroll
        for (int ks = 0; ks < 8; ++ks) { const bf16x8 af = *(const LAS bf16x8*)(hidL + r * 264 + 32 * ks + 8 * g); const bf16x8 bfr = *(const bf16x8*)(w2T + (size_t)(16 * wave + r) * 256 + 32 * ks + 8 * g); c2 = mfma16(af, bfr, c2); }
#pragma unroll
        for (int j = 0; j < 4; ++j) outL[(4 * g + j) * 65 + 16 * wave + r] = c2[j]; }
    __syncthreads();
    if (tid < 16) { float ss = 0.f; for (int d = 0; d < 64; ++d) { const float v = outL[tid * 65 + d]; ss += v * v; } rinvL[tid] = rsqrtf(ss * (1.f / 64.f) + 1e-6f); }
    __syncthreads();
    const float* kg = a.in[8] + l * 64;
    for (int idx = tid; idx < 1024; idx += 512) { const int row = idx >> 6, d = idx & 63, i = i0 + row; const float v = outL[row * 65 + d];
        if (which == 0) ((bf16_t*)(ws + WS_KCMP))[(size_t)i * 64 + d] = (i <= 1022) ? f2bf(v * rinvL[row] * kg[d]) : (bf16_t)0;
        else ((bf16_t*)(ws + WS_VCMPT))[((size_t)((i >> 5) * 64 + d)) * 32 + (i & 31)] = (i <= 1022) ? f2bf(v) : (bf16_t)0; }
    __syncthreads();
}
struct GlaPre { float asrc; float w[16]; float ba; };
__device__ __forceinline__ void gla_preload(GlaPre& p, const KArgs& a, int l, int c, int h, int tid) {
    const bf16_t* proj = (const bf16_t*)(a.ws + WS_PROJ);
    p.asrc = bf2f(proj[(size_t)(32 * c + (tid >> 4)) * NPAD + C_GA + (tid & 15)]);
    const int hk = h * 128 + (tid & 127);
#pragma unroll
    for (int r = 0; r < 16; ++r) p.w[r] = a.in[4][(size_t)l * 16 * 512 + r * 512 + hk];
    p.ba = a.in[5][l * 512 + hk];
}
__device__ __forceinline__ void gla_decay(const GlaPre& p, LAS float* bL, LAS float* aL, int tid) {
    LAS float* segL = aL + 512;
    aL[tid] = p.asrc;
    __syncthreads();
    const int kk = tid & 127, sg = tid >> 7;
    { float cum = 0.f;
#pragma unroll
        for (int tt = 0; tt < 8; ++tt) { const int t = 8 * sg + tt; float x = p.ba;
#pragma unroll
            for (int r = 0; r < 16; ++r) x += aL[t * 16 + r] * p.w[r];
            const float ls = fminf(x, 0.f) - __logf(1.f + __expf(-fabsf(x)));
            cum += ls * (1.f / 16.f); bL[t * 128 + kk] = cum; }
        segL[sg * 128 + kk] = cum; }
    __syncthreads();
    { float off = 0.f;
#pragma unroll
        for (int q = 0; q < 3; ++q) if (q < sg) off += segL[q * 128 + kk];
        if (sg > 0) {
#pragma unroll
            for (int tt = 0; tt < 8; ++tt) bL[(8 * sg + tt) * 128 + kk] += off; } }
    __syncthreads();
}
__device__ __forceinline__ void gla_g1_item(const KArgs& a, int l, LAS unsigned char* lds, int item, int tid, int wave, int lane) {
    unsigned char* ws = a.ws; const bf16_t* proj = (const bf16_t*)(ws + WS_PROJ);
    const int c = item >> 2, h = item & 3;
    LAS float* bL = (LAS float*)lds; LAS float* aL = (LAS float*)(lds + 16384);
    LAS bf16_t* kT = (LAS bf16_t*)(lds + 20480);
    LAS bf16_t* vT = (LAS bf16_t*)(lds + 20480 + 10240);
    GlaPre pre; gla_preload(pre, a, l, c, h, tid);
    const int s = tid >> 4, k0 = (tid & 15) * 8;
    const size_t ro = (size_t)(32 * c + s) * NPAD + h * 128 + k0;
    const u32x4 kraw = *(const u32x4*)(proj + ro + C_GK), vraw = *(const u32x4*)(proj + ro + C_GV);
    gla_decay(pre, bL, aL, tid);
    { float kf[8]; unpack8(kraw, kf);
      const unsigned vw[4] = {vraw.x, vraw.y, vraw.z, vraw.w};
#pragma unroll
      for (int e = 0; e < 8; ++e) { const int k = k0 + e; kT[k * 40 + s] = f2bf(kf[e] * __expf(bL[31 * 128 + k] - bL[s * 128 + k])); vT[k * 40 + s] = (bf16_t)((vw[e >> 1] >> (16 * (e & 1))) & 0xffffu); } }
    if (tid < 128) ((float*)(ws + WS_GDC))[(size_t)(c * 4 + h) * 128 + tid] = __expf(bL[31 * 128 + tid]);
    __syncthreads();
    const int r = lane & 15, g = lane >> 4;
    const bf16x8 af = *(const LAS bf16x8*)(vT + (16 * wave + r) * 40 + 8 * g);
    bf16_t* dst = (bf16_t*)(ws + WS_GST) + (size_t)(c * 4 + h) * 16384;
#pragma unroll
    for (int kb = 0; kb < 8; ++kb) { const bf16x8 bfr = *(const LAS bf16x8*)(kT + (16 * kb + r) * 40 + 8 * g);
        const f32x4 d = mfma16(af, bfr, (f32x4){0.f, 0.f, 0.f, 0.f});
#pragma unroll
        for (int j = 0; j < 4; ++j) dst[(size_t)(16 * wave + 4 * g + j) * 128 + 16 * kb + r] = f2bf(d[j]); }
    __syncthreads();
}
__device__ __forceinline__ void gla_scan(const KArgs& a, int cid) {
    bf16_t* st = (bf16_t*)(a.ws + WS_GST); const float* dc = (const float*)(a.ws + WS_GDC);
    const int h = cid >> 14, vk = cid & 16383, k = cid & 127;
    bf16_t* sp = st + (size_t)h * 16384 + vk; const float* dp = dc + (size_t)h * 128 + k;
    float state = 0.f;
    unsigned short kva[8], kvb[8]; float da[8], db[8];
#pragma unroll
    for (int i = 0; i < 8; ++i) { kva[i] = sp[(size_t)i * 65536]; da[i] = dp[(size_t)i * 512]; }
    for (int c0 = 0; c0 < 512; c0 += 16) {
#pragma unroll
        for (int i = 0; i < 8; ++i) { kvb[i] = sp[(size_t)(c0 + 8 + i) * 65536]; db[i] = dp[(size_t)(c0 + 8 + i) * 512]; }
        SCHED_FENCE_G();
#pragma unroll
        for (int i = 0; i < 8; ++i) { sp[(size_t)(c0 + i) * 65536] = f2bf(state); state = state * da[i] + bf2f(kva[i]); }
        SCHED_FENCE_G();
        if (c0 + 16 < 512) {
#pragma unroll
            for (int i = 0; i < 8; ++i) { kva[i] = sp[(size_t)(c0 + 16 + i) * 65536]; da[i] = dp[(size_t)(c0 + 16 + i) * 512]; } }
        SCHED_FENCE_G();
#pragma unroll
        for (int i = 0; i < 8; ++i) { sp[(size_t)(c0 + 8 + i) * 65536] = f2bf(state); state = state * db[i] + bf2f(kvb[i]); }
        SCHED_FENCE_G();
    }
}
__device__ __forceinline__ void gla_g3_item(const KArgs& a, int l, LAS unsigned char* lds, int item, int tid, int wave, int lane) {
    unsigned char* ws = a.ws; const bf16_t* proj = (const bf16_t*)(ws + WS_PROJ);
    const int c = item >> 2, h = item & 3;
    LAS float* bL = (LAS float*)lds; LAS float* aL = (LAS float*)(lds + 16384);
    LAS bf16_t* qL = (LAS bf16_t*)(lds + 20480);
    LAS bf16_t* kL = (LAS bf16_t*)(lds + 20480 + 8704);
    LAS bf16_t* vT = (LAS bf16_t*)(lds + 20480 + 17408);
    LAS bf16_t* scL = (LAS bf16_t*)(lds + 20480 + 27648);
    LAS float* oL = (LAS float*)(lds + 20480 + 30208);
    const int r = lane & 15, g = lane >> 4;
    GlaPre pre; gla_preload(pre, a, l, c, h, tid);
    const int s = tid >> 4, k0 = (tid & 15) * 8;
    const size_t ro = (size_t)(32 * c + s) * NPAD + h * 128 + k0;
    const u32x4 qraw = *(const u32x4*)(proj + ro + C_GQ), kraw = *(const u32x4*)(proj + ro + C_GK), vraw = *(const u32x4*)(proj + ro + C_GV), rraw = *(const u32x4*)(proj + ro + C_GR);
    const bf16_t* stT = (const bf16_t*)(ws + WS_GST) + (size_t)(c * 4 + h) * 16384;
    bf16x8 stf[4];
#pragma unroll
    for (int ks = 0; ks < 4; ++ks) stf[ks] = *(const bf16x8*)(stT + (size_t)(16 * wave + r) * 128 + 32 * ks + 8 * g);
    float ng[8];
#pragma unroll
    for (int e = 0; e < 8; ++e) ng[e] = a.in[6][l * 128 + k0 + e];
    gla_decay(pre, bL, aL, tid);
    { float qf[8], kf[8]; unpack8(qraw, qf); unpack8(kraw, kf); float qo[8], ko[8];
      const unsigned vw[4] = {vraw.x, vraw.y, vraw.z, vraw.w};
#pragma unroll
      for (int e = 0; e < 8; ++e) { const float b = bL[s * 128 + k0 + e]; qo[e] = qf[e] * __expf(b) * 0.08838834764831845f; ko[e] = kf[e] * __expf(-b); vT[(k0 + e) * 40 + s] = (bf16_t)((vw[e >> 1] >> (16 * (e & 1))) & 0xffffu); }
      *(LAS u32x4*)(qL + s * 136 + k0) = pack8(qo); *(LAS u32x4*)(kL + s * 136 + k0) = pack8(ko); }
    __syncthreads();
    if (wave < 4) { const int mb = wave >> 1, nb = wave & 1; f32x4 d = (f32x4){0.f, 0.f, 0.f, 0.f};
#pragma unroll
        for (int ks = 0; ks < 4; ++ks) d = mfma16(*(const LAS bf16x8*)(qL + (16 * mb + r) * 136 + 32 * ks + 8 * g), *(const LAS bf16x8*)(kL + (16 * nb + r) * 136 + 32 * ks + 8 * g), d);
#pragma unroll
        for (int j = 0; j < 4; ++j) { const int t = 16 * mb + 4 * g + j, sq = 16 * nb + r; scL[t * 40 + sq] = (sq <= t) ? f2bf(d[j]) : (bf16_t)0; } }
    __syncthreads();
#pragma unroll
    for (int mb = 0; mb < 2; ++mb) { f32x4 d = (f32x4){0.f, 0.f, 0.f, 0.f};
#pragma unroll
        for (int ks = 0; ks < 4; ++ks) d = mfma16(*(const LAS bf16x8*)(qL + (16 * mb + r) * 136 + 32 * ks + 8 * g), stf[ks], d);
        d = mfma16(*(const LAS bf16x8*)(scL + (16 * mb + r) * 40 + 8 * g), *(const LAS bf16x8*)(vT + (16 * wave + r) * 40 + 8 * g), d);
#pragma unroll
        for (int j = 0; j < 4; ++j) oL[(16 * mb + 4 * g + j) * 132 + 16 * wave + r] = d[j]; }
    __syncthreads();
    { float o[8]; float ss = 0.f;
#pragma unroll
        for (int e = 0; e < 8; ++e) { o[e] = oL[s * 132 + k0 + e]; ss += o[e] * o[e]; }
        ss += __shfl_xor(ss, 1); ss += __shfl_xor(ss, 2); ss += __shfl_xor(ss, 4); ss += __shfl_xor(ss, 8);
        const float rinv = rsqrtf(ss * (1.f / 128.f) + 1e-6f);
        float rr[8]; unpack8(rraw, rr); float res[8];
#pragma unroll
        for (int e = 0; e < 8; ++e) { const float on = o[e] * rinv * ng[e]; const float si = rr[e] / (1.f + __expf(-rr[e])); res[e] = on * si; }
        *(u32x4*)((bf16_t*)(ws + WS_OGLA) + (size_t)(32 * c + s) * 512 + h * 128 + k0) = pack8(res); }
    __syncthreads();
}

__device__ __forceinline__ float xor16f(float t, int g) { const auto r = __builtin_amdgcn_permlane16_swap(__float_as_uint(t), __float_as_uint(t), false, false); return __uint_as_float(r[0] == __float_as_uint(t) ? r[1] : r[0]); }
__device__ __forceinline__ float xor32f(float t, int g) { const auto r = __builtin_amdgcn_permlane32_swap(__float_as_uint(t), __float_as_uint(t), false, false); return __uint_as_float(r[0] == __float_as_uint(t) ? r[1] : r[0]); }
#define SCHED_FENCE() __builtin_amdgcn_sched_barrier(0)
template <bool DIAG>
__device__ __forceinline__ void sb_weights(const f32x4 (&S)[2], bf16x8& pf, float& carry, int g, int cc, int krel) {
    float e[8], P[8];
#pragma unroll
    for (int j = 0; j < 8; ++j) { int zi = __float_as_int(S[j >> 2][j & 3]); zi = zi < 0x41700000 ? zi : 0x41700000;
        float z = __int_as_float(zi);
        if (DIAG) { if (32 * cc + 8 * g + j >= krel) z = -1e30f; }
        e[j] = __builtin_amdgcn_exp2f(z); }
    P[0] = 1.f;
#pragma unroll
    for (int j = 1; j < 8; ++j) P[j] = P[j - 1] * (1.f + e[j - 1]);
    const float Tg = __builtin_amdgcn_rcpf(P[7] * (1.f + e[7]));
    const float t1 = __shfl_xor(Tg, 16);
    const float pp = Tg * t1;
    const float t23 = __shfl_xor(pp, 32);
    const float gex = ((g & 1) ? 1.f : t1) * ((g & 2) ? 1.f : t23);
    const float cf = Tg * gex * carry;
    carry = carry * (pp * t23);
    float w[8];
#pragma unroll
    for (int j = 0; j < 8; ++j) w[j] = (e[j] * P[j]) * cf;
    const u32x4 pw = pack8(w); __builtin_memcpy(&pf, &pw, 16);
}
template <bool DIAG>
__device__ __forceinline__ void sb_tile(const LAS bf16_t* Kt, const LAS bf16_t* Vt, const bf16x8 (&qf)[4], f32x4 (&O)[8], float& carry, int n, int g, int krel  ) {
    f32x4 S[2][2];
#pragma unroll
    for (int cc = 1; cc >= 0; --cc) {
        bf16x8 kf[2][4];
#pragma unroll
        for (int pb = 0; pb < 2; ++pb)
#pragma unroll
            for (int ks = 0; ks < 4; ++ks) kf[pb][ks] = *(const LAS bf16x8*)(Kt + (32 * cc + 16 * pb + n) * 128 + (((4 * ks + g) ^ n) << 3));
        SCHED_FENCE();
#pragma unroll
        for (int pb = 0; pb < 2; ++pb) { f32x4 sv = (f32x4){0.f, 0.f, 0.f, 0.f};
#pragma unroll
            for (int ks = 0; ks < 4; ++ks) sv = mfma16(kf[pb][ks], qf[ks], sv);
            S[cc][pb] = sv; }
        SCHED_FENCE();
    }
    bf16x8 vf[8], pf1, pf0;
#pragma unroll
    for (int db = 0; db < 8; ++db) vf[db] = *(const LAS bf16x8*)(Vt + (16 * db + n) * 64 + (((4 + g) ^ (n >> 1)) << 3));
    SCHED_FENCE();
    sb_weights<DIAG>(S[1], pf1, carry, g, 1, krel);
    SCHED_FENCE();
#pragma unroll
    for (int db = 0; db < 8; ++db) O[db] = mfma16(vf[db], pf1, O[db]);
    SCHED_FENCE();
#pragma unroll
    for (int db = 0; db < 8; ++db) vf[db] = *(const LAS bf16x8*)(Vt + (16 * db + n) * 64 + ((g ^ (n >> 1)) << 3));
    SCHED_FENCE();
    sb_weights<DIAG>(S[0], pf0, carry, g, 0, krel);
    SCHED_FENCE();
#pragma unroll
    for (int db = 0; db < 8; ++db) O[db] = mfma16(vf[db], pf0, O[db]);
    SCHED_FENCE();
}
__device__ __forceinline__ void sb_swbar(LAS unsigned* ctr, unsigned& gen, int lane) {
    asm volatile("s_waitcnt vmcnt(0) lgkmcnt(0)" ::: "memory");
    gen += 4u;
    if (lane == 0) { __hip_atomic_fetch_add(ctr, 1u, __ATOMIC_RELAXED, __HIP_MEMORY_SCOPE_WORKGROUP);
        while (__hip_atomic_load(ctr, __ATOMIC_RELAXED, __HIP_MEMORY_SCOPE_WORKGROUP) < gen) __builtin_amdgcn_s_sleep(1); }
    asm volatile("s_waitcnt lgkmcnt(0)" ::: "memory");
}
__device__ __forceinline__ void sb_unit4(const KArgs& a, LAS unsigned char* sbl, LAS unsigned* ctr, unsigned& gen, int h, int qb, int wave, int lane) {
    unsigned char* ws = a.ws; const bf16_t* proj = (const bf16_t*)(ws + WS_PROJ);
    constexpr int KT_B = 64 * 256, BUF_B = 32768;
    const int n = lane & 15, g = lane >> 4;
    const int tq = 64 * qb + 16 * wave + n;
    const float SC = 0.08838834764831845f * LOG2E;
    bf16x8 qf[4];
#pragma unroll
    for (int ks = 0; ks < 4; ++ks) { const u32x4 w = *(const u32x4*)(proj + (size_t)tq * NPAD + C_SQ + h * 128 + 32 * ks + 8 * g); float f[8]; unpack8(w, f);
#pragma unroll
        for (int e = 0; e < 8; ++e) f[e] *= SC;
        const u32x4 pw = pack8(f); __builtin_memcpy(&qf[ks], &pw, 16); }
    f32x4 O[8];
#pragma unroll
    for (int i = 0; i < 8; ++i) O[i] = (f32x4){0.f, 0.f, 0.f, 0.f};
    float carry = 1.f;
    volatile LAS unsigned* alive = (volatile LAS unsigned*)(ctr + 8);
    const int ntiles = qb + 1;
    const char* kbase = (const char*)(proj + C_SK + h * 128); const char* vbase = (const char*)((const bf16_t*)(ws + WS_SVT) + (size_t)h * 256 * 8192);
    auto issue = [&](int T, int buf) {
        const char* kt = kbase + (size_t)(64 * T) * NPAD * 2; const char* vt = vbase + (size_t)T * 16384;
#pragma unroll
        for (int i = 0; i < 4; ++i) { const int p = i * 256 + wave * 64 + lane;
            const int rho = p >> 4, c = (p & 15) ^ (rho & 15), k = (rho & 32) | ((rho & 16) >> 2) | ((rho & 12) << 1) | (rho & 3);
            const unsigned koff = (unsigned)(k * NPAD + 8 * c) * 2u;
            const int d = p >> 3, cv = (p & 7) ^ ((d >> 1) & 7);
            const unsigned voff = (unsigned)(d * 64 + 8 * cv) * 2u;
            __builtin_amdgcn_global_load_lds((const unsigned*)(kt + koff), (LAS unsigned*)(sbl + buf * BUF_B + (i * 256 + wave * 64) * 16), 16, 0, 0);
            __builtin_amdgcn_global_load_lds((const unsigned*)(vt + voff), (LAS unsigned*)(sbl + buf * BUF_B + KT_B + (i * 256 + wave * 64) * 16), 16, 0, 0); } };
    issue(ntiles - 1, 0);
    sb_swbar(ctr, gen, lane);
    for (int it = 0; it < ntiles; ++it) { const int T = ntiles - 1 - it, buf = it & 1;
        if (T > 0) issue(T - 1, buf ^ 1);
        const LAS bf16_t* Kt = (const LAS bf16_t*)(sbl + buf * BUF_B); const LAS bf16_t* Vt = (const LAS bf16_t*)(sbl + buf * BUF_B + KT_B);
        if (it == 0) sb_tile<true>(Kt, Vt, qf, O, carry, n, g, tq - 64 * T);
        else sb_tile<false>(Kt, Vt, qf, O, carry, n, g, 0);
        const bool dead = (__ballot(carry != 0.f) == 0ull);
        if (lane == 0) alive[(it & 1) * 4 + wave] = dead ? 0u : 1u;
        sb_swbar(ctr, gen, lane);
        const unsigned any = alive[(it & 1) * 4 + 0] | alive[(it & 1) * 4 + 1] | alive[(it & 1) * 4 + 2] | alive[(it & 1) * 4 + 3];
        if (__builtin_amdgcn_readfirstlane(any) == 0u) break;
    }
    bf16_t* orow = (bf16_t*)(ws + WS_OSB) + (size_t)tq * 512 + h * 128;
#pragma unroll
    for (int db = 0; db < 8; ++db) { u32x2 w; w.x = cvt_pk_bf16(O[db][0], O[db][1]); w.y = cvt_pk_bf16(O[db][2], O[db][3]); *(u32x2*)(orow + 16 * db + 4 * g) = w; }
}

struct NFrag { bf16x8 k[4]; bf16x8 v[4]; };
template <bool LV> __device__ __forceinline__ void nsa_load(NFrag& f, const bf16_t* Kb, const bf16_t* VB, int kb, int n, int g) {
    const bf16_t* kp = Kb + (size_t)(kb + 8 * (n >> 2) + (n & 3)) * 64 + 8 * g;
    f.k[0] = *(const bf16x8*)kp; f.k[1] = *(const bf16x8*)(kp + 32); f.k[2] = *(const bf16x8*)(kp + 256); f.k[3] = *(const bf16x8*)(kp + 288);
    if (LV) { const bf16_t* vp = VB + ((size_t)(kb >> 5) * 64 + n) * 32 + 8 * g;
#pragma unroll
        for (int db = 0; db < 4; ++db) f.v[db] = *(const bf16x8*)(vp + db * 512); }
}
template <int MODE, bool FAST>
__device__ __forceinline__ void nsa_compute(const NFrag& f, int kb, const bf16x8 (&qf)[2], const LAS float* LUTh, LAS float* impq,
                                            int tq, int h, int g, int qs, int qsel, float inv, float& lsum, f32x4 (&O)[4], float bfar) {
    f32x4 S[2];
#pragma unroll
    for (int pb = 0; pb < 2; ++pb) { f32x4 sv = mfma16(f.k[2 * pb], qf[0], (f32x4){0.f, 0.f, 0.f, 0.f}); S[pb] = mfma16(f.k[2 * pb + 1], qf[1], sv); }
    float p[8];
    const int dbase = (MODE <= 1) ? (tq - 31 - 16 * (kb + 8 * g)) : (tq - kb - 8 * g);
    const bool colok = (MODE == 2) ? (((qsel >> qs) & 1) != 0) : true;
    if (FAST) {
#pragma unroll
        for (int j = 0; j < 8; ++j) { const float ex = __builtin_amdgcn_exp2f(S[j >> 2][j & 3] + bfar);
            float pv = (MODE == 2) ? (colok ? ex : 0.f) : ex;
            if (MODE == 1) pv *= inv;
            p[j] = pv; if (MODE != 1) lsum += pv; }
    } else {
    float bias[8];
#pragma unroll
    for (int j = 0; j < 8; ++j) { const int dist = (MODE <= 1) ? dbase - 16 * j : dbase - j; const unsigned di = min((unsigned)dist, 1023u); bias[j] = LUTh[di * 8]; }
#pragma unroll
    for (int j = 0; j < 8; ++j) asm volatile("" : "+v"(bias[j]));
#pragma unroll
    for (int j = 0; j < 8; ++j) { const int dist = (MODE <= 1) ? dbase - 16 * j : dbase - j;
        const bool valid = (MODE == 3) ? ((unsigned)dist < 512u) : (dist >= 0 && colok);
        const float ex = __builtin_amdgcn_exp2f(S[j >> 2][j & 3] + bias[j]);
        float pv = valid ? ex : 0.f;
        if (MODE == 1) pv *= inv;
        p[j] = pv; if (MODE != 1) lsum += pv; }
    }
    if (MODE == 0) return;
    if (MODE == 1) {
#pragma unroll
        for (int j = 0; j < 8; ++j) { float v = p[j]; v += __shfl_xor(v, 1); v += __shfl_xor(v, 2); v += __shfl_xor(v, 4); if (h == 0) impq[kb + 8 * g + j] = v; } }
    const u32x4 pw = pack8(p); bf16x8 pf; __builtin_memcpy(&pf, &pw, 16);
#pragma unroll
    for (int db = 0; db < 4; ++db) O[db] = mfma16(f.v[db], pf, O[db]);
}
template <int MODE, class KBF, class QSF>
__device__ __forceinline__ void nsa_run(int niter, const bf16_t* Kb, const bf16_t* VB, KBF kbf, QSF qsf, const bf16x8 (&qf)[2], const LAS float* LUTh, LAS float* impq,
                                        int tq, int h, int n, int g, int qs, float inv, float& lsum, f32x4 (&O)[4], int t0, float bfar) {
    if (niter <= 0) return;
    NFrag A, C; const int last = niter - 1;
    nsa_load<MODE != 0>(A, Kb, VB, kbf(0), n, g);
    for (int i = 0; i < niter; i += 2) {
        nsa_load<MODE != 0>(C, Kb, VB, kbf(i + 1 < last ? i + 1 : last), n, g);
        SCHED_FENCE();
        { const int kb_ = kbf(i); const bool far_ = (MODE <= 1) ? (t0 - 31 - 16 * (kb_ + 31) >= 1023) : ((MODE == 2) ? (t0 - (kb_ + 31) >= 1023) : false);
          if (MODE != 3 && far_) nsa_compute<MODE, true>(A, kb_, qf, LUTh, impq, tq, h, g, qs, qsf(i), inv, lsum, O, bfar); else nsa_compute<MODE, false>(A, kb_, qf, LUTh, impq, tq, h, g, qs, qsf(i), inv, lsum, O, bfar); }
        SCHED_FENCE();
        if (i + 1 >= niter) break;
        nsa_load<MODE != 0>(A, Kb, VB, kbf(i + 2 < last ? i + 2 : last), n, g);
        SCHED_FENCE();
        { const int kb_ = kbf(i + 1); const bool far_ = (MODE <= 1) ? (t0 - 31 - 16 * (kb_ + 31) >= 1023) : ((MODE == 2) ? (t0 - (kb_ + 31) >= 1023) : false);
          if (MODE != 3 && far_) nsa_compute<MODE, true>(C, kb_, qf, LUTh, impq, tq, h, g, qs, qsf(i + 1), inv, lsum, O, bfar); else nsa_compute<MODE, false>(C, kb_, qf, LUTh, impq, tq, h, g, qs, qsf(i + 1), inv, lsum, O, bfar); }
        SCHED_FENCE();
    }
}
__device__ __forceinline__ float lred(float l) { l += __shfl_xor(l, 16); l += __shfl_xor(l, 32); return l; }
__device__ __forceinline__ void nsa_unit(const KArgs& a, LAS unsigned char* lds, int unit, LAS float* imp, LAS int* selL, int lane) {
    unsigned char* ws = a.ws; const bf16_t* proj = (const bf16_t*)(ws + WS_PROJ);
    const int t0 = 2 * unit, n = lane & 15, g = lane >> 4, qs = n >> 3, h = n & 7, tq = t0 + qs;
    const LAS float* LUT = (const LAS float*)lds + h;
    const float bfar = LUT[1023 * 8];
    bf16x8 qf[2];
    qf[0] = *(const bf16x8*)((const bf16_t*)(ws + WS_QN) + (size_t)tq * 512 + h * 64 + 8 * g); qf[1] = *(const bf16x8*)((const bf16_t*)(ws + WS_QN) + (size_t)tq * 512 + h * 64 + 32 + 8 * g);
    const bf16_t* gp = proj + (size_t)tq * NPAD + C_NGATE + h * 3;
    const float g0 = 1.f / (1.f + __expf(-bf2f(gp[0]))), g1 = 1.f / (1.f + __expf(-bf2f(gp[1]))), g2 = 1.f / (1.f + __expf(-bf2f(gp[2])));
    f32x4 Ot[4], Ob[4];
#pragma unroll
    for (int i = 0; i < 4; ++i) { Ot[i] = (f32x4){0.f, 0.f, 0.f, 0.f}; Ob[i] = (f32x4){0.f, 0.f, 0.f, 0.f}; }
    const int nvmax = (t0 + 1 >= 31) ? (((t0 + 1 - 31) >> 4) + 1) : 0; const int nch = (nvmax + 31) >> 5;
    const bf16_t* KC = (const bf16_t*)(ws + WS_KCMP); const bf16_t* VCT = (const bf16_t*)(ws + WS_VCMPT);
    auto kb_lin = [](int i) { return 32 * i; }; auto qs_zero = [](int) { return 0; };
    float lsum = 0.f;
    nsa_run<0>(nch, KC, VCT, kb_lin, qs_zero, qf, LUT, imp + qs * 1024, tq, h, n, g, qs, 0.f, lsum, Ob, t0, bfar);
    { const float l = lred(lsum); const float inv = l > 0.f ? 1.f / l : 0.f; float dummy = 0.f;
      nsa_run<1>(nch, KC, VCT, kb_lin, qs_zero, qf, LUT, imp + qs * 1024, tq, h, n, g, qs, inv, dummy, Ob, t0, bfar); }
#pragma unroll
    for (int i = 0; i < 4; ++i) { Ot[i] += Ob[i] * g0; Ob[i] = (f32x4){0.f, 0.f, 0.f, 0.f}; }
    LDS_FENCE();
    int cnts[2];
#pragma unroll
    for (int q2 = 0; q2 < 2; ++q2) { const int tqq = t0 + q2, cur = tqq >> 6; const LAS float* iq = imp + q2 * 1024;
        float val[4];
#pragma unroll
        for (int r = 0; r < 4; ++r) { const int b = lane + 64 * r; float v = -1.f;
            if (b >= 1 && b <= cur - 2) { v = 0.f;
#pragma unroll
                for (int i = 0; i < 5; ++i) v += iq[4 * b - 1 + i]; }
            val[r] = v; }
        int cnt = 0;
        if (lane == 0) { selL[q2 * 8 + 0] = 0; if (cur >= 1) selL[q2 * 8 + 1] = cur; if (cur >= 2) selL[q2 * 8 + 2] = cur - 1; }
        cnt = 1 + (cur >= 1) + (cur >= 2);
        int ncand = cur - 2; if (ncand < 0) ncand = 0; const int npick = ncand < 5 ? ncand : 5;
        for (int rd = 0; rd < npick; ++rd) { float bv = val[0]; int bi = lane;
#pragma unroll
            for (int r = 1; r < 4; ++r) if (val[r] > bv) { bv = val[r]; bi = lane + 64 * r; }
#pragma unroll
            for (int o = 1; o < 64; o <<= 1) { const float ov = __shfl_xor(bv, o); const int oi = __shfl_xor(bi, o); if (ov > bv || (ov == bv && oi < bi)) { bv = ov; bi = oi; } }
            if (lane == 0) selL[q2 * 8 + cnt] = bi; ++cnt;
#pragma unroll
            for (int r = 0; r < 4; ++r) if (bi == lane + 64 * r) val[r] = -2.f; }
        cnts[q2] = cnt; }
    LDS_FENCE();
#pragma unroll
    for (int i = 0; i < 4; ++i)
#pragma unroll
        for (int j = 0; j < 4; ++j) imp[(4 * i + j) * 64 + lane] = Ot[i][j];
    lsum = 0.f;
    { const int c0 = cnts[0], c1 = cnts[1];
      const int b1 = (lane < c1) ? selL[8 + lane] : -1;
      int pos = -1;
      for (int k = 0; k < c0; ++k) if (selL[k] == b1) pos = k;
      LDS_FENCE();
      if (lane < c0) selL[16 + lane] = 1;
      LDS_FENCE();
      const bool fresh = (lane < c1) && (pos < 0);
      if (lane < c1 && pos >= 0) selL[16 + pos] = 3;
      const unsigned long long nb = __ballot(fresh);
      if (fresh) { const int idx = c0 + __popcll(nb & ((1ull << lane) - 1ull)); selL[idx] = b1; selL[16 + idx] = 2; }
      const int tot = c0 + __popcll(nb);
      LDS_FENCE();
      auto kbf = [&](int i) { return 64 * __builtin_amdgcn_readfirstlane(selL[i >> 1]) + 32 * (i & 1); };
      auto qsf = [&](int i) { return __builtin_amdgcn_readfirstlane(selL[16 + (i >> 1)]); };
      nsa_run<2>(2 * tot, (const bf16_t*)(ws + WS_KSN), (const bf16_t*)(ws + WS_VST), kbf, qsf, qf, LUT, imp, tq, h, n, g, qs, 0.f, lsum, Ob, t0, bfar); }
    { const float l = lred(lsum); const float sc = l > 0.f ? g1 / l : 0.f;
#pragma unroll
      for (int i = 0; i < 4; ++i) {
#pragma unroll
          for (int j = 0; j < 4; ++j) imp[(4 * i + j) * 64 + lane] += Ob[i][j] * sc;
          Ob[i] = (f32x4){0.f, 0.f, 0.f, 0.f}; } }
    lsum = 0.f;
    { int lo = t0 - 511; if (lo < 0) lo = 0; lo &= ~31; const int nw = ((t0 + 1 - lo) >> 5) + 1;
      auto kbf = [&](int i) { return lo + 32 * i; };
      nsa_run<3>(nw, (const bf16_t*)(ws + WS_KWN), (const bf16_t*)(ws + WS_VWT), kbf, qs_zero, qf, LUT, imp, tq, h, n, g, qs, 0.f, lsum, Ob, t0, bfar);
      const float l = lred(lsum); const float sc = l > 0.f ? g2 / l : 0.f;
#pragma unroll
      for (int i = 0; i < 4; ++i)
#pragma unroll
          for (int j = 0; j < 4; ++j) Ot[i][j] = imp[(4 * i + j) * 64 + lane] + Ob[i][j] * sc; }
    bf16_t* orow = (bf16_t*)(ws + WS_ONSA) + (size_t)tq * 512 + h * 64;
#pragma unroll
    for (int db = 0; db < 4; ++db) { u32x2 w; w.x = cvt_pk_bf16(Ot[db][0], Ot[db][1]); w.y = cvt_pk_bf16(Ot[db][2], Ot[db][3]); *(u32x2*)(orow + 16 * db + 4 * g) = w; }
}


#define RLX_AGENT __ATOMIC_RELAXED, __HIP_MEMORY_SCOPE_AGENT
#define XB_TMO      128
#define XB_XCNT(j)  (256  + 64 * (j))
#define XB_XSUB(j)  (1280 + 64 * (j))
#define XB_XGEN(j)  (2304 + 64 * (j))
#define XB_TOP      3328
#define XB_TOPGEN   3392
#define XCD_BAR_WORDS 3456
#define XB_SPIN_CAP (1u << 18)

__device__ __forceinline__ unsigned xb_ld(unsigned* p)              { return __hip_atomic_load(p, __ATOMIC_RELAXED, __HIP_MEMORY_SCOPE_AGENT); }
__device__ __forceinline__ unsigned xb_add(unsigned* p, unsigned v) { return __hip_atomic_fetch_add(p, v, __ATOMIC_RELAXED, __HIP_MEMORY_SCOPE_AGENT); }
__device__ __forceinline__ unsigned xb_xcc_id() { return (unsigned)__builtin_amdgcn_s_getreg((3 << 11) | 20) & 0xFu; }
#define XB_SPIN(cond, bar) do { unsigned _sp = 0; while (cond) { __builtin_amdgcn_s_sleep(1); \
    if ((++_sp & 255u) == 0u) { if (xb_ld(&(bar)[XB_TMO])) break; if (_sp > XB_SPIN_CAP) { atomicAdd(&(bar)[XB_TMO], 1u); break; } } } } while (0)

struct XcdBarrier {
    unsigned* bar; unsigned x;
    volatile LAS unsigned* st;
};

__device__ __forceinline__ XcdBarrier xcd_barrier_post(unsigned* bar, volatile LAS unsigned* st) {
    XcdBarrier b; b.bar = bar; b.x = xb_xcc_id(); b.st = st;
    if (threadIdx.x == 0) (void)xb_add(&bar[XB_XCNT(b.x)], 1u);
    return b;
}
__device__ __forceinline__ void xcd_barrier_complete(unsigned* bar, unsigned x, unsigned& nloc, unsigned& nx) {
    const unsigned G = gridDim.x * gridDim.y * gridDim.z;
    unsigned sum, cnt, mine, sp = 0u;
    for (;;) {
        sum = 0u; cnt = 0u; mine = 0u;
#pragma unroll
        for (unsigned j = 0; j < 16; ++j) { const unsigned c = xb_ld(&bar[XB_XCNT(j)]); sum += c; cnt += (c > 0u) ? 1u : 0u; mine = (j == x) ? c : mine; }
        if (sum == G) break;
        __builtin_amdgcn_s_sleep(1);
        if ((++sp & 255u) == 0u) { if (xb_ld(&bar[XB_TMO])) break; if (sp > XB_SPIN_CAP) { atomicAdd(&bar[XB_TMO], 1u); break; } }
    }
    nloc = mine > 0u ? mine : 1u; nx = cnt > 0u ? cnt : 1u;
}

__device__ __forceinline__ void xcd_barrier(const XcdBarrier& b) {
    asm volatile("s_waitcnt vmcnt(0)" ::: "memory");
    __syncthreads();
    if (threadIdx.x == 0) {
        unsigned* bar = b.bar;
        __builtin_amdgcn_s_waitcnt(0);
        unsigned nloc = b.st[0], nx = b.st[1];
        if (nloc == 0u) { xcd_barrier_complete(bar, b.x, nloc, nx); b.st[0] = nloc; b.st[1] = nx; }
        const unsigned old = xb_add(&bar[XB_XSUB(b.x)], 1u);
        const unsigned gen = old / nloc;
        if (old + 1u == (gen + 1u) * nloc) {
            __builtin_amdgcn_fence(__ATOMIC_RELEASE, "agent");
            asm volatile("s_waitcnt vmcnt(0)" ::: "memory");
            const unsigned og = xb_add(&bar[XB_TOP], 1u);
            const unsigned tg = og / nx;
            if (og + 1u == (tg + 1u) * nx) xb_add(&bar[XB_TOPGEN], 1u);
            else XB_SPIN(xb_ld(&bar[XB_TOPGEN]) == tg, bar);
            __builtin_amdgcn_fence(__ATOMIC_ACQUIRE, "agent");
            xb_add(&bar[XB_XGEN(b.x)], 1u);
            asm volatile("s_waitcnt vmcnt(0)" ::: "memory");
        } else {
            XB_SPIN(xb_ld(&bar[XB_XGEN(b.x)]) == gen, bar);
            __builtin_amdgcn_fence(__ATOMIC_ACQUIRE, "agent");
            asm volatile("s_waitcnt vmcnt(0)" ::: "memory");
        }
    }
    __syncthreads();
}

#define GSYNC() xcd_barrier(xbar)
__global__ void __launch_bounds__(512) __attribute__((amdgpu_waves_per_eu(2, 2))) fwd_mega(KArgs a) {
    extern __shared__ __attribute__((aligned(16))) unsigned char lds_raw[];
    LAS unsigned char* lds = (LAS unsigned char*)lds_raw;
    const int G = gridDim.x, bid = blockIdx.x, NGW = G * 8;
    const int vb = (G % 8 == 0) ? (bid % 8) * (G / 8) + bid / 8 : bid;
    { volatile LAS unsigned* stw = (volatile LAS unsigned*)(lds + 132608); if (threadIdx.x < 2) stw[threadIdx.x] = 0u; }
    __syncthreads();
    XcdBarrier xbar = xcd_barrier_post((unsigned*)(a.ws + WS_CTL), (volatile LAS unsigned*)(lds + 132608));
    cg::this_grid().sync();
#define IDS() int tid = threadIdx.x; asm volatile("" : "+v"(tid)); const int lane = tid & 63, wave = __builtin_amdgcn_readfirstlane(tid >> 6); const int gw = bid * 8 + wave; (void)lane; (void)gw;
    unsigned char* ws = a.ws;
    bf16_t* PROJ = (bf16_t*)(ws + WS_PROJ); bf16_t* HN = (bf16_t*)(ws + WS_HN); bf16_t* HID = (bf16_t*)(ws + WS_HID);
#pragma unroll 1
    for (int l = 0; l < DEPTH; ++l) {
        const float* xsrc = (l == 0) ? a.in[0] : a.out;
        { IDS(); phase_convert(a, l, lds, gw, NGW, wave, lane);
          phase_rms(xsrc, a.in[1] + l * DM, HN, gw, NGW, lane); }
        GSYNC();
        { pg8::Gemm g{HN, (const bf16_t*)(ws + WS_WIN), M, NPAD, DM}; pg8::StaticOrder S; S.init(M, NPAD, G, bid);
          pg8::EpiBf16<0> E{PROJ, NPAD};
          pg8::gemm_phase<pg8::EpiBf16<0>, pg8::StaticOrder, true, true>(lds, g, S, E); }
        GSYNC();
        { IDS(); for (int it = bid; it < 256; it += G) pre_item(a, l, lds, it, tid); }
        { IDS(); for (int it = bid; it < 128; it += G) cmp_item(a, l, lds, it, tid, wave, lane); }
        { IDS();
          if (G == 256) {
              const int nk = bid < 128 ? 5 : 8;
              for (int k = 0; k < nk; ++k) gla_g1_item(a, l, lds, bid + 256 * k, tid, wave, lane);
              if (bid >= 128) for (int k = 5; k < 8; ++k) gla_g1_item(a, l, lds, (bid - 128) + 256 * k, tid, wave, lane);
          } else for (int it = bid; it < 2048; it += G) gla_g1_item(a, l, lds, it, tid, wave, lane); }
        GSYNC();
        {   IDS();
            { const float* lg = (const float*)(ws + WS_LUT); LAS float* LUT = (LAS float*)lds; for (int i = tid; i < 8192; i += 512) LUT[i] = lg[i]; }
            LAS int* ctr = (LAS int*)(lds + 132096);
            LAS unsigned* sbc = (LAS unsigned*)(lds + 132112);
            if (tid == 0) { *ctr = 0; *sbc = 0u; }
            __syncthreads();
            if (wave < 4) {
                unsigned gen = 0u;
                for (int pp = vb; pp < 512; pp += G) {
                    const int hh = pp & 3, q = pp >> 2;
                    sb_unit4(a, lds + 65536, sbc, gen, hh, 255 - q, wave, lane);
                    sb_unit4(a, lds + 65536, sbc, gen, hh, q, wave, lane); }
            } else {
                for (int c0 = (bid * 4 + (wave - 4)) * 64; c0 < 65536; c0 += G * 256) gla_scan(a, c0 + lane);
            }
            LAS float* imp = (LAS float*)(lds + (wave < 4 ? 65536 + wave * 8192 : 32768 + (wave - 4) * 8192));
            LAS int* selL = (LAS int*)(lds + 131072 + wave * 128);
            const int nper = (8192 + G - 1) / G;
            for (;;) { int idx = 0; if (lane == 0) idx = atomicAdd((int*)ctr, 1); idx = __builtin_amdgcn_readfirstlane(idx);
                if (idx >= nper) break; const int hn = nper >> 1; const int unit = (idx < hn) ? (8192 - hn * (vb + 1) + idx) : (hn * vb + (idx - hn)); if (unit >= 0 && unit < 8192) nsa_unit(a, lds, unit, imp, selL, lane); }
            __syncthreads();
        }
        GSYNC();
        { IDS(); for (int it = bid; it < 2048; it += G) gla_g3_item(a, l, lds, it, tid, wave, lane); }
        GSYNC();
        for (int b = 0; b < 3; ++b) {
            pg8::Gemm g{(const bf16_t*)(ws + WS_OGLA + b * 16 * MiB), (const bf16_t*)(ws + WS_WBR + b * MiB), M, DM, 512}; pg8::StaticOrder S; S.init(M, DM, G, bid);
            pg8::EpiGate E{HN, PROJ + C_MGATE + b * DM, NPAD, b == 0 ? 1 : 0};
            pg8::gemm_phase<pg8::EpiGate, pg8::StaticOrder, true, true>(lds, g, S, E); }
        GSYNC();
        { pg8::Gemm g{HN, (const bf16_t*)(ws + WS_WOUT), M, DM, DM}; pg8::StaticOrder S; S.init(M, DM, G, bid);
          pg8::EpiRes E{xsrc, a.out};
          pg8::gemm_phase<pg8::EpiRes, pg8::StaticOrder, true, true>(lds, g, S, E); }
        GSYNC();
        { IDS(); phase_rms(a.out, a.in[2] + l * DM, HN, gw, NGW, lane); }
        GSYNC();
        { pg8::Gemm g{HN, (const bf16_t*)(ws + WS_WUP), M, FF, DM}; pg8::StaticOrder S; S.init(M, FF, G, bid);
          pg8::EpiBf16<2> E{HID, FF};
          pg8::gemm_phase<pg8::EpiBf16<2>, pg8::StaticOrder, true, true>(lds, g, S, E); }
        GSYNC();
        { pg8::Gemm g{HID, (const bf16_t*)(ws + WS_WDN), M, DM, FF}; pg8::StaticOrder S; S.init(M, DM, G, bid);
          pg8::EpiRes E{a.out, a.out};
          pg8::gemm_phase<pg8::EpiRes, pg8::StaticOrder, true, true>(lds, g, S, E); }
        GSYNC();
    }
}

extern "C" void kernel_launch(void* const* d_in, const int* in_sizes, int n_in, void* d_out, int out_size, void* d_ws, size_t ws_size, hipStream_t stream) {
    static int grid = 0;
    if (grid == 0) {
        if (n_in != 22 || ws_size < WS_END + 65536) { fprintf(stderr, "kernel_launch: unexpected n_in %d or ws_size %zu (< %zu)\n", n_in, ws_size, (size_t)WS_END); grid = -1; return; }
        int dev = 0, cus = 0, per_cu = 0;
        hipGetDevice(&dev); hipDeviceGetAttribute(&cus, hipDeviceAttributeMultiprocessorCount, dev);
        hipFuncSetAttribute((const void*)fwd_mega, hipFuncAttributeMaxDynamicSharedMemorySize, LDS_BYTES);
        hipOccupancyMaxActiveBlocksPerMultiprocessor(&per_cu, (const void*)fwd_mega, 512, LDS_BYTES);
        if (per_cu < 1) { fprintf(stderr, "kernel_launch: occupancy query says %d blocks/CU\n", per_cu); per_cu = 1; }
        (void)hipGetLastError();
        grid = cus * 1;
    }
    if (grid < 0) return;
    if (hipMemsetAsync((char*)d_ws + WS_CTL, 0, 65536, stream) != hipSuccess) { fprintf(stderr, "kernel_launch: memset of barrier words failed\n"); return; }
    KArgs a{};
    for (int i = 0; i < 22; ++i) a.in[i] = (const float*)d_in[i];
    a.out = (float*)d_out; a.ws = (unsigned char*)d_ws;
    void* args[] = {&a};
    hipError_t e = hipLaunchCooperativeKernel((const void*)fwd_mega, dim3(grid), dim3(512), args, LDS_BYTES, stream);
    if (e != hipSuccess) fprintf(stderr, "cooperative launch failed: %s (grid %d)\n", hipGetErrorString(e), grid);
}
```

```cpp
#include <hip/hip_runtime.h>
#include <hip/hip_cooperative_groups.h>
#include <cstdio>
#include <cstdint>
namespace cg = cooperative_groups;
namespace pg8 {
#define PG8_LAS __attribute__((address_space(3)))
typedef unsigned short bf16_t;
typedef short bf16x8 __attribute__((ext_vector_type(8)));
typedef float f32x4 __attribute__((ext_vector_type(4)));
typedef unsigned u32x4 __attribute__((ext_vector_type(4)));
constexpr int BM = 256, BK = 64, HALF = 128, HTB = HALF * BK * 2  , STAGE_BYTES = 8 * HTB, NXCD = 8, WGM = 8;

__host__ __device__ __forceinline__ int lds_byte(int r, int c) { const int st = (r >> 4) * 2 + (c >> 5), rr = r & 15, cc = c & 31, ob = rr * 64 + cc * 2; return st * 1024 + (ob ^ (((ob >> 9) & 1) << 5)); }
__host__ __device__ __forceinline__ void stage_rc(int b, int& R, int& C) { const int st = b / 1024, sb = b % 1024, swz = sb ^ (((sb >> 9) & 1) << 5); R = (st >> 1) * 16 + swz / 64; C = (st & 1) * 32 + (swz % 64) / 2; }
__host__ __device__ __forceinline__ int perm32(int rho) { const int n = rho >> 4, i = rho & 15; return 8 * (i >> 2) + 4 * n + (i & 3); }

struct Unit { int pm, pn; };
struct Gemm { const bf16_t* A; const bf16_t* Bt; int M, N, K; };

struct StaticOrder {
    int nM, nN, nwg, G, c;
    __host__ __device__ void init(int M, int N, int G_, int c_) { nM = M / BM; nN = N / BM; nwg = nM * nN; G = G_; c = c_; }
    __host__ __device__ bool next(int i, Unit& u) const {
        const long L = (long)i * G + c; if (L >= nwg) return false;
        int wgid = (int)L; { const int q = nwg / NXCD, r = nwg % NXCD, xcd = wgid % NXCD, off = wgid / NXCD; wgid = (xcd < r ? xcd * (q + 1) : r * (q + 1) + (xcd - r) * q) + off; }
        const int nig = WGM * nN, gid = wgid / nig, fm = gid * WGM, gsz = (nM - fm) < WGM ? (nM - fm) : WGM;
        u.pm = fm + ((wgid % nig) % gsz); u.pn = (wgid % nig) / gsz; return true;
    }
    __device__ __forceinline__ void a_ready(const Unit&) const {}
    __device__ __forceinline__ void done(const Unit&) const {}
};

__device__ __forceinline__ unsigned cvt_pk_bf16(float lo, float hi) { unsigned r; asm("v_cvt_pk_bf16_f32 %0, %1, %2" : "=v"(r) : "v"(lo), "v"(hi)); return r; }
__device__ __forceinline__ float bflo(unsigned w) { return __uint_as_float(w << 16); }
__device__ __forceinline__ float bfhi(unsigned w) { return __uint_as_float(w & 0xffff0000u); }
template <int ACT> struct EpiBf16 {
    static constexpr bool PERM = true, AFTER_DRAIN = false;
    bf16_t* O; int ldc;
    __device__ __forceinline__ void operator()(const f32x4 (&acc)[2][2][4][2], const Unit& u, int wr, int wc, int fr, int fq) const {
        const int row0 = u.pm * BM + wr * 64 + fr; const int col0 = u.pn * BM + wc * 32 + 8 * fq;
#pragma unroll
        for (int ai = 0; ai < 2; ++ai)
#pragma unroll
            for (int m = 0; m < 4; ++m) { bf16_t* rowp = O + (size_t)(row0 + ai * HALF + m * 16) * ldc + col0;
#pragma unroll
                for (int bj = 0; bj < 2; ++bj) { f32x4 v0 = acc[ai][bj][m][0], v1 = acc[ai][bj][m][1];
                    if (ACT == 2) {
#pragma unroll
                        for (int e = 0; e < 4; ++e) { float a = fmaxf(v0[e], 0.f), b = fmaxf(v1[e], 0.f); v0[e] = a * a; v1[e] = b * b; } }
                    u32x4 w; w.x = cvt_pk_bf16(v0[0], v0[1]); w.y = cvt_pk_bf16(v0[2], v0[3]); w.z = cvt_pk_bf16(v1[0], v1[1]); w.w = cvt_pk_bf16(v1[2], v1[3]);
                    *(u32x4*)(rowp + bj * HALF) = w; } }
    }
};
struct EpiGate {
    static constexpr bool PERM = true, AFTER_DRAIN = false;
    bf16_t* O; const bf16_t* gate; int gld; int first;
    __device__ __forceinline__ void operator()(const f32x4 (&acc)[2][2][4][2], const Unit& u, int wr, int wc, int fr, int fq) const {
        const int row0 = u.pm * BM + wr * 64 + fr; const int col0 = u.pn * BM + wc * 32 + 8 * fq;
#pragma unroll
        for (int ai = 0; ai < 2; ++ai)
#pragma unroll
            for (int m = 0; m < 4; ++m) { const int row = row0 + ai * HALF + m * 16; bf16_t* rowp = O + (size_t)row * 1024 + col0; const bf16_t* gp = gate + (size_t)row * gld + col0;
#pragma unroll
                for (int bj = 0; bj < 2; ++bj) { const f32x4 v0 = acc[ai][bj][m][0], v1 = acc[ai][bj][m][1];
                    const u32x4 gw = *(const u32x4*)(gp + bj * HALF);
                    u32x4 ow = (u32x4){0u, 0u, 0u, 0u}; if (!first) ow = *(const u32x4*)(rowp + bj * HALF);
                    float gv[8] = {bflo(gw.x), bfhi(gw.x), bflo(gw.y), bfhi(gw.y), bflo(gw.z), bfhi(gw.z), bflo(gw.w), bfhi(gw.w)};
                    float ov[8] = {bflo(ow.x), bfhi(ow.x), bflo(ow.y), bfhi(ow.y), bflo(ow.z), bfhi(ow.z), bflo(ow.w), bfhi(ow.w)};
                    float av[8] = {v0[0], v0[1], v0[2], v0[3], v1[0], v1[1], v1[2], v1[3]};
                    float r[8];
#pragma unroll
                    for (int e = 0; e < 8; ++e) { const float s = 1.f / (1.f + __expf(-gv[e])); r[e] = ov[e] + s * av[e]; }
                    u32x4 w; w.x = cvt_pk_bf16(r[0], r[1]); w.y = cvt_pk_bf16(r[2], r[3]); w.z = cvt_pk_bf16(r[4], r[5]); w.w = cvt_pk_bf16(r[6], r[7]);
                    *(u32x4*)(rowp + bj * HALF) = w; } }
    }
};
struct EpiRes {
    static constexpr bool PERM = false, AFTER_DRAIN = false;
    const float* src; float* out;
    __device__ __forceinline__ void operator()(const f32x4 (&acc)[2][2][4][2], const Unit& u, int wr, int wc, int fr, int fq) const {
        const int col0 = u.pn * BM + wc * 32 + 4 * fq;
#pragma unroll
        for (int ai = 0; ai < 2; ++ai)
#pragma unroll
            for (int m = 0; m < 4; ++m) { const size_t off = (size_t)(u.pm * BM + ai * HALF + wr * 64 + m * 16 + fr) * 1024 + col0;
#pragma unroll
                for (int bj = 0; bj < 2; ++bj)
#pragma unroll
                    for (int n = 0; n < 2; ++n) { const f32x4 bs = *(const f32x4*)(src + off + bj * HALF + n * 16); *(f32x4*)(out + off + bj * HALF + n * 16) = bs + acc[ai][bj][m][n]; } }
    }
};
template <class Epi, class Sched, bool ALIGN_EPI = false, bool SP2 = false>
__device__ __forceinline__ void gemm_phase(PG8_LAS unsigned char* lds, const Gemm g, const Sched& S, const Epi& E) {
    int tid_ = threadIdx.x; asm volatile("" : "+v"(tid_));
    const int tid = tid_, wid = __builtin_amdgcn_readfirstlane(tid >> 6), lane = tid & 63, wr = wid >> 2, wc = wid & 3, fr = lane & 15, fq = lane >> 4;
    const int K = g.K, nt = K / BK;
    unsigned voffA[2], voffB[2];
#pragma unroll
    for (int i = 0; i < 2; ++i) { int R, C; stage_rc(tid * 16 + i * 8192, R, C); const int Rb = Epi::PERM ? ((R & ~31) + perm32(R & 31)) : R;
        voffA[i] = (unsigned)(R * K + C) * 2u; voffB[i] = (unsigned)(Rb * K + C) * 2u; }
    const size_t kstep = (size_t)(BK * 2);
    const size_t hstep = (size_t)HALF * K * 2;
    const size_t tstep = 2 * hstep;
    const unsigned ldsw = (unsigned)wid * 1024u;
    const int aoff = lds_byte(wr * 64 + fr, fq * 8), boff = lds_byte(wc * 32 + fr, fq * 8);
#define PG8_SA(b, h) (((b) * 2 + (h)) * HTB)
#define PG8_SB(b, h) ((4 + (b) * 2 + (h)) * HTB)
#define PG8_STAGE(bufoff, gbase, voff) do { _Pragma("unroll") for (int _i = 0; _i < 2; ++_i) \
        __builtin_amdgcn_global_load_lds((const unsigned*)((const char*)(gbase) + (voff)[_i]), (PG8_LAS unsigned*)(lds + (bufoff) + ldsw + _i * 8192), 16, 0, 0); } while (0)
#define PG8_LDA(dst, b, h) do { _Pragma("unroll") for (int m = 0; m < 4; ++m) _Pragma("unroll") for (int k = 0; k < 2; ++k) dst[m][k] = *(const PG8_LAS bf16x8*)(lds + PG8_SA(b, h) + aoff + m * 2048 + k * 1024); } while (0)
#define PG8_LDB(dst, b, h) do { _Pragma("unroll") for (int n = 0; n < 2; ++n) _Pragma("unroll") for (int k = 0; k < 2; ++k) dst[n][k] = *(const PG8_LAS bf16x8*)(lds + PG8_SB(b, h) + boff + n * 2048 + k * 1024); } while (0)
#define PG8_MMA(ai, bj, At, Bt) do { __builtin_amdgcn_s_setprio(1); _Pragma("unroll") for (int m = 0; m < 4; ++m) _Pragma("unroll") for (int n = 0; n < 2; ++n) _Pragma("unroll") for (int k = 0; k < 2; ++k) \
        acc[ai][bj][m][n] = __builtin_amdgcn_mfma_f32_16x16x32_bf16(Bt[n][k], At[m][k], acc[ai][bj][m][n], 0, 0, 0); __builtin_amdgcn_s_setprio(0); } while (0)
#define PG8_WAIT_V(n) asm volatile("s_waitcnt vmcnt(" #n ")" ::: "memory")
#define PG8_WAIT_L(n) asm volatile("s_waitcnt lgkmcnt(" #n ")" ::: "memory")
#define PG8_BAR __builtin_amdgcn_s_barrier()
#define PG8_SCHED __builtin_amdgcn_sched_barrier(0)
    Unit cur, nxt; int ui = 0;
    if (!S.next(0, cur)) return;
    f32x4 acc[2][2][4][2];
#pragma unroll
    for (int a = 0; a < 2; ++a)
#pragma unroll
        for (int b = 0; b < 2; ++b)
#pragma unroll
            for (int m = 0; m < 4; ++m)
#pragma unroll
                for (int n = 0; n < 2; ++n) acc[a][b][m][n] = (f32x4){0.f, 0.f, 0.f, 0.f};
    bf16x8 At[4][2], B0[2][2], B1[2][2];
    const char* cA = (const char*)g.A + (size_t)cur.pm * tstep; const char* cB = (const char*)g.Bt + (size_t)cur.pn * tstep;
    S.a_ready(cur);
    if constexpr (SP2) {
        PG8_STAGE(PG8_SB(0, 0), cB, voffB); PG8_STAGE(PG8_SB(0, 1), cB + hstep, voffB); PG8_STAGE(PG8_SA(0, 0), cA, voffA); PG8_STAGE(PG8_SA(0, 1), cA + hstep, voffA);
        if (wr == 1) PG8_BAR;
        PG8_WAIT_V(2); PG8_BAR;
        PG8_STAGE(PG8_SB(1, 0), cB + kstep, voffB); PG8_STAGE(PG8_SA(1, 0), cA + kstep, voffA); PG8_STAGE(PG8_SB(1, 1), cB + hstep + kstep, voffB);
        PG8_WAIT_V(6); PG8_BAR;
    } else {
        PG8_STAGE(PG8_SB(0, 0), cB, voffB); PG8_STAGE(PG8_SA(0, 0), cA, voffA); PG8_STAGE(PG8_SB(0, 1), cB + hstep, voffB); PG8_STAGE(PG8_SA(0, 1), cA + hstep, voffA);
        if (wr == 1) PG8_BAR;
        PG8_WAIT_V(4); PG8_BAR;
        PG8_STAGE(PG8_SB(1, 0), cB + kstep, voffB); PG8_STAGE(PG8_SA(1, 0), cA + kstep, voffA); PG8_STAGE(PG8_SB(1, 1), cB + hstep + kstep, voffB);
        PG8_WAIT_V(6); PG8_BAR;
    }
    for (;;) {
        const bool has_next = S.next(ui + 1, nxt);
        const char* nA = has_next ? (const char*)g.A + (size_t)nxt.pm * tstep : cA; const char* nB = has_next ? (const char*)g.Bt + (size_t)nxt.pn * tstep : cB;
        for (int t = 0; t < nt; t += 2) {
            const bool last = (t == nt - 2);
            const char* a1 = cA + (size_t)(t + 1) * kstep;
            const char* a2 = last ? nA : cA + (size_t)(t + 2) * kstep; const char* b2 = last ? nB : cB + (size_t)(t + 2) * kstep;
            const char* a3 = a2 + kstep; const char* b3 = b2 + kstep;
            if (last && has_next) S.a_ready(nxt);
            if constexpr (SP2) {
            PG8_LDB(B0, 0, 0); PG8_LDB(B1, 0, 1); PG8_SCHED; PG8_LDA(At, 0, 0); PG8_STAGE(PG8_SA(1, 1), a1 + hstep, voffA);
            PG8_WAIT_V(8); PG8_WAIT_L(0); PG8_BAR; PG8_MMA(0, 0, At, B0); PG8_MMA(0, 1, At, B1); PG8_BAR; PG8_SCHED;
            PG8_LDA(At, 0, 1); PG8_STAGE(PG8_SB(0, 0), b2, voffB); PG8_STAGE(PG8_SB(0, 1), b2 + hstep, voffB); PG8_STAGE(PG8_SA(0, 0), a2, voffA);
            PG8_WAIT_V(8); PG8_WAIT_L(0); PG8_BAR; PG8_MMA(1, 0, At, B0); PG8_MMA(1, 1, At, B1); PG8_BAR; PG8_SCHED;
            PG8_LDB(B0, 1, 0); PG8_LDB(B1, 1, 1); PG8_SCHED; PG8_LDA(At, 1, 0); PG8_STAGE(PG8_SA(0, 1), a2 + hstep, voffA);
            PG8_WAIT_V(8); PG8_WAIT_L(0); PG8_BAR; PG8_MMA(0, 0, At, B0); PG8_MMA(0, 1, At, B1); PG8_BAR; PG8_SCHED;
            PG8_LDA(At, 1, 1); PG8_STAGE(PG8_SB(1, 0), b3, voffB); PG8_STAGE(PG8_SB(1, 1), b3 + hstep, voffB); PG8_STAGE(PG8_SA(1, 0), a3, voffA);
            PG8_WAIT_V(8); PG8_WAIT_L(0); PG8_BAR; PG8_MMA(1, 0, At, B0); PG8_MMA(1, 1, At, B1); PG8_BAR; PG8_SCHED;
            } else {
            PG8_LDB(B0, 0, 0); PG8_SCHED; PG8_LDA(At, 0, 0); PG8_STAGE(PG8_SA(1, 1), a1 + hstep, voffA);
            PG8_WAIT_L(8); PG8_BAR; PG8_WAIT_L(0); PG8_MMA(0, 0, At, B0); PG8_BAR; PG8_SCHED;
            PG8_LDB(B1, 0, 1); PG8_STAGE(PG8_SB(0, 0), b2, voffB);
            PG8_BAR; PG8_WAIT_L(0); PG8_MMA(0, 1, At, B1); PG8_BAR;
            PG8_LDA(At, 0, 1); PG8_STAGE(PG8_SA(0, 0), a2, voffA);
            PG8_BAR; PG8_WAIT_L(0); PG8_MMA(1, 0, At, B0); PG8_BAR; PG8_SCHED;
            PG8_STAGE(PG8_SB(0, 1), b2 + hstep, voffB);
            PG8_WAIT_V(6); PG8_BAR; PG8_MMA(1, 1, At, B1); PG8_BAR;
            PG8_LDB(B0, 1, 0); PG8_SCHED; PG8_LDA(At, 1, 0); PG8_STAGE(PG8_SA(0, 1), a2 + hstep, voffA);
            PG8_WAIT_L(8); PG8_BAR; PG8_WAIT_L(0); PG8_MMA(0, 0, At, B0); PG8_BAR; PG8_SCHED;
            PG8_LDB(B1, 1, 1); PG8_STAGE(PG8_SB(1, 0), b3, voffB);
            PG8_BAR; PG8_WAIT_L(0); PG8_MMA(0, 1, At, B1); PG8_BAR;
            PG8_LDA(At, 1, 1); PG8_STAGE(PG8_SA(1, 0), a3, voffA);
            PG8_BAR; PG8_WAIT_L(0); PG8_MMA(1, 0, At, B0); PG8_BAR; PG8_SCHED;
            PG8_STAGE(PG8_SB(1, 1), b3 + hstep, voffB);
            PG8_WAIT_V(6); PG8_BAR; PG8_MMA(1, 1, At, B1); PG8_BAR;
            }
        }
        if constexpr (ALIGN_EPI) { if (wr == 0) PG8_BAR; }
        if constexpr (!Epi::AFTER_DRAIN) { E(acc, cur, wr, wc, fr, fq); S.done(cur); }
        if (!has_next) break;
#pragma unroll
        for (int a = 0; a < 2; ++a)
#pragma unroll
            for (int b = 0; b < 2; ++b)
#pragma unroll
                for (int m = 0; m < 4; ++m)
#pragma unroll
                    for (int n = 0; n < 2; ++n) acc[a][b][m][n] = (f32x4){0.f, 0.f, 0.f, 0.f};
        cur = nxt; cA = nA; cB = nB; ++ui;
        if constexpr (ALIGN_EPI) { if (wr == 1) PG8_BAR; }
    }
    PG8_WAIT_V(0);
    if constexpr (!ALIGN_EPI) { if (wr == 0) PG8_BAR; }
    PG8_BAR;
    if constexpr (Epi::AFTER_DRAIN) { E.fused(acc, cur, wr, wc, fr, fq, lds, wid, lane); S.done(cur); }
#undef PG8_SA
#undef PG8_SB
#undef PG8_STAGE
#undef PG8_LDA
#undef PG8_LDB
#undef PG8_MMA
#undef PG8_WAIT_V
#undef PG8_WAIT_L
#undef PG8_BAR
#undef PG8_SCHED
}
}

#define LAS __attribute__((address_space(3)))
typedef unsigned short bf16_t;
typedef short bf16x8 __attribute__((ext_vector_type(8)));
typedef float f32x4 __attribute__((ext_vector_type(4)));
typedef unsigned u32x4 __attribute__((ext_vector_type(4)));
typedef unsigned u32x2 __attribute__((ext_vector_type(2)));
using pg8::cvt_pk_bf16; using pg8::bflo; using pg8::bfhi;

constexpr int M = 16384, DM = 1024, NIN = 7592, NPAD = 7680, FF = 4096, DEPTH = 4;
constexpr int C_GQ = 0, C_GK = 512, C_GV = 1024, C_GA = 1536, C_GR = 1552, C_SQ = 2064, C_SK = 2576, C_SV = 3088, C_NQ = 3600, C_NKC = 4112, C_NVC = 4176,
              C_NKS = 4240, C_NVS = 4304, C_NKW = 4368, C_NVW = 4432, C_NGATE = 4496, C_MGATE = 4520;
constexpr size_t MiB = 1u << 20;
constexpr size_t WS_PROJ = 0, WS_HID = 0, WS_HN = 240 * MiB, WS_OGLA = 272 * MiB, WS_OSB = 288 * MiB, WS_ONSA = 304 * MiB;
constexpr size_t WS_WIN = 320 * MiB, WS_WUP = 335 * MiB, WS_WDN = 343 * MiB, WS_WOUT = 351 * MiB, WS_WBR = 353 * MiB, WS_WK1 = 356 * MiB, WS_WV1 = 357 * MiB,
                 WS_WK2 = 358 * MiB, WS_WV2 = 358 * MiB + 65536, WS_CB = 358 * MiB + 131072, WS_LUT = 358 * MiB + 196608;
constexpr size_t WS_GST = 360 * MiB, WS_GDC = 424 * MiB, WS_SVT = 425 * MiB, WS_QN = 441 * MiB, WS_KSN = 457 * MiB, WS_KWN = 459 * MiB, WS_VST = 461 * MiB, WS_VWT = 463 * MiB,
                 WS_KCMP = 465 * MiB, WS_VCMPT = 465 * MiB + 131072, WS_END = 466 * MiB, WS_CTL = 466 * MiB;
constexpr int LDS_BYTES = 133120;
constexpr float LOG2E = 1.4426950408889634f;

struct KArgs { const float* in[22]; float* out; unsigned char* ws; };

__device__ __forceinline__ float bf2f(bf16_t v) { return __uint_as_float(((unsigned)v) << 16); }
__device__ __forceinline__ bf16_t f2bf(float f) { unsigned u = __float_as_uint(f); return (bf16_t)((u + 0x7fffu + ((u >> 16) & 1u)) >> 16); }
__device__ __forceinline__ f32x4 mfma16(bf16x8 a, bf16x8 b, f32x4 c) { return __builtin_amdgcn_mfma_f32_16x16x32_bf16(a, b, c, 0, 0, 0); }
__device__ __forceinline__ float wave_sum(float v) {
#pragma unroll
    for (int o = 1; o < 64; o <<= 1) v += __shfl_xor(v, o);
    return v;
}
#define LDS_FENCE() asm volatile("s_waitcnt lgkmcnt(0)" ::: "memory")
#define SCHED_FENCE_G() __builtin_amdgcn_sched_barrier(0)
__device__ __forceinline__ void unpack8(const u32x4 w, float (&f)[8]) { f[0] = bflo(w.x); f[1] = bfhi(w.x); f[2] = bflo(w.y); f[3] = bfhi(w.y); f[4] = bflo(w.z); f[5] = bfhi(w.z); f[6] = bflo(w.w); f[7] = bfhi(w.w); }
__device__ __forceinline__ u32x4 pack8(const float (&r)[8]) { u32x4 w; w.x = cvt_pk_bf16(r[0], r[1]); w.y = cvt_pk_bf16(r[2], r[3]); w.z = cvt_pk_bf16(r[4], r[5]); w.w = cvt_pk_bf16(r[6], r[7]); return w; }

__device__ __forceinline__ void transpose_item(const float* W, int K, int N, int Npad, bf16_t* WT, LAS float* scr, int item, int lane) {
    const int nblk = Npad / 32, kb = item / nblk, nb = item % nblk, k0 = 64 * kb, n0 = 32 * nb;
    const int c4 = lane & 7, kr = lane >> 3; const int nn = n0 + 4 * c4;
    f32x4 tv[8];
#pragma unroll
    for (int i = 0; i < 8; ++i) tv[i] = (nn < N) ? *(const f32x4*)(W + (size_t)(k0 + 8 * i + kr) * N + nn) : (f32x4){0.f, 0.f, 0.f, 0.f};
#pragma unroll
    for (int i = 0; i < 8; ++i) { LAS float* d = scr + (8 * i + kr) * 33 + 4 * c4; d[0] = tv[i][0]; d[1] = tv[i][1]; d[2] = tv[i][2]; d[3] = tv[i][3]; }
    LDS_FENCE();
    const int c = lane & 7;
#pragma unroll
    for (int j = 0; j < 4; ++j) { const int n = (lane >> 3) + 8 * j; const LAS float* s = scr + (8 * c) * 33 + n;
        u32x4 o; o.x = cvt_pk_bf16(s[0 * 33], s[1 * 33]); o.y = cvt_pk_bf16(s[2 * 33], s[3 * 33]); o.z = cvt_pk_bf16(s[4 * 33], s[5 * 33]); o.w = cvt_pk_bf16(s[6 * 33], s[7 * 33]);
        *(u32x4*)(WT + (size_t)(n0 + n) * K + k0 + 8 * c) = o; }
    LDS_FENCE();
}
__device__ __forceinline__ int rel_bucket(int n) {
    if (n < 16) return n;
    int large = 16 + (int)(logf((float)n / 16.f) / 4.1588830833596715f * 16.f);
    return large < 31 ? large : 31;
}
__device__ __forceinline__ void rms_row(const float* xrow, const float* g, bf16_t* orow, int lane) {
    const f32x4* xr = (const f32x4*)xrow + lane; f32x4 v[4]; float s = 0.f;
#pragma unroll
    for (int j = 0; j < 4; ++j) { v[j] = xr[64 * j]; s += (v[j].x * v[j].x + v[j].y * v[j].y) + (v[j].z * v[j].z + v[j].w * v[j].w); }
    const float rinv = rsqrtf(wave_sum(s) * (1.f / 1024.f) + 1e-6f);
    u32x2* o8 = (u32x2*)orow + lane;
#pragma unroll
    for (int j = 0; j < 4; ++j) { const f32x4 gg = ((const f32x4*)g)[lane + 64 * j]; u32x2 w; w.x = cvt_pk_bf16(v[j].x * rinv * gg.x, v[j].y * rinv * gg.y); w.y = cvt_pk_bf16(v[j].z * rinv * gg.z, v[j].w * rinv * gg.w); o8[64 * j] = w; }
}
__device__ __forceinline__ void phase_convert(const KArgs& a, int l, LAS unsigned char* lds, int gw, int NGW, int wave, int lane) {
    unsigned char* ws = a.ws;
    LAS float* scr = (LAS float*)(lds + wave * 8704);
    constexpr int I0 = 16 * 240, I1 = 16 * 128, I2 = 64 * 32, I3 = 16 * 32, I4 = 8 * 32, I7 = 32 * 8, I9 = 4 * 2, IB = 128, IL = 128;
    constexpr int NIT = I0 + I1 + I2 + I3 + 3 * I4 + 2 * I7 + 2 * I9 + IB + IL;
    for (int it = gw; it < NIT; it += NGW) {
        int r = it;
        if (r < I0) { transpose_item(a.in[3] + (size_t)l * DM * NIN, DM, NIN, NPAD, (bf16_t*)(ws + WS_WIN), scr, r, lane); continue; } r -= I0;
        if (r < I1) { transpose_item(a.in[20] + (size_t)l * DM * FF, DM, FF, FF, (bf16_t*)(ws + WS_WUP), scr, r, lane); continue; } r -= I1;
        if (r < I2) { transpose_item(a.in[21] + (size_t)l * FF * DM, FF, DM, DM, (bf16_t*)(ws + WS_WDN), scr, r, lane); continue; } r -= I2;
        if (r < I3) { transpose_item(a.in[19] + (size_t)l * DM * DM, DM, DM, DM, (bf16_t*)(ws + WS_WOUT), scr, r, lane); continue; } r -= I3;
        if (r < 3 * I4) { const int b = r / I4; transpose_item(a.in[16 + b] + (size_t)l * 512 * DM, 512, DM, DM, (bf16_t*)(ws + WS_WBR + b * MiB), scr, r % I4, lane); continue; } r -= 3 * I4;
        if (r < I7) { transpose_item(a.in[11] + (size_t)l * 2048 * 256, 2048, 256, 256, (bf16_t*)(ws + WS_WK1), scr, r, lane); continue; } r -= I7;
        if (r < I7) { transpose_item(a.in[13] + (size_t)l * 2048 * 256, 2048, 256, 256, (bf16_t*)(ws + WS_WV1), scr, r, lane); continue; } r -= I7;
        if (r < I9) { transpose_item(a.in[12] + (size_t)l * 256 * 64, 256, 64, 64, (bf16_t*)(ws + WS_WK2), scr, r, lane); continue; } r -= I9;
        if (r < I9) { transpose_item(a.in[14] + (size_t)l * 256 * 64, 256, 64, 64, (bf16_t*)(ws + WS_WV2), scr, r, lane); continue; } r -= I9;
        if (r < IB) {
            const int p = r >> 3, which = (r >> 2) & 1, col = (r & 3) * 64 + lane;
            const float* pe = a.in[which ? 10 : 9] + (size_t)l * 2048; const float* w1 = a.in[which ? 13 : 11] + (size_t)l * 2048 * 256;
            float s = 0.f;
#pragma unroll 1
            for (int k0 = 128 * p; k0 < 128 * p + 128; k0 += 16) { float wv[16];
#pragma unroll
                for (int i = 0; i < 16; ++i) wv[i] = w1[(size_t)(k0 + i) * 256 + col];
#pragma unroll
                for (int i = 0; i < 16; ++i) s += pe[k0 + i] * wv[i]; }
            ((float*)(ws + WS_CB))[p * 512 + which * 256 + col] = s; continue; } r -= IB;
        {
            const int idx = r * 64 + lane; const int d = idx >> 3, h = idx & 7;
            ((float*)(ws + WS_LUT))[idx] = a.in[15][rel_bucket(d) * 8 + h] * LOG2E; }
    }
}
__device__ __forceinline__ void phase_rms(const float* x, const float* g, bf16_t* hn, int gw, int NGW, int lane) {
    f32x4 gg[4];
#pragma unroll
    for (int j = 0; j < 4; ++j) gg[j] = ((const f32x4*)g)[lane + 64 * j];
    for (int m = gw; m < M; m += 2 * NGW) { const int m2 = (m + NGW < M) ? m + NGW : m;
        const f32x4* xa = (const f32x4*)(x + (size_t)m * DM) + lane; const f32x4* xb = (const f32x4*)(x + (size_t)m2 * DM) + lane;
        f32x4 va[4], vb[4]; float sa = 0.f, sb = 0.f;
#pragma unroll
        for (int j = 0; j < 4; ++j) { va[j] = xa[64 * j]; vb[j] = xb[64 * j]; }
#pragma unroll
        for (int j = 0; j < 4; ++j) { sa += (va[j].x * va[j].x + va[j].y * va[j].y) + (va[j].z * va[j].z + va[j].w * va[j].w); sb += (vb[j].x * vb[j].x + vb[j].y * vb[j].y) + (vb[j].z * vb[j].z + vb[j].w * vb[j].w); }
#pragma unroll
        for (int o = 1; o < 64; o <<= 1) { sa += __shfl_xor(sa, o); sb += __shfl_xor(sb, o); }
        const float ra = rsqrtf(sa * (1.f / 1024.f) + 1e-6f), rb = rsqrtf(sb * (1.f / 1024.f) + 1e-6f);
        u32x2* oa = (u32x2*)(hn + (size_t)m * DM) + lane; u32x2* ob = (u32x2*)(hn + (size_t)m2 * DM) + lane;
#pragma unroll
        for (int j = 0; j < 4; ++j) { u32x2 w; w.x = cvt_pk_bf16(va[j].x * ra * gg[j].x, va[j].y * ra * gg[j].y); w.y = cvt_pk_bf16(va[j].z * ra * gg[j].z, va[j].w * ra * gg[j].w); oa[64 * j] = w;
            u32x2 w2; w2.x = cvt_pk_bf16(vb[j].x * rb * gg[j].x, vb[j].y * rb * gg[j].y); w2.y = cvt_pk_bf16(vb[j].z * rb * gg[j].z, vb[j].w * rb * gg[j].w); ob[64 * j] = w2; } }
}

__device__ __forceinline__ void rms64_to(const bf16_t* src, const float* g, float scale, bf16_t* dst) {
    u32x4 w[8]; float ss = 0.f;
#pragma unroll
    for (int i = 0; i < 8; ++i) { w[i] = ((const u32x4*)src)[i]; float f[8]; unpack8(w[i], f);
#pragma unroll
        for (int e = 0; e < 8; ++e) ss += f[e] * f[e]; }
    const float rinv = rsqrtf(ss * (1.f / 64.f) + 1e-6f) * scale;
#pragma unroll
    for (int i = 0; i < 8; ++i) { float f[8]; unpack8(w[i], f); float r[8];
#pragma unroll
        for (int e = 0; e < 8; ++e) r[e] = f[e] * rinv * g[8 * i + e];
        ((u32x4*)dst)[i] = pack8(r); }
}
__device__ __forceinline__ void pre_item(const KArgs& a, int l, LAS unsigned char* lds, int item, int tid) {
    unsigned char* ws = a.ws; const bf16_t* proj = (const bf16_t*)(ws + WS_PROJ);
    const int t0 = item * 64;
    {
        const int tl = tid >> 3, h = tid & 7;
        rms64_to(proj + (size_t)(t0 + tl) * NPAD + C_NQ + h * 64, a.in[7] + l * 64, 0.125f * LOG2E, (bf16_t*)(ws + WS_QN) + (size_t)(t0 + tl) * 512 + h * 64);
    }
    if (tid < 128) {
        const int tl = tid >> 1, which = tid & 1;
        rms64_to(proj + (size_t)(t0 + tl) * NPAD + (which ? C_NKW : C_NKS), a.in[8] + l * 64, 1.f, (bf16_t*)(ws + (which ? WS_KWN : WS_KSN)) + (size_t)(t0 + tl) * 64);
    }
    LAS bf16_t* T = (LAS bf16_t*)lds;
    for (int idx = tid; idx < 64 * 80; idx += 512) { const int t = idx / 80, p = idx % 80; const int col = p < 64 ? C_SV + 8 * p : (p < 72 ? C_NVS + 8 * (p - 64) : C_NVW + 8 * (p - 72));
        const u32x4 w = *(const u32x4*)(proj + (size_t)(t0 + t) * NPAD + col);
        LAS unsigned* d = (LAS unsigned*)(T + t * 648 + 8 * p); d[0] = w.x; d[1] = w.y; d[2] = w.z; d[3] = w.w; }
    __syncthreads();
    for (int idx = tid; idx < 640 * 8; idx += 512) { const int c = idx >> 3, p = idx & 7;
        unsigned short e[8];
#pragma unroll
        for (int j = 0; j < 8; ++j) e[j] = T[(8 * p + j) * 648 + c];
        u32x4 w; w.x = e[0] | ((unsigned)e[1] << 16); w.y = e[2] | ((unsigned)e[3] << 16); w.z = e[4] | ((unsigned)e[5] << 16); w.w = e[6] | ((unsigned)e[7] << 16);
        const int tk = t0 + 8 * p;
        if (c < 512) *(u32x4*)((bf16_t*)(ws + WS_SVT) + ((size_t)(((c >> 7) * 256 + (tk >> 6)) * 128 + (c & 127))) * 64 + (tk & 63)) = w;
        else { const int d = (c - 512) & 63; bf16_t* vb = (bf16_t*)(ws + (c < 576 ? WS_VST : WS_VWT)); *(u32x4*)(vb + ((size_t)((tk >> 5) * 64 + d)) * 32 + (tk & 31)) = w; } }
    __syncthreads();
}
__device__ __forceinline__ void cmp_item(const KArgs& a, int l, LAS unsigned char* lds, int item, int tid, int wave, int lane) {
    unsigned char* ws = a.ws; const bf16_t* proj = (const bf16_t*)(ws + WS_PROJ);
    const int which = item & 1, grp = item >> 1, i0 = 16 * grp;
    const int srcoff = which ? C_NVC : C_NKC;
    const bf16_t* w1T = (const bf16_t*)(ws + (which ? WS_WV1 : WS_WK1)); const bf16_t* w2T = (const bf16_t*)(ws + (which ? WS_WV2 : WS_WK2));
    LAS bf16_t* hidL = (LAS bf16_t*)lds;
    LAS float* outL = (LAS float*)(lds + 16384);
    LAS float* rinvL = (LAS float*)(lds + 24576);
    const int r = lane & 15, g = lane >> 4;
    int irow = i0 + r; if (irow > 1022) irow = 1022;
    const bf16_t* arow = proj + (size_t)(16 * irow) * NPAD + srcoff;
    f32x4 acc[2] = {(f32x4){0.f, 0.f, 0.f, 0.f}, (f32x4){0.f, 0.f, 0.f, 0.f}};
    const bf16_t* b0 = w1T + (size_t)(32 * wave + r) * 2048 + 8 * g; const bf16_t* b1 = b0 + 16 * 2048;
#pragma unroll 8
    for (int ks = 0; ks < 64; ++ks) { const int k = 32 * ks + 8 * g;
        const bf16x8 af = *(const bf16x8*)(arow + (size_t)(k >> 6) * NPAD + (k & 63));
        const bf16x8 bf0 = *(const bf16x8*)(b0 + 32 * ks), bf1 = *(const bf16x8*)(b1 + 32 * ks);
        acc[0] = mfma16(af, bf0, acc[0]); acc[1] = mfma16(af, bf1, acc[1]); }
    const float* cb = (const float*)(ws + WS_CB);
#pragma unroll
    for (int nb = 0; nb < 2; ++nb) { const int col = 32 * wave + 16 * nb + r; float bs = 0.f;
#pragma unroll
        for (int p = 0; p < 16; ++p) bs += cb[p * 512 + which * 256 + col];
#pragma unroll
        for (int j = 0; j < 4; ++j) { const float x = acc[nb][j] + bs; const float u = 0.7978845608028654f * (x + 0.044715f * x * x * x);
            const float th = 1.f - 2.f / (__expf(2.f * u) + 1.f); hidL[(4 * g + j) * 264 + col] = f2bf(0.5f * x * (1.f + th)); } }
    __syncthreads();
    if (wave < 4) { f32x4 c2 = (f32x4){0.f, 0.f, 0.f, 0.f};
#pragma unroll
        for (int ks = 0; ks < 8; ++ks) { const bf16x8 af = *(const LAS bf16x8*)(hidL + r * 264 + 32 * ks + 8 * g); const bf16x8 bfr = *(const bf16x8*)(w2T + (size_t)(16 * wave + r) * 256 + 32 * ks + 8 * g); c2 = mfma16(af, bfr, c2); }
#pragma unroll
        for (int j = 0; j < 4; ++j) outL[(4 * g + j) * 65 + 16 * wave + r] = c2[j]; }
    __syncthreads();
    if (tid < 16) { float ss = 0.f; for (int d = 0; d < 64; ++d) { const float v = outL[tid * 65 + d]; ss += v * v; } rinvL[tid] = rsqrtf(ss * (1.f / 64.f) + 1e-6f); }
    __syncthreads();
    const float* kg = a.in[8] + l * 64;
    for (int idx = tid; idx < 1024; idx += 512) { const int row = idx >> 6, d = idx & 63, i = i0 + row; const float v = outL[row * 65 + d];
        if (which == 0) ((bf16_t*)(ws + WS_KCMP))[(size_t)i * 64 + d] = (i <= 1022) ? f2bf(v * rinvL[row] * kg[d]) : (bf16_t)0;
        else ((bf16_t*)(ws + WS_VCMPT))[((size_t)((i >> 5) * 64 + d)) * 32 + (i & 31)] = (i <= 1022) ? f2bf(v) : (bf16_t)0; }
    __syncthreads();
}
struct GlaPre { float asrc; float w[16]; float ba; };
__device__ __forceinline__ void gla_preload(GlaPre& p, const KArgs& a, int l, int c, int h, int tid) {
    const bf16_t* proj = (const bf16_t*)(a.ws + WS_PROJ);
    p.asrc = bf2f(proj[(size_t)(32 * c + (tid >> 4)) * NPAD + C_GA + (tid & 15)]);
    const int hk = h * 128 + (tid & 127);
#pragma unroll
    for (int r = 0; r < 16; ++r) p.w[r] = a.in[4][(size_t)l * 16 * 512 + r * 512 + hk];
    p.ba = a.in[5][l * 512 + hk];
}
__device__ __forceinline__ void gla_decay(const GlaPre& p, LAS float* bL, LAS float* aL, int tid) {
    LAS float* segL = aL + 512;
    aL[tid] = p.asrc;
    __syncthreads();
    const int kk = tid & 127, sg = tid >> 7;
    { float cum = 0.f;
#pragma unroll
        for (int tt = 0; tt < 8; ++tt) { const int t = 8 * sg + tt; float x = p.ba;
#pragma unroll
            for (int r = 0; r < 16; ++r) x += aL[t * 16 + r] * p.w[r];
            const float ls = fminf(x, 0.f) - __logf(1.f + __expf(-fabsf(x)));
            cum += ls * (1.f / 16.f); bL[t * 128 + kk] = cum; }
        segL[sg * 128 + kk] = cum; }
    __syncthreads();
    { float off = 0.f;
#pragma unroll
        for (int q = 0; q < 3; ++q) if (q < sg) off += segL[q * 128 + kk];
        if (sg > 0) {
#pragma unroll
            for (int tt = 0; tt < 8; ++tt) bL[(8 * sg + tt) * 128 + kk] += off; } }
    __syncthreads();
}
__device__ __forceinline__ void gla_g1_item(const KArgs& a, int l, LAS unsigned char* lds, int item, int tid, int wave, int lane) {
    unsigned char* ws = a.ws; const bf16_t* proj = (const bf16_t*)(ws + WS_PROJ);
    const int c = item >> 2, h = item & 3;
    LAS float* bL = (LAS float*)lds; LAS float* aL = (LAS float*)(lds + 16384);
    LAS bf16_t* kT = (LAS bf16_t*)(lds + 20480);
    LAS bf16_t* vT = (LAS bf16_t*)(lds + 20480 + 10240);
    GlaPre pre; gla_preload(pre, a, l, c, h, tid);
    const int s = tid >> 4, k0 = (tid & 15) * 8;
    const size_t ro = (size_t)(32 * c + s) * NPAD + h * 128 + k0;
    const u32x4 kraw = *(const u32x4*)(proj + ro + C_GK), vraw = *(const u32x4*)(proj + ro + C_GV);
    gla_decay(pre, bL, aL, tid);
    { float kf[8]; unpack8(kraw, kf);
      const unsigned vw[4] = {vraw.x, vraw.y, vraw.z, vraw.w};
#pragma unroll
      for (int e = 0; e < 8; ++e) { const int k = k0 + e; kT[k * 40 + s] = f2bf(kf[e] * __expf(bL[31 * 128 + k] - bL[s * 128 + k])); vT[k * 40 + s] = (bf16_t)((vw[e >> 1] >> (16 * (e & 1))) & 0xffffu); } }
    if (tid < 128) ((float*)(ws + WS_GDC))[(size_t)(c * 4 + h) * 128 + tid] = __expf(bL[31 * 128 + tid]);
    __syncthreads();
    const int r = lane & 15, g = lane >> 4;
    const bf16x8 af = *(const LAS bf16x8*)(vT + (16 * wave + r) * 40 + 8 * g);
    bf16_t* dst = (bf16_t*)(ws + WS_GST) + (size_t)(c * 4 + h) * 16384;
#pragma unroll
    for (int kb = 0; kb < 8; ++kb) { const bf16x8 bfr = *(const LAS bf16x8*)(kT + (16 * kb + r) * 40 + 8 * g);
        const f32x4 d = mfma16(af, bfr, (f32x4){0.f, 0.f, 0.f, 0.f});
#pragma unroll
        for (int j = 0; j < 4; ++j) dst[(size_t)(16 * wave + 4 * g + j) * 128 + 16 * kb + r] = f2bf(d[j]); }
    __syncthreads();
}
__device__ __forceinline__ void gla_scan(const KArgs& a, int cid) {
    bf16_t* st = (bf16_t*)(a.ws + WS_GST); const float* dc = (const float*)(a.ws + WS_GDC);
    const int h = cid >> 14, vk = cid & 16383, k = cid & 127;
    bf16_t* sp = st + (size_t)h * 16384 + vk; const float* dp = dc + (size_t)h * 128 + k;
    float state = 0.f;
    unsigned short kva[8], kvb[8]; float da[8], db[8];
#pragma unroll
    for (int i = 0; i < 8; ++i) { kva[i] = sp[(size_t)i * 65536]; da[i] = dp[(size_t)i * 512]; }
    for (int c0 = 0; c0 < 512; c0 += 16) {
#pragma unroll
        for (int i = 0; i < 8; ++i) { kvb[i] = sp[(size_t)(c0 + 8 + i) * 65536]; db[i] = dp[(size_t)(c0 + 8 + i) * 512]; }
        SCHED_FENCE_G();
#pragma unroll
        for (int i = 0; i < 8; ++i) { sp[(size_t)(c0 + i) * 65536] = f2bf(state); state = state * da[i] + bf2f(kva[i]); }
        SCHED_FENCE_G();
        if (c0 + 16 < 512) {
#pragma unroll
            for (int i = 0; i < 8; ++i) { kva[i] = sp[(size_t)(c0 + 16 + i) * 65536]; da[i] = dp[(size_t)(c0 + 16 + i) * 512]; } }
        SCHED_FENCE_G();
#pragma unroll
        for (int i = 0; i < 8; ++i) { sp[(size_t)(c0 + 8 + i) * 65536] = f2bf(state); state = state * db[i] + bf2f(kvb[i]); }
        SCHED_FENCE_G();
    }
}
__device__ __forceinline__ void gla_g3_item(const KArgs& a, int l, LAS unsigned char* lds, int item, int tid, int wave, int lane) {
    unsigned char* ws = a.ws; const bf16_t* proj = (const bf16_t*)(ws + WS_PROJ);
    const int c = item >> 2, h = item & 3;
    LAS float* bL = (LAS float*)lds; LAS float* aL = (LAS float*)(lds + 16384);
    LAS bf16_t* qL = (LAS bf16_t*)(lds + 20480);
    LAS bf16_t* kL = (LAS bf16_t*)(lds + 20480 + 8704);
    LAS bf16_t* vT = (LAS bf16_t*)(lds + 20480 + 17408);
    LAS bf16_t* scL = (LAS bf16_t*)(lds + 20480 + 27648);
    LAS float* oL = (LAS float*)(lds + 20480 + 30208);
    const int r = lane & 15, g = lane >> 4;
    GlaPre pre; gla_preload(pre, a, l, c, h, tid);
    const int s = tid >> 4, k0 = (tid & 15) * 8;
    const size_t ro = (size_t)(32 * c + s) * NPAD + h * 128 + k0;
    const u32x4 qraw = *(const u32x4*)(proj + ro + C_GQ), kraw = *(const u32x4*)(proj + ro + C_GK), vraw = *(const u32x4*)(proj + ro + C_GV), rraw = *(const u32x4*)(proj + ro + C_GR);
    const bf16_t* stT = (const bf16_t*)(ws + WS_GST) + (size_t)(c * 4 + h) * 16384;
    bf16x8 stf[4];
#pragma unroll
    for (int ks = 0; ks < 4; ++ks) stf[ks] = *(const bf16x8*)(stT + (size_t)(16 * wave + r) * 128 + 32 * ks + 8 * g);
    float ng[8];
#pragma unroll
    for (int e = 0; e < 8; ++e) ng[e] = a.in[6][l * 128 + k0 + e];
    gla_decay(pre, bL, aL, tid);
    { float qf[8], kf[8]; unpack8(qraw, qf); unpack8(kraw, kf); float qo[8], ko[8];
      const unsigned vw[4] = {vraw.x, vraw.y, vraw.z, vraw.w};
#pragma unroll
      for (int e = 0; e < 8; ++e) { const float b = bL[s * 128 + k0 + e]; qo[e] = qf[e] * __expf(b) * 0.08838834764831845f; ko[e] = kf[e] * __expf(-b); vT[(k0 + e) * 40 + s] = (bf16_t)((vw[e >> 1] >> (16 * (e & 1))) & 0xffffu); }
      *(LAS u32x4*)(qL + s * 136 + k0) = pack8(qo); *(LAS u32x4*)(kL + s * 136 + k0) = pack8(ko); }
    __syncthreads();
    if (wave < 4) { const int mb = wave >> 1, nb = wave & 1; f32x4 d = (f32x4){0.f, 0.f, 0.f, 0.f};
#pragma unroll
        for (int ks = 0; ks < 4; ++ks) d = mfma16(*(const LAS bf16x8*)(qL + (16 * mb + r) * 136 + 32 * ks + 8 * g), *(const LAS bf16x8*)(kL + (16 * nb + r) * 136 + 32 * ks + 8 * g), d);
#pragma unroll
        for (int j = 0; j < 4; ++j) { const int t = 16 * mb + 4 * g + j, sq = 16 * nb + r; scL[t * 40 + sq] = (sq <= t) ? f2bf(d[j]) : (bf16_t)0; } }
    __syncthreads();
#pragma unroll
    for (int mb = 0; mb < 2; ++mb) { f32x4 d = (f32x4){0.f, 0.f, 0.f, 0.f};
#pragma unroll
        for (int ks = 0; ks < 4; ++ks) d = mfma16(*(const LAS bf16x8*)(qL + (16 * mb + r) * 136 + 32 * ks + 8 * g), stf[ks], d);
        d = mfma16(*(const LAS bf16x8*)(scL + (16 * mb + r) * 40 + 8 * g), *(const LAS bf16x8*)(vT + (16 * wave + r) * 40 + 8 * g), d);
#pragma unroll
        for (int j = 0; j < 4; ++j) oL[(16 * mb + 4 * g + j) * 132 + 16 * wave + r] = d[j]; }
    __syncthreads();
    { float o[8]; float ss = 0.f;
#pragma unroll
        for (int e = 0; e < 8; ++e) { o[e] = oL[s * 132 + k0 + e]; ss += o[e] * o[e]; }
        ss += __shfl_xor(ss, 1); ss += __shfl_xor(ss, 2); ss += __shfl_xor(ss, 4); ss += __shfl_xor(ss, 8);
        const float rinv = rsqrtf(ss * (1.f / 128.f) + 1e-6f);
        float rr[8]; unpack8(rraw, rr); float res[8];
#pragma unroll
        for (int e = 0; e < 8; ++e) { const float on = o[e] * rinv * ng[e]; const float si = rr[e] / (1.f + __expf(-rr[e])); res[e] = on * si; }
        *(u32x4*)((bf16_t*)(ws + WS_OGLA) + (size_t)(32 * c + s) * 512 + h * 128 + k0) = pack8(res); }
    __syncthreads();
}

__device__ __forceinline__ float xor16f(float t, int g) { const auto r = __builtin_amdgcn_permlane16_swap(__float_as_uint(t), __float_as_uint(t), false, false); return __uint_as_float(r[0] == __float_as_uint(t) ? r[1] : r[0]); }
__device__ __forceinline__ float xor32f(float t, int g) { const auto r = __builtin_amdgcn_permlane32_swap(__float_as_uint(t), __float_as_uint(t), false, false); return __uint_as_float(r[0] == __float_as_uint(t) ? r[1] : r[0]); }
#define SCHED_FENCE() __builtin_amdgcn_sched_barrier(0)
template <bool DIAG>
__device__ __forceinline__ void sb_weights(const f32x4 (&S)[2], bf16x8& pf, float& carry, int g, int cc, int krel) {
    float e[8], P[8];
#pragma unroll
    for (int j = 0; j < 8; ++j) { int zi = __float_as_int(S[j >> 2][j & 3]); zi = zi < 0x41700000 ? zi : 0x41700000;
        float z = __int_as_float(zi);
        if (DIAG) { if (32 * cc + 8 * g + j >= krel) z = -1e30f; }
        e[j] = __builtin_amdgcn_exp2f(z); }
    P[0] = 1.f;
#pragma unroll
    for (int j = 1; j < 8; ++j) P[j] = P[j - 1] * (1.f + e[j - 1]);
    const float Tg = __builtin_amdgcn_rcpf(P[7] * (1.f + e[7]));
    const float t1 = __shfl_xor(Tg, 16);
    const float pp = Tg * t1;
    const float t23 = __shfl_xor(pp, 32);
    const float gex = ((g & 1) ? 1.f : t1) * ((g & 2) ? 1.f : t23);
    const float cf = Tg * gex * carry;
    carry = carry * (pp * t23);
    float w[8];
#pragma unroll
    for (int j = 0; j < 8; ++j) w[j] = (e[j] * P[j]) * cf;
    const u32x4 pw = pack8(w); __builtin_memcpy(&pf, &pw, 16);
}
template <bool DIAG>
__device__ __forceinline__ void sb_tile(const LAS bf16_t* Kt, const LAS bf16_t* Vt, const bf16x8 (&qf)[4], f32x4 (&O)[8], float& carry, int n, int g, int krel  ) {
    f32x4 S[2][2];
#pragma unroll
    for (int cc = 1; cc >= 0; --cc) {
        bf16x8 kf[2][4];
#pragma unroll
        for (int pb = 0; pb < 2; ++pb)
#pragma unroll
            for (int ks = 0; ks < 4; ++ks) kf[pb][ks] = *(const LAS bf16x8*)(Kt + (32 * cc + 16 * pb + n) * 128 + (((4 * ks + g) ^ n) << 3));
        SCHED_FENCE();
#pragma unroll
        for (int pb = 0; pb < 2; ++pb) { f32x4 sv = (f32x4){0.f, 0.f, 0.f, 0.f};
#pragma unroll
            for (int ks = 0; ks < 4; ++ks) sv = mfma16(kf[pb][ks], qf[ks], sv);
            S[cc][pb] = sv; }
        SCHED_FENCE();
    }
    bf16x8 vf[8], pf1, pf0;
#pragma unroll
    for (int db = 0; db < 8; ++db) vf[db] = *(const LAS bf16x8*)(Vt + (16 * db + n) * 64 + (((4 + g) ^ (n >> 1)) << 3));
    SCHED_FENCE();
    sb_weights<DIAG>(S[1], pf1, carry, g, 1, krel);
    SCHED_FENCE();
#pragma unroll
    for (int db = 0; db < 8; ++db) O[db] = mfma16(vf[db], pf1, O[db]);
    SCHED_FENCE();
#pragma unroll
    for (int db = 0; db < 8; ++db) vf[db] = *(const LAS bf16x8*)(Vt + (16 * db + n) * 64 + ((g ^ (n >> 1)) << 3));
    SCHED_FENCE();
    sb_weights<DIAG>(S[0], pf0, carry, g, 0, krel);
    SCHED_FENCE();
#pragma unroll
    for (int db = 0; db < 8; ++db) O[db] = mfma16(vf[db], pf0, O[db]);
    SCHED_FENCE();
}
__device__ __forceinline__ void sb_swbar(LAS unsigned* ctr, unsigned& gen, int lane) {
    asm volatile("s_waitcnt vmcnt(0) lgkmcnt(0)" ::: "memory");
    gen += 4u;
    if (lane == 0) { __hip_atomic_fetch_add(ctr, 1u, __ATOMIC_RELAXED, __HIP_MEMORY_SCOPE_WORKGROUP);
        while (__hip_atomic_load(ctr, __ATOMIC_RELAXED, __HIP_MEMORY_SCOPE_WORKGROUP) < gen) __builtin_amdgcn_s_sleep(1); }
    asm volatile("s_waitcnt lgkmcnt(0)" ::: "memory");
}
__device__ __forceinline__ void sb_unit4(const KArgs& a, LAS unsigned char* sbl, LAS unsigned* ctr, unsigned& gen, int h, int qb, int wave, int lane) {
    unsigned char* ws = a.ws; const bf16_t* proj = (const bf16_t*)(ws + WS_PROJ);
    constexpr int KT_B = 64 * 256, BUF_B = 32768;
    const int n = lane & 15, g = lane >> 4;
    const int tq = 64 * qb + 16 * wave + n;
    const float SC = 0.08838834764831845f * LOG2E;
    bf16x8 qf[4];
#pragma unroll
    for (int ks = 0; ks < 4; ++ks) { const u32x4 w = *(const u32x4*)(proj + (size_t)tq * NPAD + C_SQ + h * 128 + 32 * ks + 8 * g); float f[8]; unpack8(w, f);
#pragma unroll
        for (int e = 0; e < 8; ++e) f[e] *= SC;
        const u32x4 pw = pack8(f); __builtin_memcpy(&qf[ks], &pw, 16); }
    f32x4 O[8];
#pragma unroll
    for (int i = 0; i < 8; ++i) O[i] = (f32x4){0.f, 0.f, 0.f, 0.f};
    float carry = 1.f;
    volatile LAS unsigned* alive = (volatile LAS unsigned*)(ctr + 8);
    const int ntiles = qb + 1;
    const char* kbase = (const char*)(proj + C_SK + h * 128); const char* vbase = (const char*)((const bf16_t*)(ws + WS_SVT) + (size_t)h * 256 * 8192);
    auto issue = [&](int T, int buf) {
        const char* kt = kbase + (size_t)(64 * T) * NPAD * 2; const char* vt = vbase + (size_t)T * 16384;
#pragma unroll
        for (int i = 0; i < 4; ++i) { const int p = i * 256 + wave * 64 + lane;
            const int rho = p >> 4, c = (p & 15) ^ (rho & 15), k = (rho & 32) | ((rho & 16) >> 2) | ((rho & 12) << 1) | (rho & 3);
            const unsigned koff = (unsigned)(k * NPAD + 8 * c) * 2u;
            const int d = p >> 3, cv = (p & 7) ^ ((d >> 1) & 7);
            const unsigned voff = (unsigned)(d * 64 + 8 * cv) * 2u;
            __builtin_amdgcn_global_load_lds((const unsigned*)(kt + koff), (LAS unsigned*)(sbl + buf * BUF_B + (i * 256 + wave * 64) * 16), 16, 0, 0);
            __builtin_amdgcn_global_load_lds((const unsigned*)(vt + voff), (LAS unsigned*)(sbl + buf * BUF_B + KT_B + (i * 256 + wave * 64) * 16), 16, 0, 0); } };
    issue(ntiles - 1, 0);
    sb_swbar(ctr, gen, lane);
    for (int it = 0; it < ntiles; ++it) { const int T = ntiles - 1 - it, buf = it & 1;
        if (T > 0) issue(T - 1, buf ^ 1);
        const LAS bf16_t* Kt = (const LAS bf16_t*)(sbl + buf * BUF_B); const LAS bf16_t* Vt = (const LAS bf16_t*)(sbl + buf * BUF_B + KT_B);
        if (it == 0) sb_tile<true>(Kt, Vt, qf, O, carry, n, g, tq - 64 * T);
        else sb_tile<false>(Kt, Vt, qf, O, carry, n, g, 0);
        const bool dead = (__ballot(carry != 0.f) == 0ull);
        if (lane == 0) alive[(it & 1) * 4 + wave] = dead ? 0u : 1u;
        sb_swbar(ctr, gen, lane);
        const unsigned any = alive[(it & 1) * 4 + 0] | alive[(it & 1) * 4 + 1] | alive[(it & 1) * 4 + 2] | alive[(it & 1) * 4 + 3];
        if (__builtin_amdgcn_readfirstlane(any) == 0u) break;
    }
    bf16_t* orow = (bf16_t*)(ws + WS_OSB) + (size_t)tq * 512 + h * 128;
#pragma unroll
    for (int db = 0; db < 8; ++db) { u32x2 w; w.x = cvt_pk_bf16(O[db][0], O[db][1]); w.y = cvt_pk_bf16(O[db][2], O[db][3]); *(u32x2*)(orow + 16 * db + 4 * g) = w; }
}

struct NFrag { bf16x8 k[4]; bf16x8 v[4]; };
template <bool LV> __device__ __forceinline__ void nsa_load(NFrag& f, const bf16_t* Kb, const bf16_t* VB, int kb, int n, int g) {
    const bf16_t* kp = Kb + (size_t)(kb + 8 * (n >> 2) + (n & 3)) * 64 + 8 * g;
    f.k[0] = *(const bf16x8*)kp; f.k[1] = *(const bf16x8*)(kp + 32); f.k[2] = *(const bf16x8*)(kp + 256); f.k[3] = *(const bf16x8*)(kp + 288);
    if (LV) { const bf16_t* vp = VB + ((size_t)(kb >> 5) * 64 + n) * 32 + 8 * g;
#pragma unroll
        for (int db = 0; db < 4; ++db) f.v[db] = *(const bf16x8*)(vp + db * 512); }
}
template <int CTRL> __device__ __forceinline__ float dppf_(float v) { return __int_as_float(__builtin_amdgcn_update_dpp(0, __float_as_int(v), CTRL, 0xf, 0xf, true)); }
template <int MODE, bool FAST>
__device__ __forceinline__ void nsa_compute(const NFrag& f, int kb, const bf16x8 (&qf)[2], const LAS float* LUTh, LAS float* impq,
                                            int tq, int h, int g, int qs, int qsel, float inv, float& lsum, f32x4 (&O)[4], float bfar) {
    f32x4 S[2];
#pragma unroll
    for (int pb = 0; pb < 2; ++pb) { f32x4 sv = mfma16(f.k[2 * pb], qf[0], (f32x4){0.f, 0.f, 0.f, 0.f}); S[pb] = mfma16(f.k[2 * pb + 1], qf[1], sv); }
    float p[8];
    const int dbase = (MODE <= 1) ? (tq - 31 - 16 * (kb + 8 * g)) : (tq - kb - 8 * g);
    const bool colok = (MODE == 2) ? (((qsel >> qs) & 1) != 0) : true;
    if (FAST) {
#pragma unroll
        for (int j = 0; j < 8; ++j) { const float ex = __builtin_amdgcn_exp2f(S[j >> 2][j & 3] + bfar);
            float pv = (MODE == 2) ? (colok ? ex : 0.f) : ex;
            if (MODE == 1) pv *= inv;
            p[j] = pv; if (MODE != 1) lsum += pv; }
    } else {
    float bias[8];
#pragma unroll
    for (int j = 0; j < 8; ++j) { const int dist = (MODE <= 1) ? dbase - 16 * j : dbase - j; const unsigned di = min((unsigned)dist, 1023u); bias[j] = LUTh[di * 8]; }
#pragma unroll
    for (int j = 0; j < 8; ++j) asm volatile("" : "+v"(bias[j]));
#pragma unroll
    for (int j = 0; j < 8; ++j) { const int dist = (MODE <= 1) ? dbase - 16 * j : dbase - j;
        const bool valid = (MODE == 3) ? ((unsigned)dist < 512u) : (dist >= 0 && colok);
        const float ex = __builtin_amdgcn_exp2f(S[j >> 2][j & 3] + bias[j]);
        float pv = valid ? ex : 0.f;
        if (MODE == 1) pv *= inv;
        p[j] = pv; if (MODE != 1) lsum += pv; }
    }
    if (MODE == 0) return;
    if (MODE == 1) {
#pragma unroll
        for (int j = 0; j < 8; ++j) { float v = p[j]; v += dppf_<0xB1>(v); v += dppf_<0x4E>(v); v += dppf_<0x141>(v); if (h == 0) impq[kb + 8 * g + j] = v; } }
    const u32x4 pw = pack8(p); bf16x8 pf; __builtin_memcpy(&pf, &pw, 16);
#pragma unroll
    for (int db = 0; db < 4; ++db) O[db] = mfma16(f.v[db], pf, O[db]);
}
template <int MODE, class KBF, class QSF>
__device__ __forceinline__ void nsa_run(int niter, const bf16_t* Kb, const bf16_t* VB, KBF kbf, QSF qsf, const bf16x8 (&qf)[2], const LAS float* LUTh, LAS float* impq,
                                        int tq, int h, int n, int g, int qs, float inv, float& lsum, f32x4 (&O)[4], int t0, float bfar) {
    if (niter <= 0) return;
    NFrag A, C; const int last = niter - 1;
    nsa_load<MODE != 0>(A, Kb, VB, kbf(0), n, g);
    for (int i = 0; i < niter; i += 2) {
        nsa_load<MODE != 0>(C, Kb, VB, kbf(i + 1 < last ? i + 1 : last), n, g);
        SCHED_FENCE();
        { const int kb_ = kbf(i); const bool far_ = (MODE <= 1) ? (t0 - 31 - 16 * (kb_ + 31) >= 1023) : ((MODE == 2) ? (t0 - (kb_ + 31) >= 1023) : false);
          if (MODE != 3 && far_) nsa_compute<MODE, true>(A, kb_, qf, LUTh, impq, tq, h, g, qs, qsf(i), inv, lsum, O, bfar); else nsa_compute<MODE, false>(A, kb_, qf, LUTh, impq, tq, h, g, qs, qsf(i), inv, lsum, O, bfar); }
        SCHED_FENCE();
        if (i + 1 >= niter) break;
        nsa_load<MODE != 0>(A, Kb, VB, kbf(i + 2 < last ? i + 2 : last), n, g);
        SCHED_FENCE();
        { const int kb_ = kbf(i + 1); const bool far_ = (MODE <= 1) ? (t0 - 31 - 16 * (kb_ + 31) >= 1023) : ((MODE == 2) ? (t0 - (kb_ + 31) >= 1023) : false);
          if (MODE != 3 && far_) nsa_compute<MODE, true>(C, kb_, qf, LUTh, impq, tq, h, g, qs, qsf(i + 1), inv, lsum, O, bfar); else nsa_compute<MODE, false>(C, kb_, qf, LUTh, impq, tq, h, g, qs, qsf(i + 1), inv, lsum, O, bfar); }
        SCHED_FENCE();
    }
}
template <int CTRL> __device__ __forceinline__ float dppf(float v) { return __int_as_float(__builtin_amdgcn_update_dpp(0, __float_as_int(v), CTRL, 0xf, 0xf, true)); }
template <int CTRL> __device__ __forceinline__ int dppi(int v) { return __builtin_amdgcn_update_dpp(0, v, CTRL, 0xf, 0xf, true); }
__device__ __forceinline__ float lred(float l) { l += __shfl_xor(l, 16); l += __shfl_xor(l, 32); return l; }
__device__ __forceinline__ void nsa_unit(const KArgs& a, LAS unsigned char* lds, int unit, LAS float* imp, LAS int* selL, int lane) {
    unsigned char* ws = a.ws; const bf16_t* proj = (const bf16_t*)(ws + WS_PROJ);
    const int t0 = 2 * unit, n = lane & 15, g = lane >> 4, qs = n >> 3, h = n & 7, tq = t0 + qs;
    const LAS float* LUT = (const LAS float*)lds + h;
    const float bfar = LUT[1023 * 8];
    bf16x8 qf[2];
    qf[0] = *(const bf16x8*)((const bf16_t*)(ws + WS_QN) + (size_t)tq * 512 + h * 64 + 8 * g); qf[1] = *(const bf16x8*)((const bf16_t*)(ws + WS_QN) + (size_t)tq * 512 + h * 64 + 32 + 8 * g);
    const bf16_t* gp = proj + (size_t)tq * NPAD + C_NGATE + h * 3;
    const float g0 = 1.f / (1.f + __expf(-bf2f(gp[0]))), g1 = 1.f / (1.f + __expf(-bf2f(gp[1]))), g2 = 1.f / (1.f + __expf(-bf2f(gp[2])));
    f32x4 Ot[4], Ob[4];
#pragma unroll
    for (int i = 0; i < 4; ++i) { Ot[i] = (f32x4){0.f, 0.f, 0.f, 0.f}; Ob[i] = (f32x4){0.f, 0.f, 0.f, 0.f}; }
    const int nvmax = (t0 + 1 >= 31) ? (((t0 + 1 - 31) >> 4) + 1) : 0; const int nch = (nvmax + 31) >> 5;
    const bf16_t* KC = (const bf16_t*)(ws + WS_KCMP); const bf16_t* VCT = (const bf16_t*)(ws + WS_VCMPT);
    auto kb_lin = [](int i) { return 32 * i; }; auto qs_zero = [](int) { return 0; };
    float lsum = 0.f;
    nsa_run<0>(nch, KC, VCT, kb_lin, qs_zero, qf, LUT, imp + qs * 1024, tq, h, n, g, qs, 0.f, lsum, Ob, t0, bfar);
    { const float l = lred(lsum); const float inv = l > 0.f ? 1.f / l : 0.f; float dummy = 0.f;
      nsa_run<1>(nch, KC, VCT, kb_lin, qs_zero, qf, LUT, imp + qs * 1024, tq, h, n, g, qs, inv, dummy, Ob, t0, bfar); }
#pragma unroll
    for (int i = 0; i < 4; ++i) { Ot[i] += Ob[i] * g0; Ob[i] = (f32x4){0.f, 0.f, 0.f, 0.f}; }
    LDS_FENCE();
    int cnts[2];
#pragma unroll
    for (int q2 = 0; q2 < 2; ++q2) { const int tqq = t0 + q2, cur = tqq >> 6; const LAS float* iq = imp + q2 * 1024;
        float val[4];
#pragma unroll
        for (int r = 0; r < 4; ++r) { const int b = lane + 64 * r; float v = -1.f;
            if (b >= 1 && b <= cur - 2) { v = 0.f;
#pragma unroll
                for (int i = 0; i < 5; ++i) v += iq[4 * b - 1 + i]; }
            val[r] = v; }
        int cnt = 0;
        if (lane == 0) { selL[q2 * 8 + 0] = 0; if (cur >= 1) selL[q2 * 8 + 1] = cur; if (cur >= 2) selL[q2 * 8 + 2] = cur - 1; }
        cnt = 1 + (cur >= 1) + (cur >= 2);
        int ncand = cur - 2; if (ncand < 0) ncand = 0; const int npick = ncand < 5 ? ncand : 5;
        for (int rd = 0; rd < npick; ++rd) { float bv = val[0]; int bi = lane;
#pragma unroll
            for (int r = 1; r < 4; ++r) if (val[r] > bv) { bv = val[r]; bi = lane + 64 * r; }
#define TOPK_DPP(C) { const float ov = dppf<C>(bv); const int oi = dppi<C>(bi); if (ov > bv || (ov == bv && oi < bi)) { bv = ov; bi = oi; } }
            TOPK_DPP(0xB1) TOPK_DPP(0x4E) TOPK_DPP(0x141) TOPK_DPP(0x140)
#undef TOPK_DPP
#pragma unroll
            for (int o = 16; o < 64; o <<= 1) { const float ov = __shfl_xor(bv, o); const int oi = __shfl_xor(bi, o); if (ov > bv || (ov == bv && oi < bi)) { bv = ov; bi = oi; } }
            if (lane == 0) selL[q2 * 8 + cnt] = bi; ++cnt;
#pragma unroll
            for (int r = 0; r < 4; ++r) if (bi == lane + 64 * r) val[r] = -2.f; }
        cnts[q2] = cnt; }
    LDS_FENCE();
#pragma unroll
    for (int i = 0; i < 4; ++i)
#pragma unroll
        for (int j = 0; j < 4; ++j) imp[(4 * i + j) * 64 + lane] = Ot[i][j];
    lsum = 0.f;
    { const int c0 = cnts[0], c1 = cnts[1];
      const int b1 = (lane < c1) ? selL[8 + lane] : -1;
      int pos = -1;
      for (int k = 0; k < c0; ++k) if (selL[k] == b1) pos = k;
      LDS_FENCE();
      if (lane < c0) selL[16 + lane] = 1;
      LDS_FENCE();
      const bool fresh = (lane < c1) && (pos < 0);
      if (lane < c1 && pos >= 0) selL[16 + pos] = 3;
      const unsigned long long nb = __ballot(fresh);
      if (fresh) { const int idx = c0 + __popcll(nb & ((1ull << lane) - 1ull)); selL[idx] = b1; selL[16 + idx] = 2; }
      const int tot = c0 + __popcll(nb);
      LDS_FENCE();
      auto kbf = [&](int i) { return 64 * __builtin_amdgcn_readfirstlane(selL[i >> 1]) + 32 * (i & 1); };
      auto qsf = [&](int i) { return __builtin_amdgcn_readfirstlane(selL[16 + (i >> 1)]); };
      nsa_run<2>(2 * tot, (const bf16_t*)(ws + WS_KSN), (const bf16_t*)(ws + WS_VST), kbf, qsf, qf, LUT, imp, tq, h, n, g, qs, 0.f, lsum, Ob, t0, bfar); }
    { const float l = lred(lsum); const float sc = l > 0.f ? g1 / l : 0.f;
#pragma unroll
      for (int i = 0; i < 4; ++i) {
#pragma unroll
          for (int j = 0; j < 4; ++j) imp[(4 * i + j) * 64 + lane] += Ob[i][j] * sc;
          Ob[i] = (f32x4){0.f, 0.f, 0.f, 0.f}; } }
    lsum = 0.f;
    { int lo = t0 - 511; if (lo < 0) lo = 0; lo &= ~31; const int nw = ((t0 + 1 - lo) >> 5) + 1;
      auto kbf = [&](int i) { return lo + 32 * i; };
      nsa_run<3>(nw, (const bf16_t*)(ws + WS_KWN), (const bf16_t*)(ws + WS_VWT), kbf, qs_zero, qf, LUT, imp, tq, h, n, g, qs, 0.f, lsum, Ob, t0, bfar);
      const float l = lred(lsum); const float sc = l > 0.f ? g2 / l : 0.f;
#pragma unroll
      for (int i = 0; i < 4; ++i)
#pragma unroll
          for (int j = 0; j < 4; ++j) Ot[i][j] = imp[(4 * i + j) * 64 + lane] + Ob[i][j] * sc; }
    bf16_t* orow = (bf16_t*)(ws + WS_ONSA) + (size_t)tq * 512 + h * 64;
#pragma unroll
    for (int db = 0; db < 4; ++db) { u32x2 w; w.x = cvt_pk_bf16(Ot[db][0], Ot[db][1]); w.y = cvt_pk_bf16(Ot[db][2], Ot[db][3]); *(u32x2*)(orow + 16 * db + 4 * g) = w; }
}


#define RLX_AGENT __ATOMIC_RELAXED, __HIP_MEMORY_SCOPE_AGENT
#define XB_TMO      128
#define XB_XCNT(j)  (256  + 64 * (j))
#define XB_XSUB(j)  (1280 + 64 * (j))
#define XB_XGEN(j)  (2304 + 64 * (j))
#define XB_TOP      3328
#define XB_TOPGEN   3392
#define XCD_BAR_WORDS 3456
#define XB_SPIN_CAP (1u << 18)

__device__ __forceinline__ unsigned xb_ld(unsigned* p)              { return __hip_atomic_load(p, __ATOMIC_RELAXED, __HIP_MEMORY_SCOPE_AGENT); }
__device__ __forceinline__ unsigned xb_add(unsigned* p, unsigned v) { return __hip_atomic_fetch_add(p, v, __ATOMIC_RELAXED, __HIP_MEMORY_SCOPE_AGENT); }
__device__ __forceinline__ unsigned xb_xcc_id() { return (unsigned)__builtin_amdgcn_s_getreg((3 << 11) | 20) & 0xFu; }
#define XB_SPIN(cond, bar) do { unsigned _sp = 0; while (cond) { __builtin_amdgcn_s_sleep(1); \
    if ((++_sp & 255u) == 0u) { if (xb_ld(&(bar)[XB_TMO])) break; if (_sp > XB_SPIN_CAP) { atomicAdd(&(bar)[XB_TMO], 1u); break; } } } } while (0)

struct XcdBarrier {
    unsigned* bar; unsigned x;
    volatile LAS unsigned* st;
};

__device__ __forceinline__ XcdBarrier xcd_barrier_post(unsigned* bar, volatile LAS unsigned* st) {
    XcdBarrier b; b.bar = bar; b.x = xb_xcc_id(); b.st = st;
    if (threadIdx.x == 0) (void)xb_add(&bar[XB_XCNT(b.x)], 1u);
    return b;
}
__device__ __forceinline__ void xcd_barrier_complete(unsigned* bar, unsigned x, unsigned& nloc, unsigned& nx) {
    const unsigned G = gridDim.x * gridDim.y * gridDim.z;
    unsigned sum, cnt, mine, sp = 0u;
    for (;;) {
        sum = 0u; cnt = 0u; mine = 0u;
#pragma unroll
        for (unsigned j = 0; j < 16; ++j) { const unsigned c = xb_ld(&bar[XB_XCNT(j)]); sum += c; cnt += (c > 0u) ? 1u : 0u; mine = (j == x) ? c : mine; }
        if (sum == G) break;
        __builtin_amdgcn_s_sleep(1);
        if ((++sp & 255u) == 0u) { if (xb_ld(&bar[XB_TMO])) break; if (sp > XB_SPIN_CAP) { atomicAdd(&bar[XB_TMO], 1u); break; } }
    }
    nloc = mine > 0u ? mine : 1u; nx = cnt > 0u ? cnt : 1u;
}

__device__ __forceinline__ void xcd_barrier(const XcdBarrier& b) {
    asm volatile("s_waitcnt vmcnt(0)" ::: "memory");
    __syncthreads();
    if (threadIdx.x == 0) {
        unsigned* bar = b.bar;
        __builtin_amdgcn_s_waitcnt(0);
        unsigned nloc = b.st[0], nx = b.st[1];
        if (nloc == 0u) { xcd_barrier_complete(bar, b.x, nloc, nx); b.st[0] = nloc; b.st[1] = nx; }
        const unsigned old = xb_add(&bar[XB_XSUB(b.x)], 1u);
        const unsigned gen = old / nloc;
        if (old + 1u == (gen + 1u) * nloc) {
            __builtin_amdgcn_fence(__ATOMIC_RELEASE, "agent");
            asm volatile("s_waitcnt vmcnt(0)" ::: "memory");
            const unsigned og = xb_add(&bar[XB_TOP], 1u);
            const unsigned tg = og / nx;
            if (og + 1u == (tg + 1u) * nx) xb_add(&bar[XB_TOPGEN], 1u);
            else XB_SPIN(xb_ld(&bar[XB_TOPGEN]) == tg, bar);
            __builtin_amdgcn_fence(__ATOMIC_ACQUIRE, "agent");
            xb_add(&bar[XB_XGEN(b.x)], 1u);
            asm volatile("s_waitcnt vmcnt(0)" ::: "memory");
        } else {
            XB_SPIN(xb_ld(&bar[XB_XGEN(b.x)]) == gen, bar);
            __builtin_amdgcn_fence(__ATOMIC_ACQUIRE, "agent");
            asm volatile("s_waitcnt vmcnt(0)" ::: "memory");
        }
    }
    __syncthreads();
}

#define GSYNC() xcd_barrier(xbar)
__global__ void __launch_bounds__(512) __attribute__((amdgpu_waves_per_eu(2, 2))) fwd_mega(KArgs a) {
    extern __shared__ __attribute__((aligned(16))) unsigned char lds_raw[];
    LAS unsigned char* lds = (LAS unsigned char*)lds_raw;
    const int G = gridDim.x, bid = blockIdx.x, NGW = G * 8;
    const int vb = (G % 8 == 0) ? (bid % 8) * (G / 8) + bid / 8 : bid;
    { volatile LAS unsigned* stw = (volatile LAS unsigned*)(lds + 132608); if (threadIdx.x < 2) stw[threadIdx.x] = 0u; }
    __syncthreads();
    XcdBarrier xbar = xcd_barrier_post((unsigned*)(a.ws + WS_CTL), (volatile LAS unsigned*)(lds + 132608));
    cg::this_grid().sync();
#define IDS() int tid = threadIdx.x; asm volatile("" : "+v"(tid)); const int lane = tid & 63, wave = __builtin_amdgcn_readfirstlane(tid >> 6); const int gw = bid * 8 + wave; (void)lane; (void)gw;
    unsigned char* ws = a.ws;
    bf16_t* PROJ = (bf16_t*)(ws + WS_PROJ); bf16_t* HN = (bf16_t*)(ws + WS_HN); bf16_t* HID = (bf16_t*)(ws + WS_HID);
#pragma unroll 1
    for (int l = 0; l < DEPTH; ++l) {
        const float* xsrc = (l == 0) ? a.in[0] : a.out;
        { IDS(); phase_convert(a, l, lds, gw, NGW, wave, lane);
          phase_rms(xsrc, a.in[1] + l * DM, HN, gw, NGW, lane); }
        GSYNC();
        { pg8::Gemm g{HN, (const bf16_t*)(ws + WS_WIN), M, NPAD, DM}; pg8::StaticOrder S; S.init(M, NPAD, G, bid);
          pg8::EpiBf16<0> E{PROJ, NPAD};
          pg8::gemm_phase<pg8::EpiBf16<0>, pg8::StaticOrder, true, true>(lds, g, S, E); }
        GSYNC();
        { IDS(); for (int it = bid; it < 256; it += G) pre_item(a, l, lds, it, tid); }
        { IDS(); for (int it = bid; it < 128; it += G) cmp_item(a, l, lds, it, tid, wave, lane); }
        { IDS();
          if (G == 256) {
              const int nk = bid < 128 ? 5 : 8;
              for (int k = 0; k < nk; ++k) gla_g1_item(a, l, lds, bid + 256 * k, tid, wave, lane);
              if (bid >= 128) for (int k = 5; k < 8; ++k) gla_g1_item(a, l, lds, (bid - 128) + 256 * k, tid, wave, lane);
          } else for (int it = bid; it < 2048; it += G) gla_g1_item(a, l, lds, it, tid, wave, lane); }
        GSYNC();
        {   IDS();
            { const float* lg = (const float*)(ws + WS_LUT); LAS float* LUT = (LAS float*)lds; for (int i = tid; i < 8192; i += 512) LUT[i] = lg[i]; }
            LAS int* ctr = (LAS int*)(lds + 132096);
            LAS unsigned* sbc = (LAS unsigned*)(lds + 132112);
            if (tid == 0) { *ctr = 0; *sbc = 0u; }
            __syncthreads();
            if (wave < 4) {
                unsigned gen = 0u;
                for (int pp = vb; pp < 512; pp += G) {
                    const int hh = pp & 3, q = pp >> 2;
                    sb_unit4(a, lds + 65536, sbc, gen, hh, 255 - q, wave, lane);
                    sb_unit4(a, lds + 65536, sbc, gen, hh, q, wave, lane); }
            } else {
                for (int c0 = (bid * 4 + (wave - 4)) * 64; c0 < 65536; c0 += G * 256) gla_scan(a, c0 + lane);
            }
            LAS float* imp = (LAS float*)(lds + (wave < 4 ? 65536 + wave * 8192 : 32768 + (wave - 4) * 8192));
            LAS int* selL = (LAS int*)(lds + 131072 + wave * 128);
            const int nper = (8192 + G - 1) / G;
            for (;;) { int idx = 0; if (lane == 0) idx = atomicAdd((int*)ctr, 1); idx = __builtin_amdgcn_readfirstlane(idx);
                if (idx >= nper) break; const int hn = nper >> 1; const int unit = (idx < hn) ? (8192 - hn * (vb + 1) + idx) : (hn * vb + (idx - hn)); if (unit >= 0 && unit < 8192) nsa_unit(a, lds, unit, imp, selL, lane); }
            __syncthreads();
        }
        GSYNC();
        { IDS(); for (int it = bid; it < 2048; it += G) gla_g3_item(a, l, lds, it, tid, wave, lane); }
        GSYNC();
        for (int b = 0; b < 3; ++b) {
            pg8::Gemm g{(const bf16_t*)(ws + WS_OGLA + b * 16 * MiB), (const bf16_t*)(ws + WS_WBR + b * MiB), M, DM, 512}; pg8::StaticOrder S; S.init(M, DM, G, bid);
            pg8::EpiGate E{HN, PROJ + C_MGATE + b * DM, NPAD, b == 0 ? 1 : 0};
            pg8::gemm_phase<pg8::EpiGate, pg8::StaticOrder, true, true>(lds, g, S, E); }
        GSYNC();
        { pg8::Gemm g{HN, (const bf16_t*)(ws + WS_WOUT), M, DM, DM}; pg8::StaticOrder S; S.init(M, DM, G, bid);
          pg8::EpiRes E{xsrc, a.out};
          pg8::gemm_phase<pg8::EpiRes, pg8::StaticOrder, true, true>(lds, g, S, E); }
        GSYNC();
        { IDS(); phase_rms(a.out, a.in[2] + l * DM, HN, gw, NGW, lane); }
        GSYNC();
        { pg8::Gemm g{HN, (const bf16_t*)(ws + WS_WUP), M, FF, DM}; pg8::StaticOrder S; S.init(M, FF, G, bid);
          pg8::EpiBf16<2> E{HID, FF};
          pg8::gemm_phase<pg8::EpiBf16<2>, pg8::StaticOrder, true, true>(lds, g, S, E); }
        GSYNC();
        { pg8::Gemm g{HID, (const bf16_t*)(ws + WS_WDN), M, DM, FF}; pg8::StaticOrder S; S.init(M, DM, G, bid);
          pg8::EpiRes E{a.out, a.out};
          pg8::gemm_phase<pg8::EpiRes, pg8::StaticOrder, true, true>(lds, g, S, E); }
        GSYNC();
    }
}

extern "C" void kernel_launch(void* const* d_in, const int* in_sizes, int n_in, void* d_out, int out_size, void* d_ws, size_t ws_size, hipStream_t stream) {
    static int grid = 0;
    if (grid == 0) {
        if (n_in != 22 || ws_size < WS_END + 65536) { fprintf(stderr, "kernel_launch: unexpected n_in %d or ws_size %zu (< %zu)\n", n_in, ws_size, (size_t)WS_END); grid = -1; return; }
        int dev = 0, cus = 0, per_cu = 0;
        hipGetDevice(&dev); hipDeviceGetAttribute(&cus, hipDeviceAttributeMultiprocessorCount, dev);
        hipFuncSetAttribute((const void*)fwd_mega, hipFuncAttributeMaxDynamicSharedMemorySize, LDS_BYTES);
        hipOccupancyMaxActiveBlocksPerMultiprocessor(&per_cu, (const void*)fwd_mega, 512, LDS_BYTES);
        if (per_cu < 1) { fprintf(stderr, "kernel_launch: occupancy query says %d blocks/CU\n", per_cu); per_cu = 1; }
        (void)hipGetLastError();
        grid = cus * 1;
    }
    if (grid < 0) return;
    if (hipMemsetAsync((char*)d_ws + WS_CTL, 0, 65536, stream) != hipSuccess) { fprintf(stderr, "kernel_launch: memset of barrier words failed\n"); return; }
    KArgs a{};
    for (int i = 0; i < 22; ++i) a.in[i] = (const float*)d_in[i];
    a.out = (float*)d_out; a.ws = (unsigned char*)d_ws;
    void* args[] = {&a};
    hipError_t e = hipLaunchCooperativeKernel((const void*)fwd_mega, dim3(grid), dim3(512), args, LDS_BYTES, stream);
    if (e != hipSuccess) fprintf(stderr, "cooperative launch failed: %s (grid %d)\n", hipGetErrorString(e), grid);
}
```
